# Optimizing an MI355X kernel written in HIP

```python
import math
import jax, jax.numpy as jnp
from jax import lax
import numpy as np

D_MODEL = 1024
BATCH = 8
SEQ = 4096
DEPTH = 2

N_MIXERS = 2
EPS = 1e-6

HYENA_ORDER = 2
HYENA_EMB_DIM = 33
HYENA_BANDS = (HYENA_EMB_DIM - 1) // 2
HYENA_FILTER_HIDDEN = 64
HYENA_SHORT_CONV = 3
HYENA_FAST_DECAY_PCT = 0.3
HYENA_SLOW_DECAY_PCT = 1.5
HYENA_DECAY_TARGET = 1e-2
HYENA_N_DIRS = 2

MLA_HEADS = 8
QK_NOPE = 128
QK_ROPE = 64
V_HEAD = 128
Q_LORA = 256
KV_LORA = 128
ROPE_THETA = 10000.0
Q_BLOCK = 128
SOFTMAX_SCALE = 1.0 / math.sqrt(QK_NOPE + QK_ROPE)

N_EXPERTS = 16
EXPERT_FF = 1024
EC_CAPACITY_FACTOR = 2

kernel_name = 'hybrid_hyena_mla_ecmoe_encoder'


def rmsnorm(x, g):
    xf = x.astype(jnp.float32)
    y = xf * lax.rsqrt(jnp.mean(xf * xf, axis=-1, keepdims=True) + EPS)
    return (y * g.astype(jnp.float32)).astype(x.dtype)


def modulate(h, shift, scale):
    return h * (1 + scale[:, None, :]) + shift[:, None, :]


def short_conv(u, w, b):
    up = jnp.pad(u, ((0, 0), (1, 1), (0, 0)))
    return w[0] * up[:, :-2] + w[1] * up[:, 1:-1] + w[2] * up[:, 2:] + b


def hyena_pos_features(L):
    t = jnp.linspace(0.0, 1.0, L, dtype=jnp.float32)[:, None]
    w = 2.0 * math.pi * jnp.arange(L, dtype=jnp.float32)[:, None] / L
    f = jnp.linspace(1e-4, HYENA_BANDS - 1, HYENA_BANDS, dtype=jnp.float32)[None, :]
    ang = f * w
    return jnp.concatenate([t, jnp.cos(ang), -jnp.sin(ang)], axis=-1)


def hyena_filters(L, w1, b1, w2, b2, w3, freq):
    z = hyena_pos_features(L)
    fr = freq.astype(jnp.float32)
    h = jnp.sin(fr * (z @ w1.astype(jnp.float32) + b1.astype(jnp.float32)))
    h = jnp.sin(fr * (h @ w2.astype(jnp.float32) + b2.astype(jnp.float32)))
    h = (h @ w3.astype(jnp.float32)).reshape(L, HYENA_ORDER - 1, HYENA_N_DIRS, D_MODEL)
    t = jnp.linspace(0.0, 1.0, L, dtype=jnp.float32)[:, None]
    min_decay = math.log(HYENA_DECAY_TARGET) / HYENA_FAST_DECAY_PCT
    max_decay = math.log(HYENA_DECAY_TARGET) / HYENA_SLOW_DECAY_PCT
    deltas = jnp.linspace(min_decay, max_decay, D_MODEL, dtype=jnp.float32)[None, :]
    decay = jnp.exp(-t * jnp.abs(deltas))
    return h * decay[:, None, None, :]


def bidir_long_conv(z, h_fwd, h_bwd, bias):
    L = z.shape[1]
    k = jnp.concatenate([h_fwd, jnp.zeros_like(h_fwd[:1]), h_bwd[:0:-1]], axis=0)
    kf = jnp.fft.rfft(k, n=2 * L, axis=0)
    zf = jnp.fft.rfft(z.astype(jnp.float32), n=2 * L, axis=1)
    y = jnp.fft.irfft(zf * kf[None], n=2 * L, axis=1)[:, :L]
    return (y + z.astype(jnp.float32) * bias.astype(jnp.float32)).astype(z.dtype)


def hyena_mixer(h, w_in, b_in, conv_w, conv_b, f_w1, f_b1, f_w2, f_b2, f_w3, f_freq, f_bias, w_out, b_out):
    L = h.shape[1]
    u = short_conv(h @ w_in + b_in, conv_w, conv_b)
    parts = jnp.split(u, HYENA_ORDER + 1, axis=-1)
    filt = hyena_filters(L, f_w1, f_b1, f_w2, f_b2, f_w3, f_freq)
    z = parts[-1]
    for o in range(HYENA_ORDER - 1):
        z = z * parts[HYENA_ORDER - 1 - o]
        z = bidir_long_conv(z, filt[:, o, 0], filt[:, o, 1], f_bias[o])
    y = z * parts[0]
    return y @ w_out + b_out


def apply_rope(x, cos, sin):
    half = x.shape[-1] // 2
    x1, x2 = x[..., :half], x[..., half:]
    return jnp.concatenate([x1 * cos - x2 * sin, x1 * sin + x2 * cos], axis=-1).astype(x.dtype)


def mla_mixer(h, positions, w_in, q_norm_g, w_qb, kv_norm_g, w_kvb, w_out):
    B, S, _ = h.shape
    a = h @ w_in
    cq, ckv, k_pe = jnp.split(a, [Q_LORA, Q_LORA + KV_LORA], axis=-1)
    q = (rmsnorm(cq, q_norm_g) @ w_qb).reshape(B, S, MLA_HEADS, QK_NOPE + QK_ROPE)
    q_nope, q_pe = q[..., :QK_NOPE], q[..., QK_NOPE:]
    kv = (rmsnorm(ckv, kv_norm_g) @ w_kvb).reshape(B, S, MLA_HEADS, QK_NOPE + V_HEAD)
    k_nope, v = kv[..., :QK_NOPE], kv[..., QK_NOPE:]
    inv_freq = ROPE_THETA ** (-jnp.arange(0, QK_ROPE, 2, dtype=jnp.float32) / QK_ROPE)
    ang = positions.astype(jnp.float32)[..., None] * inv_freq
    cos, sin = jnp.cos(ang), jnp.sin(ang)
    q_pe = apply_rope(q_pe, cos[:, :, None, :], sin[:, :, None, :])
    k_pe = apply_rope(k_pe, cos, sin)
    nb = S // Q_BLOCK
    qn_b = q_nope.reshape(B, nb, Q_BLOCK, MLA_HEADS, QK_NOPE).swapaxes(0, 1)
    qp_b = q_pe.reshape(B, nb, Q_BLOCK, MLA_HEADS, QK_ROPE).swapaxes(0, 1)

    def attend(blk):
        qn, qp = blk
        s = jnp.einsum('bqhd,bkhd->bhqk', qn, k_nope) + jnp.einsum('bqhr,bkr->bhqk', qp, k_pe)
        p = jax.nn.softmax(s.astype(jnp.float32) * SOFTMAX_SCALE, axis=-1).astype(v.dtype)
        return jnp.einsum('bhqk,bkhd->bqhd', p, v)

    o = lax.map(attend, (qn_b, qp_b))
    o = o.swapaxes(0, 1).reshape(B, S, MLA_HEADS * V_HEAD)
    return o @ w_out


def ec_moe(h, w_router, w_gate, w_up, w_down):
    B, T, D = h.shape
    C = EC_CAPACITY_FACTOR * T // N_EXPERTS
    aff = jax.nn.softmax(jnp.einsum('btd,de->bte', h, w_router).astype(jnp.float32), axis=-1)
    g, idx = lax.top_k(aff.swapaxes(1, 2), C)
    xs = jax.vmap(lambda hb, ib: hb[ib])(h, idx)
    hid = jax.nn.silu(jnp.einsum('becd,edf->becf', xs, w_gate)) * jnp.einsum('becd,edf->becf', xs, w_up)
    ye = jnp.einsum('becf,efd->becd', hid, w_down) * g[..., None].astype(h.dtype)
    return jax.vmap(lambda yb, ib: jnp.zeros((T, D), yb.dtype).at[ib.reshape(-1)].add(yb.reshape(-1, D)))(ye, idx)


def setup_inputs(seed: int = 0) -> dict:
    key = jax.random.key(seed)
    ks = jax.random.split(key, 40)
    D = D_MODEL
    nh = (DEPTH + 1) // 2
    nm = DEPTH // 2
    nrm = lambda k, shape, s: jax.random.normal(k, shape, jnp.float32) * s
    HID = HYENA_FILTER_HIDDEN
    return {
        'x': nrm(ks[0], (BATCH, SEQ, D), 1.0),
        'c': nrm(ks[1], (BATCH, D), 1.0),
        'positions': jnp.broadcast_to(jnp.arange(SEQ, dtype=jnp.int32), (BATCH, SEQ)),
        'ada_w': nrm(ks[2], (DEPTH, D, 6 * D), 0.5 * D ** -0.5),
        'ada_b': nrm(ks[3], (DEPTH, 6 * D), 0.02),
        'norm_mix_g': 1.0 + nrm(ks[4], (DEPTH, D), 0.02),
        'norm_ffn_g': 1.0 + nrm(ks[5], (DEPTH, D), 0.02),
        'hy_w_in': nrm(ks[6], (nh, D, (HYENA_ORDER + 1) * D), D ** -0.5),
        'hy_b_in': nrm(ks[7], (nh, (HYENA_ORDER + 1) * D), 0.02),
        'hy_conv_w': nrm(ks[8], (nh, HYENA_SHORT_CONV, (HYENA_ORDER + 1) * D), HYENA_SHORT_CONV ** -0.5),
        'hy_conv_b': nrm(ks[9], (nh, (HYENA_ORDER + 1) * D), 0.02),
        'hy_f_w1': nrm(ks[10], (nh, HYENA_EMB_DIM, HID), HYENA_EMB_DIM ** -0.5),
        'hy_f_b1': nrm(ks[11], (nh, HID), 0.1),
        'hy_f_w2': nrm(ks[12], (nh, HID, HID), HID ** -0.5),
        'hy_f_b2': nrm(ks[13], (nh, HID), 0.1),
        'hy_f_w3': nrm(ks[14], (nh, HID, (HYENA_ORDER - 1) * HYENA_N_DIRS * D), 0.02 * HID ** -0.5),
        'hy_f_freq': 1.0 + nrm(ks[15], (nh, HID), 0.02),
        'hy_f_bias': nrm(ks[16], (nh, HYENA_ORDER - 1, D), 0.1),
        'hy_w_out': nrm(ks[17], (nh, D, D), D ** -0.5),
        'hy_b_out': nrm(ks[18], (nh, D), 0.02),
        'mla_w_in': nrm(ks[19], (nm, D, Q_LORA + KV_LORA + QK_ROPE), D ** -0.5),
        'mla_q_norm_g': 1.0 + nrm(ks[20], (nm, Q_LORA), 0.02),
        'mla_w_qb': nrm(ks[21], (nm, Q_LORA, MLA_HEADS * (QK_NOPE + QK_ROPE)), Q_LORA ** -0.5),
        'mla_kv_norm_g': 1.0 + nrm(ks[22], (nm, KV_LORA), 0.02),
        'mla_w_kvb': nrm(ks[23], (nm, KV_LORA, MLA_HEADS * (QK_NOPE + V_HEAD)), KV_LORA ** -0.5),
        'mla_w_out': nrm(ks[24], (nm, MLA_HEADS * V_HEAD, D), (MLA_HEADS * V_HEAD) ** -0.5),
        'moe_w_router': nrm(ks[25], (DEPTH, D, N_EXPERTS), D ** -0.5),
        'moe_w_gate': nrm(ks[26], (DEPTH, N_EXPERTS, D, EXPERT_FF), D ** -0.5),
        'moe_w_up': nrm(ks[27], (DEPTH, N_EXPERTS, D, EXPERT_FF), D ** -0.5),
        'moe_w_down': nrm(ks[28], (DEPTH, N_EXPERTS, EXPERT_FF, D), EXPERT_FF ** -0.5),
        'final_norm_g': 1.0 + nrm(ks[29], (D,), 0.02),
    }


def reference(x, c, positions, ada_w, ada_b, norm_mix_g, norm_ffn_g,
              hy_w_in, hy_b_in, hy_conv_w, hy_conv_b, hy_f_w1, hy_f_b1, hy_f_w2, hy_f_b2,
              hy_f_w3, hy_f_freq, hy_f_bias, hy_w_out, hy_b_out,
              mla_w_in, mla_q_norm_g, mla_w_qb, mla_kv_norm_g, mla_w_kvb, mla_w_out,
              moe_w_router, moe_w_gate, moe_w_up, moe_w_down, final_norm_g):
    cs = jax.nn.silu(c)
    for i in range(DEPTH):
        mod = cs @ ada_w[i] + ada_b[i]
        sh1, sc1, g1, sh2, sc2, g2 = jnp.split(mod, 6, axis=-1)
        hm = modulate(rmsnorm(x, norm_mix_g[i]), sh1, sc1)
        j = i // N_MIXERS
        if i % N_MIXERS == 0:
            y = hyena_mixer(hm, hy_w_in[j], hy_b_in[j], hy_conv_w[j], hy_conv_b[j],
                            hy_f_w1[j], hy_f_b1[j], hy_f_w2[j], hy_f_b2[j], hy_f_w3[j],
                            hy_f_freq[j], hy_f_bias[j], hy_w_out[j], hy_b_out[j])
        else:
            y = mla_mixer(hm, positions, mla_w_in[j], mla_q_norm_g[j], mla_w_qb[j],
                          mla_kv_norm_g[j], mla_w_kvb[j], mla_w_out[j])
        x = x + g1[:, None, :] * y
        hf = modulate(rmsnorm(x, norm_ffn_g[i]), sh2, sc2)
        x = x + g2[:, None, :] * ec_moe(hf, moe_w_router[i], moe_w_gate[i], moe_w_up[i], moe_w_down[i])
    return rmsnorm(x, final_norm_g)
```

```cpp
#include <hip/hip_runtime.h>
#include <stdint.h>
#include <math.h>
#include <string.h>

#define DM 1024
#define NB 8
#define SEQ 4096
#define NTOK (NB * SEQ)
#define NE 16
#define CAP 512

__device__ __forceinline__ float wave_sum(float v) {
#pragma unroll
  for (int o = 32; o > 0; o >>= 1) v += __shfl_xor(v, o);
  return v;
}
__device__ __forceinline__ float block_sum256(float v, float* red) {
  v = wave_sum(v);
  __syncthreads();
  if ((threadIdx.x & 63) == 0) red[threadIdx.x >> 6] = v;
  __syncthreads();
  return red[0] + red[1] + red[2] + red[3];
}
__device__ __forceinline__ float block_max256(float v, float* red) {
#pragma unroll
  for (int o = 32; o > 0; o >>= 1) v = fmaxf(v, __shfl_xor(v, o));
  __syncthreads();
  if ((threadIdx.x & 63) == 0) red[threadIdx.x >> 6] = v;
  __syncthreads();
  return fmaxf(fmaxf(red[0], red[1]), fmaxf(red[2], red[3]));
}

__global__ __launch_bounds__(256) void k_mod(const float* __restrict__ c, const float* __restrict__ ada_w,
                                             const float* __restrict__ ada_b, float* __restrict__ mod) {
  __shared__ float cs[NB * DM];
  int i = blockIdx.y;
  for (int q = threadIdx.x; q < NB * DM; q += 256) {
    float v = c[q];
    cs[q] = v / (1.f + expf(-v));
  }
  __syncthreads();
  int j = blockIdx.x * 256 + threadIdx.x;
  float acc[NB];
#pragma unroll
  for (int b = 0; b < NB; ++b) acc[b] = 0.f;
  const float* w = ada_w + (size_t)i * DM * 6 * DM + j;
  for (int k = 0; k < DM; ++k) {
    float wv = w[(size_t)k * 6 * DM];
#pragma unroll
    for (int b = 0; b < NB; ++b) acc[b] += cs[b * DM + k] * wv;
  }
#pragma unroll
  for (int b = 0; b < NB; ++b) mod[(size_t)(i * NB + b) * 6 * DM + j] = acc[b] + ada_b[i * 6 * DM + j];
}

__global__ __launch_bounds__(256) void k_rmsmod(const float* __restrict__ x, const float* __restrict__ g,
                                                const float* __restrict__ sh, const float* __restrict__ sc,
                                                float* __restrict__ out) {
  __shared__ float red[4];
  int t = blockIdx.x;
  int b = t / SEQ;
  float4 v = ((const float4*)(x + (size_t)t * DM))[threadIdx.x];
  float ss = v.x * v.x + v.y * v.y + v.z * v.z + v.w * v.w;
  ss = block_sum256(ss, red);
  float r = rsqrtf(ss * (1.f / DM) + 1e-6f);
  float4 gg = ((const float4*)g)[threadIdx.x];
  float4 o;
  o.x = v.x * r * gg.x; o.y = v.y * r * gg.y; o.z = v.z * r * gg.z; o.w = v.w * r * gg.w;
  if (sh) {
    float4 s1 = ((const float4*)(sc + (size_t)b * 6 * DM))[threadIdx.x];
    float4 s0 = ((const float4*)(sh + (size_t)b * 6 * DM))[threadIdx.x];
    o.x = o.x * (1.f + s1.x) + s0.x; o.y = o.y * (1.f + s1.y) + s0.y;
    o.z = o.z * (1.f + s1.z) + s0.z; o.w = o.w * (1.f + s1.w) + s0.w;
  }
  ((float4*)(out + (size_t)t * DM))[threadIdx.x] = o;
}

struct GP {
  const float* A; const int* aidx; const float* B; float* C; const float* bias;
  int M, N, K, lda, ldb, ldc, btrans, pad0;
  long sA, sB, sC, sIdx;
};
__global__ __launch_bounds__(256) void k_gemm(GP p) {
  __shared__ float As[16][68];
  __shared__ float Bs[16][68];
  const int tid = threadIdx.x;
  const int z = blockIdx.z;
  const float* A = p.A + (size_t)z * p.sA;
  const float* B = p.B + (size_t)z * p.sB;
  float* C = p.C + (size_t)z * p.sC;
  const int* aidx = p.aidx ? p.aidx + (size_t)z * p.sIdx : nullptr;
  const int m0 = blockIdx.y * 64, n0 = blockIdx.x * 64;
  const int tx = tid & 15, ty = tid >> 4;
  float acc[4][4];
#pragma unroll
  for (int i = 0; i < 4; ++i)
#pragma unroll
    for (int j = 0; j < 4; ++j) acc[i][j] = 0.f;
  const int lr = tid >> 2, lk = (tid & 3) * 4;
  int arow = m0 + lr;
  if (aidx) arow = aidx[arow];
  const float* Ap = A + (size_t)arow * p.lda + lk;
  const float* Bp;
  if (p.btrans) Bp = B + (size_t)(n0 + lr) * p.ldb + lk;
  else Bp = B + (size_t)(tid >> 4) * p.ldb + n0 + (tid & 15) * 4;
  for (int k0 = 0; k0 < p.K; k0 += 16) {
    float4 av = *(const float4*)(Ap + k0);
    float4 bv;
    if (p.btrans) bv = *(const float4*)(Bp + k0);
    else bv = *(const float4*)(Bp + (size_t)k0 * p.ldb);
    __syncthreads();
    As[lk + 0][lr] = av.x; As[lk + 1][lr] = av.y; As[lk + 2][lr] = av.z; As[lk + 3][lr] = av.w;
    if (p.btrans) {
      Bs[lk + 0][lr] = bv.x; Bs[lk + 1][lr] = bv.y; Bs[lk + 2][lr] = bv.z; Bs[lk + 3][lr] = bv.w;
    } else {
      *(float4*)&Bs[tid >> 4][(tid & 15) * 4] = bv;
    }
    __syncthreads();
#pragma unroll
    for (int k = 0; k < 16; ++k) {
      float4 a4 = *(const float4*)&As[k][ty * 4];
      float4 b4 = *(const float4*)&Bs[k][tx * 4];
      float a[4] = {a4.x, a4.y, a4.z, a4.w};
      float bb[4] = {b4.x, b4.y, b4.z, b4.w};
#pragma unroll
      for (int i = 0; i < 4; ++i)
#pragma unroll
        for (int j = 0; j < 4; ++j) acc[i][j] += a[i] * bb[j];
    }
  }
#pragma unroll
  for (int i = 0; i < 4; ++i) {
    int row = m0 + ty * 4 + i;
    float4 o;
    int col = n0 + tx * 4;
    o.x = acc[i][0]; o.y = acc[i][1]; o.z = acc[i][2]; o.w = acc[i][3];
    if (p.bias) { o.x += p.bias[col]; o.y += p.bias[col + 1]; o.z += p.bias[col + 2]; o.w += p.bias[col + 3]; }
    *(float4*)(C + (size_t)row * p.ldc + col) = o;
  }
}

__global__ __launch_bounds__(256) void k_hyena_filter(const float* __restrict__ w1, const float* __restrict__ b1,
                                                      const float* __restrict__ w2, const float* __restrict__ b2,
                                                      const float* __restrict__ w3, const float* __restrict__ freq,
                                                      float* __restrict__ hf, float* __restrict__ hb) {
  __shared__ float zf[33];
  __shared__ float h1[64];
  __shared__ float h2[64];
  const int l = blockIdx.x;
  const int tid = threadIdx.x;
  const float tl = (float)l / (float)(SEQ - 1);
  if (tid == 0) zf[0] = tl;
  if (tid < 16) {
    float wv = 2.0f * 3.14159265358979323846f * (float)l / (float)SEQ;
    float f = 1e-4f + (float)tid * ((15.0f - 1e-4f) / 15.0f);
    float ang = f * wv;
    zf[1 + tid] = cosf(ang);
    zf[17 + tid] = -sinf(ang);
  }
  __syncthreads();
  if (tid < 64) {
    float a = b1[tid];
    for (int i = 0; i < 33; ++i) a += zf[i] * w1[i * 64 + tid];
    h1[tid] = sinf(freq[tid] * a);
  }
  __syncthreads();
  if (tid < 64) {
    float a = b2[tid];
    for (int i = 0; i < 64; ++i) a += h1[i] * w2[i * 64 + tid];
    h2[tid] = sinf(freq[tid] * a);
  }
  __syncthreads();
  const float min_decay = logf(1e-2f) / 0.3f, max_decay = logf(1e-2f) / 1.5f;
  for (int col = tid; col < 2048; col += 256) {
    float a = 0.f;
    for (int j = 0; j < 64; ++j) a += h2[j] * w3[j * 2048 + col];
    int d = col & 1023;
    float delta = min_decay + (float)d * ((max_decay - min_decay) / (float)(DM - 1));
    float dec = expf(-tl * fabsf(delta));
    float v = a * dec;
    if (col < 1024) hf[(size_t)l * DM + d] = v; else hb[(size_t)l * DM + d] = v;
  }
}

__global__ __launch_bounds__(256) void k_conv_gate(const float* __restrict__ upre, const float* __restrict__ cw,
                                                   const float* __restrict__ cb, float* __restrict__ z,
                                                   float* __restrict__ x0) {
  int t = blockIdx.x;
  for (int c = threadIdx.x; c < DM; c += 256) {
    float u[3];
#pragma unroll
    for (int part = 0; part < 3; ++part) {
      int ch = part * DM + c;
      float a = cb[ch];
      if (t > 0) a += cw[0 * 3072 + ch] * upre[(size_t)(t - 1) * 3072 + ch];
      a += cw[1 * 3072 + ch] * upre[(size_t)t * 3072 + ch];
      if (t < SEQ - 1) a += cw[2 * 3072 + ch] * upre[(size_t)(t + 1) * 3072 + ch];
      u[part] = a;
    }
    z[(size_t)t * DM + c] = u[2] * u[1];
    x0[(size_t)t * DM + c] = u[0];
  }
}

__global__ __launch_bounds__(256) void k_longconv(const float* __restrict__ hf, const float* __restrict__ hb,
                                                  const float* __restrict__ z, const float* __restrict__ x0,
                                                  const float* __restrict__ fbias, float* __restrict__ yg) {
  const int c = blockIdx.x * 256 + threadIdx.x;
  const int t0 = blockIdx.y * 4;
  float acc[4][NB];
#pragma unroll
  for (int i = 0; i < 4; ++i)
#pragma unroll
    for (int b = 0; b < NB; ++b) acc[i][b] = 0.f;
  for (int s = 0; s < SEQ; ++s) {
    float zv[NB];
#pragma unroll
    for (int b = 0; b < NB; ++b) zv[b] = z[((size_t)b * SEQ + s) * DM + c];
#pragma unroll
    for (int i = 0; i < 4; ++i) {
      int t = t0 + i;
      float hv = (s <= t) ? hf[(size_t)(t - s) * DM + c] : hb[(size_t)(s - t) * DM + c];
#pragma unroll
      for (int b = 0; b < NB; ++b) acc[i][b] += hv * zv[b];
    }
  }
  float fb = fbias[c];
#pragma unroll
  for (int i = 0; i < 4; ++i)
#pragma unroll
    for (int b = 0; b < NB; ++b) {
      size_t o = ((size_t)b * SEQ + t0 + i) * DM + c;
      yg[o] = (acc[i][b] + fb * z[o]) * x0[o];
    }
}

__global__ __launch_bounds__(256) void k_residual(float* __restrict__ x, const float* __restrict__ y,
                                                  const float* __restrict__ gate) {
  int t = blockIdx.x;
  int b = t / SEQ;
  float4 xv = ((float4*)(x + (size_t)t * DM))[threadIdx.x];
  float4 yv = ((const float4*)(y + (size_t)t * DM))[threadIdx.x];
  float4 gv = ((const float4*)(gate + (size_t)b * 6 * DM))[threadIdx.x];
  xv.x += gv.x * yv.x; xv.y += gv.y * yv.y; xv.z += gv.z * yv.z; xv.w += gv.w * yv.w;
  ((float4*)(x + (size_t)t * DM))[threadIdx.x] = xv;
}

__global__ __launch_bounds__(256) void k_router(const float* __restrict__ hfn, const float* __restrict__ wr,
                                                float* __restrict__ aff) {
  int wave = threadIdx.x >> 6, lane = threadIdx.x & 63;
  int t = blockIdx.x * 4 + wave;
  float acc[NE];
#pragma unroll
  for (int e = 0; e < NE; ++e) acc[e] = 0.f;
  for (int k = lane; k < DM; k += 64) {
    float hv = hfn[(size_t)t * DM + k];
    const float4* w4 = (const float4*)(wr + (size_t)k * NE);
#pragma unroll
    for (int q = 0; q < 4; ++q) {
      float4 w = w4[q];
      acc[q * 4 + 0] += hv * w.x; acc[q * 4 + 1] += hv * w.y; acc[q * 4 + 2] += hv * w.z; acc[q * 4 + 3] += hv * w.w;
    }
  }
#pragma unroll
  for (int e = 0; e < NE; ++e) acc[e] = wave_sum(acc[e]);
  if (lane == 0) {
    float m = acc[0];
#pragma unroll
    for (int e = 1; e < NE; ++e) m = fmaxf(m, acc[e]);
    float s = 0.f;
#pragma unroll
    for (int e = 0; e < NE; ++e) { acc[e] = expf(acc[e] - m); s += acc[e]; }
    float inv = 1.f / s;
    int b = t / SEQ, tt = t % SEQ;
#pragma unroll
    for (int e = 0; e < NE; ++e) aff[((size_t)b * NE + e) * SEQ + tt] = acc[e] * inv;
  }
}

__global__ __launch_bounds__(256) void k_topk(const float* __restrict__ aff, int* __restrict__ idx,
                                              float* __restrict__ gsel, int* __restrict__ slot_of) {
  __shared__ float a[SEQ];
  int be = blockIdx.y;
  const float* src = aff + (size_t)be * SEQ;
  for (int q = threadIdx.x; q < SEQ; q += 256) a[q] = src[q];
  __syncthreads();
  int t = blockIdx.x * 256 + threadIdx.x;
  float v = a[t];
  int rank = 0;
  for (int q = 0; q < SEQ; ++q) {
    float o = a[q];
    rank += (o > v || (o == v && q < t)) ? 1 : 0;
  }
  if (rank < CAP) {
    idx[(size_t)be * CAP + rank] = t;
    gsel[(size_t)be * CAP + rank] = v;
    slot_of[(size_t)be * SEQ + t] = rank;
  } else {
    slot_of[(size_t)be * SEQ + t] = -1;
  }
}

__global__ __launch_bounds__(256) void k_silu_mul(float* __restrict__ g, const float* __restrict__ u, size_t n4) {
  size_t i = (size_t)blockIdx.x * 256 + threadIdx.x;
  if (i >= n4) return;
  float4 a = ((float4*)g)[i];
  float4 b = ((const float4*)u)[i];
  a.x = a.x / (1.f + expf(-a.x)) * b.x; a.y = a.y / (1.f + expf(-a.y)) * b.y;
  a.z = a.z / (1.f + expf(-a.z)) * b.z; a.w = a.w / (1.f + expf(-a.w)) * b.w;
  ((float4*)g)[i] = a;
}

__global__ __launch_bounds__(256) void k_moe_combine(float* __restrict__ xb, const float* __restrict__ ye,
                                                     const float* __restrict__ gsel_b, const int* __restrict__ slot_b,
                                                     const float* __restrict__ g2b) {
  int t = blockIdx.x;
  float4 acc = make_float4(0.f, 0.f, 0.f, 0.f);
  for (int e = 0; e < NE; ++e) {
    int s = slot_b[(size_t)e * SEQ + t];
    if (s >= 0) {
      float g = gsel_b[e * CAP + s];
      float4 y = ((const float4*)(ye + ((size_t)e * CAP + s) * DM))[threadIdx.x];
      acc.x += g * y.x; acc.y += g * y.y; acc.z += g * y.z; acc.w += g * y.w;
    }
  }
  float4 gv = ((const float4*)g2b)[threadIdx.x];
  float4 xv = ((float4*)(xb + (size_t)t * DM))[threadIdx.x];
  xv.x += gv.x * acc.x; xv.y += gv.y * acc.y; xv.z += gv.z * acc.z; xv.w += gv.w * acc.w;
  ((float4*)(xb + (size_t)t * DM))[threadIdx.x] = xv;
}

__global__ __launch_bounds__(256) void k_mla_prep(const float* __restrict__ a, const int* __restrict__ pos,
                                                  const float* __restrict__ qg, const float* __restrict__ kvg,
                                                  float* __restrict__ cqn, float* __restrict__ ckvn,
                                                  float* __restrict__ kpe) {
  __shared__ float red[4];
  int s = blockIdx.x, tid = threadIdx.x;
  const float* ar = a + (size_t)s * 448;
  float cq = ar[tid];
  float ssq = block_sum256(cq * cq, red);
  float ckv = (tid < 128) ? ar[256 + tid] : 0.f;
  float sskv = block_sum256(ckv * ckv, red);
  cqn[(size_t)s * 256 + tid] = cq * rsqrtf(ssq * (1.f / 256.f) + 1e-6f) * qg[tid];
  if (tid < 128) ckvn[(size_t)s * 128 + tid] = ckv * rsqrtf(sskv * (1.f / 128.f) + 1e-6f) * kvg[tid];
  if (tid < 32) {
    float inv_freq = powf(10000.0f, -(float)(2 * tid) / 64.0f);
    float ang = (float)pos[s] * inv_freq;
    float cs = cosf(ang), sn = sinf(ang);
    float x1 = ar[384 + tid], x2 = ar[384 + 32 + tid];
    kpe[(size_t)s * 64 + tid] = x1 * cs - x2 * sn;
    kpe[(size_t)s * 64 + 32 + tid] = x1 * sn + x2 * cs;
  }
}

__global__ __launch_bounds__(256) void k_mla_rope(float* __restrict__ q, const float* __restrict__ kv,
                                                  const float* __restrict__ kpe, const int* __restrict__ pos,
                                                  float* __restrict__ kcat) {
  int s = blockIdx.x, tid = threadIdx.x;
  {
    int h = tid >> 5, i = tid & 31;
    float inv_freq = powf(10000.0f, -(float)(2 * i) / 64.0f);
    float ang = (float)pos[s] * inv_freq;
    float cs = cosf(ang), sn = sinf(ang);
    float* qp = q + (size_t)s * 1536 + h * 192 + 128;
    float x1 = qp[i], x2 = qp[32 + i];
    qp[i] = x1 * cs - x2 * sn;
    qp[32 + i] = x1 * sn + x2 * cs;
  }
  for (int e = tid; e < 8 * 192; e += 256) {
    int h = e / 192, d = e % 192;
    float v = (d < 128) ? kv[(size_t)s * 2048 + h * 256 + d] : kpe[(size_t)s * 64 + (d - 128)];
    kcat[((size_t)h * SEQ + s) * 192 + d] = v;
  }
}

__global__ __launch_bounds__(256) void k_softmax(float* __restrict__ S, float scale) {
  __shared__ float red[4];
  float* row = S + (size_t)blockIdx.x * SEQ;
  float v[16];
  float m = -3.0e38f;
#pragma unroll
  for (int i = 0; i < 16; ++i) { v[i] = row[i * 256 + threadIdx.x] * scale; m = fmaxf(m, v[i]); }
  m = block_max256(m, red);
  float s = 0.f;
#pragma unroll
  for (int i = 0; i < 16; ++i) { v[i] = expf(v[i] - m); s += v[i]; }
  s = block_sum256(s, red);
  float inv = 1.f / s;
#pragma unroll
  for (int i = 0; i < 16; ++i) row[i * 256 + threadIdx.x] = v[i] * inv;
}

static void gemm(hipStream_t st, const float* A, int lda, const int* aidx, const float* B, int ldb, int btrans,
                 float* C, int ldc, const float* bias, int M, int N, int K, int nz = 1, long sA = 0, long sB = 0,
                 long sC = 0, long sIdx = 0) {
  GP p;
  memset(&p, 0, sizeof(p));
  p.A = A; p.aidx = aidx; p.B = B; p.C = C; p.bias = bias;
  p.M = M; p.N = N; p.K = K; p.lda = lda; p.ldb = ldb; p.ldc = ldc; p.btrans = btrans;
  p.sA = sA; p.sB = sB; p.sC = sC; p.sIdx = sIdx;
  hipLaunchKernelGGL(k_gemm, dim3(N / 64, M / 64, nz), dim3(256), 0, st, p);
}

extern "C" void kernel_launch(void* const* d_in, const int* in_sizes, int n_in, void* d_out, int out_size,
                              void* d_ws, size_t ws_size, hipStream_t stream) {
  const float* x_in = (const float*)d_in[0];
  const float* c = (const float*)d_in[1];
  const int* positions = (const int*)d_in[2];
  const float* ada_w = (const float*)d_in[3];
  const float* ada_b = (const float*)d_in[4];
  const float* norm_mix_g = (const float*)d_in[5];
  const float* norm_ffn_g = (const float*)d_in[6];
  const float* hy_w_in = (const float*)d_in[7];
  const float* hy_b_in = (const float*)d_in[8];
  const float* hy_conv_w = (const float*)d_in[9];
  const float* hy_conv_b = (const float*)d_in[10];
  const float* hy_f_w1 = (const float*)d_in[11];
  const float* hy_f_b1 = (const float*)d_in[12];
  const float* hy_f_w2 = (const float*)d_in[13];
  const float* hy_f_b2 = (const float*)d_in[14];
  const float* hy_f_w3 = (const float*)d_in[15];
  const float* hy_f_freq = (const float*)d_in[16];
  const float* hy_f_bias = (const float*)d_in[17];
  const float* hy_w_out = (const float*)d_in[18];
  const float* hy_b_out = (const float*)d_in[19];
  const float* mla_w_in = (const float*)d_in[20];
  const float* mla_q_norm_g = (const float*)d_in[21];
  const float* mla_w_qb = (const float*)d_in[22];
  const float* mla_kv_norm_g = (const float*)d_in[23];
  const float* mla_w_kvb = (const float*)d_in[24];
  const float* mla_w_out = (const float*)d_in[25];
  const float* moe_w_router = (const float*)d_in[26];
  const float* moe_w_gate = (const float*)d_in[27];
  const float* moe_w_up = (const float*)d_in[28];
  const float* moe_w_down = (const float*)d_in[29];
  const float* final_norm_g = (const float*)d_in[30];

  float* x = (float*)d_out;
  float* ws = (float*)d_ws;
  const size_t ACT = (size_t)NTOK * DM;
  size_t off = 0;
  float* mod = ws + off; off += 2 * NB * 6 * DM;
  float* aff = ws + off; off += (size_t)NB * NE * SEQ;
  float* gsel = ws + off; off += (size_t)NB * NE * CAP;
  int* idx = (int*)(ws + off); off += (size_t)NB * NE * CAP;
  int* slot_of = (int*)(ws + off); off += (size_t)NB * NE * SEQ;
  float* RA = ws + off; off += ACT;
  float* RF = ws + off; off += 2 * (size_t)SEQ * DM;
  float* RU = ws + off; off += (size_t)SEQ * 3072;
  float* RC = ws + off; off += ACT;
  float* RD = ws + off; off += ACT;
  (void)ws_size; (void)in_sizes; (void)n_in; (void)out_size;

  (void)hipMemcpyAsync(x, x_in, ACT * sizeof(float), hipMemcpyDeviceToDevice, stream);
  hipLaunchKernelGGL(k_mod, dim3(6 * DM / 256, 2), dim3(256), 0, stream, c, ada_w, ada_b, mod);

  for (int layer = 0; layer < 2; ++layer) {
    const float* m = mod + (size_t)layer * NB * 6 * DM;
    const float *sh1 = m, *sc1 = m + DM, *g1 = m + 2 * DM, *sh2 = m + 3 * DM, *sc2 = m + 4 * DM, *g2 = m + 5 * DM;
    hipLaunchKernelGGL(k_rmsmod, dim3(NTOK), dim3(256), 0, stream, x, norm_mix_g + layer * DM, sh1, sc1, RA);
    if (layer == 0) {
      float* z = RC;
      float* x0 = RD;
      for (int b = 0; b < NB; ++b) {
        gemm(stream, RA + (size_t)b * SEQ * DM, DM, nullptr, hy_w_in, 3072, 0, RU, 3072, hy_b_in, SEQ, 3072, DM);
        hipLaunchKernelGGL(k_conv_gate, dim3(SEQ), dim3(256), 0, stream, RU, hy_conv_w, hy_conv_b,
                           z + (size_t)b * SEQ * DM, x0 + (size_t)b * SEQ * DM);
      }
      float* hf = RF;
      float* hb = RF + (size_t)SEQ * DM;
      hipLaunchKernelGGL(k_hyena_filter, dim3(SEQ), dim3(256), 0, stream, hy_f_w1, hy_f_b1, hy_f_w2, hy_f_b2,
                         hy_f_w3, hy_f_freq, hf, hb);
      hipLaunchKernelGGL(k_longconv, dim3(DM / 256, SEQ / 4), dim3(256), 0, stream, hf, hb, z, x0, hy_f_bias, RA);
      gemm(stream, RA, DM, nullptr, hy_w_out, DM, 0, RC, DM, hy_b_out, NTOK, DM, DM);
      hipLaunchKernelGGL(k_residual, dim3(NTOK), dim3(256), 0, stream, x, RC, g1);
    } else {
      float* a = RC;
      float* cqn = a + (size_t)SEQ * 448;
      float* ckvn = cqn + (size_t)SEQ * 256;
      float* kpe = ckvn + (size_t)SEQ * 128;
      float* q = kpe + (size_t)SEQ * 64;
      float* kv = q + (size_t)SEQ * 1536;
      float* kcat = kv + (size_t)SEQ * 2048;
      float* S = RF;
      float* o = RD;
      const float scale = 1.0f / sqrtf(192.0f);
      for (int b = 0; b < NB; ++b) {
        const int* pos = positions + (size_t)b * SEQ;
        gemm(stream, RA + (size_t)b * SEQ * DM, DM, nullptr, mla_w_in, 448, 0, a, 448, nullptr, SEQ, 448, DM);
        hipLaunchKernelGGL(k_mla_prep, dim3(SEQ), dim3(256), 0, stream, a, pos, mla_q_norm_g, mla_kv_norm_g, cqn,
                           ckvn, kpe);
        gemm(stream, cqn, 256, nullptr, mla_w_qb, 1536, 0, q, 1536, nullptr, SEQ, 1536, 256);
        gemm(stream, ckvn, 128, nullptr, mla_w_kvb, 2048, 0, kv, 2048, nullptr, SEQ, 2048, 128);
        hipLaunchKernelGGL(k_mla_rope, dim3(SEQ), dim3(256), 0, stream, q, kv, kpe, pos, kcat);
        for (int h = 0; h < 8; ++h) {
          gemm(stream, q + h * 192, 1536, nullptr, kcat + (size_t)h * SEQ * 192, 192, 1, S, SEQ, nullptr, SEQ, SEQ,
               192);
          hipLaunchKernelGGL(k_softmax, dim3(SEQ), dim3(256), 0, stream, S, scale);
          gemm(stream, S, SEQ, nullptr, kv + h * 256 + 128, 2048, 0, o + (size_t)b * SEQ * DM + h * 128, DM, nullptr,
               SEQ, 128, SEQ);
        }
      }
      gemm(stream, o, DM, nullptr, mla_w_out, DM, 0, RC, DM, nullptr, NTOK, DM, DM);
      hipLaunchKernelGGL(k_residual, dim3(NTOK), dim3(256), 0, stream, x, RC, g1);
    }
    hipLaunchKernelGGL(k_rmsmod, dim3(NTOK), dim3(256), 0, stream, x, norm_ffn_g + layer * DM, sh2, sc2, RA);
    hipLaunchKernelGGL(k_router, dim3(NTOK / 4), dim3(256), 0, stream, RA, moe_w_router + (size_t)layer * DM * NE,
                       aff);
    hipLaunchKernelGGL(k_topk, dim3(SEQ / 256, NB * NE), dim3(256), 0, stream, aff, idx, gsel, slot_of);
    const size_t WSZ = (size_t)DM * DM;
    const float* wg = moe_w_gate + (size_t)layer * NE * WSZ;
    const float* wu = moe_w_up + (size_t)layer * NE * WSZ;
    const float* wd = moe_w_down + (size_t)layer * NE * WSZ;
    float* gate = RC;
    float* up = RC + (size_t)NE * CAP * DM;
    for (int b = 0; b < NB; ++b) {
      const float* hfb = RA + (size_t)b * SEQ * DM;
      const int* idxb = idx + (size_t)b * NE * CAP;
      gemm(stream, hfb, DM, idxb, wg, DM, 0, gate, DM, nullptr, CAP, DM, DM, NE, 0, WSZ, (long)CAP * DM, CAP);
      gemm(stream, hfb, DM, idxb, wu, DM, 0, up, DM, nullptr, CAP, DM, DM, NE, 0, WSZ, (long)CAP * DM, CAP);
      size_t n4 = (size_t)NE * CAP * DM / 4;
      hipLaunchKernelGGL(k_silu_mul, dim3((unsigned)((n4 + 255) / 256)), dim3(256), 0, stream, gate, up, n4);
      gemm(stream, gate, DM, nullptr, wd, DM, 0, up, DM, nullptr, CAP, DM, DM, NE, (long)CAP * DM, WSZ,
           (long)CAP * DM, 0);
      hipLaunchKernelGGL(k_moe_combine, dim3(SEQ), dim3(256), 0, stream, x + (size_t)b * SEQ * DM, up,
                         gsel + (size_t)b * NE * CAP, slot_of + (size_t)b * NE * SEQ, g2 + (size_t)b * 6 * DM);
    }
  }
  hipLaunchKernelGGL(k_rmsmod, dim3(NTOK), dim3(256), 0, stream, x, final_norm_g, (const float*)nullptr,
                     (const float*)nullptr, x);
}
```

```cpp
#include <hip/hip_runtime.h>
#include <stdint.h>
#include <math.h>
#include <string.h>
#include <cstdio>

#define DM 1024
#define NB 8
#define SEQ 4096
#define NTOK (NB * SEQ)
#define NE 16
#define CAP 512
#define NTHR 512
#define GRID 256
#define LDS_BYTES 155648
#define HALF_LDS 40960

#define LAS __attribute__((address_space(3)))

#define XB_TMO      128
#define XB_XCNT(j)  (256  + 64 * (j))
#define XB_XSUB(j)  (1280 + 64 * (j))
#define XB_XGEN(j)  (2304 + 64 * (j))
#define XB_TOP      3328
#define XB_TOPGEN   3392
#define XCD_BAR_WORDS 3456
#define XB_SPIN_CAP (1u << 22)
__device__ __forceinline__ unsigned xb_ld(unsigned* p)              { return __hip_atomic_load(p, __ATOMIC_RELAXED, __HIP_MEMORY_SCOPE_AGENT); }
__device__ __forceinline__ unsigned xb_add(unsigned* p, unsigned v) { return __hip_atomic_fetch_add(p, v, __ATOMIC_RELAXED, __HIP_MEMORY_SCOPE_AGENT); }
__device__ __forceinline__ unsigned xb_xcc_id() { return (unsigned)__builtin_amdgcn_s_getreg((3 << 11) | 20) & 0xFu; }
#define XB_SPIN(cond, bar) do { unsigned _sp = 0; while (cond) { __builtin_amdgcn_s_sleep(1); \
    if ((++_sp & 255u) == 0u) { if (xb_ld(&(bar)[XB_TMO])) break; if (_sp > XB_SPIN_CAP) { atomicAdd(&(bar)[XB_TMO], 1u); break; } } } } while (0)
struct XcdBarrier { unsigned* bar; unsigned x; volatile LAS unsigned* st; };
__device__ __forceinline__ XcdBarrier xcd_barrier_post(unsigned* bar, volatile LAS unsigned* st) {
    XcdBarrier b; b.bar = bar; b.x = xb_xcc_id(); b.st = st;
    if (threadIdx.x == 0) (void)xb_add(&bar[XB_XCNT(b.x)], 1u);
    return b;
}
__device__ __forceinline__ void xcd_barrier_complete(unsigned* bar, unsigned x, unsigned& nloc, unsigned& nx) {
    const unsigned G = gridDim.x * gridDim.y * gridDim.z;
    unsigned sum, cnt, mine, sp = 0u;
    for (;;) {
        sum = 0u; cnt = 0u; mine = 0u;
#pragma unroll
        for (unsigned j = 0; j < 16; ++j) { const unsigned c = xb_ld(&bar[XB_XCNT(j)]); sum += c; cnt += (c > 0u) ? 1u : 0u; }
        if (sum == G) { mine = xb_ld(&bar[XB_XCNT(x)]); break; }
        __builtin_amdgcn_s_sleep(1);
        if ((++sp & 255u) == 0u) { if (xb_ld(&bar[XB_TMO])) break; if (sp > XB_SPIN_CAP) { atomicAdd(&bar[XB_TMO], 1u); break; } }
    }
    nloc = mine > 0u ? mine : 1u; nx = cnt > 0u ? cnt : 1u;
}
__device__ __forceinline__ void xcd_barrier(const XcdBarrier& b_in) {
    XcdBarrier b; { unsigned long long p = (unsigned long long)b_in.bar; asm volatile("" : "+s"(p)); b.bar = (unsigned*)p; unsigned xx = xb_xcc_id(); asm volatile("" : "+s"(xx)); b.x = xx; b.st = b_in.st; }
    asm volatile("s_waitcnt vmcnt(0)" ::: "memory");
    __syncthreads();
    if (threadIdx.x == 0) {
        unsigned* bar = b.bar;
        __builtin_amdgcn_s_waitcnt(0);
        unsigned nloc = b.st[0], nx = b.st[1];
        if (nloc == 0u) { xcd_barrier_complete(bar, b.x, nloc, nx); b.st[0] = nloc; b.st[1] = nx; }
        const unsigned old = xb_add(&bar[XB_XSUB(b.x)], 1u);
        const unsigned gen = old / nloc;
        if (old + 1u == (gen + 1u) * nloc) {
            __builtin_amdgcn_fence(__ATOMIC_RELEASE, "agent");
            asm volatile("s_waitcnt vmcnt(0)" ::: "memory");
            const unsigned og = xb_add(&bar[XB_TOP], 1u);
            const unsigned tg = og / nx;
            if (og + 1u == (tg + 1u) * nx) xb_add(&bar[XB_TOPGEN], 1u);
            else XB_SPIN(xb_ld(&bar[XB_TOPGEN]) == tg, bar);
            __builtin_amdgcn_fence(__ATOMIC_ACQUIRE, "agent");
            xb_add(&bar[XB_XGEN(b.x)], 1u);
            asm volatile("s_waitcnt vmcnt(0)" ::: "memory");
        } else {
            XB_SPIN(xb_ld(&bar[XB_XGEN(b.x)]) == gen, bar);
            __builtin_amdgcn_fence(__ATOMIC_ACQUIRE, "agent");
            asm volatile("s_waitcnt vmcnt(0)" ::: "memory");
        }
    }
    __syncthreads();
}

__device__ __forceinline__ void xcd_arrive(const XcdBarrier& b_in) {
    XcdBarrier b; { unsigned long long p = (unsigned long long)b_in.bar; asm volatile("" : "+s"(p)); b.bar = (unsigned*)p; unsigned xx = xb_xcc_id(); asm volatile("" : "+s"(xx)); b.x = xx; b.st = b_in.st; }
    asm volatile("s_waitcnt vmcnt(0)" ::: "memory");
    __syncthreads();
    if (threadIdx.x == 0) {
        unsigned* bar = b.bar;
        __builtin_amdgcn_s_waitcnt(0);
        unsigned nloc = b.st[0], nx = b.st[1];
        if (nloc == 0u) { xcd_barrier_complete(bar, b.x, nloc, nx); b.st[0] = nloc; b.st[1] = nx; }
        const unsigned old = xb_add(&bar[XB_XSUB(b.x)], 1u);
        const unsigned gen = old / nloc;
        unsigned last = 0u, og = 0u;
        if (old + 1u == (gen + 1u) * nloc) {
            __builtin_amdgcn_fence(__ATOMIC_RELEASE, "agent");
            asm volatile("s_waitcnt vmcnt(0)" ::: "memory");
            og = xb_add(&bar[XB_TOP], 1u); last = 1u;
        }
        b.st[2] = gen; b.st[3] = last; b.st[4] = og;
    }
}
__device__ __forceinline__ void xcd_wait(const XcdBarrier& b_in) {
    XcdBarrier b; { unsigned long long p = (unsigned long long)b_in.bar; asm volatile("" : "+s"(p)); b.bar = (unsigned*)p; unsigned xx = xb_xcc_id(); asm volatile("" : "+s"(xx)); b.x = xx; b.st = b_in.st; }
    asm volatile("s_waitcnt vmcnt(0)" ::: "memory");
    if (threadIdx.x == 0) {
        unsigned* bar = b.bar;
        const unsigned nx = b.st[1], gen = b.st[2], last = b.st[3], og = b.st[4];
        if (last) {
            const unsigned tg = og / nx;
            if (og + 1u == (tg + 1u) * nx) xb_add(&bar[XB_TOPGEN], 1u);
            else XB_SPIN(xb_ld(&bar[XB_TOPGEN]) == tg, bar);
            __builtin_amdgcn_fence(__ATOMIC_ACQUIRE, "agent");
            xb_add(&bar[XB_XGEN(b.x)], 1u);
            asm volatile("s_waitcnt vmcnt(0)" ::: "memory");
        } else {
            XB_SPIN(xb_ld(&bar[XB_XGEN(b.x)]) == gen, bar);
            __builtin_amdgcn_fence(__ATOMIC_ACQUIRE, "agent");
            asm volatile("s_waitcnt vmcnt(0)" ::: "memory");
        }
    }
    __syncthreads();
}

__device__ __forceinline__ int launder(int v) { asm volatile("" : "+v"(v)); return v; }
__device__ __forceinline__ int bid() { int b = (int)blockIdx.x; asm volatile("" : "+s"(b)); return b; }
namespace pg8 {
#define PG8_LAS __attribute__((address_space(3)))
typedef unsigned short bf16_t;
typedef short bf16x8 __attribute__((ext_vector_type(8)));
typedef float f32x4 __attribute__((ext_vector_type(4)));
typedef unsigned u32x4 __attribute__((ext_vector_type(4)));
constexpr int BM = 256, BK = 64, HALF = 128, HTB = HALF * BK * 2  , STAGE_BYTES = 8 * HTB, NXCD = 8, WGM = 2;

__host__ __device__ __forceinline__ int lds_byte(int r, int c) { const int st = (r >> 4) * 2 + (c >> 5), rr = r & 15, cc = c & 31, ob = rr * 64 + cc * 2; return st * 1024 + (ob ^ (((ob >> 9) & 1) << 5)); }
__host__ __device__ __forceinline__ void stage_rc(int b, int& R, int& C) { const int st = b / 1024, sb = b % 1024, swz = sb ^ (((sb >> 9) & 1) << 5); R = (st >> 1) * 16 + swz / 64; C = (st & 1) * 32 + (swz % 64) / 2; }
__host__ __device__ __forceinline__ int perm32(int rho) { const int n = rho >> 4, i = rho & 15; return 8 * (i >> 2) + 4 * n + (i & 3); }

struct Unit { int pm, pn; };
struct Gemm { const bf16_t* A; const bf16_t* Bt; int M, N, K; unsigned sa = 0x7f7f7f7fu, sb = 0x7f7f7f7fu; };

struct StaticOrder {
    int nM, nN, nwg, G, c;
    __host__ __device__ void init(int M, int N, int G_, int c_) { nM = M / BM; nN = N / BM; nwg = nM * nN; G = G_; c = c_; }
    __host__ __device__ bool next(int i, Unit& u) const {
        const long L = (long)i * G + c; if (L >= nwg) return false;
        int wgid = (int)L; { const int q = nwg / NXCD, r = nwg % NXCD, xcd = wgid % NXCD, off = wgid / NXCD; wgid = (xcd < r ? xcd * (q + 1) : r * (q + 1) + (xcd - r) * q) + off; }
        const int nig = WGM * nN, gid = wgid / nig, fm = gid * WGM, gsz = (nM - fm) < WGM ? (nM - fm) : WGM;
        u.pm = fm + ((wgid % nig) % gsz); u.pn = (wgid % nig) / gsz; return true;
    }
    __device__ __forceinline__ void a_ready(const Unit&) const {}
    __device__ __forceinline__ void done(const Unit&) const {}
};


__device__ __forceinline__ unsigned cvt_pk_bf16(float lo, float hi) { unsigned r; asm volatile("v_cvt_pk_bf16_f32 %0, %1, %2" : "=v"(r) : "v"(lo), "v"(hi)); return r; }
__device__ __forceinline__ unsigned pack4_fp8(float a, float b, float c, float d) { int p = __builtin_amdgcn_cvt_pk_fp8_f32(a, b, 0, false); p = __builtin_amdgcn_cvt_pk_fp8_f32(c, d, p, true); return (unsigned)p; }
template <bool IN_BF, bool OUT_BF>
struct EpiResidT {
    static constexpr bool PERM = false, AFTER_DRAIN = false;
    const void* base; void* out; const float* bias; const float* gate;
    __device__ __forceinline__ void operator()(const f32x4 (&acc)[2][2][4][2], const Unit& u, int wr, int wc, int fr, int fq) const {
        typedef unsigned u32x2r_ __attribute__((ext_vector_type(2)));
        const int col0 = u.pn * BM + wc * 32 + 4 * fq;
        const int b = (u.pm * BM) / SEQ;
        const float* gp = gate + (size_t)b * 6 * DM + col0;
        f32x4 bv[2][2], gv[2][2];
#pragma unroll
        for (int bj = 0; bj < 2; ++bj)
#pragma unroll
            for (int n = 0; n < 2; ++n) {
                bv[bj][n] = bias ? *(const f32x4*)(bias + col0 + bj * HALF + n * 16) : (f32x4){0.f, 0.f, 0.f, 0.f};
                gv[bj][n] = *(const f32x4*)(gp + bj * HALF + n * 16);
            }
#pragma unroll
        for (int ai = 0; ai < 2; ++ai)
#pragma unroll
            for (int m = 0; m < 4; ++m) {
                const size_t off = (size_t)(u.pm * BM + ai * HALF + wr * 64 + m * 16 + fr) * DM + col0;
#pragma unroll
                for (int bj = 0; bj < 2; ++bj)
#pragma unroll
                    for (int n = 0; n < 2; ++n) {
                        f32x4 xv;
                        if constexpr (IN_BF) { const u32x2r_ r = *(const u32x2r_*)((const bf16_t*)base + off + bj * HALF + n * 16);
                            xv = (f32x4){__builtin_bit_cast(float, r.x << 16), __builtin_bit_cast(float, r.x & 0xffff0000u), __builtin_bit_cast(float, r.y << 16), __builtin_bit_cast(float, r.y & 0xffff0000u)}; }
                        else xv = *(const f32x4*)((const float*)base + off + bj * HALF + n * 16);
                        const f32x4 o = xv + gv[bj][n] * (acc[ai][bj][m][n] + bv[bj][n]);
                        if constexpr (OUT_BF) { u32x2r_ w; w.x = cvt_pk_bf16(o[0], o[1]); w.y = cvt_pk_bf16(o[2], o[3]); *(u32x2r_*)((bf16_t*)out + off + bj * HALF + n * 16) = w; }
                        else *(f32x4*)((float*)out + off + bj * HALF + n * 16) = o;
                    }
            }
    }
};

struct EpiSwiGLU {
    static constexpr bool PERM = true, AFTER_DRAIN = false;
    bf16_t* O; float f8scale; float wscale;
    __device__ __forceinline__ void operator()(const f32x4 (&acc)[2][2][4][2], const Unit& u, int wr, int wc, int fr, int fq) const {
        const int row0 = u.pm * BM + wr * 64 + fr, col0 = (u.pn & 7) * 128 + wc * 32 + 8 * fq;
#pragma unroll
        for (int ai = 0; ai < 2; ++ai)
#pragma unroll
            for (int m = 0; m < 4; ++m) {
                bf16_t* rowp = O + (size_t)(row0 + ai * HALF + m * 16) * 1024 + col0;
                float h[8];
#pragma unroll
                for (int n = 0; n < 2; ++n)
#pragma unroll
                    for (int j = 0; j < 4; ++j) { const float g = acc[ai][0][m][n][j] * wscale, up = acc[ai][1][m][n][j] * wscale;
                        h[n * 4 + j] = __builtin_fminf(__builtin_fmaxf(g * __builtin_amdgcn_rcpf(1.0f + __builtin_amdgcn_exp2f(-1.4426950408889634f * g)) * up, -448.f), 448.f); }
                if (f8scale != 0.f) {
                    typedef unsigned u32x2_ __attribute__((ext_vector_type(2)));
                    u32x2_ w8; w8.x = pack4_fp8(h[0] * f8scale, h[1] * f8scale, h[2] * f8scale, h[3] * f8scale); w8.y = pack4_fp8(h[4] * f8scale, h[5] * f8scale, h[6] * f8scale, h[7] * f8scale);
                    *(u32x2_*)((unsigned char*)O + (size_t)(row0 + ai * HALF + m * 16) * 1024 + col0) = w8;
                } else {
                u32x4 w; w.x = cvt_pk_bf16(h[0], h[1]); w.y = cvt_pk_bf16(h[2], h[3]); w.z = cvt_pk_bf16(h[4], h[5]); w.w = cvt_pk_bf16(h[6], h[7]);
                *(u32x4*)rowp = w; }
            }
    }
};
struct EpiRowScale {
    static constexpr bool PERM = true, AFTER_DRAIN = false;
    bf16_t* O; const float* rs;
    static constexpr float wscale = 1.0f / 32.0f;
    __device__ __forceinline__ void operator()(const f32x4 (&acc)[2][2][4][2], const Unit& u, int wr, int wc, int fr, int fq) const {
        const int row0 = u.pm * BM + wr * 64 + fr, col0 = (u.pn & 3) * BM + wc * 32 + 8 * fq;
#pragma unroll
        for (int ai = 0; ai < 2; ++ai)
#pragma unroll
            for (int m = 0; m < 4; ++m) {
                const int row = row0 + ai * HALF + m * 16;
                const float sc = rs[row] * wscale * 16.0f;
                unsigned char* rowp = (unsigned char*)O + (size_t)row * 1024 + col0;
                typedef unsigned u32x2y_ __attribute__((ext_vector_type(2)));
#pragma unroll
                for (int bj = 0; bj < 2; ++bj) { f32x4 v0 = acc[ai][bj][m][0] * sc, v1 = acc[ai][bj][m][1] * sc;
#pragma unroll
                    for (int e = 0; e < 4; ++e) { v0[e] = __builtin_fminf(__builtin_fmaxf(v0[e], -448.f), 448.f); v1[e] = __builtin_fminf(__builtin_fmaxf(v1[e], -448.f), 448.f); }
                    u32x2y_ w; w.x = pack4_fp8(v0[0], v0[1], v0[2], v0[3]); w.y = pack4_fp8(v1[0], v1[1], v1[2], v1[3]);
                    *(u32x2y_*)(rowp + bj * HALF) = w; }
            }
    }
};

struct EpiBf16Bias {
    static constexpr bool PERM = true, AFTER_DRAIN = false;
    bf16_t* O; int ldc; const float* bias;
    __device__ __forceinline__ void operator()(const f32x4 (&acc)[2][2][4][2], const Unit& u, int wr, int wc, int fr, int fq) const {
        const int row0 = u.pm * BM + wr * 64 + fr, col0 = u.pn * BM + wc * 32 + 8 * fq;
        f32x4 bv[2][2];
#pragma unroll
        for (int bj = 0; bj < 2; ++bj)
#pragma unroll
            for (int n = 0; n < 2; ++n) bv[bj][n] = bias ? *(const f32x4*)(bias + col0 + bj * HALF + 4 * n) : (f32x4){0.f, 0.f, 0.f, 0.f};
#pragma unroll
        for (int ai = 0; ai < 2; ++ai)
#pragma unroll
            for (int m = 0; m < 4; ++m) { bf16_t* rowp = O + (size_t)(row0 + ai * HALF + m * 16) * ldc + col0;
#pragma unroll
                for (int bj = 0; bj < 2; ++bj) { const f32x4 v0 = acc[ai][bj][m][0] + bv[bj][0], v1 = acc[ai][bj][m][1] + bv[bj][1];
                    u32x4 w; w.x = cvt_pk_bf16(v0[0], v0[1]); w.y = cvt_pk_bf16(v0[2], v0[3]); w.z = cvt_pk_bf16(v1[0], v1[1]); w.w = cvt_pk_bf16(v1[2], v1[3]);
                    *(u32x4*)(rowp + bj * HALF) = w; } }
    }
};

struct EpiBf16BiasT {
    static constexpr bool PERM = true, AFTER_DRAIN = false;
    bf16_t* O; int ldc; const float* bias;
    __device__ __forceinline__ void operator()(const f32x4 (&acc)[2][2][4][2], const Unit& u, int wr, int wc, int fr, int fq) const {
        const int row0 = u.pm * BM + wr * 64 + fr, col0 = u.pn * BM + wc * 32 + 8 * fq;
#pragma unroll
        for (int ai = 0; ai < 2; ++ai)
#pragma unroll
            for (int m = 0; m < 4; ++m) { const int row = row0 + ai * HALF + m * 16; const float bb = bias[row]; bf16_t* rowp = O + (size_t)row * ldc + col0;
#pragma unroll
                for (int bj = 0; bj < 2; ++bj) { const f32x4 v0 = acc[ai][bj][m][0] + bb, v1 = acc[ai][bj][m][1] + bb;
                    u32x4 w; w.x = cvt_pk_bf16(v0[0], v0[1]); w.y = cvt_pk_bf16(v0[2], v0[3]); w.z = cvt_pk_bf16(v1[0], v1[1]); w.w = cvt_pk_bf16(v1[2], v1[3]);
                    *(u32x4*)(rowp + bj * HALF) = w; } }
    }
};

struct EpiQRope {
    static constexpr bool PERM = true, AFTER_DRAIN = false;
    bf16_t* O; const float* rope; float qscale;
    __device__ __forceinline__ void operator()(const f32x4 (&acc)[2][2][4][2], const Unit& u, int wr, int wc, int fr, int fq) const {
        const int row0 = u.pm * BM + wr * 64 + fr, col0 = u.pn * BM + wc * 32 + 8 * fq;
#pragma unroll
        for (int bj = 0; bj < 2; ++bj) {
            const int col = col0 + bj * HALF, hd = col / 192, d = col - hd * 192;
            const bool pe = d >= 128;
#pragma unroll
            for (int ai = 0; ai < 2; ++ai)
#pragma unroll
                for (int m = 0; m < 4; ++m) {
                    const unsigned row = (unsigned)(row0 + ai * HALF + m * 16);
                    f32x4 v0 = acc[ai][bj][m][0], v1 = acc[ai][bj][m][1];
                    if (pe) {
                        const unsigned ro = row * 64u + (unsigned)(d - 128);
                        const f32x4 r0 = *(const f32x4*)(rope + ro), r1 = *(const f32x4*)(rope + ro + 4u);
                        const f32x4 t0 = v0, t1 = v1;
                        v0[0] = t0[0] * r0[0] - t0[1] * r0[1]; v0[1] = t0[0] * r0[1] + t0[1] * r0[0];
                        v0[2] = t0[2] * r0[2] - t0[3] * r0[3]; v0[3] = t0[2] * r0[3] + t0[3] * r0[2];
                        v1[0] = t1[0] * r1[0] - t1[1] * r1[1]; v1[1] = t1[0] * r1[1] + t1[1] * r1[0];
                        v1[2] = t1[2] * r1[2] - t1[3] * r1[3]; v1[3] = t1[2] * r1[3] + t1[3] * r1[2];
                    }
                    v0 = v0 * qscale; v1 = v1 * qscale;
                    typedef unsigned u32x2q_ __attribute__((ext_vector_type(2)));
                    u32x2q_ w8; w8.x = pack4_fp8(v0[0], v0[1], v0[2], v0[3]); w8.y = pack4_fp8(v1[0], v1[1], v1[2], v1[3]);
                    *(u32x2q_*)((unsigned char*)O + (row * 1536u + (unsigned)col)) = w8;
                }
        }
    }
};

struct EpiKV {
    static constexpr bool PERM = true, AFTER_DRAIN = false;
    bf16_t* O; unsigned char* K8;
    __device__ __forceinline__ void operator()(const f32x4 (&acc)[2][2][4][2], const Unit& u, int wr, int wc, int fr, int fq) const {
        const int row0 = u.pm * BM + wr * 64 + fr, col0 = u.pn * BM + wc * 32 + 8 * fq;
#pragma unroll
        for (int ai = 0; ai < 2; ++ai)
#pragma unroll
            for (int m = 0; m < 4; ++m) { const unsigned row = (unsigned)(row0 + ai * HALF + m * 16); bf16_t* rowp = O + (size_t)row * 2048 + col0;
#pragma unroll
                for (int bj = 0; bj < 2; ++bj) { const f32x4 v0 = acc[ai][bj][m][0], v1 = acc[ai][bj][m][1];
                    u32x4 w; w.x = cvt_pk_bf16(v0[0], v0[1]); w.y = cvt_pk_bf16(v0[2], v0[3]); w.z = cvt_pk_bf16(v1[0], v1[1]); w.w = cvt_pk_bf16(v1[2], v1[3]);
                    *(u32x4*)(rowp + bj * HALF) = w;
                    if (bj == 0) { typedef unsigned u32x2k_ __attribute__((ext_vector_type(2)));
                        u32x2k_ w8; w8.x = pack4_fp8(v0[0], v0[1], v0[2], v0[3]); w8.y = pack4_fp8(v1[0], v1[1], v1[2], v1[3]);
                        *(u32x2k_*)(K8 + (row * 1024u + (unsigned)(u.pn * 128 + wc * 32 + 8 * fq))) = w8; } } }
    }
};
struct EpiK8 {
    static constexpr bool PERM = true, AFTER_DRAIN = false;
    unsigned char* K8;
    __device__ __forceinline__ void operator()(const f32x4 (&acc)[2][2][4][2], const Unit& u, int wr, int wc, int fr, int fq) const {
        const int row0 = u.pm * BM + wr * 64 + fr, col0 = u.pn * BM + wc * 32 + 8 * fq;
        typedef unsigned u32x2e_ __attribute__((ext_vector_type(2)));
#pragma unroll
        for (int ai = 0; ai < 2; ++ai)
#pragma unroll
            for (int m = 0; m < 4; ++m) { const unsigned row = (unsigned)(row0 + ai * HALF + m * 16);
#pragma unroll
                for (int bj = 0; bj < 2; ++bj) { const f32x4 v0 = acc[ai][bj][m][0], v1 = acc[ai][bj][m][1];
                    u32x2e_ w8; w8.x = pack4_fp8(v0[0], v0[1], v0[2], v0[3]); w8.y = pack4_fp8(v1[0], v1[1], v1[2], v1[3]);
                    *(u32x2e_*)(K8 + (row * 1024u + (unsigned)(col0 + bj * HALF))) = w8; } }
    }
};
struct EpiVT {
    static constexpr bool PERM = true, AFTER_DRAIN = false;
    unsigned char* V8T;
    __device__ __forceinline__ void operator()(const f32x4 (&acc)[2][2][4][2], const Unit& u, int wr, int wc, int fr, int fq) const {
        const int dg0 = u.pm * BM + wr * 64 + fr, n0 = u.pn * BM + wc * 32 + 8 * fq;
#pragma unroll
        for (int ai = 0; ai < 2; ++ai)
#pragma unroll
            for (int m = 0; m < 4; ++m) { const int dg = dg0 + ai * HALF + m * 16, h = dg >> 7, d = dg & 127;
#pragma unroll
                for (int bj = 0; bj < 2; ++bj) { const f32x4 v0 = acc[ai][bj][m][0], v1 = acc[ai][bj][m][1];
                    const int n = n0 + bj * HALF, b = n >> 12, key = n & 4095, j = key >> 6, kk0 = key & 63, pos0 = 16 * (kk0 >> 5) + 4 * ((kk0 >> 3) & 3);
                    unsigned char* p = V8T + ((size_t)((b * 8 + h) * 64 + j) * 8192 + (size_t)(d * 64 + pos0));
                    *(unsigned*)p = pack4_fp8(v0[0], v0[1], v0[2], v0[3]); *(unsigned*)(p + 32) = pack4_fp8(v1[0], v1[1], v1[2], v1[3]); } }
    }
};
struct MoeOrder1 { int c;
    __device__ __forceinline__ bool next(int i, Unit& u) const { if (i >= 8) return false; const int x = c & 7, s = c >> 3, e = 2 * i + (x >> 2); u.pm = e * 16 + 4 * (x & 3) + (s >> 3); u.pn = e * 8 + (s & 7); return true; }
    __device__ __forceinline__ void a_ready(const Unit&) const {}
    __device__ __forceinline__ void done(const Unit&) const {} };
struct MoeOrder2 { int c;
    __device__ __forceinline__ bool next(int i, Unit& u) const { if (i >= 4) return false; const int x = c & 7, s = c >> 3, e = 4 * i + (x >> 1); u.pm = e * 16 + 8 * (x & 1) + (s >> 2); u.pn = e * 4 + (s & 3); return true; }
    __device__ __forceinline__ void a_ready(const Unit&) const {}
    __device__ __forceinline__ void done(const Unit&) const {} };

typedef int v8i32_t __attribute__((ext_vector_type(8)));
typedef int v4i32_t __attribute__((ext_vector_type(4)));
typedef short v4i16_t __attribute__((ext_vector_type(4)));
__device__ __forceinline__ v8i32_t cat8(bf16x8 lo, bf16x8 hi) { const v4i32_t a = __builtin_bit_cast(v4i32_t, lo), b = __builtin_bit_cast(v4i32_t, hi); return __builtin_shufflevector(a, b, 0, 1, 2, 3, 4, 5, 6, 7); }
template <class Epi, class Sched, bool ALIGN_EPI = false, bool SP2 = false, bool FP8 = false, bool AT = false>
__device__ __forceinline__ void gemm_phase(PG8_LAS unsigned char* lds, const Gemm g, const Sched& S, const Epi& E) {
    int tid_ = threadIdx.x; asm volatile("" : "+v"(tid_));
    const int tid = tid_, wid = __builtin_amdgcn_readfirstlane(tid >> 6), lane = tid & 63, wr = wid >> 2, wc = wid & 3, fr = lane & 15, fq = lane >> 4;
    const int K = g.K, nt = K / BK;
    unsigned voffA[1], voffB[1];
    { int R, C; stage_rc(tid * 16, R, C); const int Rb = Epi::PERM ? ((R & ~31) + perm32(R & 31)) : R;
        voffA[0] = (unsigned)(R * K + C) * 2u; voffB[0] = (unsigned)(Rb * K + C) * 2u;
        if constexpr (AT) { const int k_ = (tid >> 2) & 63, j_ = tid & 3; voffA[0] = (unsigned)(k_ * g.M + (tid >> 8) * 32 + 8 * (j_ ^ (2 * ((k_ >> 3) & 1)))) * 2u; } }
    const size_t pstep = (size_t)64 * K * 2;
    const size_t kstep = (size_t)(BK * 2);
    const size_t hstep = (size_t)HALF * K * 2;
    const size_t tstep = 2 * hstep;
    const size_t pstepA = AT ? (size_t)128 : pstep, kstepA = AT ? (size_t)BK * g.M * 2 : kstep, hstepA = AT ? (size_t)256 : hstep, tstepA = AT ? (size_t)512 : tstep;
    const unsigned ldsw = (unsigned)wid * 1024u;
    const int aoff = lds_byte(wr * 64 + fr, fq * 8), boff = lds_byte(wc * 32 + fr, fq * 8);
    const int aoT0 = wr * 8192 + (8 * fq + (fr >> 2)) * 64 + ((fq & 1) * 32) + (fr & 3) * 8, aoT1 = aoT0 ^ 32;
#define PG8_SA(b, h) (((b) * 2 + (h)) * HTB)
#define PG8_SB(b, h) ((4 + (b) * 2 + (h)) * HTB)
#define PG8_STAGE(bufoff, gbase, voff) do { _Pragma("unroll") for (int _i = 0; _i < 2; ++_i) \
        __builtin_amdgcn_global_load_lds((const unsigned*)((const char*)(gbase) + _i * pstep + (voff)[0]), (PG8_LAS unsigned*)(lds + (bufoff) + ldsw + _i * 8192), 16, 0, 0); } while (0)
#define PG8_STAGEA(bufoff, gbase) do { _Pragma("unroll") for (int _i = 0; _i < 2; ++_i) \
        __builtin_amdgcn_global_load_lds((const unsigned*)((const char*)(gbase) + _i * pstepA + voffA[0]), (PG8_LAS unsigned*)(lds + (bufoff) + ldsw + _i * 8192), 16, 0, 0); } while (0)
#define PG8_TR(off_) __builtin_amdgcn_ds_read_tr16_b64_v4i16((PG8_LAS v4i16_t*)(lds + (off_)))
#define PG8_LDA(dst, b, h) do { if constexpr (AT) { _Pragma("unroll") for (int m = 0; m < 4; ++m) _Pragma("unroll") for (int k = 0; k < 2; ++k) { \
            const int o_ = PG8_SA(b, h) + ((m & 1) ? aoT1 : aoT0) + (m >> 1) * 4096 + k * 2048; const v4i16_t lo_ = PG8_TR(o_), hi_ = PG8_TR(o_ + 256); \
            dst[m][k] = __builtin_shufflevector(lo_, hi_, 0, 1, 2, 3, 4, 5, 6, 7); } } else _Pragma("unroll") for (int m = 0; m < 4; ++m) { if constexpr (FP8) dst##8[m] = cat8(*(const PG8_LAS bf16x8*)(lds + PG8_SA(b, h) + aoff + m * 2048), *(const PG8_LAS bf16x8*)(lds + PG8_SA(b, h) + aoff + m * 2048 + 1024)); \
        else { _Pragma("unroll") for (int k = 0; k < 2; ++k) dst[m][k] = *(const PG8_LAS bf16x8*)(lds + PG8_SA(b, h) + aoff + m * 2048 + k * 1024); } } } while (0)
#define PG8_LDB(dst, b, h) do { _Pragma("unroll") for (int n = 0; n < 2; ++n) { if constexpr (FP8) dst##8[n] = cat8(*(const PG8_LAS bf16x8*)(lds + PG8_SB(b, h) + boff + n * 2048), *(const PG8_LAS bf16x8*)(lds + PG8_SB(b, h) + boff + n * 2048 + 1024)); \
        else { _Pragma("unroll") for (int k = 0; k < 2; ++k) dst[n][k] = *(const PG8_LAS bf16x8*)(lds + PG8_SB(b, h) + boff + n * 2048 + k * 1024); } } } while (0)
#define PG8_MMA(ai, bj, At, Bt) do { __builtin_amdgcn_s_setprio(1);     \
        if constexpr (FP8) { _Pragma("unroll") for (int m = 0; m < 4; ++m) _Pragma("unroll") for (int n = 0; n < 2; ++n) \
            acc[ai][bj][m][n] = __builtin_amdgcn_mfma_scale_f32_16x16x128_f8f6f4(Bt##8[n], At##8[m], acc[ai][bj][m][n], 0, 0, 0, 0x7f7f7f7f, 0, 0x7f7f7f7f); } \
        else { _Pragma("unroll") for (int m = 0; m < 4; ++m) _Pragma("unroll") for (int n = 0; n < 2; ++n) _Pragma("unroll") for (int k = 0; k < 2; ++k) \
            acc[ai][bj][m][n] = __builtin_amdgcn_mfma_f32_16x16x32_bf16(Bt[n][k], At[m][k], acc[ai][bj][m][n], 0, 0, 0); } \
        __builtin_amdgcn_s_setprio(0); } while (0)
#define PG8_WAIT_V(n) asm volatile("s_waitcnt vmcnt(" #n ")" ::: "memory")
#define PG8_WAIT_L(n) asm volatile("s_waitcnt lgkmcnt(" #n ")" ::: "memory")
#define PG8_BAR __builtin_amdgcn_s_barrier()
#define PG8_SCHED __builtin_amdgcn_sched_barrier(0)
    Unit cur, nxt; int ui = 0;
    if (!S.next(0, cur)) return;
    f32x4 acc[2][2][4][2];
#pragma unroll
    for (int a = 0; a < 2; ++a)
#pragma unroll
        for (int b = 0; b < 2; ++b)
#pragma unroll
            for (int m = 0; m < 4; ++m)
#pragma unroll
                for (int n = 0; n < 2; ++n) { acc[a][b][m][n] = (f32x4){0.f, 0.f, 0.f, 0.f}; }
    bf16x8 At[4][2], B0[2][2], B1[2][2];
    v8i32_t At8[4], B08[2], B18[2];
    const char* cA = (const char*)g.A + (size_t)cur.pm * tstepA; const char* cB = (const char*)g.Bt + (size_t)cur.pn * tstep;
    S.a_ready(cur);
    if constexpr (SP2) {
        PG8_STAGE(PG8_SB(0, 0), cB, voffB); PG8_STAGE(PG8_SB(0, 1), cB + hstep, voffB); PG8_STAGEA(PG8_SA(0, 0), cA); PG8_STAGEA(PG8_SA(0, 1), cA + hstepA);
        if (wr == 1) PG8_BAR;
        PG8_WAIT_V(2); PG8_BAR;
        PG8_STAGE(PG8_SB(1, 0), cB + kstep, voffB); PG8_STAGEA(PG8_SA(1, 0), cA + kstepA); PG8_STAGE(PG8_SB(1, 1), cB + hstep + kstep, voffB);
        PG8_WAIT_V(6); PG8_BAR;
    } else {
        PG8_STAGE(PG8_SB(0, 0), cB, voffB); PG8_STAGEA(PG8_SA(0, 0), cA); PG8_STAGE(PG8_SB(0, 1), cB + hstep, voffB); PG8_STAGEA(PG8_SA(0, 1), cA + hstepA);
        if (wr == 1) PG8_BAR;
        PG8_WAIT_V(4); PG8_BAR;
        PG8_STAGE(PG8_SB(1, 0), cB + kstep, voffB); PG8_STAGEA(PG8_SA(1, 0), cA + kstepA); PG8_STAGE(PG8_SB(1, 1), cB + hstep + kstep, voffB);
        PG8_WAIT_V(6); PG8_BAR;
    }
    for (;;) {
        const bool has_next = S.next(ui + 1, nxt);
        const char* nA = has_next ? (const char*)g.A + (size_t)nxt.pm * tstepA : cA; const char* nB = has_next ? (const char*)g.Bt + (size_t)nxt.pn * tstep : cB;
#pragma unroll 1
        for (int t = 0; t < nt; t += 2) {
            const bool last = (t == nt - 2);
            const char* a1 = cA + (size_t)(t + 1) * kstepA;
            const char* a2 = last ? nA : cA + (size_t)(t + 2) * kstepA; const char* b2 = last ? nB : cB + (size_t)(t + 2) * kstep;
            const char* a3 = a2 + kstepA; const char* b3 = b2 + kstep;
            if (last && has_next) S.a_ready(nxt);
            if constexpr (SP2) {
            PG8_LDB(B0, 0, 0); PG8_LDB(B1, 0, 1); PG8_SCHED; PG8_LDA(At, 0, 0); PG8_STAGEA(PG8_SA(1, 1), a1 + hstepA);
            PG8_WAIT_V(8); PG8_WAIT_L(0); PG8_BAR; PG8_MMA(0, 0, At, B0); PG8_MMA(0, 1, At, B1); PG8_BAR; PG8_SCHED;
            PG8_LDA(At, 0, 1); PG8_STAGE(PG8_SB(0, 0), b2, voffB); PG8_STAGE(PG8_SB(0, 1), b2 + hstep, voffB); PG8_STAGEA(PG8_SA(0, 0), a2);
            PG8_WAIT_V(8); PG8_WAIT_L(0); PG8_BAR; PG8_MMA(1, 0, At, B0); PG8_MMA(1, 1, At, B1); PG8_BAR; PG8_SCHED;
            PG8_LDB(B0, 1, 0); PG8_LDB(B1, 1, 1); PG8_SCHED; PG8_LDA(At, 1, 0); PG8_STAGEA(PG8_SA(0, 1), a2 + hstepA);
            PG8_WAIT_V(8); PG8_WAIT_L(0); PG8_BAR; PG8_MMA(0, 0, At, B0); PG8_MMA(0, 1, At, B1); PG8_BAR; PG8_SCHED;
            PG8_LDA(At, 1, 1); PG8_STAGE(PG8_SB(1, 0), b3, voffB); PG8_STAGE(PG8_SB(1, 1), b3 + hstep, voffB); PG8_STAGEA(PG8_SA(1, 0), a3);
            PG8_WAIT_V(8); PG8_WAIT_L(0); PG8_BAR; PG8_MMA(1, 0, At, B0); PG8_MMA(1, 1, At, B1); PG8_BAR; PG8_SCHED;
            } else {
            PG8_LDB(B0, 0, 0); PG8_SCHED; PG8_LDA(At, 0, 0); PG8_STAGEA(PG8_SA(1, 1), a1 + hstepA);
            PG8_WAIT_L(8); PG8_BAR; PG8_WAIT_L(0); PG8_MMA(0, 0, At, B0); PG8_BAR; PG8_SCHED;
            PG8_LDB(B1, 0, 1); PG8_STAGE(PG8_SB(0, 0), b2, voffB);
            PG8_BAR; PG8_WAIT_L(0); PG8_MMA(0, 1, At, B1); PG8_BAR;
            PG8_LDA(At, 0, 1); PG8_STAGEA(PG8_SA(0, 0), a2);
            PG8_BAR; PG8_WAIT_L(0); PG8_MMA(1, 0, At, B0); PG8_BAR; PG8_SCHED;
            PG8_STAGE(PG8_SB(0, 1), b2 + hstep, voffB);
            PG8_WAIT_V(6); PG8_BAR; PG8_MMA(1, 1, At, B1); PG8_BAR;
            PG8_LDB(B0, 1, 0); PG8_SCHED; PG8_LDA(At, 1, 0); PG8_STAGEA(PG8_SA(0, 1), a2 + hstepA);
            PG8_WAIT_L(8); PG8_BAR; PG8_WAIT_L(0); PG8_MMA(0, 0, At, B0); PG8_BAR; PG8_SCHED;
            PG8_LDB(B1, 1, 1); PG8_STAGE(PG8_SB(1, 0), b3, voffB);
            PG8_BAR; PG8_WAIT_L(0); PG8_MMA(0, 1, At, B1); PG8_BAR;
            PG8_LDA(At, 1, 1); PG8_STAGEA(PG8_SA(1, 0), a3);
            PG8_BAR; PG8_WAIT_L(0); PG8_MMA(1, 0, At, B0); PG8_BAR; PG8_SCHED;
            PG8_STAGE(PG8_SB(1, 1), b3 + hstep, voffB);
            PG8_WAIT_V(6); PG8_BAR; PG8_MMA(1, 1, At, B1); PG8_BAR;
            }
        }
        if constexpr (ALIGN_EPI) { if (wr == 0) PG8_BAR; }
        if constexpr (!Epi::AFTER_DRAIN) { E(acc, cur, wr, wc, fr, fq); S.done(cur); }
        if (!has_next) break;
#pragma unroll
        for (int a = 0; a < 2; ++a)
#pragma unroll
            for (int b = 0; b < 2; ++b)
#pragma unroll
                for (int m = 0; m < 4; ++m)
#pragma unroll
                    for (int n = 0; n < 2; ++n) { acc[a][b][m][n] = (f32x4){0.f, 0.f, 0.f, 0.f}; }
        cur = nxt; cA = nA; cB = nB; ++ui;
        if constexpr (ALIGN_EPI) { if (wr == 1) PG8_BAR; }
    }
    PG8_WAIT_V(0);
    if constexpr (!ALIGN_EPI) { if (wr == 0) PG8_BAR; }
    PG8_BAR;
    if constexpr (Epi::AFTER_DRAIN) { E.fused(acc, cur, wr, wc, fr, fq, lds, wid, lane); S.done(cur); }
#undef PG8_SA
#undef PG8_SB
#undef PG8_STAGE
#undef PG8_STAGEA
#undef PG8_TR
#undef PG8_LDA
#undef PG8_LDB
#undef PG8_MMA
#undef PG8_WAIT_V
#undef PG8_WAIT_L
#undef PG8_BAR
#undef PG8_SCHED
}
__device__ __forceinline__ int tid_now_() { int t_ = threadIdx.x; asm volatile("" : "+v"(t_)); return t_; }
template <class Epi, class Sched, bool FP8 = false, int KC = 0>
__device__ __forceinline__ void gemm_phase_gather(PG8_LAS unsigned char* lds, const Gemm g, const int* arow, const Sched& S, const Epi& E) {
    constexpr bool ALIGN_EPI = true, SP2 = true;
    int tid_ = threadIdx.x; asm volatile("" : "+v"(tid_));
    const int tid = tid_, wid = __builtin_amdgcn_readfirstlane(tid >> 6), lane = tid & 63, wr = wid >> 2, wc = wid & 3, fr = lane & 15, fq = lane >> 4;
    const int K = KC > 0 ? KC : g.K, nt = K / BK;
    unsigned voffA[1], voffB[1];
    { int R, C; stage_rc(tid * 16, R, C); const int Rb = Epi::PERM ? ((R & ~31) + perm32(R & 31)) : R;
        voffA[0] = (unsigned)(R * K + C) * 2u; voffB[0] = (unsigned)(Rb * K + C) * 2u; }
    const size_t pstep = (size_t)64 * K * 2;
    const size_t kstep = (size_t)(BK * 2);
    const size_t hstep = (size_t)HALF * K * 2;
    const size_t tstep = 2 * hstep;
    const unsigned ldsw = (unsigned)wid * 1024u;
    const int aoff = lds_byte(wr * 64 + fr, fq * 8), boff = lds_byte(wc * 32 + fr, fq * 8);
#define PG8_SA(b, h) (((b) * 2 + (h)) * HTB)
#define PG8_SB(b, h) ((4 + (b) * 2 + (h)) * HTB)
#define PG8_STAGE(bufoff, gbase, voff) do { _Pragma("unroll") for (int _i = 0; _i < 2; ++_i) \
        __builtin_amdgcn_global_load_lds((const unsigned*)((const char*)(gbase) + _i * pstep + (voff)[0]), (PG8_LAS unsigned*)(lds + (bufoff) + ldsw + _i * 8192), 16, 0, 0); } while (0)
#define PG8_LDA(dst, b, h) do { _Pragma("unroll") for (int m = 0; m < 4; ++m) { if constexpr (FP8) dst##8[m] = cat8(*(const PG8_LAS bf16x8*)(lds + PG8_SA(b, h) + aoff + m * 2048), *(const PG8_LAS bf16x8*)(lds + PG8_SA(b, h) + aoff + m * 2048 + 1024)); \
        else { _Pragma("unroll") for (int k = 0; k < 2; ++k) dst[m][k] = *(const PG8_LAS bf16x8*)(lds + PG8_SA(b, h) + aoff + m * 2048 + k * 1024); } } } while (0)
#define PG8_LDB(dst, b, h) do { _Pragma("unroll") for (int n = 0; n < 2; ++n) { if constexpr (FP8) dst##8[n] = cat8(*(const PG8_LAS bf16x8*)(lds + PG8_SB(b, h) + boff + n * 2048), *(const PG8_LAS bf16x8*)(lds + PG8_SB(b, h) + boff + n * 2048 + 1024)); \
        else { _Pragma("unroll") for (int k = 0; k < 2; ++k) dst[n][k] = *(const PG8_LAS bf16x8*)(lds + PG8_SB(b, h) + boff + n * 2048 + k * 1024); } } } while (0)
#define PG8_MMA(ai, bj, At, Bt) do { __builtin_amdgcn_s_setprio(1);     \
        if constexpr (FP8) { _Pragma("unroll") for (int m = 0; m < 4; ++m) _Pragma("unroll") for (int n = 0; n < 2; ++n) \
            acc[ai][bj][m][n] = __builtin_amdgcn_mfma_scale_f32_16x16x128_f8f6f4(Bt##8[n], At##8[m], acc[ai][bj][m][n], 0, 0, 0, 0x7f7f7f7f, 0, 0x7f7f7f7f); } \
        else { _Pragma("unroll") for (int m = 0; m < 4; ++m) _Pragma("unroll") for (int n = 0; n < 2; ++n) _Pragma("unroll") for (int k = 0; k < 2; ++k) \
            acc[ai][bj][m][n] = __builtin_amdgcn_mfma_f32_16x16x32_bf16(Bt[n][k], At[m][k], acc[ai][bj][m][n], 0, 0, 0); } \
        __builtin_amdgcn_s_setprio(0); } while (0)
#define PG8_WAIT_V(n) asm volatile("s_waitcnt vmcnt(" #n ")" ::: "memory")
#define PG8_WAIT_L(n) asm volatile("s_waitcnt lgkmcnt(" #n ")" ::: "memory")
#define PG8_BAR __builtin_amdgcn_s_barrier()
#define PG8_SCHED __builtin_amdgcn_sched_barrier(0)
    Unit cur, nxt; int ui = 0;
    if (!S.next(0, cur)) return;
    f32x4 acc[2][2][4][2];
#pragma unroll
    for (int a = 0; a < 2; ++a)
#pragma unroll
        for (int b = 0; b < 2; ++b)
#pragma unroll
            for (int m = 0; m < 4; ++m)
#pragma unroll
                for (int n = 0; n < 2; ++n) { acc[a][b][m][n] = (f32x4){0.f, 0.f, 0.f, 0.f}; }
    bf16x8 At[4][2], B0[2][2], B1[2][2];
    v8i32_t At8[4], B08[2], B18[2];
    const char* cB = (const char*)g.Bt + (size_t)cur.pn * tstep;
    int R0_, C0_; stage_rc(tid * 16, R0_, C0_);
    const unsigned rowb = (unsigned)(K * 2), colb = (unsigned)(C0_ * 2);
#define ost ((PG8_LAS unsigned*)(lds + STAGE_BYTES) + tid_now_() * 8)
#define cbuf (ui & 1)
#pragma unroll
    for (int h = 0; h < 2; ++h)
#pragma unroll
        for (int i = 0; i < 2; ++i) ost[h * 2 + i] = (unsigned)arow[cur.pm * BM + h * HALF + 64 * i + R0_] * rowb + colb;
#define PG8_STAGE_A(bufoff, h, kb, nx) do { typedef unsigned u32x2s_ __attribute__((ext_vector_type(2))); \
        const u32x2s_ o_ = *(const PG8_LAS u32x2s_*)(ost + (((nx) ? (cbuf ^ 1) : cbuf) * 4 + (h) * 2)); _Pragma("unroll") for (int _i = 0; _i < 2; ++_i) \
        __builtin_amdgcn_global_load_lds((const unsigned*)((const char*)g.A + (size_t)(kb) + o_[_i]), (PG8_LAS unsigned*)(lds + (bufoff) + ldsw + _i * 8192), 16, 0, 0); } while (0)
    S.a_ready(cur);
    if constexpr (SP2) {
        PG8_STAGE(PG8_SB(0, 0), cB, voffB); PG8_STAGE(PG8_SB(0, 1), cB + hstep, voffB); PG8_STAGE_A(PG8_SA(0, 0), 0, 0, false); PG8_STAGE_A(PG8_SA(0, 1), 1, 0, false);
        if (wr == 1) PG8_BAR;
        PG8_WAIT_V(2); PG8_BAR;
        PG8_STAGE(PG8_SB(1, 0), cB + kstep, voffB); PG8_STAGE_A(PG8_SA(1, 0), 0, kstep, false); PG8_STAGE(PG8_SB(1, 1), cB + hstep + kstep, voffB);
        PG8_WAIT_V(6); PG8_BAR;
    }
    for (;;) {
        const bool has_next = S.next(ui + 1, nxt);
        const char* nB = has_next ? (const char*)g.Bt + (size_t)nxt.pn * tstep : cB;
        int tu_ = threadIdx.x; asm volatile("" : "+v"(tu_)); int R1_, C1_; stage_rc(tu_ * 16, R1_, C1_);
#pragma unroll
        for (int h = 0; h < 2; ++h)
#pragma unroll
            for (int i = 0; i < 2; ++i) ost[(cbuf ^ 1) * 4 + h * 2 + i] = has_next ? (unsigned)arow[nxt.pm * BM + h * HALF + 64 * i + R1_] * rowb + (unsigned)(C1_ * 2) : ost[cbuf * 4 + h * 2 + i];
#pragma unroll 1
        for (int t = 0; t < nt; t += 2) {
            const bool last = (t == nt - 2);
            const size_t k1 = (size_t)(t + 1) * kstep, k2 = last ? 0 : (size_t)(t + 2) * kstep, k3 = k2 + kstep;
            const char* b2 = last ? nB : cB + (size_t)(t + 2) * kstep; const char* b3 = b2 + kstep;
            if (last && has_next) S.a_ready(nxt);
            if constexpr (SP2) {
            PG8_LDB(B0, 0, 0); PG8_LDB(B1, 0, 1); PG8_SCHED; PG8_LDA(At, 0, 0); PG8_STAGE_A(PG8_SA(1, 1), 1, k1, false);
            PG8_WAIT_V(8); PG8_WAIT_L(0); PG8_BAR; PG8_MMA(0, 0, At, B0); PG8_MMA(0, 1, At, B1); PG8_BAR; PG8_SCHED;
            PG8_LDA(At, 0, 1); PG8_STAGE(PG8_SB(0, 0), b2, voffB); PG8_STAGE(PG8_SB(0, 1), b2 + hstep, voffB); PG8_STAGE_A(PG8_SA(0, 0), 0, k2, last);
            PG8_WAIT_V(8); PG8_WAIT_L(0); PG8_BAR; PG8_MMA(1, 0, At, B0); PG8_MMA(1, 1, At, B1); PG8_BAR; PG8_SCHED;
            PG8_LDB(B0, 1, 0); PG8_LDB(B1, 1, 1); PG8_SCHED; PG8_LDA(At, 1, 0); PG8_STAGE_A(PG8_SA(0, 1), 1, k2, last);
            PG8_WAIT_V(8); PG8_WAIT_L(0); PG8_BAR; PG8_MMA(0, 0, At, B0); PG8_MMA(0, 1, At, B1); PG8_BAR; PG8_SCHED;
            PG8_LDA(At, 1, 1); PG8_STAGE(PG8_SB(1, 0), b3, voffB); PG8_STAGE(PG8_SB(1, 1), b3 + hstep, voffB); PG8_STAGE_A(PG8_SA(1, 0), 0, k3, last);
            PG8_WAIT_V(8); PG8_WAIT_L(0); PG8_BAR; PG8_MMA(1, 0, At, B0); PG8_MMA(1, 1, At, B1); PG8_BAR; PG8_SCHED;
            }
        }
        if constexpr (ALIGN_EPI) { if (wr == 0) PG8_BAR; }
        if constexpr (!Epi::AFTER_DRAIN) { int te_ = threadIdx.x; asm volatile("" : "+v"(te_)); const int we_ = __builtin_amdgcn_readfirstlane(te_ >> 6);
            E(acc, cur, we_ >> 2, we_ & 3, te_ & 15, (te_ & 63) >> 4); S.done(cur); }
        if (!has_next) break;
#pragma unroll
        for (int a = 0; a < 2; ++a)
#pragma unroll
            for (int b = 0; b < 2; ++b)
#pragma unroll
                for (int m = 0; m < 4; ++m)
#pragma unroll
                    for (int n = 0; n < 2; ++n) { acc[a][b][m][n] = (f32x4){0.f, 0.f, 0.f, 0.f}; }
        cur = nxt; cB = nB; ++ui;
        if constexpr (ALIGN_EPI) { if (wr == 1) PG8_BAR; }
    }
    PG8_WAIT_V(0);
    if constexpr (!ALIGN_EPI) { if (wr == 0) PG8_BAR; }
    PG8_BAR;
    if constexpr (Epi::AFTER_DRAIN) { E.fused(acc, cur, wr, wc, fr, fq, lds, wid, lane); S.done(cur); }
#undef PG8_STAGE_A
#undef cbuf
#undef ost
#undef PG8_SA
#undef PG8_SB
#undef PG8_STAGE
#undef PG8_LDA
#undef PG8_LDB
#undef PG8_MMA
#undef PG8_WAIT_V
#undef PG8_WAIT_L
#undef PG8_BAR
#undef PG8_SCHED
}
}

typedef unsigned short bf16;
typedef unsigned v4u __attribute__((ext_vector_type(4)));
typedef unsigned v2u __attribute__((ext_vector_type(2)));
#define GAS __attribute__((address_space(1)))
#define LDS_WAIT() asm volatile("s_waitcnt lgkmcnt(0)" ::: "memory")
__device__ __forceinline__ unsigned f2bf(float f) { unsigned u = __builtin_bit_cast(unsigned, f); return (u + 0x7fffu + ((u >> 16) & 1u)) >> 16; }
__device__ __forceinline__ unsigned pk2(float lo, float hi) { return f2bf(lo) | (f2bf(hi) << 16); }
template <int MODE> __device__ __forceinline__ int tr_row(int n) {
    if (MODE == 1) return (n >> 7) * 256 + (n & 127);
    if (MODE == 2) { if (n < 384) return n; const int i = n - 384; return 384 + (i < 32 ? 2 * i : 2 * (i - 32) + 1); }
    if (MODE == 3) { const int h = n / 192, d = n - h * 192; if (d < 128) return n; const int i = d - 128; return h * 192 + 128 + (i < 32 ? 2 * i : 2 * (i - 32) + 1); }
    return n;
}
template <int MODE>
__device__ __forceinline__ void transpose_item(const float* W, int K, int N, bf16* WT, int row_off, LAS float* scr, int item, int lane, int ldk = 0) {
    if (ldk == 0) ldk = K;
    const int nblk = N / 32, kb = item / nblk, nb = item % nblk, k0 = 64 * kb, n0 = 32 * nb;
#pragma unroll 8
    for (int i = 0; i < 32; ++i) { const int kk = 2 * i + (lane >> 5); scr[kk * 33 + (lane & 31)] = W[(size_t)(k0 + kk) * N + n0 + (lane & 31)]; }
    LDS_WAIT(); asm volatile("" ::: "memory");
    const int c = lane & 7;
#pragma unroll
    for (int j = 0; j < 4; ++j) { const int n = (lane >> 3) + 8 * j; const LAS float* s = scr + (8 * c) * 33 + n;
        v4u o; o.x = pk2(s[0 * 33], s[1 * 33]); o.y = pk2(s[2 * 33], s[3 * 33]); o.z = pk2(s[4 * 33], s[5 * 33]); o.w = pk2(s[6 * 33], s[7 * 33]);
        *(GAS v4u*)(WT + (size_t)(row_off + tr_row<MODE>(n0 + n)) * ldk + k0 + 8 * c) = o; }
    LDS_WAIT(); asm volatile("" ::: "memory");
}
template <int MODE>
__device__ __forceinline__ void transpose_item_fp8(const float* W, int K, int N, unsigned char* WT, int row_off, LAS float* scr, int item, int lane) {
    const int nblk = N / 32, kb = item / nblk, nb = item % nblk, k0 = 64 * kb, n0 = 32 * nb;
#pragma unroll 8
    for (int i = 0; i < 32; ++i) { const int kk = 2 * i + (lane >> 5); scr[kk * 33 + (lane & 31)] = W[(size_t)(k0 + kk) * N + n0 + (lane & 31)]; }
    LDS_WAIT(); asm volatile("" ::: "memory");
    const int c = lane & 7;
#pragma unroll
    for (int j = 0; j < 4; ++j) { const int n = (lane >> 3) + 8 * j; const LAS float* s = scr + (8 * c) * 33 + n;
        v2u o; o.x = pg8::pack4_fp8(s[0 * 33] * 32.f, s[1 * 33] * 32.f, s[2 * 33] * 32.f, s[3 * 33] * 32.f); o.y = pg8::pack4_fp8(s[4 * 33] * 32.f, s[5 * 33] * 32.f, s[6 * 33] * 32.f, s[7 * 33] * 32.f);
        *(GAS v2u*)(WT + (size_t)(row_off + tr_row<MODE>(n0 + n)) * K + k0 + 8 * c) = o; }
    LDS_WAIT(); asm volatile("" ::: "memory");
}
__device__ __forceinline__ void mod_phase(int tid_in, unsigned char* lds_, const float* c, const float* ada_w, const float* ada_b, float* modp) {
  const int tid = launder(tid_in), wave = __builtin_amdgcn_readfirstlane(tid >> 6), lane = tid & 63;
  LAS float* cs = (LAS float*)lds_;
  LAS float* part = cs + NB * DM;
  __syncthreads();
  for (int q = tid; q < NB * DM; q += NTHR) { const float v = c[q]; cs[q] = v / (1.f + expf(-v)); }
  __syncthreads();
  const int col0 = bid() * 48, i = col0 / (6 * DM), j0 = col0 - i * 6 * DM;
  float acc[NB];
#pragma unroll
  for (int b = 0; b < NB; ++b) acc[b] = 0.f;
  if (lane < 48) {
    const float* w = ada_w + (size_t)i * DM * 6 * DM + j0 + lane;
#pragma unroll 8
    for (int kk = 0; kk < 128; ++kk) {
      const int k = wave * 128 + kk;
      const float wv = w[(size_t)k * 6 * DM];
#pragma unroll
      for (int b = 0; b < NB; ++b) acc[b] += cs[b * DM + k] * wv;
    }
#pragma unroll
    for (int b = 0; b < NB; ++b) part[(wave * NB + b) * 48 + lane] = acc[b];
  }
  __syncthreads();
  if (tid < NB * 48) {
    const int b = tid / 48, j = tid - b * 48;
    float sacc = ada_b[i * 6 * DM + j0 + j];
#pragma unroll
    for (int w8 = 0; w8 < 8; ++w8) sacc += part[(w8 * NB + b) * 48 + j];
    modp[(size_t)(i * NB + b) * 6 * DM + j0 + j] = sacc;
  }
  __syncthreads();
}

struct Args { const float* in[31]; float* out; unsigned char* ws; };

#define FOR_VB(n) for (int vb = bid() * 2 + (launder(tid) >> 8); vb < (n); vb += GRID * 2) \
    if (const int t = launder(tid) & 255; true) if (float* sm = (float*)(lds + (launder(tid) >> 8) * HALF_LDS); true)
#define GBF(LAYER_, K0_, NK_) do { XcdBarrier b_; b_.bar = (unsigned*)WSB + 4096; b_.x = 0; b_.st = (volatile LAS unsigned*)((LAS unsigned char*)lds + (LDS_BYTES - 256)) + 8; xcd_arrive(b_); \
    moe_convert(tid, lds, K0_, NK_, moe_w_gate + (size_t)(LAYER_) * NE * DM * DM, moe_w_up + (size_t)(LAYER_) * NE * DM * DM, moe_w_down + (size_t)(LAYER_) * NE * DM * DM, (unsigned char*)Wmoe + (size_t)(LAYER_) * 48 * MiB); \
    xcd_wait(b_); } while (0)
#define GB() do { XcdBarrier b_; b_.bar = (unsigned*)WSB + 4096; b_.x = 0; b_.st = (volatile LAS unsigned*)((LAS unsigned char*)lds + (LDS_BYTES - 256)) + 8; xcd_barrier(b_); } while (0)

typedef float f32x4_t __attribute__((ext_vector_type(4)));

template <int M> __device__ __forceinline__ float swz_xor(float v) { return __uint_as_float((unsigned)__builtin_amdgcn_ds_swizzle((int)__float_as_uint(v), (M << 10) | 0x1f)); }
__device__ __forceinline__ float sum_x32(float v) { auto rr = __builtin_amdgcn_permlane32_swap(__float_as_uint(v), __float_as_uint(v), false, false); return __uint_as_float(rr[0]) + __uint_as_float(rr[1]); }
__device__ __forceinline__ float max_x32(float v) { auto rr = __builtin_amdgcn_permlane32_swap(__float_as_uint(v), __float_as_uint(v), false, false); return fmaxf(__uint_as_float(rr[0]), __uint_as_float(rr[1])); }
__device__ __forceinline__ float get_x32(float v, bool hi) { auto rr = __builtin_amdgcn_permlane32_swap(__float_as_uint(v), __float_as_uint(v), false, false); return hi ? __uint_as_float(rr[0]) : __uint_as_float(rr[1]); }
__device__ __forceinline__ float wsum64(float v) {
  v += swz_xor<1>(v); v += swz_xor<2>(v); v += swz_xor<4>(v); v += swz_xor<8>(v); v += swz_xor<16>(v);
  return sum_x32(v);
}
__device__ __forceinline__ float router_reduce(const float* acc, int lane) {
  float a8[8], a4[4], a2[2], a1;
  { const bool hi = (lane & 32) != 0;
#pragma unroll
    for (int i = 0; i < 8; ++i) { const float keep = hi ? acc[i + 8] : acc[i], send = hi ? acc[i] : acc[i + 8]; a8[i] = keep + get_x32(send, hi); } }
  { const bool hi = (lane & 16) != 0;
#pragma unroll
    for (int i = 0; i < 4; ++i) { const float keep = hi ? a8[i + 4] : a8[i], send = hi ? a8[i] : a8[i + 4]; a4[i] = keep + swz_xor<16>(send); } }
  { const bool hi = (lane & 8) != 0;
#pragma unroll
    for (int i = 0; i < 2; ++i) { const float keep = hi ? a4[i + 2] : a4[i], send = hi ? a4[i] : a4[i + 2]; a2[i] = keep + swz_xor<8>(send); } }
  { const bool hi = (lane & 4) != 0; const float keep = hi ? a2[1] : a2[0], send = hi ? a2[0] : a2[1]; a1 = keep + swz_xor<4>(send); }
  a1 += swz_xor<1>(a1); a1 += swz_xor<2>(a1);
  return a1;
}
template <bool ROUTER>
__device__ __forceinline__ void norm_rows_phase(int tid_in, unsigned char* lds, const float* xin, const float* gnorm, const float* sh, const float* sc,
                                                bf16* XN, const float* wr, float* aff) {
  const int tid = launder(tid_in), wave = __builtin_amdgcn_readfirstlane(tid >> 6), lane = tid & 63;
  LAS float* wl = (LAS float*)lds;
  constexpr int NR = ROUTER ? 4 : 2;
  if (ROUTER) {
    __syncthreads();
    for (int q = tid; q < DM * NE / 4; q += NTHR) { const f32x4_t w4 = ((const f32x4_t*)wr)[q]; const int k = q >> 2, e0 = (q & 3) * 4;
      wl[(e0 + 0) * DM + k] = w4.x; wl[(e0 + 1) * DM + k] = w4.y; wl[(e0 + 2) * DM + k] = w4.z; wl[(e0 + 3) * DM + k] = w4.w; }
    __syncthreads();
  }
  for (int rp = bid() * 8 + wave; rp < NTOK / NR; rp += GRID * 8) {
    const int row0 = NR * rp, b = row0 / SEQ;
    float rs[NR];
#pragma unroll
    for (int r = 0; r < NR; ++r) {
      const f32x4_t* xr = (const f32x4_t*)(xin + (size_t)(row0 + r) * DM) + lane; float ss = 0.f;
#pragma unroll
      for (int j = 0; j < 4; ++j) { const f32x4_t v = xr[64 * j]; ss += (v.x * v.x + v.y * v.y) + (v.z * v.z + v.w * v.w); }
      rs[r] = rsqrtf(wsum64(ss) * (1.f / DM) + 1e-6f);
    }
    float acc[NR][NE];
#pragma unroll
    for (int r = 0; r < NR; ++r)
#pragma unroll
      for (int e = 0; e < NE; ++e) acc[r][e] = 0.f;
#pragma unroll 1
    for (int j = 0; j < 4; ++j) {
      const int cj = launder(lane + 64 * j);
      const f32x4_t gg = ((const f32x4_t*)gnorm)[cj];
      const f32x4_t s1 = ((const f32x4_t*)(sc + (size_t)b * 6 * DM))[cj];
      const f32x4_t s0 = ((const f32x4_t*)(sh + (size_t)b * 6 * DM))[cj];
      f32x4_t y[NR];
#pragma unroll
      for (int r = 0; r < NR; ++r) {
        y[r] = ((const f32x4_t*)(xin + (size_t)(row0 + r) * DM))[cj] * rs[r] * gg * (s1 + 1.0f) + s0;
        if (ROUTER) ((unsigned*)((unsigned char*)XN + (size_t)(row0 + r) * DM))[cj] = pg8::pack4_fp8(y[r].x, y[r].y, y[r].z, y[r].w);
        else { uint2 w; w.x = pk2(y[r].x, y[r].y); w.y = pk2(y[r].z, y[r].w);
        ((uint2*)(XN + (size_t)(row0 + r) * DM))[cj] = w; }
      }
      if (ROUTER) {
        const unsigned wofs = (unsigned)cj * 16u;
#pragma unroll
        for (int e = 0; e < NE; ++e) {
          const f32x4_t w4 = *(const LAS f32x4_t*)((LAS unsigned char*)wl + wofs + e * (DM * 4));
#pragma unroll
          for (int r = 0; r < NR; ++r) acc[r][e] += (y[r].x * w4.x + y[r].y * w4.y) + (y[r].z * w4.z + y[r].w * w4.w);
        }
      }
    }
    if (ROUTER) {
#pragma unroll
      for (int r = 0; r < NR; ++r) {
        const float a1 = router_reduce(acc[r], lane);
        float mx = a1;
        mx = fmaxf(mx, swz_xor<4>(mx)); mx = fmaxf(mx, swz_xor<8>(mx)); mx = fmaxf(mx, swz_xor<16>(mx)); mx = max_x32(mx);
        const float p = expf(a1 - mx);
        float sm_ = p;
        sm_ += swz_xor<4>(sm_); sm_ += swz_xor<8>(sm_); sm_ += swz_xor<16>(sm_); sm_ = sum_x32(sm_);
        if ((lane & 3) == 0) aff[((size_t)b * NE + (lane >> 2)) * SEQ + (row0 + r - b * SEQ)] = p / sm_;
      }
    }
  }
}

__device__ __forceinline__ void topk_phase(int tid_in, unsigned char* lds, const float* aff, int* idx_row, float* gsel_row, int* slot_of) {
  const int tid = launder(tid_in), wave = __builtin_amdgcn_readfirstlane(tid >> 6), lane = tid & 63;
  LAS unsigned* hist = (LAS unsigned*)lds;
  LAS unsigned* bc = hist + 256;
  LAS unsigned* wtot = hist + 272;
  for (int be = bid(); be < NB * NE; be += GRID) {
    const int b = be / NE, e = be % NE;
    unsigned v[8];
    { const uint4* src = (const uint4*)(aff + (size_t)be * SEQ) + 2 * tid; const uint4 p0 = src[0], p1 = src[1];
      v[0] = p0.x; v[1] = p0.y; v[2] = p0.z; v[3] = p0.w; v[4] = p1.x; v[5] = p1.y; v[6] = p1.z; v[7] = p1.w; }
    unsigned prefix = 0u, need = CAP;
#pragma unroll 1
    for (int pass = 0; pass < 4; ++pass) {
      const int shift = 24 - 8 * pass;
      __syncthreads();
      if (tid < 256) hist[tid] = 0u;
      __syncthreads();
#pragma unroll
      for (int i = 0; i < 8; ++i) {
        const bool match = (pass == 0) || ((v[i] >> (shift + 8)) == prefix);
        if (match) __hip_atomic_fetch_add(&hist[(v[i] >> shift) & 255u], 1u, __ATOMIC_RELAXED, __HIP_MEMORY_SCOPE_WORKGROUP);
      }
      __syncthreads();
      if (wave == 0) {
        const unsigned c0 = hist[4 * lane], c1 = hist[4 * lane + 1], c2 = hist[4 * lane + 2], c3 = hist[4 * lane + 3];
        const unsigned cs = c0 + c1 + c2 + c3;
        unsigned suf = cs;
#pragma unroll
        for (int o = 1; o < 64; o <<= 1) { const unsigned t2 = (unsigned)__builtin_amdgcn_ds_bpermute(((lane + o) & 63) << 2, (int)suf); if (lane + o < 64) suf += t2; }
        const unsigned above = suf - cs;
        if (suf >= need && above < need) {
          unsigned ab = above, bin;
          if (ab + c3 >= need) bin = 3; else { ab += c3; if (ab + c2 >= need) bin = 2; else { ab += c2; if (ab + c1 >= need) bin = 1; else { ab += c1; bin = 0; } } }
          bc[0] = 4 * lane + bin; bc[1] = ab;
        }
      }
      __syncthreads();
      prefix = (prefix << 8) | bc[0];
      need -= bc[1];
    }
    unsigned cg = 0u, ce = 0u;
#pragma unroll
    for (int i = 0; i < 8; ++i) { cg += (v[i] > prefix) ? 1u : 0u; ce += (v[i] == prefix) ? 1u : 0u; }
    unsigned pk = cg | (ce << 16), inc = pk;
#pragma unroll
    for (int o = 1; o < 64; o <<= 1) { const unsigned t2 = (unsigned)__builtin_amdgcn_ds_bpermute(((lane - o) & 63) << 2, (int)inc); if (lane >= o) inc += t2; }
    __syncthreads();
    if (lane == 63) wtot[wave] = inc;
    __syncthreads();
    unsigned base = 0u;
#pragma unroll
    for (int w = 0; w < 8; ++w) if (w < wave) base += wtot[w];
    unsigned ex = base + inc - pk;
    unsigned gtb = ex & 0xffffu, eqb = ex >> 16;
#pragma unroll
    for (int i = 0; i < 8; ++i) {
      const int t = 8 * tid + i;
      const bool gt = v[i] > prefix, eq = v[i] == prefix;
      const bool sel = gt || (eq && eqb < need);
      const unsigned slot = gtb + (eqb < need ? eqb : need);
      if (sel) { const size_t r = (size_t)e * (NB * CAP) + b * CAP + slot; idx_row[r] = b * SEQ + t; gsel_row[r] = __uint_as_float(v[i]); }
      slot_of[(size_t)be * SEQ + t] = sel ? (int)slot : -1;
      gtb += gt ? 1u : 0u; eqb += eq ? 1u : 0u;
    }
  }
}

__device__ __forceinline__ void gather_phase(int tid_in, const bf16* XN, const int* idx_row, bf16* XS) {
  const int tid = launder(tid_in), wave = __builtin_amdgcn_readfirstlane(tid >> 6), lane = tid & 63;
  for (int r = bid() * 8 + wave; r < NE * NB * CAP; r += GRID * 8) {
    const int src = idx_row[r];
    const uint4* s = (const uint4*)(XN + (size_t)src * DM) + lane;
    uint4* d = (uint4*)(XS + (size_t)r * DM) + lane;
    const uint4 a = s[0], c = s[64];
    d[0] = a; d[64] = c;
  }
}

template <bool FINAL>
__device__ __forceinline__ void combine_norm_phase(int tid_in, bf16* xb, float* xfin, const bf16* ye, const int* slot_of, const float* g2, const float* gnext, const float* sh, const float* sc, bf16* XN) {
  const int tid = launder(tid_in), wave = __builtin_amdgcn_readfirstlane(tid >> 6), lane = tid & 63;
  for (int row = bid() * 8 + wave; row < NTOK; row += GRID * 8) {
    const int b = row / SEQ, t = row - b * SEQ;
    const int myslot = slot_of[((size_t)b * NE + (lane & 15)) * SEQ + t];
    uint2* xr = (uint2*)(xb + (size_t)row * DM) + lane;
    uint2 xw[4];
#pragma unroll
    for (int j = 0; j < 4; ++j) xw[j] = xr[64 * j];
    unsigned long long m = __ballot(myslot >= 0) & 0xffffull;
    f32x4_t acc[4];
#pragma unroll
    for (int j = 0; j < 4; ++j) acc[j] = (f32x4_t){0.f, 0.f, 0.f, 0.f};
    while (m) {
      const int e0 = __builtin_ctzll(m); m &= m - 1;
      const int e1 = m ? __builtin_ctzll(m) : -1; if (m) m &= m - 1;
      const int s0 = __builtin_amdgcn_readlane(myslot, e0);
      const unsigned* y0 = (const unsigned*)((const unsigned char*)ye + ((size_t)e0 * (NB * CAP) + b * CAP + s0) * DM) + lane;
      unsigned w0[4], w1[4];
#pragma unroll
      for (int j = 0; j < 4; ++j) w0[j] = y0[64 * j];
      if (e1 >= 0) {
        const int s1 = __builtin_amdgcn_readlane(myslot, e1);
        const unsigned* y1 = (const unsigned*)((const unsigned char*)ye + ((size_t)e1 * (NB * CAP) + b * CAP + s1) * DM) + lane;
#pragma unroll
        for (int j = 0; j < 4; ++j) w1[j] = y1[64 * j];
      } else {
#pragma unroll
        for (int j = 0; j < 4; ++j) w1[j] = 0u;
      }
#pragma unroll
      for (int j = 0; j < 4; ++j) {
        const auto a0 = __builtin_amdgcn_cvt_pk_f32_fp8((int)w0[j], false), a1 = __builtin_amdgcn_cvt_pk_f32_fp8((int)w0[j], true);
        const auto b0 = __builtin_amdgcn_cvt_pk_f32_fp8((int)w1[j], false), b1 = __builtin_amdgcn_cvt_pk_f32_fp8((int)w1[j], true);
        acc[j].x += a0[0] + b0[0]; acc[j].y += a0[1] + b0[1]; acc[j].z += a1[0] + b1[0]; acc[j].w += a1[1] + b1[1]; }
    }
    float ss = 0.f;
#pragma unroll
    for (int j = 0; j < 4; ++j) { const f32x4_t gv = ((const f32x4_t*)(g2 + (size_t)b * 6 * DM))[lane + 64 * j] * (1.f / 16.f);
      const f32x4_t xv = {__uint_as_float(xw[j].x << 16), __uint_as_float(xw[j].x & 0xffff0000u), __uint_as_float(xw[j].y << 16), __uint_as_float(xw[j].y & 0xffff0000u)}; acc[j] = xv + gv * acc[j];
      ss += (acc[j].x * acc[j].x + acc[j].y * acc[j].y) + (acc[j].z * acc[j].z + acc[j].w * acc[j].w); }
    const float r = rsqrtf(wsum64(ss) * (1.f / DM) + 1e-6f);
#pragma unroll
    for (int j = 0; j < 4; ++j) {
      const f32x4_t gg = ((const f32x4_t*)gnext)[lane + 64 * j];
      if (FINAL) ((f32x4_t*)(xfin + (size_t)row * DM) + lane)[64 * j] = acc[j] * r * gg;
      else {
        { uint2 w; w.x = pk2(acc[j].x, acc[j].y); w.y = pk2(acc[j].z, acc[j].w); xr[64 * j] = w; }
        const f32x4_t s1 = ((const f32x4_t*)(sc + (size_t)b * 6 * DM))[lane + 64 * j], s0 = ((const f32x4_t*)(sh + (size_t)b * 6 * DM))[lane + 64 * j];
        const f32x4_t y = acc[j] * r * gg * (s1 + 1.0f) + s0;
        uint2 w; w.x = pk2(y.x, y.y); w.y = pk2(y.z, y.w);
        ((uint2*)(XN + (size_t)row * DM) + lane)[64 * j] = w;
      }
    }
  }
}

typedef short bf16x8_t __attribute__((ext_vector_type(8)));
typedef float f32x16_t __attribute__((ext_vector_type(16)));
__device__ __forceinline__ float bflo(unsigned w) { return __uint_as_float(w << 16); }
__device__ __forceinline__ float bfhi(unsigned w) { return __uint_as_float(w & 0xffff0000u); }
__device__ __forceinline__ void unpack8(const v4u v, float* f) { f[0] = bflo(v.x); f[1] = bfhi(v.x); f[2] = bflo(v.y); f[3] = bfhi(v.y); f[4] = bflo(v.z); f[5] = bfhi(v.z); f[6] = bflo(v.w); f[7] = bfhi(v.w); }

__device__ __forceinline__ void norm_router_phase(int tid_in, unsigned char* lds_, const bf16* xin, const float* gnorm, const float* sh, const float* sc,
                                                  unsigned char* XN8, const float* wr, float* aff) {
  const int tid = launder(tid_in), wave = __builtin_amdgcn_readfirstlane(tid >> 6), lane = tid & 63, r = lane & 15, kg = lane >> 4;
  LAS unsigned char* lds = (LAS unsigned char*)lds_;
  constexpr int O_A = 0, O_S0 = 4096, O_SS = 8192, O_LP = 9216, O_CP = 25600;
  const int b = bid() / (SEQ / 128), rowW = bid() * 128, c0 = wave * 128 + kg * 8;
  __syncthreads();
  for (int k = tid; k < DM; k += NTHR) {
    *(LAS float*)(lds + O_A + k * 4) = gnorm[k] * (sc[(size_t)b * 6 * DM + k] + 1.0f); *(LAS float*)(lds + O_S0 + k * 4) = sh[(size_t)b * 6 * DM + k]; }
  bf16x8_t bh[4], bl[4];
  { float cpart = 0.f;
#pragma unroll
    for (int ks = 0; ks < 4; ++ks) {
      float wv[8];
#pragma unroll
      for (int j = 0; j < 8; ++j) wv[j] = wr[(size_t)(c0 + 32 * ks + j) * NE + r];
      const f32x4_t s0 = *(const f32x4_t*)(sh + (size_t)b * 6 * DM + c0 + 32 * ks), s1 = *(const f32x4_t*)(sh + (size_t)b * 6 * DM + c0 + 32 * ks + 4);
      cpart += (s0.x * wv[0] + s0.y * wv[1]) + (s0.z * wv[2] + s0.w * wv[3]) + (s1.x * wv[4] + s1.y * wv[5]) + (s1.z * wv[6] + s1.w * wv[7]);
      unsigned h[4], l[4];
#pragma unroll
      for (int j = 0; j < 4; ++j) { h[j] = pg8::cvt_pk_bf16(wv[2 * j], wv[2 * j + 1]);
        l[j] = pg8::cvt_pk_bf16(wv[2 * j] - __uint_as_float(h[j] << 16), wv[2 * j + 1] - __uint_as_float(h[j] & 0xffff0000u)); }
      const v4u hu = {h[0], h[1], h[2], h[3]}, lu = {l[0], l[1], l[2], l[3]};
      bh[ks] = __builtin_bit_cast(bf16x8_t, hu); bl[ks] = __builtin_bit_cast(bf16x8_t, lu);
    }
    cpart += swz_xor<16>(cpart); cpart = sum_x32(cpart);
    if (kg == 0) *(LAS float*)(lds + O_CP + (wave * 16 + r) * 4) = cpart;
  }
  __syncthreads();
  float csum = 0.f;
#pragma unroll
  for (int w = 0; w < 8; ++w) csum += *(const LAS float*)(lds + O_CP + (w * 16 + (tid & 15)) * 4);
  const bf16* xp = xin + (size_t)(rowW + r) * DM + c0;
  unsigned char* xo = XN8 + (size_t)(rowW + r) * DM + c0;
  unsigned aoff = (unsigned)(O_A + c0 * 4), soff = (unsigned)(O_S0 + c0 * 4);
  asm volatile("" : "+v"(aoff), "+v"(soff));
#define NR_LOAD(V, G) do { _Pragma("unroll") for (int ks = 0; ks < 4; ++ks) { const v4u r_ = *(const v4u*)(xp + (size_t)(G) * 16 * DM + 32 * ks); \
      V[2 * ks] = (f32x4_t){__uint_as_float(r_.x << 16), __uint_as_float(r_.x & 0xffff0000u), __uint_as_float(r_.y << 16), __uint_as_float(r_.y & 0xffff0000u)}; \
      V[2 * ks + 1] = (f32x4_t){__uint_as_float(r_.z << 16), __uint_as_float(r_.z & 0xffff0000u), __uint_as_float(r_.w << 16), __uint_as_float(r_.w & 0xffff0000u)}; } } while (0)
#define NR_PROC(V, G, BUF) do { \
    f32x4_t acc = {0.f, 0.f, 0.f, 0.f}; float ss = 0.f; \
    _Pragma("unroll") for (int ks = 0; ks < 4; ++ks) { \
      const f32x4_t a0 = *(const LAS f32x4_t*)(lds + aoff + 128 * ks), a1 = *(const LAS f32x4_t*)(lds + aoff + 128 * ks + 16); \
      const f32x4_t v0 = V[2 * ks], v1 = V[2 * ks + 1]; \
      ss += (v0.x * v0.x + v0.y * v0.y) + (v0.z * v0.z + v0.w * v0.w) + (v1.x * v1.x + v1.y * v1.y) + (v1.z * v1.z + v1.w * v1.w); \
      const f32x4_t y0 = v0 * a0, y1 = v1 * a1; V[2 * ks] = y0; V[2 * ks + 1] = y1; \
      const unsigned h0 = pg8::cvt_pk_bf16(y0.x, y0.y), h1 = pg8::cvt_pk_bf16(y0.z, y0.w), h2 = pg8::cvt_pk_bf16(y1.x, y1.y), h3 = pg8::cvt_pk_bf16(y1.z, y1.w); \
      const unsigned l0 = pg8::cvt_pk_bf16(y0.x - __uint_as_float(h0 << 16), y0.y - __uint_as_float(h0 & 0xffff0000u)), l1 = pg8::cvt_pk_bf16(y0.z - __uint_as_float(h1 << 16), y0.w - __uint_as_float(h1 & 0xffff0000u)); \
      const unsigned l2 = pg8::cvt_pk_bf16(y1.x - __uint_as_float(h2 << 16), y1.y - __uint_as_float(h2 & 0xffff0000u)), l3 = pg8::cvt_pk_bf16(y1.z - __uint_as_float(h3 << 16), y1.w - __uint_as_float(h3 & 0xffff0000u)); \
      const v4u ahu = {h0, h1, h2, h3}, alu = {l0, l1, l2, l3}; \
      const bf16x8_t ah = __builtin_bit_cast(bf16x8_t, ahu), al = __builtin_bit_cast(bf16x8_t, alu); \
      acc = __builtin_amdgcn_mfma_f32_16x16x32_bf16(ah, bh[ks], acc, 0, 0, 0); \
      acc = __builtin_amdgcn_mfma_f32_16x16x32_bf16(al, bh[ks], acc, 0, 0, 0); \
      acc = __builtin_amdgcn_mfma_f32_16x16x32_bf16(ah, bl[ks], acc, 0, 0, 0); } \
    ss += swz_xor<16>(ss); ss = sum_x32(ss); \
    if (kg == 0) *(LAS float*)(lds + O_SS + ((BUF) * 128 + wave * 16 + r) * 4) = ss; \
    _Pragma("unroll") for (int j = 0; j < 4; ++j) *(LAS float*)(lds + O_LP + ((BUF) * 2048 + wave * 256 + (4 * kg + j) * 16 + r) * 4) = acc[j]; \
    __syncthreads(); \
    { float st = 0.f; _Pragma("unroll") for (int w = 0; w < 8; ++w) st += *(const LAS float*)(lds + O_SS + ((BUF) * 128 + w * 16 + r) * 4); \
      const float rs = rsqrtf(st * (1.f / DM) + 1e-6f); \
      _Pragma("unroll") for (int ks = 0; ks < 4; ++ks) { \
        const f32x4_t s0 = *(const LAS f32x4_t*)(lds + soff + 128 * ks), s1 = *(const LAS f32x4_t*)(lds + soff + 128 * ks + 16); \
        const f32x4_t y0 = V[2 * ks] * rs + s0, y1 = V[2 * ks + 1] * rs + s1; \
        v2u o; o.x = pg8::pack4_fp8(y0.x, y0.y, y0.z, y0.w); o.y = pg8::pack4_fp8(y1.x, y1.y, y1.z, y1.w); \
        *(v2u*)(xo + (size_t)(G) * 16 * DM + 32 * ks) = o; } } \
    if (tid < 256) { const int row = tid >> 4, e = tid & 15; float st = 0.f, lg = 0.f; \
      _Pragma("unroll") for (int w = 0; w < 8; ++w) { st += *(const LAS float*)(lds + O_SS + ((BUF) * 128 + w * 16 + row) * 4); lg += *(const LAS float*)(lds + O_LP + ((BUF) * 2048 + w * 256 + tid) * 4); } \
      const float a1 = lg * rsqrtf(st * (1.f / DM) + 1e-6f) + csum; \
      float mx = a1; mx = fmaxf(mx, swz_xor<1>(mx)); mx = fmaxf(mx, swz_xor<2>(mx)); mx = fmaxf(mx, swz_xor<4>(mx)); mx = fmaxf(mx, swz_xor<8>(mx)); \
      const float p = expf(a1 - mx); \
      float sm_ = p; sm_ += swz_xor<1>(sm_); sm_ += swz_xor<2>(sm_); sm_ += swz_xor<4>(sm_); sm_ += swz_xor<8>(sm_); \
      aff[((size_t)b * NE + e) * SEQ + (rowW + (G) * 16 + row - b * SEQ)] = p / sm_; } \
  } while (0)
  f32x4_t va[8], vb[8];
  NR_LOAD(va, 0);
#pragma unroll 1
  for (int gi = 0; gi < 8; gi += 2) {
    NR_LOAD(vb, gi + 1);
    NR_PROC(va, gi, 0);
    if (gi + 2 < 8) NR_LOAD(va, gi + 2);
    NR_PROC(vb, gi + 1, 1);
  }
#undef NR_LOAD
#undef NR_PROC
}
__device__ __forceinline__ void filter_phase(int tid_in, unsigned char* lds_, const float* w1, const float* b1, const float* w2, const float* b2,
                                             const bf16* W3T, const float* freq, const float* fbias, unsigned char* KR8, float* K0) {
  const int tid = launder(tid_in);
  LAS float* zf = (LAS float*)lds_;
  LAS float* h1 = zf + 16 * 36;
  LAS float* h2 = h1 + 16 * 64;
  LAS float* w1l = h2 + 64 * 16;
  LAS float* w2l = w1l + 33 * 64;
  __syncthreads();
  for (int q = tid; q < 33 * 64; q += NTHR) w1l[q] = w1[q];
  for (int q = tid; q < 64 * 64; q += NTHR) w2l[q] = w2[q];
  for (int item = bid(); item < SEQ / 16; item += GRID) {
    const int l0 = item * 16;
    __syncthreads();
    if (tid < 16 * 17) {
      const int li = tid / 17, f = tid - li * 17, l = l0 + li;
      if (f == 0) zf[li * 36] = (float)l / (float)(SEQ - 1);
      else {
        const int j = f - 1;
        const float wv = 2.0f * 3.14159265358979323846f * (float)l / (float)SEQ;
        const float fr = 1e-4f + (float)j * ((15.0f - 1e-4f) / 15.0f);
        const float ang = fr * wv;
        zf[li * 36 + 1 + j] = cosf(ang);
        zf[li * 36 + 17 + j] = -sinf(ang);
      }
    }
    __syncthreads();
    for (int o = tid; o < 1024; o += NTHR) {
      const int li = o >> 6, j = o & 63;
      float a = b1[j];
#pragma unroll
      for (int i = 0; i < 33; ++i) a += zf[li * 36 + i] * w1l[i * 64 + j];
      h1[li * 64 + j] = sinf(freq[j] * a);
    }
    __syncthreads();
    for (int o = tid; o < 1024; o += NTHR) {
      const int li = o >> 6, j = o & 63;
      float a = b2[j];
#pragma unroll 16
      for (int i = 0; i < 64; ++i) a += h1[li * 64 + i] * w2l[i * 64 + j];
      ((LAS unsigned short*)h2)[li * 64 + j] = (unsigned short)f2bf(sinf(freq[j] * a));
    }
    __syncthreads();
    const float min_decay = logf(1e-2f) / 0.3f, max_decay = logf(1e-2f) / 1.5f;
    {
      const int wave = __builtin_amdgcn_readfirstlane(tid >> 6), lane = tid & 63, cn = lane & 15, g = lane >> 4;
      const bf16x8_t a0 = *(const LAS bf16x8_t*)((LAS unsigned char*)h2 + cn * 128 + g * 16), a1 = *(const LAS bf16x8_t*)((LAS unsigned char*)h2 + cn * 128 + 64 + g * 16);
#pragma unroll 1
      for (int tb = 0; tb < 16; tb += 8) {
        bf16x8_t b0[8], b1[8];
#pragma unroll
        for (int t = 0; t < 8; ++t) { const bf16* wp = W3T + (size_t)(wave * 256 + (tb + t) * 16 + cn) * 64 + g * 8;
          b0[t] = *(const bf16x8_t*)wp; b1[t] = *(const bf16x8_t*)(wp + 32); }
#pragma unroll
        for (int t = 0; t < 8; ++t) {
          f32x4_t acc = {0.f, 0.f, 0.f, 0.f};
          acc = __builtin_amdgcn_mfma_f32_16x16x32_bf16(a0, b0[t], acc, 0, 0, 0);
          acc = __builtin_amdgcn_mfma_f32_16x16x32_bf16(a1, b1[t], acc, 0, 0, 0);
          const int col = wave * 256 + (tb + t) * 16 + cn, d = col & 1023, lb = l0 + 4 * g;
          const float delta = min_decay + (float)d * ((max_decay - min_decay) / (float)(DM - 1));
          unsigned char* kr = KR8 + (size_t)d * 8192;
          float h[4];
#pragma unroll
          for (int e = 0; e < 4; ++e) {
            const int l = lb + e;
            const float tl = (float)l / (float)(SEQ - 1);
            float v = acc[e] * expf(-tl * fabsf(delta));
            if (wave < 4 && l == 0) v += fbias[d];
            h[e] = fminf(fmaxf(v * 32.f, -448.f), 448.f);
          }
          if (wave < 4) {
            unsigned char* cb_ = kr + 4092 - lb;
            const unsigned pa = pg8::pack4_fp8(h[0], h[3], h[2], h[1]);
            cb_[4] = (unsigned char)pa;
            cb_[1] = (unsigned char)(pa >> 8);
            *(unsigned short*)(cb_ + 2) = (unsigned short)(pa >> 16);
            if (lb == 4092) cb_[0] = 0;
          } else {
            const unsigned w0 = pg8::pack4_fp8(h[0], h[1], h[2], h[3]);
            if (lb == 0) { kr[4097] = (unsigned char)(w0 >> 8); *(unsigned short*)(kr + 4098) = (unsigned short)(w0 >> 16); }
            else *(unsigned*)(kr + 4096 + lb) = w0;
          }
        }
      }
    }
  }
}

template <int LD> __device__ __forceinline__ void sconv8_load(const bf16* up, int col, int t, v4u* r) {
  const v4u z4 = (v4u){0u, 0u, 0u, 0u};
  r[0] = t > 0 ? *(const v4u*)(up - LD + col) : z4;
  r[1] = *(const v4u*)(up + col);
  r[2] = t < SEQ - 1 ? *(const v4u*)(up + LD + col) : z4;
}
__device__ __forceinline__ void sconv8_calc(const v4u* r, int col, const float* cw, const float* cb, float* out) {
  float um[8], u0[8], u1[8];
  unpack8(r[0], um); unpack8(r[1], u0); unpack8(r[2], u1);
#pragma unroll
  for (int h = 0; h < 2; ++h) {
    const f32x4_t w0 = *(const f32x4_t*)(cw + col + 4 * h), w1 = *(const f32x4_t*)(cw + 3072 + col + 4 * h), w2 = *(const f32x4_t*)(cw + 6144 + col + 4 * h), bb = *(const f32x4_t*)(cb + col + 4 * h);
#pragma unroll
    for (int k = 0; k < 4; ++k) out[4 * h + k] = bb[k] + w0[k] * um[4 * h + k] + w1[k] * u0[4 * h + k] + w2[k] * u1[4 * h + k];
  }
}
__device__ __forceinline__ void gateT_phase(int tid_in, unsigned char* lds_, const bf16* U, const float* cw, const float* cb, const bf16* ycT, bf16* Yg) {
  const int tid = launder(tid_in), cch = tid & 7, tl = tid >> 3;
  LAS bf16* tile = (LAS bf16*)lds_;
  constexpr int NITEM = NB * 64 * 16;
  const int rowc = tid >> 3, chunk = tid & 7;
  v4u ra[3], na[3], yv, nyv;
  {
    const int item = bid(), cbk = item & 15, r = item >> 4, tb = r & 63, b = r >> 6, c0 = cbk * 64 + cch * 8, t = tb * 64 + tl;
    yv = *(const v4u*)(ycT + ((size_t)(cbk * 64 + rowc) * NB + b) * SEQ + tb * 64 + chunk * 8);
    sconv8_load<DM>(U + (size_t)(b * SEQ + t) * DM, c0, t, ra);
  }
  for (int item = bid(); item < NITEM; item += GRID) {
    const int cbk = item & 15, r = item >> 4, tb = r & 63, b = r >> 6;
    const int c0 = cbk * 64 + cch * 8, t = tb * 64 + tl;
    {
      const int nitem = item + GRID < NITEM ? item + GRID : item, nr = nitem >> 4, ntb = nr & 63, nbb = nr >> 6, nt = ntb * 64 + tl;
      nyv = *(const v4u*)(ycT + ((size_t)(cbk * 64 + rowc) * NB + nbb) * SEQ + ntb * 64 + chunk * 8);
      sconv8_load<DM>(U + (size_t)(nbb * SEQ + nt) * DM, c0, nt, na);
    }
    float a0[8];
    sconv8_calc(ra, c0, cw, cb, a0);
    __syncthreads();
    *(LAS v4u*)(tile + rowc * 72 + chunk * 8) = yv;
    __syncthreads();
    float y[8];
#pragma unroll
    for (int k = 0; k < 8; ++k) y[k] = __uint_as_float((unsigned)tile[(cch * 8 + k) * 72 + tl] << 16) * a0[k];
    v4u o; o.x = pk2(y[0], y[1]); o.y = pk2(y[2], y[3]); o.z = pk2(y[4], y[5]); o.w = pk2(y[6], y[7]);
    *(v4u*)(Yg + (size_t)(b * SEQ + t) * DM + c0) = o;
#pragma unroll
    for (int k = 0; k < 3; ++k) ra[k] = na[k];
    yv = nyv;
  }
}

#define LC8_ZB 34816
#define LC8_FS 4208
#define LC8_ZF (LC8_ZB + 16 * LC8_FS)
typedef int lc_v4i __attribute__((ext_vector_type(4)));
typedef int lc_v8i __attribute__((ext_vector_type(8)));
__device__ __forceinline__ unsigned lc8_zslot(int Jp, int e, int b) { return (unsigned)((((Jp >> 1) * 4 + e * 2 + (Jp & 1)) * 8 + b) * 16); }
__device__ __forceinline__ lc_v8i lc_cat(lc_v4i a, lc_v4i b) { return __builtin_shufflevector(a, b, 0, 1, 2, 3, 4, 5, 6, 7); }
__device__ __forceinline__ void longconv_phase(int tid_in, unsigned char* lds_, const bf16* UT, const float* cw, const float* cb, const unsigned char* KR8, bf16* ycT) {
  LAS unsigned char* lds = (LAS unsigned char*)lds_;
  for (int c = bid(); c < DM; c += GRID) {
    const int tid = launder(tid_in), wave = __builtin_amdgcn_readfirstlane(tid >> 6), lane = tid & 63;
    const int n = lane & 31, half = lane >> 5, q = n >> 3, bb = n & 7, sigma = n >> 4, rho = n & 15;
    const int IL = 8 * wave, IH = 120 - 8 * wave;
    __syncthreads();
    if (tid >= 128 && tid < 132) *(LAS v4u*)(lds + LC8_ZF + (tid - 128) * 16) = (v4u){0u, 0u, 0u, 0u};
    if (tid < 128) {
      const int b = tid & 7, e = (tid >> 3) & 1, jb = tid >> 4, Jp = jb < 4 ? jb : 128 + jb;
      *(LAS v4u*)(lds + lc8_zslot(Jp, e, b)) = (v4u){0u, 0u, 0u, 0u};
    }
    {
      const float w10 = cw[1024 + c], w11 = cw[3072 + 1024 + c], w12 = cw[6144 + 1024 + c], b1_ = cb[1024 + c];
      const float w20 = cw[2048 + c], w21 = cw[3072 + 2048 + c], w22 = cw[6144 + 2048 + c], b2_ = cb[2048 + c];
      const bf16* x1r = UT + (size_t)(1024 + c) * NTOK; const bf16* vr = UT + (size_t)(2048 + c) * NTOK;
      v4u xa[4], xb[4], va[4], vb[4]; unsigned xm[4], xn[4], vm[4], vn[4];
#pragma unroll
      for (int k = 0; k < 4; ++k) {
        const int s_ = tid + NTHR * k, b = s_ >> 8, ch = s_ & 255, t0 = ch * 16;
        const bf16* xp = x1r + b * SEQ + t0; const bf16* vp = vr + b * SEQ + t0;
        xa[k] = *(const v4u*)xp; xb[k] = *(const v4u*)(xp + 8); va[k] = *(const v4u*)vp; vb[k] = *(const v4u*)(vp + 8);
        xm[k] = t0 > 0 ? (unsigned)xp[-1] : 0u; xn[k] = t0 + 16 < SEQ ? (unsigned)xp[16] : 0u; vm[k] = t0 > 0 ? (unsigned)vp[-1] : 0u; vn[k] = t0 + 16 < SEQ ? (unsigned)vp[16] : 0u;
      }
#pragma unroll
      for (int k = 0; k < 4; ++k) {
        const int s_ = tid + NTHR * k, b = s_ >> 8, ch = s_ & 255;
        float x[18], v[18];
        x[0] = __uint_as_float(xm[k] << 16); x[17] = __uint_as_float(xn[k] << 16); v[0] = __uint_as_float(vm[k] << 16); v[17] = __uint_as_float(vn[k] << 16);
        { const unsigned dx[8] = {xa[k].x, xa[k].y, xa[k].z, xa[k].w, xb[k].x, xb[k].y, xb[k].z, xb[k].w}, dv[8] = {va[k].x, va[k].y, va[k].z, va[k].w, vb[k].x, vb[k].y, vb[k].z, vb[k].w};
#pragma unroll
          for (int e = 0; e < 8; ++e) { x[1 + 2 * e] = __uint_as_float(dx[e] << 16); x[2 + 2 * e] = __uint_as_float(dx[e] & 0xffff0000u); v[1 + 2 * e] = __uint_as_float(dv[e] << 16); v[2 + 2 * e] = __uint_as_float(dv[e] & 0xffff0000u); } }
        float f[16];
#pragma unroll
        for (int e = 0; e < 16; ++e) { const float c1 = b1_ + w10 * x[e] + w11 * x[e + 1] + w12 * x[e + 2], c2 = b2_ + w20 * v[e] + w21 * v[e + 1] + w22 * v[e + 2];
          f[e] = fminf(fmaxf(c1 * c2 * 4.f, -448.f), 448.f); }
        v4u o; o.x = pg8::pack4_fp8(f[0], f[1], f[2], f[3]); o.y = pg8::pack4_fp8(f[4], f[5], f[6], f[7]); o.z = pg8::pack4_fp8(f[8], f[9], f[10], f[11]); o.w = pg8::pack4_fp8(f[12], f[13], f[14], f[15]);
        *(LAS v4u*)(lds + lc8_zslot((ch >> 1) + 4, ch & 1, b)) = o;
        __builtin_amdgcn_sched_barrier(0);
      }
    }
    f32x16_t acc[4];
#pragma unroll
    for (int tau = 0; tau < 4; ++tau)
#pragma unroll
      for (int r = 0; r < 16; ++r) acc[tau][r] = 0.f;
    const unsigned char* krc = KR8 + (size_t)c * 8192;
#pragma unroll 1
    for (int pass = 0; pass < 2; ++pass) {
      __syncthreads();
      for (int a = tid; a < 263; a += NTHR) {
        const int cl = a + (pass ? 255 : -3);
        const v4u lo = (cl >= 0 && cl < 512) ? *(const v4u*)(krc + (size_t)cl * 16) : (v4u){0u, 0u, 0u, 0u};
        const v4u hi = (cl >= -1 && cl < 511) ? *(const v4u*)(krc + (size_t)(cl + 1) * 16) : (v4u){0u, 0u, 0u, 0u};
        const unsigned d[8] = {lo.x, lo.y, lo.z, lo.w, hi.x, hi.y, hi.z, hi.w};
#pragma unroll
        for (int rh = 0; rh < 16; ++rh) {
          const int o_ = 16 - rh, j0 = o_ >> 2, sh = o_ & 3;
          v4u o;
          if (sh == 0) { o.x = d[j0]; o.y = d[j0 + 1]; o.z = d[j0 + 2]; o.w = d[j0 + 3]; }
          else { o.x = __builtin_amdgcn_alignbyte(d[j0 + 1], d[j0], sh); o.y = __builtin_amdgcn_alignbyte(d[j0 + 2], d[j0 + 1], sh);
                 o.z = __builtin_amdgcn_alignbyte(d[j0 + 3], d[j0 + 2], sh); o.w = __builtin_amdgcn_alignbyte(d[(j0 + 4) & 7], d[j0 + 3], sh); }
          *(LAS v4u*)(lds + LC8_ZB + rh * LC8_FS + a * 16) = o;
        }
      }
      __syncthreads();
      const int Dlo = pass ? -128 : 0, Dhi = pass ? -2 : 128, Ca = pass ? 0 : 258;
      const unsigned fbaseu = (unsigned)(LC8_ZB + rho * LC8_FS + (2 * half - sigma + Ca) * 16);
      const unsigned zfragu = (unsigned)LC8_ZF;
      lc_v8i P, Q, R, S, Bf;
#define LC_LDA(X, PTR, D_) do { const unsigned fa_ = ((D_) >= Dlo && (D_) <= Dhi) ? (PTR) : zfragu; X = lc_cat(*(const LAS lc_v4i*)(lds + fa_), *(const LAS lc_v4i*)(lds + fa_ + 16)); } while (0)
#define LC_MMA(A_, C_) C_ = __builtin_amdgcn_mfma_scale_f32_32x32x64_f8f6f4(A_, Bf, C_, 0, 0, 0, 0x7f7f7f7f, 0, 0x7f7f7f7f)
#define LC_STEP(DOL, DOH, T0, T1, T2, T3) do { \
        if (DOL) LC_LDA(T0, pl_, IL - J0); if (DOH) LC_LDA(T2, ph_, IH - J0); \
        Bf = lc_cat(*(const LAS lc_v4i*)(lds + pb_), *(const LAS lc_v4i*)(lds + pb_ + 256)); \
        if (DOL) { LC_MMA(T0, acc[0]); LC_MMA(T1, acc[1]); } \
        if (DOH) { LC_MMA(T2, acc[2]); LC_MMA(T3, acc[3]); } \
        J0 += 4; pl_ += 128u; ph_ += 128u; pb_ += 1024u; } while (0)
#define LC_RUN(DOL, DOH, JLO, JHI) do { \
        int J0 = (JLO) + (((r - (JLO)) % 4) + 4) % 4; const int jhi_ = (JHI); \
        unsigned pl_ = fbaseu + (unsigned)(32 * (J0 - IL)), ph_ = fbaseu + (unsigned)(32 * (J0 - IH)), pb_ = lc8_zslot(J0 + q + half + 4, 0, bb); \
        asm volatile("" : "+v"(pl_), "+v"(ph_), "+v"(pb_)); \
        if (DOL) LC_LDA(Q, pl_ - 128u, IL + 4 - J0); if (DOH) LC_LDA(S, ph_ - 128u, IH + 4 - J0); \
        _Pragma("unroll 1") while (J0 <= jhi_) { \
          LC_STEP(DOL, DOH, P, Q, R, S); if (J0 > jhi_) break; \
          LC_STEP(DOL, DOH, Q, P, S, R); } } while (0)
#pragma unroll 1
      for (int r = 0; r < 4; r += 2) {
        if (pass == 0) {
          LC_RUN(1, 1, -4, IL + 4);
          LC_RUN(0, 1, IL + 5, IH + 4);
        } else {
          LC_RUN(1, 0, IL + 1, IH);
          LC_RUN(1, 1, IH + 1, 126);
        }
      }
#undef LC_RUN
#undef LC_LDA
#undef LC_MMA
#undef LC_STEP
    }
    __syncthreads();
#pragma unroll
    for (int tau = 0; tau < 4; ++tau)
#pragma unroll
      for (int g = 0; g < 4; ++g) {
        const int t = 32 * ((tau < 2 ? IL : IH) + 4 * (tau & 1) + q) + 8 * g + 4 * half;
        v2u w; w.x = pk2(acc[tau][4 * g] * (1.f / 128.f), acc[tau][4 * g + 1] * (1.f / 128.f)); w.y = pk2(acc[tau][4 * g + 2] * (1.f / 128.f), acc[tau][4 * g + 3] * (1.f / 128.f));
        *(LAS v2u*)(lds + bb * 8208 + t * 2) = w;
      }
    {
      const float w0 = cw[c], w1 = cw[3072 + c], w2 = cw[6144 + c], b0_ = cb[c];
      const bf16* x0r = UT + (size_t)c * NTOK;
      v4u xg[8]; unsigned xm[8], xn[8];
#pragma unroll
      for (int k = 0; k < 8; ++k) {
        const int s_ = tid + NTHR * k, b = s_ >> 9, ch = s_ & 511, t0 = ch * 8; const bf16* xp = x0r + b * SEQ + t0;
        xg[k] = *(const v4u*)xp; xm[k] = t0 > 0 ? (unsigned)xp[-1] : 0u; xn[k] = t0 + 8 < SEQ ? (unsigned)xp[8] : 0u;
      }
      __syncthreads();
#pragma unroll
      for (int k = 0; k < 8; ++k) {
        const int s_ = tid + NTHR * k, b = s_ >> 9, ch = s_ & 511;
        const v4u yv = *(const LAS v4u*)(lds + b * 8208 + ch * 16);
        float x[10], y[8];
        x[0] = __uint_as_float(xm[k] << 16); x[9] = __uint_as_float(xn[k] << 16);
        { const unsigned dx[4] = {xg[k].x, xg[k].y, xg[k].z, xg[k].w};
#pragma unroll
          for (int e = 0; e < 4; ++e) { x[1 + 2 * e] = __uint_as_float(dx[e] << 16); x[2 + 2 * e] = __uint_as_float(dx[e] & 0xffff0000u); } }
        unpack8(yv, y);
#pragma unroll
        for (int e = 0; e < 8; ++e) y[e] *= b0_ + w0 * x[e] + w1 * x[e + 1] + w2 * x[e + 2];
        v4u o; o.x = pk2(y[0], y[1]); o.y = pk2(y[2], y[3]); o.z = pk2(y[4], y[5]); o.w = pk2(y[6], y[7]);
        *(v4u*)(ycT + ((size_t)c * NB + b) * SEQ + ch * 8) = o;
      }
    }
  }
}

__device__ __forceinline__ void mla_prep_phase(int tid_in, const bf16* A, const int* pos, const float* qg, const float* kvg, bf16* CQN, bf16* CKVN, bf16* KPE, unsigned char* KPE8, const float* ROPE) {
  const int tid = launder(tid_in), wave = __builtin_amdgcn_readfirstlane(tid >> 6), lane = tid & 63;
  for (int row4 = (bid() * 8 + wave) * 4; row4 < NTOK; row4 += GRID * 8 * 4) {
    v4u raw[4];
#pragma unroll
    for (int rr = 0; rr < 4; ++rr) raw[rr] = *(const v4u*)(A + (size_t)(row4 + rr) * 512 + lane * 8);
#pragma unroll
    for (int rr = 0; rr < 4; ++rr) {
    const int row = row4 + rr;
    float v[8];
    unpack8(raw[rr], v);
    float ss = 0.f;
#pragma unroll
    for (int k = 0; k < 8; ++k) ss += v[k] * v[k];
    const float ssq = wsum64(lane < 32 ? ss : 0.f), sskv = wsum64((lane >= 32 && lane < 48) ? ss : 0.f);
    if (lane < 32) {
      const float r = rsqrtf(ssq * (1.f / 256.f) + 1e-6f);
      const f32x4_t g0 = *(const f32x4_t*)(qg + lane * 8), g1 = *(const f32x4_t*)(qg + lane * 8 + 4);
      v4u o; o.x = pk2(v[0] * r * g0.x, v[1] * r * g0.y); o.y = pk2(v[2] * r * g0.z, v[3] * r * g0.w); o.z = pk2(v[4] * r * g1.x, v[5] * r * g1.y); o.w = pk2(v[6] * r * g1.z, v[7] * r * g1.w);
      *(v4u*)(CQN + (size_t)row * 256 + lane * 8) = o;
    } else if (lane < 48) {
      const int l = lane - 32;
      const float r = rsqrtf(sskv * (1.f / 128.f) + 1e-6f);
      const f32x4_t g0 = *(const f32x4_t*)(kvg + l * 8), g1 = *(const f32x4_t*)(kvg + l * 8 + 4);
      v4u o; o.x = pk2(v[0] * r * g0.x, v[1] * r * g0.y); o.y = pk2(v[2] * r * g0.z, v[3] * r * g0.w); o.z = pk2(v[4] * r * g1.x, v[5] * r * g1.y); o.w = pk2(v[6] * r * g1.z, v[7] * r * g1.w);
      *(v4u*)(CKVN + (size_t)row * 128 + l * 8) = o;
    } else {
      if (lane < 56) {
        const int l = lane - 48;
        const float* rp = ROPE + (size_t)row * 64 + l * 8;
        const f32x4_t r0 = *(const f32x4_t*)rp, r1 = *(const f32x4_t*)(rp + 4);
        const float cs[4] = {r0.x, r0.z, r1.x, r1.z}, sn[4] = {r0.y, r0.w, r1.y, r1.w};
        float o1[4], o2[4];
#pragma unroll
        for (int k = 0; k < 4; ++k) {
          o1[k] = v[2 * k] * cs[k] - v[2 * k + 1] * sn[k];
          o2[k] = v[2 * k] * sn[k] + v[2 * k + 1] * cs[k];
        }
        v4u o; o.x = pk2(o1[0], o2[0]); o.y = pk2(o1[1], o2[1]); o.z = pk2(o1[2], o2[2]); o.w = pk2(o1[3], o2[3]);
        *(v4u*)(KPE + (size_t)row * 64 + l * 8) = o;
        { v2u o8; o8.x = pg8::pack4_fp8(o1[0], o2[0], o1[1], o2[1]); o8.y = pg8::pack4_fp8(o1[2], o2[2], o1[3], o2[3]); *(v2u*)(KPE8 + (size_t)row * 64 + l * 8) = o8; }
      }
    }
    }
  }
}

struct EpiMlaPrep {
    static constexpr bool PERM = true, AFTER_DRAIN = true;
    const float* qg; const float* kvg; bf16* CQN; bf16* CKVN; bf16* KPE; unsigned char* KPE8; const float* ROPE;
    __device__ __forceinline__ void fused(const pg8::f32x4 (&acc)[2][2][4][2], const pg8::Unit& u, int wr, int wc, int fr, int fq, PG8_LAS unsigned char* lds, int wid, int lane) const {
        constexpr int RS = 528;
#pragma unroll
        for (int ai = 0; ai < 2; ++ai)
#pragma unroll
            for (int m = 0; m < 4; ++m) { const int rl = wr * 64 + fr + ai * pg8::HALF + m * 16;
#pragma unroll
                for (int bj = 0; bj < 2; ++bj) { const pg8::f32x4 v0 = acc[ai][bj][m][0], v1 = acc[ai][bj][m][1];
                    v4u w; w.x = pg8::cvt_pk_bf16(v0[0], v0[1]); w.y = pg8::cvt_pk_bf16(v0[2], v0[3]); w.z = pg8::cvt_pk_bf16(v1[0], v1[1]); w.w = pg8::cvt_pk_bf16(v1[2], v1[3]);
                    *(PG8_LAS v4u*)(lds + rl * RS + (wc * 32 + 8 * fq + bj * pg8::HALF) * 2) = w; } }
        __syncthreads();
        const int l = lane & 31;
#pragma unroll 1
        for (int p = 0; p < 16; ++p) {
            const int rl = wid * 32 + 2 * p + (lane >> 5); const size_t row = (size_t)u.pm * pg8::BM + rl;
            if (u.pn == 0) {
                float v[8]; unpack8(*(const PG8_LAS v4u*)(lds + rl * RS + l * 16), v);
                float ss = 0.f;
#pragma unroll
                for (int k = 0; k < 8; ++k) ss += v[k] * v[k];
                ss += swz_xor<1>(ss); ss += swz_xor<2>(ss); ss += swz_xor<4>(ss); ss += swz_xor<8>(ss); ss += swz_xor<16>(ss);
                const float r = rsqrtf(ss * (1.f / 256.f) + 1e-6f);
                const f32x4_t g0 = *(const f32x4_t*)(qg + l * 8), g1 = *(const f32x4_t*)(qg + l * 8 + 4);
                v4u o; o.x = pk2(v[0] * r * g0.x, v[1] * r * g0.y); o.y = pk2(v[2] * r * g0.z, v[3] * r * g0.w); o.z = pk2(v[4] * r * g1.x, v[5] * r * g1.y); o.w = pk2(v[6] * r * g1.z, v[7] * r * g1.w);
                *(v4u*)(CQN + row * 256 + l * 8) = o;
            } else {
                float v[8]; unpack8(*(const PG8_LAS v4u*)(lds + rl * RS + (l < 24 ? l : 0) * 16), v);
                float ss = 0.f;
#pragma unroll
                for (int k = 0; k < 8; ++k) ss += v[k] * v[k];
                ss += swz_xor<1>(ss); ss += swz_xor<2>(ss); ss += swz_xor<4>(ss); ss += swz_xor<8>(ss);
                if (l < 16) {
                    const float r = rsqrtf(ss * (1.f / 128.f) + 1e-6f);
                    const f32x4_t g0 = *(const f32x4_t*)(kvg + l * 8), g1 = *(const f32x4_t*)(kvg + l * 8 + 4);
                    v4u o; o.x = pk2(v[0] * r * g0.x, v[1] * r * g0.y); o.y = pk2(v[2] * r * g0.z, v[3] * r * g0.w); o.z = pk2(v[4] * r * g1.x, v[5] * r * g1.y); o.w = pk2(v[6] * r * g1.z, v[7] * r * g1.w);
                    *(v4u*)(CKVN + row * 128 + l * 8) = o;
                } else if (l < 24) {
                    const int lp = l - 16;
                    const float* rp = ROPE + row * 64 + lp * 8;
                    const f32x4_t r0 = *(const f32x4_t*)rp, r1 = *(const f32x4_t*)(rp + 4);
                    const float cs[4] = {r0.x, r0.z, r1.x, r1.z}, sn[4] = {r0.y, r0.w, r1.y, r1.w};
                    float o1[4], o2[4];
#pragma unroll
                    for (int k = 0; k < 4; ++k) { o1[k] = v[2 * k] * cs[k] - v[2 * k + 1] * sn[k]; o2[k] = v[2 * k] * sn[k] + v[2 * k + 1] * cs[k]; }
                    v4u o; o.x = pk2(o1[0], o2[0]); o.y = pk2(o1[1], o2[1]); o.z = pk2(o1[2], o2[2]); o.w = pk2(o1[3], o2[3]);
                    *(v4u*)(KPE + row * 64 + lp * 8) = o;
                    { v2u o8; o8.x = pg8::pack4_fp8(o1[0], o2[0], o1[1], o2[1]); o8.y = pg8::pack4_fp8(o1[2], o2[2], o1[3], o2[3]); *(v2u*)(KPE8 + row * 64 + lp * 8) = o8; }
                }
            }
        }
    }
};

namespace att {
typedef short s16x4 __attribute__((ext_vector_type(4)));
typedef unsigned u32x4_ __attribute__((ext_vector_type(4)));
constexpr int SHM_V = 64 * 128 * 2, SHM_K = 64 * 192 * 2;
constexpr float THRL = 8.f * 1.4426950408889634f;
constexpr int NQR = 12;
#define AT_KSWZ(row, colB) ((row) * 384 + ((colB) ^ (((row) & 7) << 4)))
#define AT_SBAR() __builtin_amdgcn_sched_barrier(0)
__device__ __forceinline__ int crow(int r, int hi) { return (r & 3) + 8 * (r >> 2) + 4 * hi; }
__device__ __forceinline__ unsigned cvtpk(float lo, float hi) { unsigned r; asm volatile("v_cvt_pk_bf16_f32 %0, %1, %2" : "=v"(r) : "v"(lo), "v"(hi)); return r; }
__device__ __forceinline__ void partialSM(f32x16_t& p0, f32x16_t& p1, float& m_reg, float& mn, float& alpha) {
  float pmax = p0[0];
#pragma unroll
  for (int r = 1; r < 16; ++r) pmax = fmaxf(pmax, p0[r]);
#pragma unroll
  for (int r = 0; r < 16; ++r) pmax = fmaxf(pmax, p1[r]);
  { auto rr = __builtin_amdgcn_permlane32_swap(__float_as_uint(pmax), __float_as_uint(pmax), false, false);
    pmax = fmaxf(__uint_as_float(rr[0]), __uint_as_float(rr[1])); }
  if (__builtin_expect(__all(pmax - m_reg <= THRL), 1)) { mn = m_reg; alpha = 1.f; }
  else { mn = fmaxf(m_reg, pmax); alpha = __builtin_amdgcn_exp2f(m_reg - mn); m_reg = mn; }
#pragma unroll
  for (int r = 0; r < 16; ++r) p0[r] = p0[r] - mn;
#pragma unroll
  for (int r = 0; r < 16; ++r) p1[r] = p1[r] - mn;
#pragma unroll
  for (int r = 0; r < 16; ++r) p0[r] = __builtin_amdgcn_exp2f(p0[r]);
}
__device__ __forceinline__ void finishSM(f32x16_t& p0, f32x16_t& p1, float alpha, float& l_reg, bf16x8_t& pa0, bf16x8_t& pa1, bf16x8_t& pa2, bf16x8_t& pa3) {
#pragma unroll
  for (int r = 0; r < 16; ++r) p1[r] = __builtin_amdgcn_exp2f(p1[r]);
  float ps = 0;
#pragma unroll
  for (int r = 0; r < 16; ++r) ps += p0[r];
#pragma unroll
  for (int r = 0; r < 16; ++r) ps += p1[r];
  { auto rr = __builtin_amdgcn_permlane32_swap(__float_as_uint(ps), __float_as_uint(ps), false, false);
    ps = __uint_as_float(rr[0]) + __uint_as_float(rr[1]); }
  l_reg = l_reg * alpha + ps;
#define AT_PK4(P, BASE, OUT) do { unsigned a0 = cvtpk(P[BASE + 0], P[BASE + 1]), a1 = cvtpk(P[BASE + 2], P[BASE + 3]);   \
    unsigned b0 = cvtpk(P[BASE + 4], P[BASE + 5]), b1 = cvtpk(P[BASE + 6], P[BASE + 7]);                              \
    auto r0 = __builtin_amdgcn_permlane32_swap(a0, b0, false, false); auto r1 = __builtin_amdgcn_permlane32_swap(a1, b1, false, false); \
    u32x4_ w = {r0[0], r1[0], r0[1], r1[1]}; OUT = __builtin_bit_cast(bf16x8_t, w); } while (0)
  AT_PK4(p0, 0, pa0); AT_PK4(p0, 8, pa1); AT_PK4(p1, 0, pa2); AT_PK4(p1, 8, pa3);
#undef AT_PK4
}
__device__ __forceinline__ void qkt(f32x16_t& p0, f32x16_t& p1, const LAS char* Ks, const bf16x8_t* qr, const LAS char* qpe, int r32, int hi) {
#pragma unroll
  for (int r = 0; r < 16; ++r) { p0[r] = 0.f; p1[r] = 0.f; }
#pragma unroll
  for (int d0 = 0; d0 < 12; ++d0) { const int cb = (d0 * 16 + hi * 8) * 2;
    const bf16x8_t b0 = *(const LAS bf16x8_t*)(Ks + AT_KSWZ(r32, cb));
    const bf16x8_t b1 = *(const LAS bf16x8_t*)(Ks + AT_KSWZ(32 + r32, cb));
    const bf16x8_t qf = d0 < NQR ? qr[d0 < NQR ? d0 : 0] : *(const LAS bf16x8_t*)(qpe + (d0 - NQR) * 1024);
    p0 = __builtin_amdgcn_mfma_f32_32x32x16_bf16(b0, qf, p0, 0, 0, 0);
    p1 = __builtin_amdgcn_mfma_f32_32x32x16_bf16(b1, qf, p1, 0, 0, 0);
    if ((d0 & 3) == 3) AT_SBAR(); }
}
__device__ __forceinline__ int v_st(int k, int c) { const int kk = (k & ~0xC) | ((k & 4) << 1) | ((k & 8) >> 1); return ((kk >> 3) * 4 + (c >> 5)) * 512 + ((kk & 7) * 32 + (c & 31)) * 2; }
__device__ __forceinline__ int v_rd_base(int lane) { return ((lane & 3) << 3) | (((lane >> 2) & 3) << 6) | (((lane >> 4) & 1) << 5) | (((lane >> 5) & 1) << 8); }
constexpr int v_rd_off(int d0, int ks, int half) { return d0 * 512 + ks * 4096 + half * 2048; }
template <int OFF> __device__ __forceinline__ s16x4 tr_read(int vb) {
  s16x4 r; asm volatile("ds_read_b64_tr_b16 %0, %1 offset:%2" : "=&v"(r) : "v"(vb), "i"(OFF) : "memory"); return r;
}
template <int D0> __device__ __forceinline__ void pv_one(f32x16_t& od, int vb, bf16x8_t pa0, bf16x8_t pa1, bf16x8_t pa2, bf16x8_t pa3) {
  const s16x4 l0 = tr_read<v_rd_off(D0, 0, 0)>(vb), h0 = tr_read<v_rd_off(D0, 0, 1)>(vb), l1 = tr_read<v_rd_off(D0, 1, 0)>(vb), h1 = tr_read<v_rd_off(D0, 1, 1)>(vb);
  const s16x4 l2 = tr_read<v_rd_off(D0, 2, 0)>(vb), h2 = tr_read<v_rd_off(D0, 2, 1)>(vb), l3 = tr_read<v_rd_off(D0, 3, 0)>(vb), h3 = tr_read<v_rd_off(D0, 3, 1)>(vb);
  asm volatile("s_waitcnt lgkmcnt(0)" ::: "memory"); AT_SBAR();
#define AT_PK(L, H) (bf16x8_t){L[0], L[1], L[2], L[3], H[0], H[1], H[2], H[3]}
  od = __builtin_amdgcn_mfma_f32_32x32x16_bf16(pa0, AT_PK(l0, h0), od, 0, 0, 0);
  od = __builtin_amdgcn_mfma_f32_32x32x16_bf16(pa1, AT_PK(l1, h1), od, 0, 0, 0);
  od = __builtin_amdgcn_mfma_f32_32x32x16_bf16(pa2, AT_PK(l2, h2), od, 0, 0, 0);
  od = __builtin_amdgcn_mfma_f32_32x32x16_bf16(pa3, AT_PK(l3, h3), od, 0, 0, 0);
#undef AT_PK
}
__device__ __forceinline__ void pv_d0(f32x16_t* o, int vb, bf16x8_t pa0, bf16x8_t pa1, bf16x8_t pa2, bf16x8_t pa3) {
  pv_one<0>(o[0], vb, pa0, pa1, pa2, pa3); pv_one<1>(o[1], vb, pa0, pa1, pa2, pa3); pv_one<2>(o[2], vb, pa0, pa1, pa2, pa3); pv_one<3>(o[3], vb, pa0, pa1, pa2, pa3);
}
__device__ __forceinline__ void attn_unit(int tid, const bf16* __restrict__ Qb, const bf16* __restrict__ Kn, const bf16* __restrict__ Kp, const bf16* __restrict__ Vh,
                                          bf16* __restrict__ Ob, LAS char* lds) {
  (void)Vh;
  const int wid = tid >> 6, lane = tid & 63, r32 = lane & 31, hi = lane >> 5;
  LAS char* V_lds = lds; LAS char* K_lds = lds + 2 * SHM_V;
  LAS float* wsx = (LAS float*)(lds + 2 * SHM_V + 2 * SHM_K) + wid * 64; LAS float* li_l = wsx; LAS float* al_l = wsx + 32;
  float m_reg = -1e30f, l_reg = 0;
  f32x16_t o[4];
#pragma unroll
  for (int d = 0; d < 4; ++d)
#pragma unroll
    for (int r = 0; r < 16; ++r) o[d][r] = 0.f;
  bf16x8_t qr[NQR];
  LAS char* qpe = lds + 2 * SHM_V + 2 * SHM_K + 2048 + wid * ((12 - NQR) * 1024) + lane * 16;
  const unsigned qoff = (unsigned)((wid * 32 + r32) * 1536 + hi * 8);
#pragma unroll
  for (int d0 = 0; d0 < NQR; ++d0) qr[d0] = *(const bf16x8_t*)(Qb + (qoff + (unsigned)(d0 * 16)));
#pragma unroll
  for (int d0 = NQR; d0 < 12; ++d0) *(LAS bf16x8_t*)(qpe + (d0 - NQR) * 1024) = *(const bf16x8_t*)(Qb + (qoff + (unsigned)(d0 * 16)));
  const int sr = tid >> 4, sc = (tid & 15) * 8, vst0 = v_st(sr, sc), vst1 = v_st(32 + sr, sc);
  const int rk = tid >> 3, ck = (tid & 7) * 8;
  const int vb0 = (int)(unsigned)(size_t)V_lds + v_rd_base(lane);
  bf16x8_t vs0, vs1, ks0, ks1, kp0;
  const unsigned okv = (unsigned)(sr * 2048 + sc), okp = (unsigned)(rk * 64 + ck);
#define AT_SLOAD(k0) do { const unsigned t0_ = (unsigned)(k0) * 2048u + okv, t1_ = t0_ + 32u * 2048u; \
    ks0 = *(const bf16x8_t*)(Kn + t0_); vs0 = *(const bf16x8_t*)(Kn + t0_ + 128u); ks1 = *(const bf16x8_t*)(Kn + t1_); vs1 = *(const bf16x8_t*)(Kn + t1_ + 128u); \
    kp0 = *(const bf16x8_t*)(Kp + (unsigned)(k0) * 64u + okp); } while (0)
#define AT_SWRITE(b) do { *(LAS bf16x8_t*)(V_lds + (b) * SHM_V + vst0) = vs0; *(LAS bf16x8_t*)(V_lds + (b) * SHM_V + vst1) = vs1; \
    *(LAS bf16x8_t*)(K_lds + (b) * SHM_K + AT_KSWZ(sr, sc * 2)) = ks0; *(LAS bf16x8_t*)(K_lds + (b) * SHM_K + AT_KSWZ(32 + sr, sc * 2)) = ks1; \
    *(LAS bf16x8_t*)(K_lds + (b) * SHM_K + AT_KSWZ(rk, 256 + ck * 2)) = kp0; } while (0)
#define AT_SWAIT() asm volatile("s_waitcnt vmcnt(0)" ::: "memory")
#define AT_RESC(a) do { if (__any((a) < 1.f)) { if (hi == 0) al_l[r32] = (a); asm volatile("s_waitcnt lgkmcnt(0)" ::: "memory"); \
    _Pragma("unroll") for (int d = 0; d < 4; ++d) _Pragma("unroll") for (int r = 0; r < 16; ++r) o[d][r] *= al_l[crow(r, hi)]; } } while (0)
  f32x16_t pA0, pA1, pB0, pB1; float mnA, mnB, alA, alB; bf16x8_t pa0, pa1, pa2, pa3; constexpr int NT = SEQ / 64;
  AT_SLOAD(0); AT_SWAIT(); AT_SWRITE(0); __syncthreads();
  qkt(pA0, pA1, K_lds, qr, qpe, r32, hi); partialSM(pA0, pA1, m_reg, mnA, alA);
  AT_SLOAD(64);
  AT_SWAIT(); AT_SWRITE(1); __syncthreads();
  for (int j = 1; j + 1 < NT; j += 2) {
    AT_SBAR(); AT_SLOAD((j + 1) * 64); AT_SBAR();
    qkt(pB0, pB1, K_lds + SHM_K, qr, qpe, r32, hi);
    finishSM(pA0, pA1, alA, l_reg, pa0, pa1, pa2, pa3); AT_SBAR();
    pv_d0(o, vb0, pa0, pa1, pa2, pa3); partialSM(pB0, pB1, m_reg, mnB, alB);
    __syncthreads(); AT_SWAIT(); AT_SWRITE(0);
    AT_RESC(alB); __syncthreads();
    AT_SBAR(); AT_SLOAD((j + 2) * 64); AT_SBAR();
    qkt(pA0, pA1, K_lds, qr, qpe, r32, hi);
    finishSM(pB0, pB1, alB, l_reg, pa0, pa1, pa2, pa3); AT_SBAR();
    pv_d0(o, vb0 + SHM_V, pa0, pa1, pa2, pa3); partialSM(pA0, pA1, m_reg, mnA, alA);
    __syncthreads(); AT_SWAIT(); AT_SWRITE(1);
    AT_RESC(alA); __syncthreads();
  }
  AT_SBAR(); qkt(pB0, pB1, K_lds + SHM_K, qr, qpe, r32, hi);
  finishSM(pA0, pA1, alA, l_reg, pa0, pa1, pa2, pa3); AT_SBAR();
  pv_d0(o, vb0, pa0, pa1, pa2, pa3); partialSM(pB0, pB1, m_reg, mnB, alB);
  __syncthreads(); AT_RESC(alB);
  finishSM(pB0, pB1, alB, l_reg, pa0, pa1, pa2, pa3); AT_SBAR();
  pv_d0(o, vb0 + SHM_V, pa0, pa1, pa2, pa3);
  if (hi == 0) li_l[r32] = l_reg;
  asm volatile("s_waitcnt lgkmcnt(0)" ::: "memory");
  float rli[16];
#pragma unroll
  for (int r = 0; r < 16; ++r) rli[r] = __builtin_amdgcn_rcpf(li_l[crow(r, hi)]);
  bf16* Ow = Ob + (size_t)(wid * 32) * 1024 + (hi * 4) * 1024 + r32;
#pragma unroll
  for (int r = 0; r < 16; ++r) {
#pragma unroll
    for (int d0 = 0; d0 < 4; ++d0) Ow[((r & 3) + 8 * (r >> 2)) * 1024 + d0 * 32] = (bf16)f2bf(o[d0][r] * rli[r]); }
#undef AT_SLOAD
#undef AT_SWRITE
#undef AT_SWAIT
#undef AT_RESC
}

constexpr int DK0 = 0, DV0 = 2 * SHM_K, DWS = DV0 + 3 * SHM_V, DQ = DWS + 2048;
__device__ __forceinline__ void glds16(const void* gsrc, unsigned lds_dst) { unsigned keep;
  asm volatile("s_mov_b32 %0, m0\n\ts_mov_b32 m0, %2\n\ts_nop 0\n\tglobal_load_lds_dwordx4 %1, off\n\ts_mov_b32 m0, %0" : "=&s"(keep) : "v"(gsrc), "s"(lds_dst) : "memory"); }
#define AT_VMWAIT() asm volatile("s_waitcnt vmcnt(0)" ::: "memory")
__device__ __forceinline__ void attn_unit_dma(int tid, const bf16* __restrict__ Qb, const bf16* __restrict__ Kn, const bf16* __restrict__ Kp, bf16* __restrict__ Ob, LAS char* lds) {
  const int wid = __builtin_amdgcn_readfirstlane(tid >> 6), lane = tid & 63, r32 = lane & 31, hi = lane >> 5;
  LAS char* K_lds = lds + DK0; LAS char* V_lds = lds + DV0;
  LAS float* wsx = (LAS float*)(lds + DWS) + wid * 64; LAS float* li_l = wsx; LAS float* al_l = wsx + 32;
  float m_reg = -1e30f, l_reg = 0;
  f32x16_t o[4];
#pragma unroll
  for (int d = 0; d < 4; ++d)
#pragma unroll
    for (int r = 0; r < 16; ++r) o[d][r] = 0.f;
  bf16x8_t qr[NQR];
  LAS char* qpe = lds + DQ + wid * ((12 - NQR) * 1024) + lane * 16;
  const unsigned qoff = (unsigned)((wid * 32 + r32) * 1536 + hi * 8);
#pragma unroll
  for (int d0 = 0; d0 < NQR; ++d0) qr[d0] = *(const bf16x8_t*)(Qb + (qoff + (unsigned)(d0 * 16)));
#pragma unroll
  for (int d0 = NQR; d0 < 12; ++d0) *(LAS bf16x8_t*)(qpe + (d0 - NQR) * 1024) = *(const bf16x8_t*)(Qb + (qoff + (unsigned)(d0 * 16)));
  unsigned ksrc[3]; bool kpe[3]; unsigned vsrc[2];
#pragma unroll
  for (int i = 0; i < 3; ++i) { const int p = (3 * wid + i) * 64 + lane, row = p / 24, chp = p - row * 24, c = chp ^ (row & 7);
    kpe[i] = c >= 16; ksrc[i] = kpe[i] ? (unsigned)(row * 64 + (c - 16) * 8) : (unsigned)(row * 2048 + c * 8); }
#pragma unroll
  for (int i = 0; i < 2; ++i) { const int p = (2 * wid + i) * 64 + lane, sub = p >> 5, kk = (sub >> 2) * 8 + ((p >> 2) & 7), c = (sub & 3) * 32 + (p & 3) * 8;
    const int k = (kk & ~0xC) | ((kk & 4) << 1) | ((kk & 8) >> 1);
    vsrc[i] = (unsigned)(k * 2048 + c + 128); }
  const unsigned ldsb = (unsigned)(size_t)lds;
  const unsigned kdst = ldsb + DK0 + (unsigned)(3 * wid) * 1024u, vdst = ldsb + DV0 + (unsigned)(2 * wid) * 1024u;
#define AT_DMA(k0, ks, vs) do { const unsigned tk_ = (unsigned)(k0) * 2048u, tp_ = (unsigned)(k0) * 64u; \
    _Pragma("unroll") for (int i_ = 0; i_ < 3; ++i_) glds16(kpe[i_] ? (const void*)(Kp + (tp_ + ksrc[i_])) : (const void*)(Kn + (tk_ + ksrc[i_])), kdst + (unsigned)(ks) * SHM_K + i_ * 1024u); \
    _Pragma("unroll") for (int i_ = 0; i_ < 2; ++i_) glds16((const void*)(Kn + (tk_ + vsrc[i_])), vdst + (unsigned)(vs) * SHM_V + i_ * 1024u); } while (0)
#define AT_RESC(a) do { if (__any((a) < 1.f)) { if (hi == 0) al_l[r32] = (a); asm volatile("s_waitcnt lgkmcnt(0)" ::: "memory"); \
    _Pragma("unroll") for (int d = 0; d < 4; ++d) _Pragma("unroll") for (int r = 0; r < 16; ++r) o[d][r] *= al_l[crow(r, hi)]; } } while (0)
  const int vbb = (int)(ldsb + DV0) + v_rd_base(lane);
  f32x16_t pA0, pA1, pB0, pB1; float mnA, mnB, alA, alB; bf16x8_t pa0, pa1, pa2, pa3; constexpr int NT = SEQ / 64;
  AT_DMA(0, 0, 0); AT_VMWAIT(); __syncthreads();
  AT_DMA(64, 1, 1);
  qkt(pA0, pA1, K_lds, qr, qpe, r32, hi); partialSM(pA0, pA1, m_reg, mnA, alA);
  AT_VMWAIT(); __syncthreads();
  int vprev = 0;
#pragma unroll 1
  for (int j = 1; j + 1 < NT; j += 2) {
    const int v1 = vprev == 2 ? 0 : vprev + 1, v2 = v1 == 2 ? 0 : v1 + 1, v3 = v2 == 2 ? 0 : v2 + 1;
    AT_DMA((j + 1) * 64, 0, v2);
    AT_SBAR(); qkt(pB0, pB1, K_lds + SHM_K, qr, qpe, r32, hi);
    finishSM(pA0, pA1, alA, l_reg, pa0, pa1, pa2, pa3); AT_SBAR();
    pv_d0(o, vbb + vprev * SHM_V, pa0, pa1, pa2, pa3); partialSM(pB0, pB1, m_reg, mnB, alB);
    AT_RESC(alB);
    AT_VMWAIT(); __syncthreads();
    AT_DMA((j + 2) * 64, 1, v3);
    AT_SBAR(); qkt(pA0, pA1, K_lds, qr, qpe, r32, hi);
    finishSM(pB0, pB1, alB, l_reg, pa0, pa1, pa2, pa3); AT_SBAR();
    pv_d0(o, vbb + v1 * SHM_V, pa0, pa1, pa2, pa3); partialSM(pA0, pA1, m_reg, mnA, alA);
    AT_RESC(alA);
    AT_VMWAIT(); __syncthreads();
    vprev = v2;
  }
  {
    const int v1 = vprev == 2 ? 0 : vprev + 1;
    AT_SBAR(); qkt(pB0, pB1, K_lds + SHM_K, qr, qpe, r32, hi);
    finishSM(pA0, pA1, alA, l_reg, pa0, pa1, pa2, pa3); AT_SBAR();
    pv_d0(o, vbb + vprev * SHM_V, pa0, pa1, pa2, pa3); partialSM(pB0, pB1, m_reg, mnB, alB);
    AT_RESC(alB);
    finishSM(pB0, pB1, alB, l_reg, pa0, pa1, pa2, pa3); AT_SBAR();
    pv_d0(o, vbb + v1 * SHM_V, pa0, pa1, pa2, pa3);
  }
  if (hi == 0) li_l[r32] = l_reg;
  asm volatile("s_waitcnt lgkmcnt(0)" ::: "memory");
  float rli[16];
#pragma unroll
  for (int r = 0; r < 16; ++r) rli[r] = __builtin_amdgcn_rcpf(li_l[crow(r, hi)]);
  bf16* Ow = Ob + (size_t)(wid * 32) * 1024 + (hi * 4) * 1024 + r32;
#pragma unroll
  for (int r = 0; r < 16; ++r) {
#pragma unroll
    for (int d0 = 0; d0 < 4; ++d0) Ow[((r & 3) + 8 * (r >> 2)) * 1024 + d0 * 32] = (bf16)f2bf(o[d0][r] * rli[r]); }
#undef AT_DMA
#undef AT_RESC
}

constexpr int SHM_K8 = 64 * 192;
constexpr int EK0 = 0, EV0 = 2 * SHM_K8, EWS = EV0 + 3 * SHM_V;
typedef int v8i32a_t __attribute__((ext_vector_type(8)));
typedef int v4i32a_t __attribute__((ext_vector_type(4)));
__device__ __forceinline__ v8i32a_t cat8a(v4i32a_t a, v4i32a_t b) { return __builtin_shufflevector(a, b, 0, 1, 2, 3, 4, 5, 6, 7); }
__device__ __forceinline__ void qkt8(f32x16_t& p0, f32x16_t& p1, const LAS char* Ks, const v8i32a_t* q8, int r32, int hi) {
#pragma unroll
  for (int r = 0; r < 16; ++r) { p0[r] = 0.f; p1[r] = 0.f; }
  const int f0 = (r32 >> 2) & 3;
#pragma unroll
  for (int ks = 0; ks < 3; ++ks) {
    const int L0 = 4 * ks + 2 * hi;
    const LAS char* ra = Ks + r32 * 192; const LAS char* rb = Ks + (32 + r32) * 192;
    const v8i32a_t ka = cat8a(*(const LAS v4i32a_t*)(ra + ((L0 ^ f0) << 4)), *(const LAS v4i32a_t*)(ra + (((L0 + 1) ^ f0) << 4)));
    const v8i32a_t kb = cat8a(*(const LAS v4i32a_t*)(rb + ((L0 ^ f0) << 4)), *(const LAS v4i32a_t*)(rb + (((L0 + 1) ^ f0) << 4)));
    p0 = __builtin_amdgcn_mfma_scale_f32_32x32x64_f8f6f4(ka, q8[ks], p0, 0, 0, 0, 0x7f7f7f7f, 0, 0x7f7f7f7f);
    p1 = __builtin_amdgcn_mfma_scale_f32_32x32x64_f8f6f4(kb, q8[ks], p1, 0, 0, 0, 0x7f7f7f7f, 0, 0x7f7f7f7f);
  }
}
__device__ __forceinline__ void attn_unit_dma8(int tid, const unsigned char* __restrict__ Q8, const unsigned char* __restrict__ K8, const unsigned char* __restrict__ Kp8,
                                               const bf16* __restrict__ Vb, bf16* __restrict__ Ob, LAS char* lds) {
  const int wid = __builtin_amdgcn_readfirstlane(tid >> 6), lane = tid & 63, r32 = lane & 31, hi = lane >> 5;
  LAS char* K_lds = lds + EK0;
  LAS float* wsx = (LAS float*)(lds + EWS) + wid * 64; LAS float* li_l = wsx; LAS float* al_l = wsx + 32;
  float m_reg = -1e30f, l_reg = 0;
  f32x16_t o[4];
#pragma unroll
  for (int d = 0; d < 4; ++d)
#pragma unroll
    for (int r = 0; r < 16; ++r) o[d][r] = 0.f;
  v8i32a_t q8[3];
  { const unsigned qoff = (unsigned)((wid * 32 + r32) * 1536 + hi * 32);
#pragma unroll
    for (int ks = 0; ks < 3; ++ks) q8[ks] = cat8a(*(const v4i32a_t*)(Q8 + qoff + ks * 64), *(const v4i32a_t*)(Q8 + qoff + ks * 64 + 16)); }
  unsigned ksrc[2]; bool kpe[2]; unsigned vsrc[2];
#pragma unroll
  for (int i = 0; i < 2; ++i) { const int p = (8 * i + wid) * 64 + lane, row = p / 12, chp = p - row * 12, c = chp ^ ((row >> 2) & 3);
    kpe[i] = c >= 8; ksrc[i] = kpe[i] ? (unsigned)(row * 64 + (c - 8) * 16) : (unsigned)(row * 1024 + c * 16); }
#pragma unroll
  for (int i = 0; i < 2; ++i) { const int p = (2 * wid + i) * 64 + lane, sub = p >> 5, kk = (sub >> 2) * 8 + ((p >> 2) & 7), c = (sub & 3) * 32 + (p & 3) * 8;
    const int k = (kk & ~0xC) | ((kk & 4) << 1) | ((kk & 8) >> 1);
    vsrc[i] = (unsigned)(k * 2048 + c); }
  const unsigned ldsb = (unsigned)(size_t)lds;
  const unsigned kdst = ldsb + EK0 + (unsigned)wid * 1024u, vdst = ldsb + EV0 + (unsigned)(2 * wid) * 1024u;
#define AT_DMA8(k0, ks, vs) do { const unsigned tk_ = (unsigned)(k0) * 1024u, tp_ = (unsigned)(k0) * 64u, tv_ = (unsigned)(k0) * 2048u; \
    glds16(kpe[0] ? (const void*)(Kp8 + (tp_ + ksrc[0])) : (const void*)(K8 + (tk_ + ksrc[0])), kdst + (unsigned)(ks) * SHM_K8); \
    if (wid < 4) glds16(kpe[1] ? (const void*)(Kp8 + (tp_ + ksrc[1])) : (const void*)(K8 + (tk_ + ksrc[1])), kdst + (unsigned)(ks) * SHM_K8 + 8192u); \
    _Pragma("unroll") for (int i_ = 0; i_ < 2; ++i_) glds16((const void*)(Vb + (tv_ + vsrc[i_])), vdst + (unsigned)(vs) * SHM_V + i_ * 1024u); } while (0)
#define AT_RESC(a) do { if (__any((a) < 1.f)) { if (hi == 0) al_l[r32] = (a); asm volatile("s_waitcnt lgkmcnt(0)" ::: "memory"); \
    _Pragma("unroll") for (int d = 0; d < 4; ++d) _Pragma("unroll") for (int r = 0; r < 16; ++r) o[d][r] *= al_l[crow(r, hi)]; } } while (0)
  const int vbb = (int)(ldsb + EV0) + v_rd_base(lane);
  f32x16_t pA0, pA1, pB0, pB1; float mnA, mnB, alA, alB; bf16x8_t pa0, pa1, pa2, pa3; constexpr int NT = SEQ / 64;
  AT_DMA8(0, 0, 0); AT_VMWAIT(); __syncthreads();
  AT_DMA8(64, 1, 1);
  qkt8(pA0, pA1, K_lds, q8, r32, hi); partialSM(pA0, pA1, m_reg, mnA, alA);
  AT_VMWAIT(); __syncthreads();
  int vprev = 0;
#pragma unroll 1
  for (int j = 1; j + 1 < NT; j += 2) {
    const int v1 = vprev == 2 ? 0 : vprev + 1, v2 = v1 == 2 ? 0 : v1 + 1, v3 = v2 == 2 ? 0 : v2 + 1;
    AT_DMA8((j + 1) * 64, 0, v2);
    AT_SBAR(); qkt8(pB0, pB1, K_lds + SHM_K8, q8, r32, hi);
    finishSM(pA0, pA1, alA, l_reg, pa0, pa1, pa2, pa3); AT_SBAR();
    pv_d0(o, vbb + vprev * SHM_V, pa0, pa1, pa2, pa3); partialSM(pB0, pB1, m_reg, mnB, alB);
    AT_RESC(alB);
    AT_VMWAIT(); __syncthreads();
    AT_DMA8((j + 2) * 64, 1, v3);
    AT_SBAR(); qkt8(pA0, pA1, K_lds, q8, r32, hi);
    finishSM(pB0, pB1, alB, l_reg, pa0, pa1, pa2, pa3); AT_SBAR();
    pv_d0(o, vbb + v1 * SHM_V, pa0, pa1, pa2, pa3); partialSM(pA0, pA1, m_reg, mnA, alA);
    AT_RESC(alA);
    AT_VMWAIT(); __syncthreads();
    vprev = v2;
  }
  {
    const int v1 = vprev == 2 ? 0 : vprev + 1;
    AT_SBAR(); qkt8(pB0, pB1, K_lds + SHM_K8, q8, r32, hi);
    finishSM(pA0, pA1, alA, l_reg, pa0, pa1, pa2, pa3); AT_SBAR();
    pv_d0(o, vbb + vprev * SHM_V, pa0, pa1, pa2, pa3); partialSM(pB0, pB1, m_reg, mnB, alB);
    AT_RESC(alB);
    finishSM(pB0, pB1, alB, l_reg, pa0, pa1, pa2, pa3); AT_SBAR();
    pv_d0(o, vbb + v1 * SHM_V, pa0, pa1, pa2, pa3);
  }
  if (hi == 0) li_l[r32] = l_reg;
  asm volatile("s_waitcnt lgkmcnt(0)" ::: "memory");
  float rli[16];
#pragma unroll
  for (int r = 0; r < 16; ++r) rli[r] = __builtin_amdgcn_rcpf(li_l[crow(r, hi)]);
  bf16* Ow = Ob + (size_t)(wid * 32) * 1024 + (hi * 4) * 1024 + r32;
#pragma unroll
  for (int r = 0; r < 16; ++r) {
#pragma unroll
    for (int d0 = 0; d0 < 4; ++d0) Ow[((r & 3) + 8 * (r >> 2)) * 1024 + d0 * 32] = (bf16)f2bf(o[d0][r] * rli[r]); }
#undef AT_DMA8
#undef AT_RESC
}

constexpr int SHM_V8 = 128 * 64;
constexpr int FK0 = 0, FV0 = 2 * SHM_K8, FWS = FV0 + 3 * SHM_V8;
constexpr float THRL8 = 8.0f;
__device__ __forceinline__ unsigned pk4f8(float a, float b, float c, float d) { int p = __builtin_amdgcn_cvt_pk_fp8_f32(a, b, 0, false); p = __builtin_amdgcn_cvt_pk_fp8_f32(c, d, p, true); return (unsigned)p; }
__device__ __forceinline__ void partialSM8(f32x16_t& p0, f32x16_t& p1, float& m_reg, float& mn, float& alpha) {
  float pmax = p0[0];
#pragma unroll
  for (int r = 1; r < 16; ++r) pmax = fmaxf(pmax, p0[r]);
#pragma unroll
  for (int r = 0; r < 16; ++r) pmax = fmaxf(pmax, p1[r]);
  { auto rr = __builtin_amdgcn_permlane32_swap(__float_as_uint(pmax), __float_as_uint(pmax), false, false);
    pmax = fmaxf(__uint_as_float(rr[0]), __uint_as_float(rr[1])); }
  if (__builtin_expect(__all(pmax - m_reg <= THRL8), 1)) { mn = m_reg; alpha = 1.f; }
  else { mn = fmaxf(m_reg, pmax); alpha = __builtin_amdgcn_exp2f(m_reg - mn); m_reg = mn; }
#pragma unroll
  for (int r = 0; r < 16; ++r) p0[r] = p0[r] - mn;
#pragma unroll
  for (int r = 0; r < 16; ++r) p1[r] = p1[r] - mn;
#pragma unroll
  for (int r = 0; r < 16; ++r) p0[r] = __builtin_amdgcn_exp2f(p0[r]);
}
__device__ __forceinline__ void finishSM8(f32x16_t& p0, f32x16_t& p1, float alpha, float& l_reg, v8i32a_t& pa) {
#pragma unroll
  for (int r = 0; r < 16; ++r) p1[r] = __builtin_amdgcn_exp2f(p1[r]);
  float ps = 0;
#pragma unroll
  for (int r = 0; r < 16; ++r) ps += p0[r];
#pragma unroll
  for (int r = 0; r < 16; ++r) ps += p1[r];
  { auto rr = __builtin_amdgcn_permlane32_swap(__float_as_uint(ps), __float_as_uint(ps), false, false);
    ps = __uint_as_float(rr[0]) + __uint_as_float(rr[1]); }
  l_reg = l_reg * alpha + ps;
  pa[0] = (int)pk4f8(p0[0], p0[1], p0[2], p0[3]);   pa[1] = (int)pk4f8(p0[4], p0[5], p0[6], p0[7]);
  pa[2] = (int)pk4f8(p0[8], p0[9], p0[10], p0[11]); pa[3] = (int)pk4f8(p0[12], p0[13], p0[14], p0[15]);
  pa[4] = (int)pk4f8(p1[0], p1[1], p1[2], p1[3]);   pa[5] = (int)pk4f8(p1[4], p1[5], p1[6], p1[7]);
  pa[6] = (int)pk4f8(p1[8], p1[9], p1[10], p1[11]); pa[7] = (int)pk4f8(p1[12], p1[13], p1[14], p1[15]);
}
__device__ __forceinline__ void pv8(f32x16_t* o, const LAS char* Vs, v8i32a_t pa, int r32, int hi) {
#pragma unroll
  for (int d0 = 0; d0 < 4; ++d0) {
    const int d = 32 * d0 + r32, f = (d >> 2) & 3;
    const LAS char* rp = Vs + d * 64;
    const v8i32a_t vf = cat8a(*(const LAS v4i32a_t*)(rp + (((2 * hi) ^ f) << 4)), *(const LAS v4i32a_t*)(rp + (((2 * hi + 1) ^ f) << 4)));
    o[d0] = __builtin_amdgcn_mfma_scale_f32_32x32x64_f8f6f4(pa, vf, o[d0], 0, 0, 0, 0x7f7f7f7f, 0, 0x7f7f7f7f);
  }
}
__device__ __forceinline__ void attn_unit_f8(int tid, const unsigned char* __restrict__ Q8, const unsigned char* __restrict__ K8, const unsigned char* __restrict__ Kp8,
                                             const unsigned char* __restrict__ V8T, bf16* __restrict__ Ob, LAS char* lds) {
  const int wid = __builtin_amdgcn_readfirstlane(tid >> 6), lane = tid & 63, r32 = lane & 31, hi = lane >> 5;
  LAS char* K_lds = lds + FK0; LAS char* V_lds = lds + FV0;
  LAS float* wsx = (LAS float*)(lds + FWS) + wid * 64; LAS float* li_l = wsx; LAS float* al_l = wsx + 32;
  float m_reg = -1e30f, l_reg = 0;
  f32x16_t o[4];
#pragma unroll
  for (int d = 0; d < 4; ++d)
#pragma unroll
    for (int r = 0; r < 16; ++r) o[d][r] = 0.f;
  v8i32a_t q8[3];
  { const unsigned qoff = (unsigned)((wid * 32 + r32) * 1536 + hi * 32);
#pragma unroll
    for (int ks = 0; ks < 3; ++ks) q8[ks] = cat8a(*(const v4i32a_t*)(Q8 + qoff + ks * 64), *(const v4i32a_t*)(Q8 + qoff + ks * 64 + 16)); }
  unsigned ksrc[2]; bool kpe[2]; unsigned vsrc;
#pragma unroll
  for (int i = 0; i < 2; ++i) { const int p = (8 * i + wid) * 64 + lane, row = p / 12, chp = p - row * 12, c = chp ^ ((row >> 2) & 3);
    kpe[i] = c >= 8; ksrc[i] = kpe[i] ? (unsigned)(row * 64 + (c - 8) * 16) : (unsigned)(row * 1024 + c * 16); }
  { const int p = wid * 64 + lane, d = p >> 2, c = (p & 3) ^ ((d >> 2) & 3); vsrc = (unsigned)(d * 64 + c * 16); }
  const unsigned ldsb = (unsigned)(size_t)lds;
  const unsigned kdst = ldsb + FK0 + (unsigned)wid * 1024u, vdst = ldsb + FV0 + (unsigned)wid * 1024u;
#define AT_DMAF(k0, ks, vs) do { const unsigned tk_ = (unsigned)(k0) * 1024u, tp_ = (unsigned)(k0) * 64u, tv_ = (unsigned)(k0) * 128u; \
    glds16(kpe[0] ? (const void*)(Kp8 + (tp_ + ksrc[0])) : (const void*)(K8 + (tk_ + ksrc[0])), kdst + (unsigned)(ks) * SHM_K8); \
    if (wid < 4) glds16(kpe[1] ? (const void*)(Kp8 + (tp_ + ksrc[1])) : (const void*)(K8 + (tk_ + ksrc[1])), kdst + (unsigned)(ks) * SHM_K8 + 8192u); \
    glds16((const void*)(V8T + (tv_ + vsrc)), vdst + (unsigned)(vs) * SHM_V8); } while (0)
#define AT_RESC(a) do { if (__any((a) < 1.f)) { if (hi == 0) al_l[r32] = (a); asm volatile("s_waitcnt lgkmcnt(0)" ::: "memory"); \
    _Pragma("unroll") for (int d = 0; d < 4; ++d) _Pragma("unroll") for (int r = 0; r < 16; ++r) o[d][r] *= al_l[crow(r, hi)]; } } while (0)
  f32x16_t pA0, pA1, pB0, pB1; float mnA, mnB, alA, alB; v8i32a_t pa; constexpr int NT = SEQ / 64;
  AT_DMAF(0, 0, 0); AT_VMWAIT(); __syncthreads();
  AT_DMAF(64, 1, 1);
  qkt8(pA0, pA1, K_lds, q8, r32, hi); partialSM8(pA0, pA1, m_reg, mnA, alA);
  AT_VMWAIT(); __syncthreads();
  int vprev = 0;
#pragma unroll 1
  for (int j = 1; j + 1 < NT; j += 2) {
    const int v1 = vprev == 2 ? 0 : vprev + 1, v2 = v1 == 2 ? 0 : v1 + 1, v3 = v2 == 2 ? 0 : v2 + 1;
    AT_DMAF((j + 1) * 64, 0, v2);
    AT_SBAR(); qkt8(pB0, pB1, K_lds + SHM_K8, q8, r32, hi);
    finishSM8(pA0, pA1, alA, l_reg, pa); AT_SBAR();
    pv8(o, V_lds + vprev * SHM_V8, pa, r32, hi); partialSM8(pB0, pB1, m_reg, mnB, alB);
    AT_RESC(alB);
    AT_VMWAIT(); __syncthreads();
    AT_DMAF((j + 2) * 64, 1, v3);
    AT_SBAR(); qkt8(pA0, pA1, K_lds, q8, r32, hi);
    finishSM8(pB0, pB1, alB, l_reg, pa); AT_SBAR();
    pv8(o, V_lds + v1 * SHM_V8, pa, r32, hi); partialSM8(pA0, pA1, m_reg, mnA, alA);
    AT_RESC(alA);
    AT_VMWAIT(); __syncthreads();
    vprev = v2;
  }
  {
    const int v1 = vprev == 2 ? 0 : vprev + 1;
    AT_SBAR(); qkt8(pB0, pB1, K_lds + SHM_K8, q8, r32, hi);
    finishSM8(pA0, pA1, alA, l_reg, pa); AT_SBAR();
    pv8(o, V_lds + vprev * SHM_V8, pa, r32, hi); partialSM8(pB0, pB1, m_reg, mnB, alB);
    AT_RESC(alB);
    finishSM8(pB0, pB1, alB, l_reg, pa); AT_SBAR();
    pv8(o, V_lds + v1 * SHM_V8, pa, r32, hi);
  }
  if (hi == 0) li_l[r32] = l_reg;
  asm volatile("s_waitcnt lgkmcnt(0)" ::: "memory");
  float rli[16];
#pragma unroll
  for (int r = 0; r < 16; ++r) rli[r] = __builtin_amdgcn_rcpf(li_l[crow(r, hi)]);
  bf16* Ow = Ob + (size_t)(wid * 32) * 1024 + (hi * 4) * 1024 + r32;
#pragma unroll
  for (int r = 0; r < 16; ++r) {
#pragma unroll
    for (int d0 = 0; d0 < 4; ++d0) Ow[((r & 3) + 8 * (r >> 2)) * 1024 + d0 * 32] = (bf16)f2bf(o[d0][r] * rli[r]); }
#undef AT_DMAF
#undef AT_RESC
}
}
__device__ __forceinline__ const float* karg(int i) {
  unsigned long long p = (unsigned long long)__builtin_amdgcn_kernarg_segment_ptr();
  asm volatile("" : "+s"(p));
  return ((const float* const __attribute__((address_space(4)))*)p)[i];
}
#define x_in karg(0)
#define C_IN karg(1)
#define positions_f karg(2)
#define ada_w karg(3)
#define ada_b karg(4)
#define norm_mix_g karg(5)
#define norm_ffn_g karg(6)
#define hy_w_in karg(7)
#define hy_b_in karg(8)
#define hy_conv_w karg(9)
#define hy_conv_b karg(10)
#define hy_f_w1 karg(11)
#define hy_f_b1 karg(12)
#define hy_f_w2 karg(13)
#define hy_f_b2 karg(14)
#define hy_f_w3 karg(15)
#define hy_f_freq karg(16)
#define hy_f_bias karg(17)
#define hy_w_out karg(18)
#define hy_b_out karg(19)
#define mla_w_in karg(20)
#define mla_q_norm_g karg(21)
#define mla_w_qb karg(22)
#define mla_kv_norm_g karg(23)
#define mla_w_kvb karg(24)
#define mla_w_out karg(25)
#define moe_w_router karg(26)
#define moe_w_gate karg(27)
#define moe_w_up karg(28)
#define moe_w_down karg(29)
#define final_norm_g karg(30)
#define positions ((const int*)karg(2))
#define XRES ((float*)karg(31))
#define WSB ((unsigned char*)karg(32))
#define MiB ((size_t)1 << 20)
#define WhoT ((bf16*)(WSB + 24 * MiB))
#define WmoT ((bf16*)(WSB + 26 * MiB))
#define Ybf ((bf16*)(WSB + 512 * MiB))
#define ws ((float*)(WSB + 40 * MiB))
#define Wmoe ((bf16*)(WSB + 48 * MiB))
#define WmoeD ((bf16*)((unsigned char*)Wmoe + (size_t)NE * 2048 * 1024))
#define XNb ((bf16*)(WSB + 144 * MiB))
#define XSb ((bf16*)(WSB + 208 * MiB))
#define HIDb ((bf16*)(WSB + 336 * MiB))
#define WinT ((bf16*)(WSB + 28 * MiB))
#define Upre ((bf16*)(WSB + 208 * MiB))
#define UTb ((bf16*)(WSB + 208 * MiB))
#define XBb ((bf16*)(WSB + 400 * MiB))
#define zTb ((bf16*)(WSB + 400 * MiB))
#define ycTb ((bf16*)(WSB + 464 * MiB))
#define KRb ((unsigned char*)(WSB + 560 * MiB))
#define K0b ((float*)(WSB + 568 * MiB))
#define W3Tb ((bf16*)(WSB + 569 * MiB))
#define WaT ((bf16*)(WSB + 34 * MiB))
#define WqbT ((bf16*)(WSB + 35 * MiB))
#define WkvbT ((bf16*)(WSB + 36 * MiB))
#define Abuf ((bf16*)(WSB + 208 * MiB))
#define CQNb ((bf16*)(WSB + 240 * MiB))
#define CKVNb ((bf16*)(WSB + 256 * MiB))
#define KPEb ((bf16*)(WSB + 272 * MiB))
#define ROPEb ((float*)(WSB + 528 * MiB))
#define Qbuf ((bf16*)(WSB + 288 * MiB))
#define KVbuf ((bf16*)(WSB + 384 * MiB))
#define KPE8b ((unsigned char*)(WSB + 276 * MiB))
#define K8nb ((unsigned char*)(WSB + 336 * MiB))
#define V8Tb ((unsigned char*)(WSB + 208 * MiB))
#define idx_id ((int*)(WSB + 10 * MiB))
#define idx_row ((int*)(WSB + 8 * MiB))
#define gsel_row ((float*)(WSB + 9 * MiB))
#define ACT ((size_t)NTOK * DM)
#define mod (ws)
#define aff (mod + 2 * NB * 6 * DM)
#define gsel (aff + (size_t)NB * NE * SEQ)
#define idx ((int*)(gsel + (size_t)NB * NE * CAP))
#define slot_of (idx + (size_t)NB * NE * CAP)
#define RA ((float*)(slot_of + (size_t)NB * NE * SEQ))
#define RF (RA + ACT)
#define RU (RF + 2 * (size_t)SEQ * DM)
#define RC (RU + (size_t)SEQ * 3072)
#define RD (RC + ACT)

__device__ __forceinline__ void vtrans_phase(int tid_in, unsigned char* lds_, const bf16* KV, unsigned char* V8T) {
  const int tid = launder(tid_in);
  LAS unsigned char* tile = (LAS unsigned char*)lds_;
  const int key = tid & 63, dg = tid >> 6;
  const int a_ = key >> 5, k5 = key & 31, hi_ = (k5 >> 2) & 1, r_ = (k5 & 3) | ((k5 >> 3) << 2), pos = 32 * hi_ + 16 * a_ + r_;
  constexpr int NITEM = NB * 8 * (SEQ / 64);
  v4u ra[2], na[2];
  { const int item = bid(), t = item & 63, bh = item >> 6, b = bh >> 3, h = bh & 7;
    const bf16* src = KV + (size_t)(b * SEQ + t * 64 + key) * 2048 + h * 256 + 128 + dg * 16;
    ra[0] = *(const v4u*)src; ra[1] = *(const v4u*)(src + 8); }
  for (int item = bid(); item < NITEM; item += GRID) {
    { const int nitem = item + GRID < NITEM ? item + GRID : item, t = nitem & 63, bh = nitem >> 6, b = bh >> 3, h = bh & 7;
      const bf16* src = KV + (size_t)(b * SEQ + t * 64 + key) * 2048 + h * 256 + 128 + dg * 16;
      na[0] = *(const v4u*)src; na[1] = *(const v4u*)(src + 8); }
    float v[16];
    unpack8(ra[0], v); unpack8(ra[1], v + 8);
    __syncthreads();
#pragma unroll
    for (int q = 0; q < 4; ++q) { const unsigned w = pg8::pack4_fp8(v[4 * q], v[4 * q + 1], v[4 * q + 2], v[4 * q + 3]);
#pragma unroll
      for (int e = 0; e < 4; ++e) tile[(dg * 16 + 4 * q + e) * 80 + pos] = (unsigned char)(w >> (8 * e)); }
    __syncthreads();
    const int d = tid >> 2, c = tid & 3;
    const v4u o = *(const LAS v4u*)(tile + d * 80 + c * 16);
    *(v4u*)(V8T + (size_t)item * 8192 + d * 64 + c * 16) = o;
    ra[0] = na[0]; ra[1] = na[1];
  }
}
__device__ __forceinline__ void attn_phase(int tid_in, unsigned char* lds_) {
  const int tid = launder(tid_in);
  const int c = bid(), x = c & 7, s_ = c >> 3;
#pragma unroll 1
  for (int i = 0; i < 4; ++i) {
    const int bh = i * 16 + x * 2 + (s_ >> 4), qb = s_ & 15, b = bh >> 3, h = bh & 7;
    __syncthreads();
    att::attn_unit_f8(launder(tid), (const unsigned char*)Qbuf + (size_t)(b * SEQ + qb * 256) * 1536 + h * 192, K8nb + (size_t)(b * SEQ) * 1024 + h * 128, KPE8b + (size_t)(b * SEQ) * 64,
                      V8Tb + (size_t)bh * (64 * 8192), Ybf + (size_t)(b * SEQ + qb * 256) * 1024 + h * 128, (LAS char*)lds_);
  }
}
#define MODL (mod + (size_t)layer * NB * 6 * DM)
#define sh1 (MODL)
#define sc1 (MODL + DM)
#define g1 (MODL + 2 * DM)
#define sh2 (MODL + 3 * DM)
#define sc2 (MODL + 4 * DM)
#define g2 (MODL + 5 * DM)
__device__ __forceinline__ void moe_convert(int tid_in, unsigned char* lds_, int k0, int nk, const float* wg, const float* wu, const float* wd, unsigned char* wm) {
  const int t_ = launder(tid_in), wave = __builtin_amdgcn_readfirstlane(t_ >> 6), lane = t_ & 63;
  LAS float* scr = (LAS float*)((LAS unsigned char*)lds_ + wave * 16384);
  constexpr int I_W = (DM / 64) * (DM / 32);
  const size_t WSZ = (size_t)DM * DM;
  const int gw = bid() * 8 + wave;
#pragma unroll 1
  for (int k = k0; k < k0 + nk; ++k) {
    const int it = gw + k * (GRID * 8);
    const int e = it / (3 * I_W), r = it - e * 3 * I_W, which = r / I_W, item = r - which * I_W;
    if (which == 0) transpose_item_fp8<1>(wg + (size_t)e * WSZ, DM, DM, wm, e * 2048, scr, item, lane);
    else if (which == 1) transpose_item_fp8<1>(wu + (size_t)e * WSZ, DM, DM, wm, e * 2048 + 128, scr, item, lane);
    else transpose_item_fp8<0>(wd + (size_t)e * WSZ, DM, DM, wm + (size_t)NE * 2048 * 1024, e * 1024, scr, item, lane);
  }
}
constexpr int MOE_TA = 20480;
__global__ void __launch_bounds__(NTHR, 2) fwd_megakernel(Args args) {
  extern __shared__ __attribute__((aligned(16))) unsigned char lds[];
  const int tid = threadIdx.x;
  volatile LAS unsigned* misc = (volatile LAS unsigned*)((LAS unsigned char*)lds + (LDS_BYTES - 256));
  if (tid < 64) misc[tid] = 0u;
  __syncthreads();
  unsigned* ctl = (unsigned*)WSB;
  (void)xcd_barrier_post(ctl + 4096, misc + 8);

  mod_phase(tid, lds, C_IN, ada_w, ada_b, mod);
  {
    const int wave = __builtin_amdgcn_readfirstlane(tid >> 6), lane = tid & 63;
    LAS float* scr = (LAS float*)((LAS unsigned char*)lds + wave * 16384);
    const int gw = bid() * 8 + wave, NGW = GRID * 8;
    constexpr int I_O = (DM / 64) * (DM / 32);
    constexpr int I_IN = (DM / 64) * (3072 / 32);
    for (int it = gw; it < 2 * I_O + I_IN; it += NGW) {
      if (it < I_O) transpose_item<0>(hy_w_out, DM, DM, WhoT, 0, scr, it, lane);
      else if (it < 2 * I_O) transpose_item<0>(mla_w_out, DM, DM, WmoT, 0, scr, it - I_O, lane);
      else transpose_item<0>(hy_w_in, DM, 3072, WinT, 0, scr, it - 2 * I_O, lane);
    }
    constexpr int I_A = (DM / 64) * (448 / 32), I_Q = (256 / 64) * (1536 / 32);
    for (int it = gw; it < I_A + I_Q; it += NGW) {
      if (it < I_A) transpose_item<2>(mla_w_in, DM, 448, WaT, 0, scr, it, lane);
      else if (it < I_A + I_Q) transpose_item<3>(mla_w_qb, 256, 1536, WqbT, 0, scr, it - I_A, lane);
    }
    {
      const int gt = bid() * NTHR + launder(tid), NGT = GRID * NTHR;
      for (int q = gt; q < NTOK * 32; q += NGT) {
        const int row = q >> 5, i = q & 31;
        const float ang = (float)positions[row] * powf(10000.0f, -(float)(2 * i) / 64.0f);
        float sn, cs; sincosf(ang, &sn, &cs);
        *(float2*)(ROPEb + (size_t)row * 64 + 2 * i) = make_float2(cs, sn);
      }
    }
    { const int gt = bid() * NTHR + launder(tid); for (int q = gt; q < NE * NB * CAP; q += GRID * NTHR) idx_id[q] = q; }
    {
      const int gt = bid() * NTHR + launder(tid);
      for (int q = gt; q < 2048 * 16; q += GRID * NTHR) {
        const int n = q & 2047, k0 = (q >> 11) * 8, hh = n >> 8, wi = n & 255;
        float w[8];
#pragma unroll
        for (int e = 0; e < 8; ++e) w[e] = mla_w_kvb[(size_t)(k0 + e) * 2048 + n];
        v4u o; o.x = pk2(w[0], w[1]); o.y = pk2(w[2], w[3]); o.z = pk2(w[4], w[5]); o.w = pk2(w[6], w[7]);
        *(v4u*)(WkvbT + (size_t)((wi < 128 ? 0 : 1024) + hh * 128 + (wi & 127)) * 128 + k0) = o;
      }
    }
    {
      const int gt = bid() * NTHR + launder(tid);
      for (int q = gt; q < 2048 * 8; q += GRID * NTHR) {
        const int col = q & 2047, j0 = (q >> 11) * 8;
        float w[8];
#pragma unroll
        for (int e = 0; e < 8; ++e) w[e] = hy_f_w3[(size_t)(j0 + e) * 2048 + col];
        v4u o; o.x = pk2(w[0], w[1]); o.y = pk2(w[2], w[3]); o.z = pk2(w[4], w[5]); o.w = pk2(w[6], w[7]);
        *(v4u*)(W3Tb + (size_t)col * 64 + j0) = o;
      }
    }
    {
      const int gt = bid() * NTHR + launder(tid), NGT = GRID * NTHR;
      for (int q = gt; q < 64 * 1024 / 8; q += NGT) *(v4u*)(WaT + (size_t)448 * 1024 + (size_t)q * 8) = (v4u){0u, 0u, 0u, 0u};
    }
  }
  GBF(0, 0, 2);

  {
    constexpr int layer = 0;
      norm_rows_phase<false>(tid, lds, x_in, norm_mix_g, sh1, sc1, XNb, nullptr, nullptr);
      filter_phase(tid, lds, hy_f_w1, hy_f_b1, hy_f_w2, hy_f_b2, W3Tb, hy_f_freq, hy_f_bias, KRb, K0b);
      GBF(0, 2, 2);
      {
        pg8::Gemm g{WinT, XNb, 3 * DM, NTOK, DM}; pg8::StaticOrder S; S.init(3 * DM, NTOK, GRID, bid());
        pg8::EpiBf16BiasT E{UTb, NTOK, hy_b_in};
        pg8::gemm_phase<pg8::EpiBf16BiasT, pg8::StaticOrder, true, true>((LAS unsigned char*)lds, g, S, E);
      }
      GBF(0, 4, 2);
      longconv_phase(tid, lds, UTb, hy_conv_w, hy_conv_b, KRb, ycTb);
      GBF(0, 6, 2);
      {
        pg8::Gemm g{ycTb, WhoT, NTOK, DM, DM}; pg8::StaticOrder S; S.init(NTOK, DM, GRID, bid());
        pg8::EpiResidT<false, true> E{x_in, XBb, hy_b_out, g1};
        pg8::gemm_phase<pg8::EpiResidT<false, true>, pg8::StaticOrder, true, true, false, true>((LAS unsigned char*)lds, g, S, E);
      }
      GBF(0, 8, 2);
    norm_router_phase(tid, lds, XBb, norm_ffn_g + layer * DM, sh2, sc2, (unsigned char*)XNb, moe_w_router + (size_t)layer * DM * NE, aff);
    GBF(0, 10, 2);
    topk_phase(tid, lds, aff, idx_row, gsel_row, slot_of);
    GBF(1, 0, 2);
    {
      pg8::Gemm g{XNb, (bf16*)((unsigned char*)Wmoe + (size_t)layer * 48 * MiB), NE * NB * CAP, NE * 2048, DM / 2}; pg8::MoeOrder1 S{bid()};
      pg8::EpiSwiGLU E{HIDb, 1.0f, 1.0f / 32.0f};
      pg8::gemm_phase_gather<pg8::EpiSwiGLU, pg8::MoeOrder1, true>((LAS unsigned char*)lds, g, idx_row, S, E);
    }
    GBF(1, 2, 1);
    {
      pg8::Gemm g{HIDb, (bf16*)((unsigned char*)WmoeD + (size_t)layer * 48 * MiB), NE * NB * CAP, NE * 1024, DM / 2}; pg8::MoeOrder2 S{bid()};
      pg8::EpiRowScale E{XSb, gsel_row};
      pg8::gemm_phase_gather<pg8::EpiRowScale, pg8::MoeOrder2, true, DM / 2>((LAS unsigned char*)lds, g, idx_id, S, E);
    }
    GBF(1, 3, 1);
    combine_norm_phase<false>(tid, XBb, nullptr, XSb, slot_of, g2, norm_mix_g + DM, mod + (size_t)NB * 6 * DM, mod + (size_t)NB * 6 * DM + DM, XNb);
    GBF(1, 4, 1);
  }
  {
    constexpr int layer = 1;
      {
        pg8::Gemm g{XNb, WaT, NTOK, 512, DM}; pg8::StaticOrder S; S.init(NTOK, 512, GRID, bid());
        EpiMlaPrep E{mla_q_norm_g, mla_kv_norm_g, CQNb, CKVNb, KPEb, KPE8b, ROPEb};
        pg8::gemm_phase<EpiMlaPrep, pg8::StaticOrder, true, true>((LAS unsigned char*)lds, g, S, E);
      }
      GBF(1, 5, 1);
      {
        pg8::Gemm g{CQNb, WqbT, NTOK, 1536, 256}; pg8::StaticOrder S; S.init(NTOK, 1536, GRID, bid());
        pg8::EpiQRope E{Qbuf, ROPEb, 0.07216878364870323f * 1.4426950408889634f};
        pg8::gemm_phase<pg8::EpiQRope, pg8::StaticOrder, true, false>((LAS unsigned char*)lds, g, S, E);
      }
      {
        pg8::Gemm g{CKVNb, WkvbT, NTOK, 1024, 128}; pg8::StaticOrder S; S.init(NTOK, 1024, GRID, bid());
        pg8::EpiK8 E{K8nb};
        pg8::gemm_phase<pg8::EpiK8, pg8::StaticOrder, true, true>((LAS unsigned char*)lds, g, S, E);
      }
      {
        pg8::Gemm g{WkvbT + (size_t)1024 * 128, CKVNb, 1024, NTOK, 128}; pg8::StaticOrder S; S.init(1024, NTOK, GRID, bid());
        pg8::EpiVT E{V8Tb};
        pg8::gemm_phase<pg8::EpiVT, pg8::StaticOrder, true, true>((LAS unsigned char*)lds, g, S, E);
      }
      GBF(1, 6, 2);
      attn_phase(tid, lds);
      GBF(1, 8, 2);
      {
        pg8::Gemm g{Ybf, WmoT, NTOK, DM, DM}; pg8::StaticOrder S; S.init(NTOK, DM, GRID, bid());
        pg8::EpiResidT<true, true> E{XBb, XBb, nullptr, g1};
        pg8::gemm_phase<pg8::EpiResidT<true, true>, pg8::StaticOrder, true, true>((LAS unsigned char*)lds, g, S, E);
      }
      GBF(1, 10, 1);
    norm_router_phase(tid, lds, XBb, norm_ffn_g + layer * DM, sh2, sc2, (unsigned char*)XNb, moe_w_router + (size_t)layer * DM * NE, aff);
    GBF(1, 11, 1);
    topk_phase(tid, lds, aff, idx_row, gsel_row, slot_of);
    GB();
    {
      pg8::Gemm g{XNb, (bf16*)((unsigned char*)Wmoe + (size_t)layer * 48 * MiB), NE * NB * CAP, NE * 2048, DM / 2}; pg8::MoeOrder1 S{bid()};
      pg8::EpiSwiGLU E{HIDb, 1.0f, 1.0f / 32.0f};
      pg8::gemm_phase_gather<pg8::EpiSwiGLU, pg8::MoeOrder1, true>((LAS unsigned char*)lds, g, idx_row, S, E);
    }
    GB();
    {
      pg8::Gemm g{HIDb, (bf16*)((unsigned char*)WmoeD + (size_t)layer * 48 * MiB), NE * NB * CAP, NE * 1024, DM / 2}; pg8::MoeOrder2 S{bid()};
      pg8::EpiRowScale E{XSb, gsel_row};
      pg8::gemm_phase_gather<pg8::EpiRowScale, pg8::MoeOrder2, true, DM / 2>((LAS unsigned char*)lds, g, idx_id, S, E);
    }
    GB();
    combine_norm_phase<true>(tid, XBb, XRES, XSb, slot_of, g2, final_norm_g, nullptr, nullptr, nullptr);
  }
}

#undef x_in
#undef C_IN
#undef positions_f
#undef ada_w
#undef ada_b
#undef norm_mix_g
#undef norm_ffn_g
#undef hy_w_in
#undef hy_b_in
#undef hy_conv_w
#undef hy_conv_b
#undef hy_f_w1
#undef hy_f_b1
#undef hy_f_w2
#undef hy_f_b2
#undef hy_f_w3
#undef hy_f_freq
#undef hy_f_bias
#undef hy_w_out
#undef hy_b_out
#undef mla_w_in
#undef mla_q_norm_g
#undef mla_w_qb
#undef mla_kv_norm_g
#undef mla_w_kvb
#undef mla_w_out
#undef moe_w_router
#undef moe_w_gate
#undef moe_w_up
#undef moe_w_down
#undef final_norm_g
#undef positions
#undef XRES
#undef WSB
#undef MiB
#undef WhoT
#undef WmoT
#undef Ybf
#undef ws
#undef ACT
#undef mod
#undef aff
#undef gsel
#undef idx
#undef slot_of
#undef RA
#undef RF
#undef RU
#undef RC
#undef RD
#undef V8Tb
#undef K8nb
#undef KPE8b
#undef idx_id
#undef g2
#undef sc2
#undef sh2
#undef g1
#undef sc1
#undef sh1
#undef MODL
#undef KVbuf
#undef Qbuf
#undef ROPEb
#undef KPEb
#undef CKVNb
#undef CQNb
#undef Abuf
#undef WkvbT
#undef WqbT
#undef WaT
#undef KRb
#undef K0b
#undef W3Tb
#undef ycTb
#undef zTb
#undef XBb
#undef Upre
#undef UTb
#undef WinT
#undef gsel_row
#undef idx_row
#undef HIDb
#undef XSb
#undef XNb
#undef WmoeD
#undef Wmoe
extern "C" void kernel_launch(void* const* d_in, const int* in_sizes, int n_in, void* d_out, int out_size,
                              void* d_ws, size_t ws_size, hipStream_t stream) {
  static int grid = 0;
  if (grid == 0) {
    int dev = 0, cus = 0;
    if (hipGetDevice(&dev) != hipSuccess ||
        hipDeviceGetAttribute(&cus, hipDeviceAttributeMultiprocessorCount, dev) != hipSuccess) { grid = -1; return; }
    if (hipFuncSetAttribute((const void*)fwd_megakernel, hipFuncAttributeMaxDynamicSharedMemorySize, LDS_BYTES) != hipSuccess) {
      fprintf(stderr, "hipFuncSetAttribute failed\n"); grid = -1; return;
    }
    int per_cu = 0;
    (void)hipOccupancyMaxActiveBlocksPerMultiprocessor(&per_cu, (const void*)fwd_megakernel, NTHR, LDS_BYTES);
    (void)hipGetLastError();
    if (per_cu < 1) fprintf(stderr, "occupancy query says %d blocks/CU\n", per_cu);
    if (ws_size < (size_t)576 * 1024 * 1024) { fprintf(stderr, "kernel_launch: workspace too small: %zu bytes (needs 576 MiB); nothing launched\n", ws_size); grid = -1; return; }
    if (cus != GRID) fprintf(stderr, "device has %d CUs, kernel built for %d\n", cus, GRID);
    grid = GRID;
  }
  if (grid < 0) return;
  (void)in_sizes; (void)n_in; (void)out_size;
  (void)hipMemsetAsync(d_ws, 0, 1u << 20, stream);
  Args a;
  memset(&a, 0, sizeof(a));
  for (int i = 0; i < 31; ++i) a.in[i] = (const float*)d_in[i];
  a.out = (float*)d_out;
  a.ws = (unsigned char*)d_ws;
  hipLaunchKernelGGL(fwd_megakernel, dim3(grid), dim3(NTHR), LDS_BYTES, stream, a);
}
```

```cpp
#include <hip/hip_runtime.h>
#include <stdint.h>
#include <math.h>
#include <string.h>
#include <cstdio>

#define DM 1024
#define NB 8
#define SEQ 4096
#define NTOK (NB * SEQ)
#define NE 16
#define CAP 512
#define NTHR 512
#define GRID 256
#define LDS_BYTES 155648
#define HALF_LDS 40960

#define LAS __attribute__((address_space(3)))

#define XB_TMO      128
#define XB_XCNT(j)  (256  + 64 * (j))
#define XB_XSUB(j)  (1280 + 64 * (j))
#define XB_XGEN(j)  (2304 + 64 * (j))
#define XB_TOP      3328
#define XB_TOPGEN   3392
#define XCD_BAR_WORDS 3456
#define XB_SPIN_CAP (1u << 22)
__device__ __forceinline__ unsigned xb_ld(unsigned* p)              { return __hip_atomic_load(p, __ATOMIC_RELAXED, __HIP_MEMORY_SCOPE_AGENT); }
__device__ __forceinline__ unsigned xb_add(unsigned* p, unsigned v) { return __hip_atomic_fetch_add(p, v, __ATOMIC_RELAXED, __HIP_MEMORY_SCOPE_AGENT); }
__device__ __forceinline__ unsigned xb_xcc_id() { return (unsigned)__builtin_amdgcn_s_getreg((3 << 11) | 20) & 0xFu; }
#define XB_SPIN(cond, bar) do { unsigned _sp = 0; while (cond) { __builtin_amdgcn_s_sleep(1); \
    if ((++_sp & 255u) == 0u) { if (xb_ld(&(bar)[XB_TMO])) break; if (_sp > XB_SPIN_CAP) { atomicAdd(&(bar)[XB_TMO], 1u); break; } } } } while (0)
struct XcdBarrier { unsigned* bar; unsigned x; volatile LAS unsigned* st; };
__device__ __forceinline__ XcdBarrier xcd_barrier_post(unsigned* bar, volatile LAS unsigned* st) {
    XcdBarrier b; b.bar = bar; b.x = xb_xcc_id(); b.st = st;
    if (threadIdx.x == 0) (void)xb_add(&bar[XB_XCNT(b.x)], 1u);
    return b;
}
__device__ __forceinline__ void xcd_barrier_complete(unsigned* bar, unsigned x, unsigned& nloc, unsigned& nx) {
    const unsigned G = gridDim.x * gridDim.y * gridDim.z;
    unsigned sum, cnt, mine, sp = 0u;
    for (;;) {
        sum = 0u; cnt = 0u; mine = 0u;
#pragma unroll
        for (unsigned j = 0; j < 16; ++j) { const unsigned c = xb_ld(&bar[XB_XCNT(j)]); sum += c; cnt += (c > 0u) ? 1u : 0u; }
        if (sum == G) { mine = xb_ld(&bar[XB_XCNT(x)]); break; }
        __builtin_amdgcn_s_sleep(1);
        if ((++sp & 255u) == 0u) { if (xb_ld(&bar[XB_TMO])) break; if (sp > XB_SPIN_CAP) { atomicAdd(&bar[XB_TMO], 1u); break; } }
    }
    nloc = mine > 0u ? mine : 1u; nx = cnt > 0u ? cnt : 1u;
}
__device__ __forceinline__ void xcd_barrier(const XcdBarrier& b_in) {
    XcdBarrier b; { unsigned long long p = (unsigned long long)b_in.bar; asm volatile("" : "+s"(p)); b.bar = (unsigned*)p; unsigned xx = xb_xcc_id(); asm volatile("" : "+s"(xx)); b.x = xx; b.st = b_in.st; }
    asm volatile("s_waitcnt vmcnt(0)" ::: "memory");
    __syncthreads();
    if (threadIdx.x == 0) {
        unsigned* bar = b.bar;
        __builtin_amdgcn_s_waitcnt(0);
        unsigned nloc = b.st[0], nx = b.st[1];
        if (nloc == 0u) { xcd_barrier_complete(bar, b.x, nloc, nx); b.st[0] = nloc; b.st[1] = nx; }
        const unsigned old = xb_add(&bar[XB_XSUB(b.x)], 1u);
        const unsigned gen = old / nloc;
        if (old + 1u == (gen + 1u) * nloc) {
            __builtin_amdgcn_fence(__ATOMIC_RELEASE, "agent");
            asm volatile("s_waitcnt vmcnt(0)" ::: "memory");
            const unsigned og = xb_add(&bar[XB_TOP], 1u);
            const unsigned tg = og / nx;
            if (og + 1u == (tg + 1u) * nx) xb_add(&bar[XB_TOPGEN], 1u);
            else XB_SPIN(xb_ld(&bar[XB_TOPGEN]) == tg, bar);
            __builtin_amdgcn_fence(__ATOMIC_ACQUIRE, "agent");
            xb_add(&bar[XB_XGEN(b.x)], 1u);
            asm volatile("s_waitcnt vmcnt(0)" ::: "memory");
        } else {
            XB_SPIN(xb_ld(&bar[XB_XGEN(b.x)]) == gen, bar);
            __builtin_amdgcn_fence(__ATOMIC_ACQUIRE, "agent");
            asm volatile("s_waitcnt vmcnt(0)" ::: "memory");
        }
    }
    __syncthreads();
}

__device__ __forceinline__ void xcd_arrive(const XcdBarrier& b_in) {
    XcdBarrier b; { unsigned long long p = (unsigned long long)b_in.bar; asm volatile("" : "+s"(p)); b.bar = (unsigned*)p; unsigned xx = xb_xcc_id(); asm volatile("" : "+s"(xx)); b.x = xx; b.st = b_in.st; }
    asm volatile("s_waitcnt vmcnt(0)" ::: "memory");
    __syncthreads();
    if (threadIdx.x == 0) {
        unsigned* bar = b.bar;
        __builtin_amdgcn_s_waitcnt(0);
        unsigned nloc = b.st[0], nx = b.st[1];
        if (nloc == 0u) { xcd_barrier_complete(bar, b.x, nloc, nx); b.st[0] = nloc; b.st[1] = nx; }
        const unsigned old = xb_add(&bar[XB_XSUB(b.x)], 1u);
        const unsigned gen = old / nloc;
        unsigned last = 0u, og = 0u;
        if (old + 1u == (gen + 1u) * nloc) {
            __builtin_amdgcn_fence(__ATOMIC_RELEASE, "agent");
            asm volatile("s_waitcnt vmcnt(0)" ::: "memory");
            og = xb_add(&bar[XB_TOP], 1u); last = 1u;
        }
        b.st[2] = gen; b.st[3] = last; b.st[4] = og;
    }
}
__device__ __forceinline__ void xcd_wait(const XcdBarrier& b_in) {
    XcdBarrier b; { unsigned long long p = (unsigned long long)b_in.bar; asm volatile("" : "+s"(p)); b.bar = (unsigned*)p; unsigned xx = xb_xcc_id(); asm volatile("" : "+s"(xx)); b.x = xx; b.st = b_in.st; }
    asm volatile("s_waitcnt vmcnt(0)" ::: "memory");
    if (threadIdx.x == 0) {
        unsigned* bar = b.bar;
        const unsigned nx = b.st[1], gen = b.st[2], last = b.st[3], og = b.st[4];
        if (last) {
            const unsigned tg = og / nx;
            if (og + 1u == (tg + 1u) * nx) xb_add(&bar[XB_TOPGEN], 1u);
            else XB_SPIN(xb_ld(&bar[XB_TOPGEN]) == tg, bar);
            __builtin_amdgcn_fence(__ATOMIC_ACQUIRE, "agent");
            xb_add(&bar[XB_XGEN(b.x)], 1u);
            asm volatile("s_waitcnt vmcnt(0)" ::: "memory");
        } else {
            XB_SPIN(xb_ld(&bar[XB_XGEN(b.x)]) == gen, bar);
            __builtin_amdgcn_fence(__ATOMIC_ACQUIRE, "agent");
            asm volatile("s_waitcnt vmcnt(0)" ::: "memory");
        }
    }
    __syncthreads();
}

__device__ __forceinline__ int launder(int v) { asm volatile("" : "+v"(v)); return v; }
__device__ __forceinline__ int bid() { int b = (int)blockIdx.x; asm volatile("" : "+s"(b)); return b; }
namespace pg8 {
#define PG8_LAS __attribute__((address_space(3)))
typedef unsigned short bf16_t;
typedef short bf16x8 __attribute__((ext_vector_type(8)));
typedef float f32x4 __attribute__((ext_vector_type(4)));
typedef unsigned u32x4 __attribute__((ext_vector_type(4)));
constexpr int BM = 256, BK = 64, HALF = 128, HTB = HALF * BK * 2  , STAGE_BYTES = 8 * HTB, NXCD = 8, WGM = 2;

__host__ __device__ __forceinline__ int lds_byte(int r, int c) { const int st = (r >> 4) * 2 + (c >> 5), rr = r & 15, cc = c & 31, ob = rr * 64 + cc * 2; return st * 1024 + (ob ^ (((ob >> 9) & 1) << 5)); }
__host__ __device__ __forceinline__ void stage_rc(int b, int& R, int& C) { const int st = b / 1024, sb = b % 1024, swz = sb ^ (((sb >> 9) & 1) << 5); R = (st >> 1) * 16 + swz / 64; C = (st & 1) * 32 + (swz % 64) / 2; }
__host__ __device__ __forceinline__ int perm32(int rho) { const int n = rho >> 4, i = rho & 15; return 8 * (i >> 2) + 4 * n + (i & 3); }

struct Unit { int pm, pn; };
struct Gemm { const bf16_t* A; const bf16_t* Bt; int M, N, K; unsigned sa = 0x7f7f7f7fu, sb = 0x7f7f7f7fu; };

struct StaticOrder {
    int nM, nN, nwg, G, c;
    __host__ __device__ void init(int M, int N, int G_, int c_) { nM = M / BM; nN = N / BM; nwg = nM * nN; G = G_; c = c_; }
    __host__ __device__ bool next(int i, Unit& u) const {
        const long L = (long)i * G + c; if (L >= nwg) return false;
        int wgid = (int)L; { const int q = nwg / NXCD, r = nwg % NXCD, xcd = wgid % NXCD, off = wgid / NXCD; wgid = (xcd < r ? xcd * (q + 1) : r * (q + 1) + (xcd - r) * q) + off; }
        const int nig = WGM * nN, gid = wgid / nig, fm = gid * WGM, gsz = (nM - fm) < WGM ? (nM - fm) : WGM;
        u.pm = fm + ((wgid % nig) % gsz); u.pn = (wgid % nig) / gsz; return true;
    }
    __device__ __forceinline__ void a_ready(const Unit&) const {}
    __device__ __forceinline__ void done(const Unit&) const {}
};


__device__ __forceinline__ unsigned cvt_pk_bf16(float lo, float hi) { unsigned r; asm volatile("v_cvt_pk_bf16_f32 %0, %1, %2" : "=v"(r) : "v"(lo), "v"(hi)); return r; }
__device__ __forceinline__ unsigned pack4_fp8(float a, float b, float c, float d) { int p = __builtin_amdgcn_cvt_pk_fp8_f32(a, b, 0, false); p = __builtin_amdgcn_cvt_pk_fp8_f32(c, d, p, true); return (unsigned)p; }
template <bool IN_BF, bool OUT_BF>
struct EpiResidT {
    static constexpr bool PERM = false, AFTER_DRAIN = false;
    const void* base; void* out; const float* bias; const float* gate;
    __device__ __forceinline__ void operator()(const f32x4 (&acc)[2][2][4][2], const Unit& u, int wr, int wc, int fr, int fq) const {
        typedef unsigned u32x2r_ __attribute__((ext_vector_type(2)));
        const int col0 = u.pn * BM + wc * 32 + 4 * fq;
        const int b = (u.pm * BM) / SEQ;
        const float* gp = gate + (size_t)b * 6 * DM + col0;
        f32x4 bv[2][2], gv[2][2];
#pragma unroll
        for (int bj = 0; bj < 2; ++bj)
#pragma unroll
            for (int n = 0; n < 2; ++n) {
                bv[bj][n] = bias ? *(const f32x4*)(bias + col0 + bj * HALF + n * 16) : (f32x4){0.f, 0.f, 0.f, 0.f};
                gv[bj][n] = *(const f32x4*)(gp + bj * HALF + n * 16);
            }
#pragma unroll
        for (int ai = 0; ai < 2; ++ai)
#pragma unroll
            for (int m = 0; m < 4; ++m) {
                const size_t off = (size_t)(u.pm * BM + ai * HALF + wr * 64 + m * 16 + fr) * DM + col0;
#pragma unroll
                for (int bj = 0; bj < 2; ++bj)
#pragma unroll
                    for (int n = 0; n < 2; ++n) {
                        f32x4 xv;
                        if constexpr (IN_BF) { const u32x2r_ r = *(const u32x2r_*)((const bf16_t*)base + off + bj * HALF + n * 16);
                            xv = (f32x4){__builtin_bit_cast(float, r.x << 16), __builtin_bit_cast(float, r.x & 0xffff0000u), __builtin_bit_cast(float, r.y << 16), __builtin_bit_cast(float, r.y & 0xffff0000u)}; }
                        else xv = *(const f32x4*)((const float*)base + off + bj * HALF + n * 16);
                        const f32x4 o = xv + gv[bj][n] * (acc[ai][bj][m][n] + bv[bj][n]);
                        if constexpr (OUT_BF) { u32x2r_ w; w.x = cvt_pk_bf16(o[0], o[1]); w.y = cvt_pk_bf16(o[2], o[3]); *(u32x2r_*)((bf16_t*)out + off + bj * HALF + n * 16) = w; }
                        else *(f32x4*)((float*)out + off + bj * HALF + n * 16) = o;
                    }
            }
    }
};

struct EpiSwiGLU {
    static constexpr bool PERM = true, AFTER_DRAIN = false;
    bf16_t* O; float f8scale; float wscale;
    __device__ __forceinline__ void operator()(const f32x4 (&acc)[2][2][4][2], const Unit& u, int wr, int wc, int fr, int fq) const {
        const int row0 = u.pm * BM + wr * 64 + fr, col0 = (u.pn & 7) * 128 + wc * 32 + 8 * fq;
#pragma unroll
        for (int ai = 0; ai < 2; ++ai)
#pragma unroll
            for (int m = 0; m < 4; ++m) {
                bf16_t* rowp = O + (size_t)(row0 + ai * HALF + m * 16) * 1024 + col0;
                float h[8];
#pragma unroll
                for (int n = 0; n < 2; ++n)
#pragma unroll
                    for (int j = 0; j < 4; ++j) { const float g = acc[ai][0][m][n][j] * wscale, up = acc[ai][1][m][n][j] * wscale;
                        h[n * 4 + j] = __builtin_fminf(__builtin_fmaxf(g * __builtin_amdgcn_rcpf(1.0f + __builtin_amdgcn_exp2f(-1.4426950408889634f * g)) * up, -448.f), 448.f); }
                if (f8scale != 0.f) {
                    typedef unsigned u32x2_ __attribute__((ext_vector_type(2)));
                    u32x2_ w8; w8.x = pack4_fp8(h[0] * f8scale, h[1] * f8scale, h[2] * f8scale, h[3] * f8scale); w8.y = pack4_fp8(h[4] * f8scale, h[5] * f8scale, h[6] * f8scale, h[7] * f8scale);
                    *(u32x2_*)((unsigned char*)O + (size_t)(row0 + ai * HALF + m * 16) * 1024 + col0) = w8;
                } else {
                u32x4 w; w.x = cvt_pk_bf16(h[0], h[1]); w.y = cvt_pk_bf16(h[2], h[3]); w.z = cvt_pk_bf16(h[4], h[5]); w.w = cvt_pk_bf16(h[6], h[7]);
                *(u32x4*)rowp = w; }
            }
    }
};
struct EpiRowScale {
    static constexpr bool PERM = true, AFTER_DRAIN = false;
    bf16_t* O; const float* rs;
    static constexpr float wscale = 1.0f / 32.0f;
    __device__ __forceinline__ void operator()(const f32x4 (&acc)[2][2][4][2], const Unit& u, int wr, int wc, int fr, int fq) const {
        const int row0 = u.pm * BM + wr * 64 + fr, col0 = (u.pn & 3) * BM + wc * 32 + 8 * fq;
#pragma unroll
        for (int ai = 0; ai < 2; ++ai)
#pragma unroll
            for (int m = 0; m < 4; ++m) {
                const int row = row0 + ai * HALF + m * 16;
                const float sc = rs[row] * wscale * 16.0f;
                unsigned char* rowp = (unsigned char*)O + (size_t)row * 1024 + col0;
                typedef unsigned u32x2y_ __attribute__((ext_vector_type(2)));
#pragma unroll
                for (int bj = 0; bj < 2; ++bj) { f32x4 v0 = acc[ai][bj][m][0] * sc, v1 = acc[ai][bj][m][1] * sc;
#pragma unroll
                    for (int e = 0; e < 4; ++e) { v0[e] = __builtin_fminf(__builtin_fmaxf(v0[e], -448.f), 448.f); v1[e] = __builtin_fminf(__builtin_fmaxf(v1[e], -448.f), 448.f); }
                    u32x2y_ w; w.x = pack4_fp8(v0[0], v0[1], v0[2], v0[3]); w.y = pack4_fp8(v1[0], v1[1], v1[2], v1[3]);
                    *(u32x2y_*)(rowp + bj * HALF) = w; }
            }
    }
};

struct EpiBf16Bias {
    static constexpr bool PERM = true, AFTER_DRAIN = false;
    bf16_t* O; int ldc; const float* bias;
    __device__ __forceinline__ void operator()(const f32x4 (&acc)[2][2][4][2], const Unit& u, int wr, int wc, int fr, int fq) const {
        const int row0 = u.pm * BM + wr * 64 + fr, col0 = u.pn * BM + wc * 32 + 8 * fq;
        f32x4 bv[2][2];
#pragma unroll
        for (int bj = 0; bj < 2; ++bj)
#pragma unroll
            for (int n = 0; n < 2; ++n) bv[bj][n] = bias ? *(const f32x4*)(bias + col0 + bj * HALF + 4 * n) : (f32x4){0.f, 0.f, 0.f, 0.f};
#pragma unroll
        for (int ai = 0; ai < 2; ++ai)
#pragma unroll
            for (int m = 0; m < 4; ++m) { bf16_t* rowp = O + (size_t)(row0 + ai * HALF + m * 16) * ldc + col0;
#pragma unroll
                for (int bj = 0; bj < 2; ++bj) { const f32x4 v0 = acc[ai][bj][m][0] + bv[bj][0], v1 = acc[ai][bj][m][1] + bv[bj][1];
                    u32x4 w; w.x = cvt_pk_bf16(v0[0], v0[1]); w.y = cvt_pk_bf16(v0[2], v0[3]); w.z = cvt_pk_bf16(v1[0], v1[1]); w.w = cvt_pk_bf16(v1[2], v1[3]);
                    *(u32x4*)(rowp + bj * HALF) = w; } }
    }
};

struct EpiBf16BiasT {
    static constexpr bool PERM = true, AFTER_DRAIN = false;
    bf16_t* O; int ldc; const float* bias;
    __device__ __forceinline__ void operator()(const f32x4 (&acc)[2][2][4][2], const Unit& u, int wr, int wc, int fr, int fq) const {
        const int row0 = u.pm * BM + wr * 64 + fr, col0 = u.pn * BM + wc * 32 + 8 * fq;
#pragma unroll
        for (int ai = 0; ai < 2; ++ai)
#pragma unroll
            for (int m = 0; m < 4; ++m) { const int row = row0 + ai * HALF + m * 16; const float bb = bias[row]; bf16_t* rowp = O + (size_t)row * ldc + col0;
#pragma unroll
                for (int bj = 0; bj < 2; ++bj) { const f32x4 v0 = acc[ai][bj][m][0] + bb, v1 = acc[ai][bj][m][1] + bb;
                    u32x4 w; w.x = cvt_pk_bf16(v0[0], v0[1]); w.y = cvt_pk_bf16(v0[2], v0[3]); w.z = cvt_pk_bf16(v1[0], v1[1]); w.w = cvt_pk_bf16(v1[2], v1[3]);
                    *(u32x4*)(rowp + bj * HALF) = w; } }
    }
};

struct EpiQRope {
    static constexpr bool PERM = true, AFTER_DRAIN = false;
    bf16_t* O; const float* rope; float qscale;
    __device__ __forceinline__ void operator()(const f32x4 (&acc)[2][2][4][2], const Unit& u, int wr, int wc, int fr, int fq) const {
        const int row0 = u.pm * BM + wr * 64 + fr, col0 = u.pn * BM + wc * 32 + 8 * fq;
#pragma unroll
        for (int bj = 0; bj < 2; ++bj) {
            const int col = col0 + bj * HALF, hd = col / 192, d = col - hd * 192;
            const bool pe = d >= 128;
#pragma unroll
            for (int ai = 0; ai < 2; ++ai)
#pragma unroll
                for (int m = 0; m < 4; ++m) {
                    const unsigned row = (unsigned)(row0 + ai * HALF + m * 16);
                    f32x4 v0 = acc[ai][bj][m][0], v1 = acc[ai][bj][m][1];
                    if (pe) {
                        const unsigned ro = row * 64u + (unsigned)(d - 128);
                        const f32x4 r0 = *(const f32x4*)(rope + ro), r1 = *(const f32x4*)(rope + ro + 4u);
                        const f32x4 t0 = v0, t1 = v1;
                        v0[0] = t0[0] * r0[0] - t0[1] * r0[1]; v0[1] = t0[0] * r0[1] + t0[1] * r0[0];
                        v0[2] = t0[2] * r0[2] - t0[3] * r0[3]; v0[3] = t0[2] * r0[3] + t0[3] * r0[2];
                        v1[0] = t1[0] * r1[0] - t1[1] * r1[1]; v1[1] = t1[0] * r1[1] + t1[1] * r1[0];
                        v1[2] = t1[2] * r1[2] - t1[3] * r1[3]; v1[3] = t1[2] * r1[3] + t1[3] * r1[2];
                    }
                    v0 = v0 * qscale; v1 = v1 * qscale;
                    typedef unsigned u32x2q_ __attribute__((ext_vector_type(2)));
                    u32x2q_ w8; w8.x = pack4_fp8(v0[0], v0[1], v0[2], v0[3]); w8.y = pack4_fp8(v1[0], v1[1], v1[2], v1[3]);
                    *(u32x2q_*)((unsigned char*)O + (row * 1536u + (unsigned)col)) = w8;
                }
        }
    }
};

struct EpiKV {
    static constexpr bool PERM = true, AFTER_DRAIN = false;
    bf16_t* O; unsigned char* K8;
    __device__ __forceinline__ void operator()(const f32x4 (&acc)[2][2][4][2], const Unit& u, int wr, int wc, int fr, int fq) const {
        const int row0 = u.pm * BM + wr * 64 + fr, col0 = u.pn * BM + wc * 32 + 8 * fq;
#pragma unroll
        for (int ai = 0; ai < 2; ++ai)
#pragma unroll
            for (int m = 0; m < 4; ++m) { const unsigned row = (unsigned)(row0 + ai * HALF + m * 16); bf16_t* rowp = O + (size_t)row * 2048 + col0;
#pragma unroll
                for (int bj = 0; bj < 2; ++bj) { const f32x4 v0 = acc[ai][bj][m][0], v1 = acc[ai][bj][m][1];
                    u32x4 w; w.x = cvt_pk_bf16(v0[0], v0[1]); w.y = cvt_pk_bf16(v0[2], v0[3]); w.z = cvt_pk_bf16(v1[0], v1[1]); w.w = cvt_pk_bf16(v1[2], v1[3]);
                    *(u32x4*)(rowp + bj * HALF) = w;
                    if (bj == 0) { typedef unsigned u32x2k_ __attribute__((ext_vector_type(2)));
                        u32x2k_ w8; w8.x = pack4_fp8(v0[0], v0[1], v0[2], v0[3]); w8.y = pack4_fp8(v1[0], v1[1], v1[2], v1[3]);
                        *(u32x2k_*)(K8 + (row * 1024u + (unsigned)(u.pn * 128 + wc * 32 + 8 * fq))) = w8; } } }
    }
};
struct EpiK8 {
    static constexpr bool PERM = true, AFTER_DRAIN = false;
    unsigned char* K8;
    __device__ __forceinline__ void operator()(const f32x4 (&acc)[2][2][4][2], const Unit& u, int wr, int wc, int fr, int fq) const {
        const int row0 = u.pm * BM + wr * 64 + fr, col0 = u.pn * BM + wc * 32 + 8 * fq;
        typedef unsigned u32x2e_ __attribute__((ext_vector_type(2)));
#pragma unroll
        for (int ai = 0; ai < 2; ++ai)
#pragma unroll
            for (int m = 0; m < 4; ++m) { const unsigned row = (unsigned)(row0 + ai * HALF + m * 16);
#pragma unroll
                for (int bj = 0; bj < 2; ++bj) { const f32x4 v0 = acc[ai][bj][m][0], v1 = acc[ai][bj][m][1];
                    u32x2e_ w8; w8.x = pack4_fp8(v0[0], v0[1], v0[2], v0[3]); w8.y = pack4_fp8(v1[0], v1[1], v1[2], v1[3]);
                    *(u32x2e_*)(K8 + (row * 1024u + (unsigned)(col0 + bj * HALF))) = w8; } }
    }
};
struct EpiVT {
    static constexpr bool PERM = true, AFTER_DRAIN = false;
    unsigned char* V8T;
    __device__ __forceinline__ void operator()(const f32x4 (&acc)[2][2][4][2], const Unit& u, int wr, int wc, int fr, int fq) const {
        const int dg0 = u.pm * BM + wr * 64 + fr, n0 = u.pn * BM + wc * 32 + 8 * fq;
#pragma unroll
        for (int ai = 0; ai < 2; ++ai)
#pragma unroll
            for (int m = 0; m < 4; ++m) { const int dg = dg0 + ai * HALF + m * 16, h = dg >> 7, d = dg & 127;
#pragma unroll
                for (int bj = 0; bj < 2; ++bj) { const f32x4 v0 = acc[ai][bj][m][0], v1 = acc[ai][bj][m][1];
                    const int n = n0 + bj * HALF, b = n >> 12, key = n & 4095, j = key >> 6, kk0 = key & 63, pos0 = 16 * (kk0 >> 5) + 4 * ((kk0 >> 3) & 3);
                    unsigned char* p = V8T + ((size_t)((b * 8 + h) * 64 + j) * 8192 + (size_t)(d * 64 + pos0));
                    *(unsigned*)p = pack4_fp8(v0[0], v0[1], v0[2], v0[3]); *(unsigned*)(p + 32) = pack4_fp8(v1[0], v1[1], v1[2], v1[3]); } }
    }
};
struct MoeOrder1 { int c;
    __device__ __forceinline__ bool next(int i, Unit& u) const { if (i >= 8) return false; const int x = c & 7, s = c >> 3, e = 2 * i + (x >> 2); u.pm = e * 16 + 4 * (x & 3) + (s >> 3); u.pn = e * 8 + (s & 7); return true; }
    __device__ __forceinline__ void a_ready(const Unit&) const {}
    __device__ __forceinline__ void done(const Unit&) const {} };
struct MoeOrder2 { int c;
    __device__ __forceinline__ bool next(int i, Unit& u) const { if (i >= 4) return false; const int x = c & 7, s = c >> 3, e = 4 * i + (x >> 1); u.pm = e * 16 + 8 * (x & 1) + (s >> 2); u.pn = e * 4 + (s & 3); return true; }
    __device__ __forceinline__ void a_ready(const Unit&) const {}
    __device__ __forceinline__ void done(const Unit&) const {} };

typedef int v8i32_t __attribute__((ext_vector_type(8)));
typedef int v4i32_t __attribute__((ext_vector_type(4)));
typedef short v4i16_t __attribute__((ext_vector_type(4)));
__device__ __forceinline__ v8i32_t cat8(bf16x8 lo, bf16x8 hi) { const v4i32_t a = __builtin_bit_cast(v4i32_t, lo), b = __builtin_bit_cast(v4i32_t, hi); return __builtin_shufflevector(a, b, 0, 1, 2, 3, 4, 5, 6, 7); }
template <class Epi, class Sched, bool ALIGN_EPI = false, bool SP2 = false, bool FP8 = false, bool AT = false>
__device__ __forceinline__ void gemm_phase(PG8_LAS unsigned char* lds, const Gemm g, const Sched& S, const Epi& E) {
    int tid_ = threadIdx.x; asm volatile("" : "+v"(tid_));
    const int tid = tid_, wid = __builtin_amdgcn_readfirstlane(tid >> 6), lane = tid & 63, wr = wid >> 2, wc = wid & 3, fr = lane & 15, fq = lane >> 4;
    const int K = g.K, nt = K / BK;
    unsigned voffA[1], voffB[1];
    { int R, C; stage_rc(tid * 16, R, C); const int Rb = Epi::PERM ? ((R & ~31) + perm32(R & 31)) : R;
        voffA[0] = (unsigned)(R * K + C) * 2u; voffB[0] = (unsigned)(Rb * K + C) * 2u;
        if constexpr (AT) { const int k_ = (tid >> 2) & 63, j_ = tid & 3; voffA[0] = (unsigned)(k_ * g.M + (tid >> 8) * 32 + 8 * (j_ ^ (2 * ((k_ >> 3) & 1)))) * 2u; } }
    const size_t pstep = (size_t)64 * K * 2;
    const size_t kstep = (size_t)(BK * 2);
    const size_t hstep = (size_t)HALF * K * 2;
    const size_t tstep = 2 * hstep;
    const size_t pstepA = AT ? (size_t)128 : pstep, kstepA = AT ? (size_t)BK * g.M * 2 : kstep, hstepA = AT ? (size_t)256 : hstep, tstepA = AT ? (size_t)512 : tstep;
    const unsigned ldsw = (unsigned)wid * 1024u;
    const int aoff = lds_byte(wr * 64 + fr, fq * 8), boff = lds_byte(wc * 32 + fr, fq * 8);
    const int aoT0 = wr * 8192 + (8 * fq + (fr >> 2)) * 64 + ((fq & 1) * 32) + (fr & 3) * 8, aoT1 = aoT0 ^ 32;
#define PG8_SA(b, h) (((b) * 2 + (h)) * HTB)
#define PG8_SB(b, h) ((4 + (b) * 2 + (h)) * HTB)
#define PG8_STAGE(bufoff, gbase, voff) do { _Pragma("unroll") for (int _i = 0; _i < 2; ++_i) \
        __builtin_amdgcn_global_load_lds((const unsigned*)((const char*)(gbase) + _i * pstep + (voff)[0]), (PG8_LAS unsigned*)(lds + (bufoff) + ldsw + _i * 8192), 16, 0, 0); } while (0)
#define PG8_STAGEA(bufoff, gbase) do { _Pragma("unroll") for (int _i = 0; _i < 2; ++_i) \
        __builtin_amdgcn_global_load_lds((const unsigned*)((const char*)(gbase) + _i * pstepA + voffA[0]), (PG8_LAS unsigned*)(lds + (bufoff) + ldsw + _i * 8192), 16, 0, 0); } while (0)
#define PG8_TR(off_) __builtin_amdgcn_ds_read_tr16_b64_v4i16((PG8_LAS v4i16_t*)(lds + (off_)))
#define PG8_LDA(dst, b, h) do { if constexpr (AT) { _Pragma("unroll") for (int m = 0; m < 4; ++m) _Pragma("unroll") for (int k = 0; k < 2; ++k) { \
            const int o_ = PG8_SA(b, h) + ((m & 1) ? aoT1 : aoT0) + (m >> 1) * 4096 + k * 2048; const v4i16_t lo_ = PG8_TR(o_), hi_ = PG8_TR(o_ + 256); \
            dst[m][k] = __builtin_shufflevector(lo_, hi_, 0, 1, 2, 3, 4, 5, 6, 7); } } else _Pragma("unroll") for (int m = 0; m < 4; ++m) { if constexpr (FP8) dst##8[m] = cat8(*(const PG8_LAS bf16x8*)(lds + PG8_SA(b, h) + aoff + m * 2048), *(const PG8_LAS bf16x8*)(lds + PG8_SA(b, h) + aoff + m * 2048 + 1024)); \
        else { _Pragma("unroll") for (int k = 0; k < 2; ++k) dst[m][k] = *(const PG8_LAS bf16x8*)(lds + PG8_SA(b, h) + aoff + m * 2048 + k * 1024); } } } while (0)
#define PG8_LDB(dst, b, h) do { _Pragma("unroll") for (int n = 0; n < 2; ++n) { if constexpr (FP8) dst##8[n] = cat8(*(const PG8_LAS bf16x8*)(lds + PG8_SB(b, h) + boff + n * 2048), *(const PG8_LAS bf16x8*)(lds + PG8_SB(b, h) + boff + n * 2048 + 1024)); \
        else { _Pragma("unroll") for (int k = 0; k < 2; ++k) dst[n][k] = *(const PG8_LAS bf16x8*)(lds + PG8_SB(b, h) + boff + n * 2048 + k * 1024); } } } while (0)
#define PG8_MMA(ai, bj, At, Bt) do { __builtin_amdgcn_s_setprio(1);     \
        if constexpr (FP8) { _Pragma("unroll") for (int m = 0; m < 4; ++m) _Pragma("unroll") for (int n = 0; n < 2; ++n) \
            acc[ai][bj][m][n] = __builtin_amdgcn_mfma_scale_f32_16x16x128_f8f6f4(Bt##8[n], At##8[m], acc[ai][bj][m][n], 0, 0, 0, 0x7f7f7f7f, 0, 0x7f7f7f7f); } \
        else { _Pragma("unroll") for (int m = 0; m < 4; ++m) _Pragma("unroll") for (int n = 0; n < 2; ++n) _Pragma("unroll") for (int k = 0; k < 2; ++k) \
            acc[ai][bj][m][n] = __builtin_amdgcn_mfma_f32_16x16x32_bf16(Bt[n][k], At[m][k], acc[ai][bj][m][n], 0, 0, 0); } \
        __builtin_amdgcn_s_setprio(0); } while (0)
#define PG8_WAIT_V(n) asm volatile("s_waitcnt vmcnt(" #n ")" ::: "memory")
#define PG8_WAIT_L(n) asm volatile("s_waitcnt lgkmcnt(" #n ")" ::: "memory")
#define PG8_BAR __builtin_amdgcn_s_barrier()
#define PG8_SCHED __builtin_amdgcn_sched_barrier(0)
    Unit cur, nxt; int ui = 0;
    if (!S.next(0, cur)) return;
    f32x4 acc[2][2][4][2];
#pragma unroll
    for (int a = 0; a < 2; ++a)
#pragma unroll
        for (int b = 0; b < 2; ++b)
#pragma unroll
            for (int m = 0; m < 4; ++m)
#pragma unroll
                for (int n = 0; n < 2; ++n) { acc[a][b][m][n] = (f32x4){0.f, 0.f, 0.f, 0.f}; }
    bf16x8 At[4][2], B0[2][2], B1[2][2];
    v8i32_t At8[4], B08[2], B18[2];
    const char* cA = (const char*)g.A + (size_t)cur.pm * tstepA; const char* cB = (const char*)g.Bt + (size_t)cur.pn * tstep;
    S.a_ready(cur);
    if constexpr (SP2) {
        PG8_STAGE(PG8_SB(0, 0), cB, voffB); PG8_STAGE(PG8_SB(0, 1), cB + hstep, voffB); PG8_STAGEA(PG8_SA(0, 0), cA); PG8_STAGEA(PG8_SA(0, 1), cA + hstepA);
        if (wr == 1) PG8_BAR;
        PG8_WAIT_V(2); PG8_BAR;
        PG8_STAGE(PG8_SB(1, 0), cB + kstep, voffB); PG8_STAGEA(PG8_SA(1, 0), cA + kstepA); PG8_STAGE(PG8_SB(1, 1), cB + hstep + kstep, voffB);
        PG8_WAIT_V(6); PG8_BAR;
    } else {
        PG8_STAGE(PG8_SB(0, 0), cB, voffB); PG8_STAGEA(PG8_SA(0, 0), cA); PG8_STAGE(PG8_SB(0, 1), cB + hstep, voffB); PG8_STAGEA(PG8_SA(0, 1), cA + hstepA);
        if (wr == 1) PG8_BAR;
        PG8_WAIT_V(4); PG8_BAR;
        PG8_STAGE(PG8_SB(1, 0), cB + kstep, voffB); PG8_STAGEA(PG8_SA(1, 0), cA + kstepA); PG8_STAGE(PG8_SB(1, 1), cB + hstep + kstep, voffB);
        PG8_WAIT_V(6); PG8_BAR;
    }
    for (;;) {
        const bool has_next = S.next(ui + 1, nxt);
        const char* nA = has_next ? (const char*)g.A + (size_t)nxt.pm * tstepA : cA; const char* nB = has_next ? (const char*)g.Bt + (size_t)nxt.pn * tstep : cB;
#pragma unroll 1
        for (int t = 0; t < nt; t += 2) {
            const bool last = (t == nt - 2);
            const char* a1 = cA + (size_t)(t + 1) * kstepA;
            const char* a2 = last ? nA : cA + (size_t)(t + 2) * kstepA; const char* b2 = last ? nB : cB + (size_t)(t + 2) * kstep;
            const char* a3 = a2 + kstepA; const char* b3 = b2 + kstep;
            if (last && has_next) S.a_ready(nxt);
            if constexpr (SP2) {
            PG8_LDB(B0, 0, 0); PG8_LDB(B1, 0, 1); PG8_SCHED; PG8_LDA(At, 0, 0); PG8_STAGEA(PG8_SA(1, 1), a1 + hstepA);
            PG8_WAIT_V(8); PG8_WAIT_L(0); PG8_BAR; PG8_MMA(0, 0, At, B0); PG8_MMA(0, 1, At, B1); PG8_BAR; PG8_SCHED;
            PG8_LDA(At, 0, 1); PG8_STAGE(PG8_SB(0, 0), b2, voffB); PG8_STAGE(PG8_SB(0, 1), b2 + hstep, voffB); PG8_STAGEA(PG8_SA(0, 0), a2);
            PG8_WAIT_V(8); PG8_WAIT_L(0); PG8_BAR; PG8_MMA(1, 0, At, B0); PG8_MMA(1, 1, At, B1); PG8_BAR; PG8_SCHED;
            PG8_LDB(B0, 1, 0); PG8_LDB(B1, 1, 1); PG8_SCHED; PG8_LDA(At, 1, 0); PG8_STAGEA(PG8_SA(0, 1), a2 + hstepA);
            PG8_WAIT_V(8); PG8_WAIT_L(0); PG8_BAR; PG8_MMA(0, 0, At, B0); PG8_MMA(0, 1, At, B1); PG8_BAR; PG8_SCHED;
            PG8_LDA(At, 1, 1); PG8_STAGE(PG8_SB(1, 0), b3, voffB); PG8_STAGE(PG8_SB(1, 1), b3 + hstep, voffB); PG8_STAGEA(PG8_SA(1, 0), a3);
            PG8_WAIT_V(8); PG8_WAIT_L(0); PG8_BAR; PG8_MMA(1, 0, At, B0); PG8_MMA(1, 1, At, B1); PG8_BAR; PG8_SCHED;
            } else {
            PG8_LDB(B0, 0, 0); PG8_SCHED; PG8_LDA(At, 0, 0); PG8_STAGEA(PG8_SA(1, 1), a1 + hstepA);
            PG8_WAIT_L(8); PG8_BAR; PG8_WAIT_L(0); PG8_MMA(0, 0, At, B0); PG8_BAR; PG8_SCHED;
            PG8_LDB(B1, 0, 1); PG8_STAGE(PG8_SB(0, 0), b2, voffB);
            PG8_BAR; PG8_WAIT_L(0); PG8_MMA(0, 1, At, B1); PG8_BAR;
            PG8_LDA(At, 0, 1); PG8_STAGEA(PG8_SA(0, 0), a2);
            PG8_BAR; PG8_WAIT_L(0); PG8_MMA(1, 0, At, B0); PG8_BAR; PG8_SCHED;
            PG8_STAGE(PG8_SB(0, 1), b2 + hstep, voffB);
            PG8_WAIT_V(6); PG8_BAR; PG8_MMA(1, 1, At, B1); PG8_BAR;
            PG8_LDB(B0, 1, 0); PG8_SCHED; PG8_LDA(At, 1, 0); PG8_STAGEA(PG8_SA(0, 1), a2 + hstepA);
            PG8_WAIT_L(8); PG8_BAR; PG8_WAIT_L(0); PG8_MMA(0, 0, At, B0); PG8_BAR; PG8_SCHED;
            PG8_LDB(B1, 1, 1); PG8_STAGE(PG8_SB(1, 0), b3, voffB);
            PG8_BAR; PG8_WAIT_L(0); PG8_MMA(0, 1, At, B1); PG8_BAR;
            PG8_LDA(At, 1, 1); PG8_STAGEA(PG8_SA(1, 0), a3);
            PG8_BAR; PG8_WAIT_L(0); PG8_MMA(1, 0, At, B0); PG8_BAR; PG8_SCHED;
            PG8_STAGE(PG8_SB(1, 1), b3 + hstep, voffB);
            PG8_WAIT_V(6); PG8_BAR; PG8_MMA(1, 1, At, B1); PG8_BAR;
            }
        }
        if constexpr (ALIGN_EPI) { if (wr == 0) PG8_BAR; }
        if constexpr (!Epi::AFTER_DRAIN) { E(acc, cur, wr, wc, fr, fq); S.done(cur); }
        if (!has_next) break;
#pragma unroll
        for (int a = 0; a < 2; ++a)
#pragma unroll
            for (int b = 0; b < 2; ++b)
#pragma unroll
                for (int m = 0; m < 4; ++m)
#pragma unroll
                    for (int n = 0; n < 2; ++n) { acc[a][b][m][n] = (f32x4){0.f, 0.f, 0.f, 0.f}; }
        cur = nxt; cA = nA; cB = nB; ++ui;
        if constexpr (ALIGN_EPI) { if (wr == 1) PG8_BAR; }
    }
    PG8_WAIT_V(0);
    if constexpr (!ALIGN_EPI) { if (wr == 0) PG8_BAR; }
    PG8_BAR;
    if constexpr (Epi::AFTER_DRAIN) { E.fused(acc, cur, wr, wc, fr, fq, lds, wid, lane); S.done(cur); }
#undef PG8_SA
#undef PG8_SB
#undef PG8_STAGE
#undef PG8_STAGEA
#undef PG8_TR
#undef PG8_LDA
#undef PG8_LDB
#undef PG8_MMA
#undef PG8_WAIT_V
#undef PG8_WAIT_L
#undef PG8_BAR
#undef PG8_SCHED
}
__device__ __forceinline__ int tid_now_() { int t_ = threadIdx.x; asm volatile("" : "+v"(t_)); return t_; }
template <class Epi, class Sched, bool FP8 = false, int KC = 0>
__device__ __forceinline__ void gemm_phase_gather(PG8_LAS unsigned char* lds, const Gemm g, const int* arow, const Sched& S, const Epi& E) {
    constexpr bool ALIGN_EPI = true, SP2 = true;
    int tid_ = threadIdx.x; asm volatile("" : "+v"(tid_));
    const int tid = tid_, wid = __builtin_amdgcn_readfirstlane(tid >> 6), lane = tid & 63, wr = wid >> 2, wc = wid & 3, fr = lane & 15, fq = lane >> 4;
    const int K = KC > 0 ? KC : g.K, nt = K / BK;
    unsigned voffA[1], voffB[1];
    { int R, C; stage_rc(tid * 16, R, C); const int Rb = Epi::PERM ? ((R & ~31) + perm32(R & 31)) : R;
        voffA[0] = (unsigned)(R * K + C) * 2u; voffB[0] = (unsigned)(Rb * K + C) * 2u; }
    const size_t pstep = (size_t)64 * K * 2;
    const size_t kstep = (size_t)(BK * 2);
    const size_t hstep = (size_t)HALF * K * 2;
    const size_t tstep = 2 * hstep;
    const unsigned ldsw = (unsigned)wid * 1024u;
    const int aoff = lds_byte(wr * 64 + fr, fq * 8), boff = lds_byte(wc * 32 + fr, fq * 8);
#define PG8_SA(b, h) (((b) * 2 + (h)) * HTB)
#define PG8_SB(b, h) ((4 + (b) * 2 + (h)) * HTB)
#define PG8_STAGE(bufoff, gbase, voff) do { _Pragma("unroll") for (int _i = 0; _i < 2; ++_i) \
        __builtin_amdgcn_global_load_lds((const unsigned*)((const char*)(gbase) + _i * pstep + (voff)[0]), (PG8_LAS unsigned*)(lds + (bufoff) + ldsw + _i * 8192), 16, 0, 0); } while (0)
#define PG8_LDA(dst, b, h) do { _Pragma("unroll") for (int m = 0; m < 4; ++m) { if constexpr (FP8) dst##8[m] = cat8(*(const PG8_LAS bf16x8*)(lds + PG8_SA(b, h) + aoff + m * 2048), *(const PG8_LAS bf16x8*)(lds + PG8_SA(b, h) + aoff + m * 2048 + 1024)); \
        else { _Pragma("unroll") for (int k = 0; k < 2; ++k) dst[m][k] = *(const PG8_LAS bf16x8*)(lds + PG8_SA(b, h) + aoff + m * 2048 + k * 1024); } } } while (0)
#define PG8_LDB(dst, b, h) do { _Pragma("unroll") for (int n = 0; n < 2; ++n) { if constexpr (FP8) dst##8[n] = cat8(*(const PG8_LAS bf16x8*)(lds + PG8_SB(b, h) + boff + n * 2048), *(const PG8_LAS bf16x8*)(lds + PG8_SB(b, h) + boff + n * 2048 + 1024)); \
        else { _Pragma("unroll") for (int k = 0; k < 2; ++k) dst[n][k] = *(const PG8_LAS bf16x8*)(lds + PG8_SB(b, h) + boff + n * 2048 + k * 1024); } } } while (0)
#define PG8_MMA(ai, bj, At, Bt) do { __builtin_amdgcn_s_setprio(1);     \
        if constexpr (FP8) { _Pragma("unroll") for (int m = 0; m < 4; ++m) _Pragma("unroll") for (int n = 0; n < 2; ++n) \
            acc[ai][bj][m][n] = __builtin_amdgcn_mfma_scale_f32_16x16x128_f8f6f4(Bt##8[n], At##8[m], acc[ai][bj][m][n], 0, 0, 0, 0x7f7f7f7f, 0, 0x7f7f7f7f); } \
        else { _Pragma("unroll") for (int m = 0; m < 4; ++m) _Pragma("unroll") for (int n = 0; n < 2; ++n) _Pragma("unroll") for (int k = 0; k < 2; ++k) \
            acc[ai][bj][m][n] = __builtin_amdgcn_mfma_f32_16x16x32_bf16(Bt[n][k], At[m][k], acc[ai][bj][m][n], 0, 0, 0); } \
        __builtin_amdgcn_s_setprio(0); } while (0)
#define PG8_WAIT_V(n) asm volatile("s_waitcnt vmcnt(" #n ")" ::: "memory")
#define PG8_WAIT_L(n) asm volatile("s_waitcnt lgkmcnt(" #n ")" ::: "memory")
#define PG8_BAR __builtin_amdgcn_s_barrier()
#define PG8_SCHED __builtin_amdgcn_sched_barrier(0)
    Unit cur, nxt; int ui = 0;
    if (!S.next(0, cur)) return;
    f32x4 acc[2][2][4][2];
#pragma unroll
    for (int a = 0; a < 2; ++a)
#pragma unroll
        for (int b = 0; b < 2; ++b)
#pragma unroll
            for (int m = 0; m < 4; ++m)
#pragma unroll
                for (int n = 0; n < 2; ++n) { acc[a][b][m][n] = (f32x4){0.f, 0.f, 0.f, 0.f}; }
    bf16x8 At[4][2], B0[2][2], B1[2][2];
    v8i32_t At8[4], B08[2], B18[2];
    const char* cB = (const char*)g.Bt + (size_t)cur.pn * tstep;
    int R0_, C0_; stage_rc(tid * 16, R0_, C0_);
    const unsigned rowb = (unsigned)(K * 2), colb = (unsigned)(C0_ * 2);
#define ost ((PG8_LAS unsigned*)(lds + STAGE_BYTES) + tid_now_() * 8)
#define cbuf (ui & 1)
#pragma unroll
    for (int h = 0; h < 2; ++h)
#pragma unroll
        for (int i = 0; i < 2; ++i) ost[h * 2 + i] = (unsigned)arow[cur.pm * BM + h * HALF + 64 * i + R0_] * rowb + colb;
#define PG8_STAGE_A(bufoff, h, kb, nx) do { typedef unsigned u32x2s_ __attribute__((ext_vector_type(2))); \
        const u32x2s_ o_ = *(const PG8_LAS u32x2s_*)(ost + (((nx) ? (cbuf ^ 1) : cbuf) * 4 + (h) * 2)); _Pragma("unroll") for (int _i = 0; _i < 2; ++_i) \
        __builtin_amdgcn_global_load_lds((const unsigned*)((const char*)g.A + (size_t)(kb) + o_[_i]), (PG8_LAS unsigned*)(lds + (bufoff) + ldsw + _i * 8192), 16, 0, 0); } while (0)
    S.a_ready(cur);
    if constexpr (SP2) {
        PG8_STAGE(PG8_SB(0, 0), cB, voffB); PG8_STAGE(PG8_SB(0, 1), cB + hstep, voffB); PG8_STAGE_A(PG8_SA(0, 0), 0, 0, false); PG8_STAGE_A(PG8_SA(0, 1), 1, 0, false);
        if (wr == 1) PG8_BAR;
        PG8_WAIT_V(2); PG8_BAR;
        PG8_STAGE(PG8_SB(1, 0), cB + kstep, voffB); PG8_STAGE_A(PG8_SA(1, 0), 0, kstep, false); PG8_STAGE(PG8_SB(1, 1), cB + hstep + kstep, voffB);
        PG8_WAIT_V(6); PG8_BAR;
    }
    for (;;) {
        const bool has_next = S.next(ui + 1, nxt);
        const char* nB = has_next ? (const char*)g.Bt + (size_t)nxt.pn * tstep : cB;
        int tu_ = threadIdx.x; asm volatile("" : "+v"(tu_)); int R1_, C1_; stage_rc(tu_ * 16, R1_, C1_);
#pragma unroll
        for (int h = 0; h < 2; ++h)
#pragma unroll
            for (int i = 0; i < 2; ++i) ost[(cbuf ^ 1) * 4 + h * 2 + i] = has_next ? (unsigned)arow[nxt.pm * BM + h * HALF + 64 * i + R1_] * rowb + (unsigned)(C1_ * 2) : ost[cbuf * 4 + h * 2 + i];
#pragma unroll 1
        for (int t = 0; t < nt; t += 2) {
            const bool last = (t == nt - 2);
            const size_t k1 = (size_t)(t + 1) * kstep, k2 = last ? 0 : (size_t)(t + 2) * kstep, k3 = k2 + kstep;
            const char* b2 = last ? nB : cB + (size_t)(t + 2) * kstep; const char* b3 = b2 + kstep;
            if (last && has_next) S.a_ready(nxt);
            if constexpr (SP2) {
            PG8_LDB(B0, 0, 0); PG8_LDB(B1, 0, 1); PG8_SCHED; PG8_LDA(At, 0, 0); PG8_STAGE_A(PG8_SA(1, 1), 1, k1, false);
            PG8_WAIT_V(8); PG8_WAIT_L(0); PG8_BAR; PG8_MMA(0, 0, At, B0); PG8_MMA(0, 1, At, B1); PG8_BAR; PG8_SCHED;
            PG8_LDA(At, 0, 1); PG8_STAGE(PG8_SB(0, 0), b2, voffB); PG8_STAGE(PG8_SB(0, 1), b2 + hstep, voffB); PG8_STAGE_A(PG8_SA(0, 0), 0, k2, last);
            PG8_WAIT_V(8); PG8_WAIT_L(0); PG8_BAR; PG8_MMA(1, 0, At, B0); PG8_MMA(1, 1, At, B1); PG8_BAR; PG8_SCHED;
            PG8_LDB(B0, 1, 0); PG8_LDB(B1, 1, 1); PG8_SCHED; PG8_LDA(At, 1, 0); PG8_STAGE_A(PG8_SA(0, 1), 1, k2, last);
            PG8_WAIT_V(8); PG8_WAIT_L(0); PG8_BAR; PG8_MMA(0, 0, At, B0); PG8_MMA(0, 1, At, B1); PG8_BAR; PG8_SCHED;
            PG8_LDA(At, 1, 1); PG8_STAGE(PG8_SB(1, 0), b3, voffB); PG8_STAGE(PG8_SB(1, 1), b3 + hstep, voffB); PG8_STAGE_A(PG8_SA(1, 0), 0, k3, last);
            PG8_WAIT_V(8); PG8_WAIT_L(0); PG8_BAR; PG8_MMA(1, 0, At, B0); PG8_MMA(1, 1, At, B1); PG8_BAR; PG8_SCHED;
            }
        }
        if constexpr (ALIGN_EPI) { if (wr == 0) PG8_BAR; }
        if constexpr (!Epi::AFTER_DRAIN) { int te_ = threadIdx.x; asm volatile("" : "+v"(te_)); const int we_ = __builtin_amdgcn_readfirstlane(te_ >> 6);
            E(acc, cur, we_ >> 2, we_ & 3, te_ & 15, (te_ & 63) >> 4); S.done(cur); }
        if (!has_next) break;
#pragma unroll
        for (int a = 0; a < 2; ++a)
#pragma unroll
            for (int b = 0; b < 2; ++b)
#pragma unroll
                for (int m = 0; m < 4; ++m)
#pragma unroll
                    for (int n = 0; n < 2; ++n) { acc[a][b][m][n] = (f32x4){0.f, 0.f, 0.f, 0.f}; }
        cur = nxt; cB = nB; ++ui;
        if constexpr (ALIGN_EPI) { if (wr == 1) PG8_BAR; }
    }
    PG8_WAIT_V(0);
    if constexpr (!ALIGN_EPI) { if (wr == 0) PG8_BAR; }
    PG8_BAR;
    if constexpr (Epi::AFTER_DRAIN) { E.fused(acc, cur, wr, wc, fr, fq, lds, wid, lane); S.done(cur); }
#undef PG8_STAGE_A
#undef cbuf
#undef ost
#undef PG8_SA
#undef PG8_SB
#undef PG8_STAGE
#undef PG8_LDA
#undef PG8_LDB
#undef PG8_MMA
#undef PG8_WAIT_V
#undef PG8_WAIT_L
#undef PG8_BAR
#undef PG8_SCHED
}
}

typedef unsigned short bf16;
typedef unsigned v4u __attribute__((ext_vector_type(4)));
typedef unsigned v2u __attribute__((ext_vector_type(2)));
#define GAS __attribute__((address_space(1)))
#define LDS_WAIT() asm volatile("s_waitcnt lgkmcnt(0)" ::: "memory")
__device__ __forceinline__ unsigned f2bf(float f) { unsigned u = __builtin_bit_cast(unsigned, f); return (u + 0x7fffu + ((u >> 16) & 1u)) >> 16; }
__device__ __forceinline__ unsigned pk2(float lo, float hi) { return f2bf(lo) | (f2bf(hi) << 16); }
template <int MODE> __device__ __forceinline__ int tr_row(int n) {
    if (MODE == 1) return (n >> 7) * 256 + (n & 127);
    if (MODE == 2) { if (n < 384) return n; const int i = n - 384; return 384 + (i < 32 ? 2 * i : 2 * (i - 32) + 1); }
    if (MODE == 3) { const int h = n / 192, d = n - h * 192; if (d < 128) return n; const int i = d - 128; return h * 192 + 128 + (i < 32 ? 2 * i : 2 * (i - 32) + 1); }
    return n;
}
template <int MODE>
__device__ __forceinline__ void transpose_item(const float* W, int K, int N, bf16* WT, int row_off, LAS float* scr, int item, int lane, int ldk = 0) {
    if (ldk == 0) ldk = K;
    const int nblk = N / 32, kb = item / nblk, nb = item % nblk, k0 = 64 * kb, n0 = 32 * nb;
#pragma unroll 8
    for (int i = 0; i < 32; ++i) { const int kk = 2 * i + (lane >> 5); scr[kk * 33 + (lane & 31)] = W[(size_t)(k0 + kk) * N + n0 + (lane & 31)]; }
    LDS_WAIT(); asm volatile("" ::: "memory");
    const int c = lane & 7;
#pragma unroll
    for (int j = 0; j < 4; ++j) { const int n = (lane >> 3) + 8 * j; const LAS float* s = scr + (8 * c) * 33 + n;
        v4u o; o.x = pk2(s[0 * 33], s[1 * 33]); o.y = pk2(s[2 * 33], s[3 * 33]); o.z = pk2(s[4 * 33], s[5 * 33]); o.w = pk2(s[6 * 33], s[7 * 33]);
        *(GAS v4u*)(WT + (size_t)(row_off + tr_row<MODE>(n0 + n)) * ldk + k0 + 8 * c) = o; }
    LDS_WAIT(); asm volatile("" ::: "memory");
}
template <int MODE>
__device__ __forceinline__ void transpose_item_fp8(const float* W, int K, int N, unsigned char* WT, int row_off, LAS float* scr, int item, int lane) {
    const int nblk = N / 32, kb = item / nblk, nb = item % nblk, k0 = 64 * kb, n0 = 32 * nb;
    { float v_[32];
      const float* wp_ = W + (size_t)(k0 + (lane >> 5)) * N + n0 + (lane & 31);
#pragma unroll
      for (int i = 0; i < 32; ++i) v_[i] = wp_[(size_t)(2 * i) * N];
#pragma unroll
      for (int i = 0; i < 32; ++i) scr[(2 * i + (lane >> 5)) * 33 + (lane & 31)] = v_[i]; }
    LDS_WAIT(); asm volatile("" ::: "memory");
    const int c = lane & 7;
#pragma unroll
    for (int j = 0; j < 4; ++j) { const int n = (lane >> 3) + 8 * j; const LAS float* s = scr + (8 * c) * 33 + n;
        v2u o; o.x = pg8::pack4_fp8(s[0 * 33] * 32.f, s[1 * 33] * 32.f, s[2 * 33] * 32.f, s[3 * 33] * 32.f); o.y = pg8::pack4_fp8(s[4 * 33] * 32.f, s[5 * 33] * 32.f, s[6 * 33] * 32.f, s[7 * 33] * 32.f);
        *(GAS v2u*)(WT + (size_t)(row_off + tr_row<MODE>(n0 + n)) * K + k0 + 8 * c) = o; }
    LDS_WAIT(); asm volatile("" ::: "memory");
}
__device__ __forceinline__ void mod_phase(int tid_in, unsigned char* lds_, const float* c, const float* ada_w, const float* ada_b, float* modp) {
  const int tid = launder(tid_in), wave = __builtin_amdgcn_readfirstlane(tid >> 6), lane = tid & 63;
  LAS float* cs = (LAS float*)lds_;
  LAS float* part = cs + NB * DM;
  __syncthreads();
  for (int q = tid; q < NB * DM; q += NTHR) { const float v = c[q]; cs[q] = v / (1.f + expf(-v)); }
  __syncthreads();
  const int col0 = bid() * 48, i = col0 / (6 * DM), j0 = col0 - i * 6 * DM;
  float acc[NB];
#pragma unroll
  for (int b = 0; b < NB; ++b) acc[b] = 0.f;
  if (lane < 48) {
    const float* w = ada_w + (size_t)i * DM * 6 * DM + j0 + lane;
#pragma unroll 8
    for (int kk = 0; kk < 128; ++kk) {
      const int k = wave * 128 + kk;
      const float wv = w[(size_t)k * 6 * DM];
#pragma unroll
      for (int b = 0; b < NB; ++b) acc[b] += cs[b * DM + k] * wv;
    }
#pragma unroll
    for (int b = 0; b < NB; ++b) part[(wave * NB + b) * 48 + lane] = acc[b];
  }
  __syncthreads();
  if (tid < NB * 48) {
    const int b = tid / 48, j = tid - b * 48;
    float sacc = ada_b[i * 6 * DM + j0 + j];
#pragma unroll
    for (int w8 = 0; w8 < 8; ++w8) sacc += part[(w8 * NB + b) * 48 + j];
    modp[(size_t)(i * NB + b) * 6 * DM + j0 + j] = sacc;
  }
  __syncthreads();
}

struct Args { const float* in[31]; float* out; unsigned char* ws; };

#define FOR_VB(n) for (int vb = bid() * 2 + (launder(tid) >> 8); vb < (n); vb += GRID * 2) \
    if (const int t = launder(tid) & 255; true) if (float* sm = (float*)(lds + (launder(tid) >> 8) * HALF_LDS); true)
#define GBF(LAYER_, K0_, NK_) do { XcdBarrier b_; b_.bar = (unsigned*)WSB + 4096; b_.x = 0; b_.st = (volatile LAS unsigned*)((LAS unsigned char*)lds + (LDS_BYTES - 256)) + 8; xcd_arrive(b_); \
    moe_convert(tid, lds, K0_, NK_, moe_w_gate + (size_t)(LAYER_) * NE * DM * DM, moe_w_up + (size_t)(LAYER_) * NE * DM * DM, moe_w_down + (size_t)(LAYER_) * NE * DM * DM, (unsigned char*)Wmoe + (size_t)(LAYER_) * 48 * MiB); \
    xcd_wait(b_); } while (0)
#define GB() do { XcdBarrier b_; b_.bar = (unsigned*)WSB + 4096; b_.x = 0; b_.st = (volatile LAS unsigned*)((LAS unsigned char*)lds + (LDS_BYTES - 256)) + 8; xcd_barrier(b_); } while (0)

typedef float f32x4_t __attribute__((ext_vector_type(4)));

template <int M> __device__ __forceinline__ float swz_xor(float v) { return __uint_as_float((unsigned)__builtin_amdgcn_ds_swizzle((int)__float_as_uint(v), (M << 10) | 0x1f)); }
__device__ __forceinline__ float sum_x32(float v) { auto rr = __builtin_amdgcn_permlane32_swap(__float_as_uint(v), __float_as_uint(v), false, false); return __uint_as_float(rr[0]) + __uint_as_float(rr[1]); }
__device__ __forceinline__ float max_x32(float v) { auto rr = __builtin_amdgcn_permlane32_swap(__float_as_uint(v), __float_as_uint(v), false, false); return fmaxf(__uint_as_float(rr[0]), __uint_as_float(rr[1])); }
__device__ __forceinline__ float get_x32(float v, bool hi) { auto rr = __builtin_amdgcn_permlane32_swap(__float_as_uint(v), __float_as_uint(v), false, false); return hi ? __uint_as_float(rr[0]) : __uint_as_float(rr[1]); }
__device__ __forceinline__ float wsum64(float v) {
  v += swz_xor<1>(v); v += swz_xor<2>(v); v += swz_xor<4>(v); v += swz_xor<8>(v); v += swz_xor<16>(v);
  return sum_x32(v);
}
__device__ __forceinline__ float router_reduce(const float* acc, int lane) {
  float a8[8], a4[4], a2[2], a1;
  { const bool hi = (lane & 32) != 0;
#pragma unroll
    for (int i = 0; i < 8; ++i) { const float keep = hi ? acc[i + 8] : acc[i], send = hi ? acc[i] : acc[i + 8]; a8[i] = keep + get_x32(send, hi); } }
  { const bool hi = (lane & 16) != 0;
#pragma unroll
    for (int i = 0; i < 4; ++i) { const float keep = hi ? a8[i + 4] : a8[i], send = hi ? a8[i] : a8[i + 4]; a4[i] = keep + swz_xor<16>(send); } }
  { const bool hi = (lane & 8) != 0;
#pragma unroll
    for (int i = 0; i < 2; ++i) { const float keep = hi ? a4[i + 2] : a4[i], send = hi ? a4[i] : a4[i + 2]; a2[i] = keep + swz_xor<8>(send); } }
  { const bool hi = (lane & 4) != 0; const float keep = hi ? a2[1] : a2[0], send = hi ? a2[0] : a2[1]; a1 = keep + swz_xor<4>(send); }
  a1 += swz_xor<1>(a1); a1 += swz_xor<2>(a1);
  return a1;
}
template <bool ROUTER>
__device__ __forceinline__ void norm_rows_phase(int tid_in, unsigned char* lds, const float* xin, const float* gnorm, const float* sh, const float* sc,
                                                bf16* XN, const float* wr, float* aff) {
  const int tid = launder(tid_in), wave = __builtin_amdgcn_readfirstlane(tid >> 6), lane = tid & 63;
  LAS float* wl = (LAS float*)lds;
  constexpr int NR = ROUTER ? 4 : 2;
  if (ROUTER) {
    __syncthreads();
    for (int q = tid; q < DM * NE / 4; q += NTHR) { const f32x4_t w4 = ((const f32x4_t*)wr)[q]; const int k = q >> 2, e0 = (q & 3) * 4;
      wl[(e0 + 0) * DM + k] = w4.x; wl[(e0 + 1) * DM + k] = w4.y; wl[(e0 + 2) * DM + k] = w4.z; wl[(e0 + 3) * DM + k] = w4.w; }
    __syncthreads();
  }
  for (int rp = bid() * 8 + wave; rp < NTOK / NR; rp += GRID * 8) {
    const int row0 = NR * rp, b = row0 / SEQ;
    float rs[NR];
#pragma unroll
    for (int r = 0; r < NR; ++r) {
      const f32x4_t* xr = (const f32x4_t*)(xin + (size_t)(row0 + r) * DM) + lane; float ss = 0.f;
#pragma unroll
      for (int j = 0; j < 4; ++j) { const f32x4_t v = xr[64 * j]; ss += (v.x * v.x + v.y * v.y) + (v.z * v.z + v.w * v.w); }
      rs[r] = rsqrtf(wsum64(ss) * (1.f / DM) + 1e-6f);
    }
    float acc[NR][NE];
#pragma unroll
    for (int r = 0; r < NR; ++r)
#pragma unroll
      for (int e = 0; e < NE; ++e) acc[r][e] = 0.f;
#pragma unroll 1
    for (int j = 0; j < 4; ++j) {
      const int cj = launder(lane + 64 * j);
      const f32x4_t gg = ((const f32x4_t*)gnorm)[cj];
      const f32x4_t s1 = ((const f32x4_t*)(sc + (size_t)b * 6 * DM))[cj];
      const f32x4_t s0 = ((const f32x4_t*)(sh + (size_t)b * 6 * DM))[cj];
      f32x4_t y[NR];
#pragma unroll
      for (int r = 0; r < NR; ++r) {
        y[r] = ((const f32x4_t*)(xin + (size_t)(row0 + r) * DM))[cj] * rs[r] * gg * (s1 + 1.0f) + s0;
        if (ROUTER) ((unsigned*)((unsigned char*)XN + (size_t)(row0 + r) * DM))[cj] = pg8::pack4_fp8(y[r].x, y[r].y, y[r].z, y[r].w);
        else { uint2 w; w.x = pk2(y[r].x, y[r].y); w.y = pk2(y[r].z, y[r].w);
        ((uint2*)(XN + (size_t)(row0 + r) * DM))[cj] = w; }
      }
      if (ROUTER) {
        const unsigned wofs = (unsigned)cj * 16u;
#pragma unroll
        for (int e = 0; e < NE; ++e) {
          const f32x4_t w4 = *(const LAS f32x4_t*)((LAS unsigned char*)wl + wofs + e * (DM * 4));
#pragma unroll
          for (int r = 0; r < NR; ++r) acc[r][e] += (y[r].x * w4.x + y[r].y * w4.y) + (y[r].z * w4.z + y[r].w * w4.w);
        }
      }
    }
    if (ROUTER) {
#pragma unroll
      for (int r = 0; r < NR; ++r) {
        const float a1 = router_reduce(acc[r], lane);
        float mx = a1;
        mx = fmaxf(mx, swz_xor<4>(mx)); mx = fmaxf(mx, swz_xor<8>(mx)); mx = fmaxf(mx, swz_xor<16>(mx)); mx = max_x32(mx);
        const float p = expf(a1 - mx);
        float sm_ = p;
        sm_ += swz_xor<4>(sm_); sm_ += swz_xor<8>(sm_); sm_ += swz_xor<16>(sm_); sm_ = sum_x32(sm_);
        if ((lane & 3) == 0) aff[((size_t)b * NE + (lane >> 2)) * SEQ + (row0 + r - b * SEQ)] = p / sm_;
      }
    }
  }
}

__device__ __forceinline__ void topk_phase(int tid_in, unsigned char* lds, const float* aff, int* idx_row, float* gsel_row, int* slot_of) {
  const int tid = launder(tid_in), wave = __builtin_amdgcn_readfirstlane(tid >> 6), lane = tid & 63;
  LAS unsigned* hist = (LAS unsigned*)lds;
  LAS unsigned* bc = hist + 256;
  LAS unsigned* wtot = hist + 272;
  for (int be = bid(); be < NB * NE; be += GRID) {
    const int b = be / NE, e = be % NE;
    unsigned v[8];
    { const uint4* src = (const uint4*)(aff + (size_t)be * SEQ) + 2 * tid; const uint4 p0 = src[0], p1 = src[1];
      v[0] = p0.x; v[1] = p0.y; v[2] = p0.z; v[3] = p0.w; v[4] = p1.x; v[5] = p1.y; v[6] = p1.z; v[7] = p1.w; }
    unsigned prefix = 0u, need = CAP;
#pragma unroll 1
    for (int pass = 0; pass < 4; ++pass) {
      const int shift = 24 - 8 * pass;
      __syncthreads();
      if (tid < 256) hist[tid] = 0u;
      __syncthreads();
#pragma unroll
      for (int i = 0; i < 8; ++i) {
        const bool match = (pass == 0) || ((v[i] >> (shift + 8)) == prefix);
        if (match) __hip_atomic_fetch_add(&hist[(v[i] >> shift) & 255u], 1u, __ATOMIC_RELAXED, __HIP_MEMORY_SCOPE_WORKGROUP);
      }
      __syncthreads();
      if (wave == 0) {
        const unsigned c0 = hist[4 * lane], c1 = hist[4 * lane + 1], c2 = hist[4 * lane + 2], c3 = hist[4 * lane + 3];
        const unsigned cs = c0 + c1 + c2 + c3;
        unsigned suf = cs;
#pragma unroll
        for (int o = 1; o < 64; o <<= 1) { const unsigned t2 = (unsigned)__builtin_amdgcn_ds_bpermute(((lane + o) & 63) << 2, (int)suf); if (lane + o < 64) suf += t2; }
        const unsigned above = suf - cs;
        if (suf >= need && above < need) {
          unsigned ab = above, bin;
          if (ab + c3 >= need) bin = 3; else { ab += c3; if (ab + c2 >= need) bin = 2; else { ab += c2; if (ab + c1 >= need) bin = 1; else { ab += c1; bin = 0; } } }
          bc[0] = 4 * lane + bin; bc[1] = ab;
        }
      }
      __syncthreads();
      prefix = (prefix << 8) | bc[0];
      need -= bc[1];
    }
    unsigned cg = 0u, ce = 0u;
#pragma unroll
    for (int i = 0; i < 8; ++i) { cg += (v[i] > prefix) ? 1u : 0u; ce += (v[i] == prefix) ? 1u : 0u; }
    unsigned pk = cg | (ce << 16), inc = pk;
#pragma unroll
    for (int o = 1; o < 64; o <<= 1) { const unsigned t2 = (unsigned)__builtin_amdgcn_ds_bpermute(((lane - o) & 63) << 2, (int)inc); if (lane >= o) inc += t2; }
    __syncthreads();
    if (lane == 63) wtot[wave] = inc;
    __syncthreads();
    unsigned base = 0u;
#pragma unroll
    for (int w = 0; w < 8; ++w) if (w < wave) base += wtot[w];
    unsigned ex = base + inc - pk;
    unsigned gtb = ex & 0xffffu, eqb = ex >> 16;
#pragma unroll
    for (int i = 0; i < 8; ++i) {
      const int t = 8 * tid + i;
      const bool gt = v[i] > prefix, eq = v[i] == prefix;
      const bool sel = gt || (eq && eqb < need);
      const unsigned slot = gtb + (eqb < need ? eqb : need);
      if (sel) { const size_t r = (size_t)e * (NB * CAP) + b * CAP + slot; idx_row[r] = b * SEQ + t; gsel_row[r] = __uint_as_float(v[i]); }
      slot_of[(size_t)be * SEQ + t] = sel ? (int)slot : -1;
      gtb += gt ? 1u : 0u; eqb += eq ? 1u : 0u;
    }
  }
}

__device__ __forceinline__ void gather_phase(int tid_in, const bf16* XN, const int* idx_row, bf16* XS) {
  const int tid = launder(tid_in), wave = __builtin_amdgcn_readfirstlane(tid >> 6), lane = tid & 63;
  for (int r = bid() * 8 + wave; r < NE * NB * CAP; r += GRID * 8) {
    const int src = idx_row[r];
    const uint4* s = (const uint4*)(XN + (size_t)src * DM) + lane;
    uint4* d = (uint4*)(XS + (size_t)r * DM) + lane;
    const uint4 a = s[0], c = s[64];
    d[0] = a; d[64] = c;
  }
}

template <bool FINAL>
__device__ __forceinline__ void combine_norm_phase(int tid_in, bf16* xb, float* xfin, const bf16* ye, const int* slot_of, const float* g2, const float* gnext, const float* sh, const float* sc, bf16* XN) {
  const int tid = launder(tid_in), wave = __builtin_amdgcn_readfirstlane(tid >> 6), lane = tid & 63;
  for (int row = bid() * 8 + wave; row < NTOK; row += GRID * 8) {
    const int b = row / SEQ, t = row - b * SEQ;
    const int myslot = slot_of[((size_t)b * NE + (lane & 15)) * SEQ + t];
    uint2* xr = (uint2*)(xb + (size_t)row * DM) + lane;
    uint2 xw[4];
#pragma unroll
    for (int j = 0; j < 4; ++j) xw[j] = xr[64 * j];
    unsigned long long m = __ballot(myslot >= 0) & 0xffffull;
    f32x4_t acc[4];
#pragma unroll
    for (int j = 0; j < 4; ++j) acc[j] = (f32x4_t){0.f, 0.f, 0.f, 0.f};
    while (m) {
      const int e0 = __builtin_ctzll(m); m &= m - 1;
      const int e1 = m ? __builtin_ctzll(m) : -1; if (m) m &= m - 1;
      const int s0 = __builtin_amdgcn_readlane(myslot, e0);
      const unsigned* y0 = (const unsigned*)((const unsigned char*)ye + ((size_t)e0 * (NB * CAP) + b * CAP + s0) * DM) + lane;
      unsigned w0[4], w1[4];
#pragma unroll
      for (int j = 0; j < 4; ++j) w0[j] = y0[64 * j];
      if (e1 >= 0) {
        const int s1 = __builtin_amdgcn_readlane(myslot, e1);
        const unsigned* y1 = (const unsigned*)((const unsigned char*)ye + ((size_t)e1 * (NB * CAP) + b * CAP + s1) * DM) + lane;
#pragma unroll
        for (int j = 0; j < 4; ++j) w1[j] = y1[64 * j];
      } else {
#pragma unroll
        for (int j = 0; j < 4; ++j) w1[j] = 0u;
      }
#pragma unroll
      for (int j = 0; j < 4; ++j) {
        const auto a0 = __builtin_amdgcn_cvt_pk_f32_fp8((int)w0[j], false), a1 = __builtin_amdgcn_cvt_pk_f32_fp8((int)w0[j], true);
        const auto b0 = __builtin_amdgcn_cvt_pk_f32_fp8((int)w1[j], false), b1 = __builtin_amdgcn_cvt_pk_f32_fp8((int)w1[j], true);
        acc[j].x += a0[0] + b0[0]; acc[j].y += a0[1] + b0[1]; acc[j].z += a1[0] + b1[0]; acc[j].w += a1[1] + b1[1]; }
    }
    float ss = 0.f;
#pragma unroll
    for (int j = 0; j < 4; ++j) { const f32x4_t gv = ((const f32x4_t*)(g2 + (size_t)b * 6 * DM))[lane + 64 * j] * (1.f / 16.f);
      const f32x4_t xv = {__uint_as_float(xw[j].x << 16), __uint_as_float(xw[j].x & 0xffff0000u), __uint_as_float(xw[j].y << 16), __uint_as_float(xw[j].y & 0xffff0000u)}; acc[j] = xv + gv * acc[j];
      ss += (acc[j].x * acc[j].x + acc[j].y * acc[j].y) + (acc[j].z * acc[j].z + acc[j].w * acc[j].w); }
    const float r = rsqrtf(wsum64(ss) * (1.f / DM) + 1e-6f);
#pragma unroll
    for (int j = 0; j < 4; ++j) {
      const f32x4_t gg = ((const f32x4_t*)gnext)[lane + 64 * j];
      if (FINAL) ((f32x4_t*)(xfin + (size_t)row * DM) + lane)[64 * j] = acc[j] * r * gg;
      else {
        { uint2 w; w.x = pk2(acc[j].x, acc[j].y); w.y = pk2(acc[j].z, acc[j].w); xr[64 * j] = w; }
        const f32x4_t s1 = ((const f32x4_t*)(sc + (size_t)b * 6 * DM))[lane + 64 * j], s0 = ((const f32x4_t*)(sh + (size_t)b * 6 * DM))[lane + 64 * j];
        const f32x4_t y = acc[j] * r * gg * (s1 + 1.0f) + s0;
        uint2 w; w.x = pk2(y.x, y.y); w.y = pk2(y.z, y.w);
        ((uint2*)(XN + (size_t)row * DM) + lane)[64 * j] = w;
      }
    }
  }
}

typedef short bf16x8_t __attribute__((ext_vector_type(8)));
typedef float f32x16_t __attribute__((ext_vector_type(16)));
__device__ __forceinline__ float bflo(unsigned w) { return __uint_as_float(w << 16); }
__device__ __forceinline__ float bfhi(unsigned w) { return __uint_as_float(w & 0xffff0000u); }
__device__ __forceinline__ void unpack8(const v4u v, float* f) { f[0] = bflo(v.x); f[1] = bfhi(v.x); f[2] = bflo(v.y); f[3] = bfhi(v.y); f[4] = bflo(v.z); f[5] = bfhi(v.z); f[6] = bflo(v.w); f[7] = bfhi(v.w); }

__device__ __forceinline__ void norm_router_phase(int tid_in, unsigned char* lds_, const bf16* xin, const float* gnorm, const float* sh, const float* sc,
                                                  unsigned char* XN8, const float* wr, float* aff) {
  const int tid = launder(tid_in), wave = __builtin_amdgcn_readfirstlane(tid >> 6), lane = tid & 63, r = lane & 15, kg = lane >> 4;
  LAS unsigned char* lds = (LAS unsigned char*)lds_;
  constexpr int O_A = 0, O_S0 = 4096, O_SS = 8192, O_LP = 9216, O_CP = 25600;
  const int b = bid() / (SEQ / 128), rowW = bid() * 128, c0 = wave * 128 + kg * 8;
  __syncthreads();
  for (int k = tid; k < DM; k += NTHR) {
    *(LAS float*)(lds + O_A + k * 4) = gnorm[k] * (sc[(size_t)b * 6 * DM + k] + 1.0f); *(LAS float*)(lds + O_S0 + k * 4) = sh[(size_t)b * 6 * DM + k]; }
  bf16x8_t bh[4], bl[4];
  { float cpart = 0.f;
#pragma unroll
    for (int ks = 0; ks < 4; ++ks) {
      float wv[8];
#pragma unroll
      for (int j = 0; j < 8; ++j) wv[j] = wr[(size_t)(c0 + 32 * ks + j) * NE + r];
      const f32x4_t s0 = *(const f32x4_t*)(sh + (size_t)b * 6 * DM + c0 + 32 * ks), s1 = *(const f32x4_t*)(sh + (size_t)b * 6 * DM + c0 + 32 * ks + 4);
      cpart += (s0.x * wv[0] + s0.y * wv[1]) + (s0.z * wv[2] + s0.w * wv[3]) + (s1.x * wv[4] + s1.y * wv[5]) + (s1.z * wv[6] + s1.w * wv[7]);
      unsigned h[4], l[4];
#pragma unroll
      for (int j = 0; j < 4; ++j) { h[j] = pg8::cvt_pk_bf16(wv[2 * j], wv[2 * j + 1]);
        l[j] = pg8::cvt_pk_bf16(wv[2 * j] - __uint_as_float(h[j] << 16), wv[2 * j + 1] - __uint_as_float(h[j] & 0xffff0000u)); }
      const v4u hu = {h[0], h[1], h[2], h[3]}, lu = {l[0], l[1], l[2], l[3]};
      bh[ks] = __builtin_bit_cast(bf16x8_t, hu); bl[ks] = __builtin_bit_cast(bf16x8_t, lu);
    }
    cpart += swz_xor<16>(cpart); cpart = sum_x32(cpart);
    if (kg == 0) *(LAS float*)(lds + O_CP + (wave * 16 + r) * 4) = cpart;
  }
  __syncthreads();
  float csum = 0.f;
#pragma unroll
  for (int w = 0; w < 8; ++w) csum += *(const LAS float*)(lds + O_CP + (w * 16 + (tid & 15)) * 4);
  const bf16* xp = xin + (size_t)(rowW + r) * DM + c0;
  unsigned char* xo = XN8 + (size_t)(rowW + r) * DM + c0;
  unsigned aoff = (unsigned)(O_A + c0 * 4), soff = (unsigned)(O_S0 + c0 * 4);
  asm volatile("" : "+v"(aoff), "+v"(soff));
#define NR_LOAD(V, G) do { _Pragma("unroll") for (int ks = 0; ks < 4; ++ks) { const v4u r_ = *(const v4u*)(xp + (size_t)(G) * 16 * DM + 32 * ks); \
      V[2 * ks] = (f32x4_t){__uint_as_float(r_.x << 16), __uint_as_float(r_.x & 0xffff0000u), __uint_as_float(r_.y << 16), __uint_as_float(r_.y & 0xffff0000u)}; \
      V[2 * ks + 1] = (f32x4_t){__uint_as_float(r_.z << 16), __uint_as_float(r_.z & 0xffff0000u), __uint_as_float(r_.w << 16), __uint_as_float(r_.w & 0xffff0000u)}; } } while (0)
#define NR_PROC(V, G, BUF) do { \
    f32x4_t acc = {0.f, 0.f, 0.f, 0.f}; float ss = 0.f; \
    _Pragma("unroll") for (int ks = 0; ks < 4; ++ks) { \
      const f32x4_t a0 = *(const LAS f32x4_t*)(lds + aoff + 128 * ks), a1 = *(const LAS f32x4_t*)(lds + aoff + 128 * ks + 16); \
      const f32x4_t v0 = V[2 * ks], v1 = V[2 * ks + 1]; \
      ss += (v0.x * v0.x + v0.y * v0.y) + (v0.z * v0.z + v0.w * v0.w) + (v1.x * v1.x + v1.y * v1.y) + (v1.z * v1.z + v1.w * v1.w); \
      const f32x4_t y0 = v0 * a0, y1 = v1 * a1; V[2 * ks] = y0; V[2 * ks + 1] = y1; \
      const unsigned h0 = pg8::cvt_pk_bf16(y0.x, y0.y), h1 = pg8::cvt_pk_bf16(y0.z, y0.w), h2 = pg8::cvt_pk_bf16(y1.x, y1.y), h3 = pg8::cvt_pk_bf16(y1.z, y1.w); \
      const unsigned l0 = pg8::cvt_pk_bf16(y0.x - __uint_as_float(h0 << 16), y0.y - __uint_as_float(h0 & 0xffff0000u)), l1 = pg8::cvt_pk_bf16(y0.z - __uint_as_float(h1 << 16), y0.w - __uint_as_float(h1 & 0xffff0000u)); \
      const unsigned l2 = pg8::cvt_pk_bf16(y1.x - __uint_as_float(h2 << 16), y1.y - __uint_as_float(h2 & 0xffff0000u)), l3 = pg8::cvt_pk_bf16(y1.z - __uint_as_float(h3 << 16), y1.w - __uint_as_float(h3 & 0xffff0000u)); \
      const v4u ahu = {h0, h1, h2, h3}, alu = {l0, l1, l2, l3}; \
      const bf16x8_t ah = __builtin_bit_cast(bf16x8_t, ahu), al = __builtin_bit_cast(bf16x8_t, alu); \
      acc = __builtin_amdgcn_mfma_f32_16x16x32_bf16(ah, bh[ks], acc, 0, 0, 0); \
      acc = __builtin_amdgcn_mfma_f32_16x16x32_bf16(al, bh[ks], acc, 0, 0, 0); \
      acc = __builtin_amdgcn_mfma_f32_16x16x32_bf16(ah, bl[ks], acc, 0, 0, 0); } \
    ss += swz_xor<16>(ss); ss = sum_x32(ss); \
    if (kg == 0) *(LAS float*)(lds + O_SS + ((BUF) * 128 + wave * 16 + r) * 4) = ss; \
    _Pragma("unroll") for (int j = 0; j < 4; ++j) *(LAS float*)(lds + O_LP + ((BUF) * 2048 + wave * 256 + (4 * kg + j) * 16 + r) * 4) = acc[j]; \
    __syncthreads(); \
    { float st = 0.f; _Pragma("unroll") for (int w = 0; w < 8; ++w) st += *(const LAS float*)(lds + O_SS + ((BUF) * 128 + w * 16 + r) * 4); \
      const float rs = rsqrtf(st * (1.f / DM) + 1e-6f); \
      _Pragma("unroll") for (int ks = 0; ks < 4; ++ks) { \
        const f32x4_t s0 = *(const LAS f32x4_t*)(lds + soff + 128 * ks), s1 = *(const LAS f32x4_t*)(lds + soff + 128 * ks + 16); \
        const f32x4_t y0 = V[2 * ks] * rs + s0, y1 = V[2 * ks + 1] * rs + s1; \
        v2u o; o.x = pg8::pack4_fp8(y0.x, y0.y, y0.z, y0.w); o.y = pg8::pack4_fp8(y1.x, y1.y, y1.z, y1.w); \
        *(v2u*)(xo + (size_t)(G) * 16 * DM + 32 * ks) = o; } } \
    if (tid < 256) { const int row = tid >> 4, e = tid & 15; float st = 0.f, lg = 0.f; \
      _Pragma("unroll") for (int w = 0; w < 8; ++w) { st += *(const LAS float*)(lds + O_SS + ((BUF) * 128 + w * 16 + row) * 4); lg += *(const LAS float*)(lds + O_LP + ((BUF) * 2048 + w * 256 + tid) * 4); } \
      const float a1 = lg * rsqrtf(st * (1.f / DM) + 1e-6f) + csum; \
      float mx = a1; mx = fmaxf(mx, swz_xor<1>(mx)); mx = fmaxf(mx, swz_xor<2>(mx)); mx = fmaxf(mx, swz_xor<4>(mx)); mx = fmaxf(mx, swz_xor<8>(mx)); \
      const float p = expf(a1 - mx); \
      float sm_ = p; sm_ += swz_xor<1>(sm_); sm_ += swz_xor<2>(sm_); sm_ += swz_xor<4>(sm_); sm_ += swz_xor<8>(sm_); \
      aff[((size_t)b * NE + e) * SEQ + (rowW + (G) * 16 + row - b * SEQ)] = p / sm_; } \
  } while (0)
  f32x4_t va[8], vb[8];
  NR_LOAD(va, 0);
#pragma unroll 1
  for (int gi = 0; gi < 8; gi += 2) {
    NR_LOAD(vb, gi + 1);
    NR_PROC(va, gi, 0);
    if (gi + 2 < 8) NR_LOAD(va, gi + 2);
    NR_PROC(vb, gi + 1, 1);
  }
#undef NR_LOAD
#undef NR_PROC
}
__device__ __forceinline__ void filter_phase(int tid_in, unsigned char* lds_, const float* w1, const float* b1, const float* w2, const float* b2,
                                             const bf16* W3T, const float* freq, const float* fbias, unsigned char* KR8, float* K0) {
  const int tid = launder(tid_in);
  LAS float* zf = (LAS float*)lds_;
  LAS float* h1 = zf + 16 * 36;
  LAS float* h2 = h1 + 16 * 64;
  LAS float* w1l = h2 + 64 * 16;
  LAS float* w2l = w1l + 33 * 64;
  __syncthreads();
  for (int q = tid; q < 33 * 64; q += NTHR) w1l[q] = w1[q];
  for (int q = tid; q < 64 * 64; q += NTHR) w2l[q] = w2[q];
  for (int item = bid(); item < SEQ / 16; item += GRID) {
    const int l0 = item * 16;
    __syncthreads();
    if (tid < 16 * 17) {
      const int li = tid / 17, f = tid - li * 17, l = l0 + li;
      if (f == 0) zf[li * 36] = (float)l / (float)(SEQ - 1);
      else {
        const int j = f - 1;
        const float wv = 2.0f * 3.14159265358979323846f * (float)l / (float)SEQ;
        const float fr = 1e-4f + (float)j * ((15.0f - 1e-4f) / 15.0f);
        const float ang = fr * wv;
        zf[li * 36 + 1 + j] = cosf(ang);
        zf[li * 36 + 17 + j] = -sinf(ang);
      }
    }
    __syncthreads();
    for (int o = tid; o < 1024; o += NTHR) {
      const int li = o >> 6, j = o & 63;
      float a = b1[j];
#pragma unroll
      for (int i = 0; i < 33; ++i) a += zf[li * 36 + i] * w1l[i * 64 + j];
      h1[li * 64 + j] = sinf(freq[j] * a);
    }
    __syncthreads();
    for (int o = tid; o < 1024; o += NTHR) {
      const int li = o >> 6, j = o & 63;
      float a = b2[j];
#pragma unroll 16
      for (int i = 0; i < 64; ++i) a += h1[li * 64 + i] * w2l[i * 64 + j];
      ((LAS unsigned short*)h2)[li * 64 + j] = (unsigned short)f2bf(sinf(freq[j] * a));
    }
    __syncthreads();
    const float min_decay = logf(1e-2f) / 0.3f, max_decay = logf(1e-2f) / 1.5f;
    {
      const int wave = __builtin_amdgcn_readfirstlane(tid >> 6), lane = tid & 63, cn = lane & 15, g = lane >> 4;
      const bf16x8_t a0 = *(const LAS bf16x8_t*)((LAS unsigned char*)h2 + cn * 128 + g * 16), a1 = *(const LAS bf16x8_t*)((LAS unsigned char*)h2 + cn * 128 + 64 + g * 16);
#pragma unroll 1
      for (int tb = 0; tb < 16; tb += 8) {
        bf16x8_t b0[8], b1[8];
#pragma unroll
        for (int t = 0; t < 8; ++t) { const bf16* wp = W3T + (size_t)(wave * 256 + (tb + t) * 16 + cn) * 64 + g * 8;
          b0[t] = *(const bf16x8_t*)wp; b1[t] = *(const bf16x8_t*)(wp + 32); }
#pragma unroll
        for (int t = 0; t < 8; ++t) {
          f32x4_t acc = {0.f, 0.f, 0.f, 0.f};
          acc = __builtin_amdgcn_mfma_f32_16x16x32_bf16(a0, b0[t], acc, 0, 0, 0);
          acc = __builtin_amdgcn_mfma_f32_16x16x32_bf16(a1, b1[t], acc, 0, 0, 0);
          const int col = wave * 256 + (tb + t) * 16 + cn, d = col & 1023, lb = l0 + 4 * g;
          const float delta = min_decay + (float)d * ((max_decay - min_decay) / (float)(DM - 1));
          unsigned char* kr = KR8 + (size_t)d * 8192;
          float h[4];
#pragma unroll
          for (int e = 0; e < 4; ++e) {
            const int l = lb + e;
            const float tl = (float)l / (float)(SEQ - 1);
            float v = acc[e] * expf(-tl * fabsf(delta));
            if (wave < 4 && l == 0) v += fbias[d];
            h[e] = fminf(fmaxf(v * 32.f, -448.f), 448.f);
          }
          if (wave < 4) {
            unsigned char* cb_ = kr + 4092 - lb;
            const unsigned pa = pg8::pack4_fp8(h[0], h[3], h[2], h[1]);
            cb_[4] = (unsigned char)pa;
            cb_[1] = (unsigned char)(pa >> 8);
            *(unsigned short*)(cb_ + 2) = (unsigned short)(pa >> 16);
            if (lb == 4092) cb_[0] = 0;
          } else {
            const unsigned w0 = pg8::pack4_fp8(h[0], h[1], h[2], h[3]);
            if (lb == 0) { kr[4097] = (unsigned char)(w0 >> 8); *(unsigned short*)(kr + 4098) = (unsigned short)(w0 >> 16); }
            else *(unsigned*)(kr + 4096 + lb) = w0;
          }
        }
      }
    }
  }
}

template <int LD> __device__ __forceinline__ void sconv8_load(const bf16* up, int col, int t, v4u* r) {
  const v4u z4 = (v4u){0u, 0u, 0u, 0u};
  r[0] = t > 0 ? *(const v4u*)(up - LD + col) : z4;
  r[1] = *(const v4u*)(up + col);
  r[2] = t < SEQ - 1 ? *(const v4u*)(up + LD + col) : z4;
}
__device__ __forceinline__ void sconv8_calc(const v4u* r, int col, const float* cw, const float* cb, float* out) {
  float um[8], u0[8], u1[8];
  unpack8(r[0], um); unpack8(r[1], u0); unpack8(r[2], u1);
#pragma unroll
  for (int h = 0; h < 2; ++h) {
    const f32x4_t w0 = *(const f32x4_t*)(cw + col + 4 * h), w1 = *(const f32x4_t*)(cw + 3072 + col + 4 * h), w2 = *(const f32x4_t*)(cw + 6144 + col + 4 * h), bb = *(const f32x4_t*)(cb + col + 4 * h);
#pragma unroll
    for (int k = 0; k < 4; ++k) out[4 * h + k] = bb[k] + w0[k] * um[4 * h + k] + w1[k] * u0[4 * h + k] + w2[k] * u1[4 * h + k];
  }
}
__device__ __forceinline__ void gateT_phase(int tid_in, unsigned char* lds_, const bf16* U, const float* cw, const float* cb, const bf16* ycT, bf16* Yg) {
  const int tid = launder(tid_in), cch = tid & 7, tl = tid >> 3;
  LAS bf16* tile = (LAS bf16*)lds_;
  constexpr int NITEM = NB * 64 * 16;
  const int rowc = tid >> 3, chunk = tid & 7;
  v4u ra[3], na[3], yv, nyv;
  {
    const int item = bid(), cbk = item & 15, r = item >> 4, tb = r & 63, b = r >> 6, c0 = cbk * 64 + cch * 8, t = tb * 64 + tl;
    yv = *(const v4u*)(ycT + ((size_t)(cbk * 64 + rowc) * NB + b) * SEQ + tb * 64 + chunk * 8);
    sconv8_load<DM>(U + (size_t)(b * SEQ + t) * DM, c0, t, ra);
  }
  for (int item = bid(); item < NITEM; item += GRID) {
    const int cbk = item & 15, r = item >> 4, tb = r & 63, b = r >> 6;
    const int c0 = cbk * 64 + cch * 8, t = tb * 64 + tl;
    {
      const int nitem = item + GRID < NITEM ? item + GRID : item, nr = nitem >> 4, ntb = nr & 63, nbb = nr >> 6, nt = ntb * 64 + tl;
      nyv = *(const v4u*)(ycT + ((size_t)(cbk * 64 + rowc) * NB + nbb) * SEQ + ntb * 64 + chunk * 8);
      sconv8_load<DM>(U + (size_t)(nbb * SEQ + nt) * DM, c0, nt, na);
    }
    float a0[8];
    sconv8_calc(ra, c0, cw, cb, a0);
    __syncthreads();
    *(LAS v4u*)(tile + rowc * 72 + chunk * 8) = yv;
    __syncthreads();
    float y[8];
#pragma unroll
    for (int k = 0; k < 8; ++k) y[k] = __uint_as_float((unsigned)tile[(cch * 8 + k) * 72 + tl] << 16) * a0[k];
    v4u o; o.x = pk2(y[0], y[1]); o.y = pk2(y[2], y[3]); o.z = pk2(y[4], y[5]); o.w = pk2(y[6], y[7]);
    *(v4u*)(Yg + (size_t)(b * SEQ + t) * DM + c0) = o;
#pragma unroll
    for (int k = 0; k < 3; ++k) ra[k] = na[k];
    yv = nyv;
  }
}

#define LC8_ZB 34816
#define LC8_FS 4208
#define LC8_ZF (LC8_ZB + 16 * LC8_FS)
typedef int lc_v4i __attribute__((ext_vector_type(4)));
typedef int lc_v8i __attribute__((ext_vector_type(8)));
__device__ __forceinline__ unsigned lc8_zslot(int Jp, int e, int b) { return (unsigned)((((Jp >> 1) * 4 + e * 2 + (Jp & 1)) * 8 + b) * 16); }
__device__ __forceinline__ lc_v8i lc_cat(lc_v4i a, lc_v4i b) { return __builtin_shufflevector(a, b, 0, 1, 2, 3, 4, 5, 6, 7); }
__device__ __forceinline__ void longconv_phase(int tid_in, unsigned char* lds_, const bf16* UT, const float* cw, const float* cb, const unsigned char* KR8, bf16* ycT) {
  LAS unsigned char* lds = (LAS unsigned char*)lds_;
  for (int c = bid(); c < DM; c += GRID) {
    const int tid = launder(tid_in), wave = __builtin_amdgcn_readfirstlane(tid >> 6), lane = tid & 63;
    const int n = lane & 31, half = lane >> 5, q = n >> 3, bb = n & 7, sigma = n >> 4, rho = n & 15;
    const int IL = 8 * wave, IH = 120 - 8 * wave;
    __syncthreads();
    if (tid >= 128 && tid < 132) *(LAS v4u*)(lds + LC8_ZF + (tid - 128) * 16) = (v4u){0u, 0u, 0u, 0u};
    if (tid < 128) {
      const int b = tid & 7, e = (tid >> 3) & 1, jb = tid >> 4, Jp = jb < 4 ? jb : 128 + jb;
      *(LAS v4u*)(lds + lc8_zslot(Jp, e, b)) = (v4u){0u, 0u, 0u, 0u};
    }
    {
      const float w10 = cw[1024 + c], w11 = cw[3072 + 1024 + c], w12 = cw[6144 + 1024 + c], b1_ = cb[1024 + c];
      const float w20 = cw[2048 + c], w21 = cw[3072 + 2048 + c], w22 = cw[6144 + 2048 + c], b2_ = cb[2048 + c];
      const bf16* x1r = UT + (size_t)(1024 + c) * NTOK; const bf16* vr = UT + (size_t)(2048 + c) * NTOK;
      v4u xa[4], xb[4], va[4], vb[4]; unsigned xm[4], xn[4], vm[4], vn[4];
#pragma unroll
      for (int k = 0; k < 4; ++k) {
        const int s_ = tid + NTHR * k, b = s_ >> 8, ch = s_ & 255, t0 = ch * 16;
        const bf16* xp = x1r + b * SEQ + t0; const bf16* vp = vr + b * SEQ + t0;
        xa[k] = *(const v4u*)xp; xb[k] = *(const v4u*)(xp + 8); va[k] = *(const v4u*)vp; vb[k] = *(const v4u*)(vp + 8);
        xm[k] = t0 > 0 ? (unsigned)xp[-1] : 0u; xn[k] = t0 + 16 < SEQ ? (unsigned)xp[16] : 0u; vm[k] = t0 > 0 ? (unsigned)vp[-1] : 0u; vn[k] = t0 + 16 < SEQ ? (unsigned)vp[16] : 0u;
      }
#pragma unroll
      for (int k = 0; k < 4; ++k) {
        const int s_ = tid + NTHR * k, b = s_ >> 8, ch = s_ & 255;
        float x[18], v[18];
        x[0] = __uint_as_float(xm[k] << 16); x[17] = __uint_as_float(xn[k] << 16); v[0] = __uint_as_float(vm[k] << 16); v[17] = __uint_as_float(vn[k] << 16);
        { const unsigned dx[8] = {xa[k].x, xa[k].y, xa[k].z, xa[k].w, xb[k].x, xb[k].y, xb[k].z, xb[k].w}, dv[8] = {va[k].x, va[k].y, va[k].z, va[k].w, vb[k].x, vb[k].y, vb[k].z, vb[k].w};
#pragma unroll
          for (int e = 0; e < 8; ++e) { x[1 + 2 * e] = __uint_as_float(dx[e] << 16); x[2 + 2 * e] = __uint_as_float(dx[e] & 0xffff0000u); v[1 + 2 * e] = __uint_as_float(dv[e] << 16); v[2 + 2 * e] = __uint_as_float(dv[e] & 0xffff0000u); } }
        float f[16];
#pragma unroll
        for (int e = 0; e < 16; ++e) { const float c1 = b1_ + w10 * x[e] + w11 * x[e + 1] + w12 * x[e + 2], c2 = b2_ + w20 * v[e] + w21 * v[e + 1] + w22 * v[e + 2];
          f[e] = fminf(fmaxf(c1 * c2 * 4.f, -448.f), 448.f); }
        v4u o; o.x = pg8::pack4_fp8(f[0], f[1], f[2], f[3]); o.y = pg8::pack4_fp8(f[4], f[5], f[6], f[7]); o.z = pg8::pack4_fp8(f[8], f[9], f[10], f[11]); o.w = pg8::pack4_fp8(f[12], f[13], f[14], f[15]);
        *(LAS v4u*)(lds + lc8_zslot((ch >> 1) + 4, ch & 1, b)) = o;
        __builtin_amdgcn_sched_barrier(0);
      }
    }
    f32x16_t acc[4];
#pragma unroll
    for (int tau = 0; tau < 4; ++tau)
#pragma unroll
      for (int r = 0; r < 16; ++r) acc[tau][r] = 0.f;
    const unsigned char* krc = KR8 + (size_t)c * 8192;
#pragma unroll 1
    for (int pass = 0; pass < 2; ++pass) {
      __syncthreads();
      for (int a = tid; a < 263; a += NTHR) {
        const int cl = a + (pass ? 255 : -3);
        const v4u lo = (cl >= 0 && cl < 512) ? *(const v4u*)(krc + (size_t)cl * 16) : (v4u){0u, 0u, 0u, 0u};
        const v4u hi = (cl >= -1 && cl < 511) ? *(const v4u*)(krc + (size_t)(cl + 1) * 16) : (v4u){0u, 0u, 0u, 0u};
        const unsigned d[8] = {lo.x, lo.y, lo.z, lo.w, hi.x, hi.y, hi.z, hi.w};
#pragma unroll
        for (int rh = 0; rh < 16; ++rh) {
          const int o_ = 16 - rh, j0 = o_ >> 2, sh = o_ & 3;
          v4u o;
          if (sh == 0) { o.x = d[j0]; o.y = d[j0 + 1]; o.z = d[j0 + 2]; o.w = d[j0 + 3]; }
          else { o.x = __builtin_amdgcn_alignbyte(d[j0 + 1], d[j0], sh); o.y = __builtin_amdgcn_alignbyte(d[j0 + 2], d[j0 + 1], sh);
                 o.z = __builtin_amdgcn_alignbyte(d[j0 + 3], d[j0 + 2], sh); o.w = __builtin_amdgcn_alignbyte(d[(j0 + 4) & 7], d[j0 + 3], sh); }
          *(LAS v4u*)(lds + LC8_ZB + rh * LC8_FS + a * 16) = o;
        }
      }
      __syncthreads();
      const int Dlo = pass ? -128 : 0, Dhi = pass ? -2 : 128, Ca = pass ? 0 : 258;
      const unsigned fbaseu = (unsigned)(LC8_ZB + rho * LC8_FS + (2 * half - sigma + Ca) * 16);
      const unsigned zfragu = (unsigned)LC8_ZF;
      lc_v8i P, Q, R, S, Bf;
#define LC_LDA(X, PTR, D_) do { const unsigned fa_ = ((D_) >= Dlo && (D_) <= Dhi) ? (PTR) : zfragu; X = lc_cat(*(const LAS lc_v4i*)(lds + fa_), *(const LAS lc_v4i*)(lds + fa_ + 16)); } while (0)
#define LC_MMA(A_, C_) C_ = __builtin_amdgcn_mfma_scale_f32_32x32x64_f8f6f4(A_, Bf, C_, 0, 0, 0, 0x7f7f7f7f, 0, 0x7f7f7f7f)
#define LC_STEP(DOL, DOH, T0, T1, T2, T3) do { \
        if (DOL) LC_LDA(T0, pl_, IL - J0); if (DOH) LC_LDA(T2, ph_, IH - J0); \
        Bf = lc_cat(*(const LAS lc_v4i*)(lds + pb_), *(const LAS lc_v4i*)(lds + pb_ + 256)); \
        if (DOL) { LC_MMA(T0, acc[0]); LC_MMA(T1, acc[1]); } \
        if (DOH) { LC_MMA(T2, acc[2]); LC_MMA(T3, acc[3]); } \
        J0 += 4; pl_ += 128u; ph_ += 128u; pb_ += 1024u; } while (0)
#define LC_RUN(DOL, DOH, JLO, JHI) do { \
        int J0 = (JLO) + (((r - (JLO)) % 4) + 4) % 4; const int jhi_ = (JHI); \
        unsigned pl_ = fbaseu + (unsigned)(32 * (J0 - IL)), ph_ = fbaseu + (unsigned)(32 * (J0 - IH)), pb_ = lc8_zslot(J0 + q + half + 4, 0, bb); \
        asm volatile("" : "+v"(pl_), "+v"(ph_), "+v"(pb_)); \
        if (DOL) LC_LDA(Q, pl_ - 128u, IL + 4 - J0); if (DOH) LC_LDA(S, ph_ - 128u, IH + 4 - J0); \
        _Pragma("unroll 1") while (J0 <= jhi_) { \
          LC_STEP(DOL, DOH, P, Q, R, S); if (J0 > jhi_) break; \
          LC_STEP(DOL, DOH, Q, P, S, R); } } while (0)
#pragma unroll 1
      for (int r = 0; r < 4; r += 2) {
        if (pass == 0) {
          LC_RUN(1, 1, -4, IL + 4);
          LC_RUN(0, 1, IL + 5, IH + 4);
        } else {
          LC_RUN(1, 0, IL + 1, IH);
          LC_RUN(1, 1, IH + 1, 126);
        }
      }
#undef LC_RUN
#undef LC_LDA
#undef LC_MMA
#undef LC_STEP
    }
    __syncthreads();
#pragma unroll
    for (int tau = 0; tau < 4; ++tau)
#pragma unroll
      for (int g = 0; g < 4; ++g) {
        const int t = 32 * ((tau < 2 ? IL : IH) + 4 * (tau & 1) + q) + 8 * g + 4 * half;
        v2u w; w.x = pk2(acc[tau][4 * g] * (1.f / 128.f), acc[tau][4 * g + 1] * (1.f / 128.f)); w.y = pk2(acc[tau][4 * g + 2] * (1.f / 128.f), acc[tau][4 * g + 3] * (1.f / 128.f));
        *(LAS v2u*)(lds + bb * 8208 + t * 2) = w;
      }
    {
      const float w0 = cw[c], w1 = cw[3072 + c], w2 = cw[6144 + c], b0_ = cb[c];
      const bf16* x0r = UT + (size_t)c * NTOK;
      v4u xg[8]; unsigned xm[8], xn[8];
#pragma unroll
      for (int k = 0; k < 8; ++k) {
        const int s_ = tid + NTHR * k, b = s_ >> 9, ch = s_ & 511, t0 = ch * 8; const bf16* xp = x0r + b * SEQ + t0;
        xg[k] = *(const v4u*)xp; xm[k] = t0 > 0 ? (unsigned)xp[-1] : 0u; xn[k] = t0 + 8 < SEQ ? (unsigned)xp[8] : 0u;
      }
      __syncthreads();
#pragma unroll
      for (int k = 0; k < 8; ++k) {
        const int s_ = tid + NTHR * k, b = s_ >> 9, ch = s_ & 511;
        const v4u yv = *(const LAS v4u*)(lds + b * 8208 + ch * 16);
        float x[10], y[8];
        x[0] = __uint_as_float(xm[k] << 16); x[9] = __uint_as_float(xn[k] << 16);
        { const unsigned dx[4] = {xg[k].x, xg[k].y, xg[k].z, xg[k].w};
#pragma unroll
          for (int e = 0; e < 4; ++e) { x[1 + 2 * e] = __uint_as_float(dx[e] << 16); x[2 + 2 * e] = __uint_as_float(dx[e] & 0xffff0000u); } }
        unpack8(yv, y);
#pragma unroll
        for (int e = 0; e < 8; ++e) y[e] *= b0_ + w0 * x[e] + w1 * x[e + 1] + w2 * x[e + 2];
        v4u o; o.x = pk2(y[0], y[1]); o.y = pk2(y[2], y[3]); o.z = pk2(y[4], y[5]); o.w = pk2(y[6], y[7]);
        *(v4u*)(ycT + ((size_t)c * NB + b) * SEQ + ch * 8) = o;
      }
    }
  }
}

__device__ __forceinline__ void mla_prep_phase(int tid_in, const bf16* A, const int* pos, const float* qg, const float* kvg, bf16* CQN, bf16* CKVN, bf16* KPE, unsigned char* KPE8, const float* ROPE) {
  const int tid = launder(tid_in), wave = __builtin_amdgcn_readfirstlane(tid >> 6), lane = tid & 63;
  for (int row4 = (bid() * 8 + wave) * 4; row4 < NTOK; row4 += GRID * 8 * 4) {
    v4u raw[4];
#pragma unroll
    for (int rr = 0; rr < 4; ++rr) raw[rr] = *(const v4u*)(A + (size_t)(row4 + rr) * 512 + lane * 8);
#pragma unroll
    for (int rr = 0; rr < 4; ++rr) {
    const int row = row4 + rr;
    float v[8];
    unpack8(raw[rr], v);
    float ss = 0.f;
#pragma unroll
    for (int k = 0; k < 8; ++k) ss += v[k] * v[k];
    const float ssq = wsum64(lane < 32 ? ss : 0.f), sskv = wsum64((lane >= 32 && lane < 48) ? ss : 0.f);
    if (lane < 32) {
      const float r = rsqrtf(ssq * (1.f / 256.f) + 1e-6f);
      const f32x4_t g0 = *(const f32x4_t*)(qg + lane * 8), g1 = *(const f32x4_t*)(qg + lane * 8 + 4);
      v4u o; o.x = pk2(v[0] * r * g0.x, v[1] * r * g0.y); o.y = pk2(v[2] * r * g0.z, v[3] * r * g0.w); o.z = pk2(v[4] * r * g1.x, v[5] * r * g1.y); o.w = pk2(v[6] * r * g1.z, v[7] * r * g1.w);
      *(v4u*)(CQN + (size_t)row * 256 + lane * 8) = o;
    } else if (lane < 48) {
      const int l = lane - 32;
      const float r = rsqrtf(sskv * (1.f / 128.f) + 1e-6f);
      const f32x4_t g0 = *(const f32x4_t*)(kvg + l * 8), g1 = *(const f32x4_t*)(kvg + l * 8 + 4);
      v4u o; o.x = pk2(v[0] * r * g0.x, v[1] * r * g0.y); o.y = pk2(v[2] * r * g0.z, v[3] * r * g0.w); o.z = pk2(v[4] * r * g1.x, v[5] * r * g1.y); o.w = pk2(v[6] * r * g1.z, v[7] * r * g1.w);
      *(v4u*)(CKVN + (size_t)row * 128 + l * 8) = o;
    } else {
      if (lane < 56) {
        const int l = lane - 48;
        const float* rp = ROPE + (size_t)row * 64 + l * 8;
        const f32x4_t r0 = *(const f32x4_t*)rp, r1 = *(const f32x4_t*)(rp + 4);
        const float cs[4] = {r0.x, r0.z, r1.x, r1.z}, sn[4] = {r0.y, r0.w, r1.y, r1.w};
        float o1[4], o2[4];
#pragma unroll
        for (int k = 0; k < 4; ++k) {
          o1[k] = v[2 * k] * cs[k] - v[2 * k + 1] * sn[k];
          o2[k] = v[2 * k] * sn[k] + v[2 * k + 1] * cs[k];
        }
        v4u o; o.x = pk2(o1[0], o2[0]); o.y = pk2(o1[1], o2[1]); o.z = pk2(o1[2], o2[2]); o.w = pk2(o1[3], o2[3]);
        *(v4u*)(KPE + (size_t)row * 64 + l * 8) = o;
        { v2u o8; o8.x = pg8::pack4_fp8(o1[0], o2[0], o1[1], o2[1]); o8.y = pg8::pack4_fp8(o1[2], o2[2], o1[3], o2[3]); *(v2u*)(KPE8 + (size_t)row * 64 + l * 8) = o8; }
      }
    }
    }
  }
}

struct EpiMlaPrep {
    static constexpr bool PERM = true, AFTER_DRAIN = true;
    const float* qg; const float* kvg; bf16* CQN; bf16* CKVN; bf16* KPE; unsigned char* KPE8; const float* ROPE;
    __device__ __forceinline__ void fused(const pg8::f32x4 (&acc)[2][2][4][2], const pg8::Unit& u, int wr, int wc, int fr, int fq, PG8_LAS unsigned char* lds, int wid, int lane) const {
        constexpr int RS = 528;
#pragma unroll
        for (int ai = 0; ai < 2; ++ai)
#pragma unroll
            for (int m = 0; m < 4; ++m) { const int rl = wr * 64 + fr + ai * pg8::HALF + m * 16;
#pragma unroll
                for (int bj = 0; bj < 2; ++bj) { const pg8::f32x4 v0 = acc[ai][bj][m][0], v1 = acc[ai][bj][m][1];
                    v4u w; w.x = pg8::cvt_pk_bf16(v0[0], v0[1]); w.y = pg8::cvt_pk_bf16(v0[2], v0[3]); w.z = pg8::cvt_pk_bf16(v1[0], v1[1]); w.w = pg8::cvt_pk_bf16(v1[2], v1[3]);
                    *(PG8_LAS v4u*)(lds + rl * RS + (wc * 32 + 8 * fq + bj * pg8::HALF) * 2) = w; } }
        __syncthreads();
        const int l = lane & 31;
#pragma unroll 1
        for (int p = 0; p < 16; ++p) {
            const int rl = wid * 32 + 2 * p + (lane >> 5); const size_t row = (size_t)u.pm * pg8::BM + rl;
            if (u.pn == 0) {
                float v[8]; unpack8(*(const PG8_LAS v4u*)(lds + rl * RS + l * 16), v);
                float ss = 0.f;
#pragma unroll
                for (int k = 0; k < 8; ++k) ss += v[k] * v[k];
                ss += swz_xor<1>(ss); ss += swz_xor<2>(ss); ss += swz_xor<4>(ss); ss += swz_xor<8>(ss); ss += swz_xor<16>(ss);
                const float r = rsqrtf(ss * (1.f / 256.f) + 1e-6f);
                const f32x4_t g0 = *(const f32x4_t*)(qg + l * 8), g1 = *(const f32x4_t*)(qg + l * 8 + 4);
                v4u o; o.x = pk2(v[0] * r * g0.x, v[1] * r * g0.y); o.y = pk2(v[2] * r * g0.z, v[3] * r * g0.w); o.z = pk2(v[4] * r * g1.x, v[5] * r * g1.y); o.w = pk2(v[6] * r * g1.z, v[7] * r * g1.w);
                *(v4u*)(CQN + row * 256 + l * 8) = o;
            } else {
                float v[8]; unpack8(*(const PG8_LAS v4u*)(lds + rl * RS + (l < 24 ? l : 0) * 16), v);
                float ss = 0.f;
#pragma unroll
                for (int k = 0; k < 8; ++k) ss += v[k] * v[k];
                ss += swz_xor<1>(ss); ss += swz_xor<2>(ss); ss += swz_xor<4>(ss); ss += swz_xor<8>(ss);
                if (l < 16) {
                    const float r = rsqrtf(ss * (1.f / 128.f) + 1e-6f);
                    const f32x4_t g0 = *(const f32x4_t*)(kvg + l * 8), g1 = *(const f32x4_t*)(kvg + l * 8 + 4);
                    v4u o; o.x = pk2(v[0] * r * g0.x, v[1] * r * g0.y); o.y = pk2(v[2] * r * g0.z, v[3] * r * g0.w); o.z = pk2(v[4] * r * g1.x, v[5] * r * g1.y); o.w = pk2(v[6] * r * g1.z, v[7] * r * g1.w);
                    *(v4u*)(CKVN + row * 128 + l * 8) = o;
                } else if (l < 24) {
                    const int lp = l - 16;
                    const float* rp = ROPE + row * 64 + lp * 8;
                    const f32x4_t r0 = *(const f32x4_t*)rp, r1 = *(const f32x4_t*)(rp + 4);
                    const float cs[4] = {r0.x, r0.z, r1.x, r1.z}, sn[4] = {r0.y, r0.w, r1.y, r1.w};
                    float o1[4], o2[4];
#pragma unroll
                    for (int k = 0; k < 4; ++k) { o1[k] = v[2 * k] * cs[k] - v[2 * k + 1] * sn[k]; o2[k] = v[2 * k] * sn[k] + v[2 * k + 1] * cs[k]; }
                    v4u o; o.x = pk2(o1[0], o2[0]); o.y = pk2(o1[1], o2[1]); o.z = pk2(o1[2], o2[2]); o.w = pk2(o1[3], o2[3]);
                    *(v4u*)(KPE + row * 64 + lp * 8) = o;
                    { v2u o8; o8.x = pg8::pack4_fp8(o1[0], o2[0], o1[1], o2[1]); o8.y = pg8::pack4_fp8(o1[2], o2[2], o1[3], o2[3]); *(v2u*)(KPE8 + row * 64 + lp * 8) = o8; }
                }
            }
        }
    }
};

namespace att {
typedef short s16x4 __attribute__((ext_vector_type(4)));
typedef unsigned u32x4_ __attribute__((ext_vector_type(4)));
constexpr int SHM_V = 64 * 128 * 2, SHM_K = 64 * 192 * 2;
constexpr float THRL = 8.f * 1.4426950408889634f;
constexpr int NQR = 12;
#define AT_KSWZ(row, colB) ((row) * 384 + ((colB) ^ (((row) & 7) << 4)))
#define AT_SBAR() __builtin_amdgcn_sched_barrier(0)
__device__ __forceinline__ int crow(int r, int hi) { return (r & 3) + 8 * (r >> 2) + 4 * hi; }
__device__ __forceinline__ unsigned cvtpk(float lo, float hi) { unsigned r; asm volatile("v_cvt_pk_bf16_f32 %0, %1, %2" : "=v"(r) : "v"(lo), "v"(hi)); return r; }
__device__ __forceinline__ void partialSM(f32x16_t& p0, f32x16_t& p1, float& m_reg, float& mn, float& alpha) {
  float pmax = p0[0];
#pragma unroll
  for (int r = 1; r < 16; ++r) pmax = fmaxf(pmax, p0[r]);
#pragma unroll
  for (int r = 0; r < 16; ++r) pmax = fmaxf(pmax, p1[r]);
  { auto rr = __builtin_amdgcn_permlane32_swap(__float_as_uint(pmax), __float_as_uint(pmax), false, false);
    pmax = fmaxf(__uint_as_float(rr[0]), __uint_as_float(rr[1])); }
  if (__builtin_expect(__all(pmax - m_reg <= THRL), 1)) { mn = m_reg; alpha = 1.f; }
  else { mn = fmaxf(m_reg, pmax); alpha = __builtin_amdgcn_exp2f(m_reg - mn); m_reg = mn; }
#pragma unroll
  for (int r = 0; r < 16; ++r) p0[r] = p0[r] - mn;
#pragma unroll
  for (int r = 0; r < 16; ++r) p1[r] = p1[r] - mn;
#pragma unroll
  for (int r = 0; r < 16; ++r) p0[r] = __builtin_amdgcn_exp2f(p0[r]);
}
__device__ __forceinline__ void finishSM(f32x16_t& p0, f32x16_t& p1, float alpha, float& l_reg, bf16x8_t& pa0, bf16x8_t& pa1, bf16x8_t& pa2, bf16x8_t& pa3) {
#pragma unroll
  for (int r = 0; r < 16; ++r) p1[r] = __builtin_amdgcn_exp2f(p1[r]);
  float ps = 0;
#pragma unroll
  for (int r = 0; r < 16; ++r) ps += p0[r];
#pragma unroll
  for (int r = 0; r < 16; ++r) ps += p1[r];
  { auto rr = __builtin_amdgcn_permlane32_swap(__float_as_uint(ps), __float_as_uint(ps), false, false);
    ps = __uint_as_float(rr[0]) + __uint_as_float(rr[1]); }
  l_reg = l_reg * alpha + ps;
#define AT_PK4(P, BASE, OUT) do { unsigned a0 = cvtpk(P[BASE + 0], P[BASE + 1]), a1 = cvtpk(P[BASE + 2], P[BASE + 3]);   \
    unsigned b0 = cvtpk(P[BASE + 4], P[BASE + 5]), b1 = cvtpk(P[BASE + 6], P[BASE + 7]);                              \
    auto r0 = __builtin_amdgcn_permlane32_swap(a0, b0, false, false); auto r1 = __builtin_amdgcn_permlane32_swap(a1, b1, false, false); \
    u32x4_ w = {r0[0], r1[0], r0[1], r1[1]}; OUT = __builtin_bit_cast(bf16x8_t, w); } while (0)
  AT_PK4(p0, 0, pa0); AT_PK4(p0, 8, pa1); AT_PK4(p1, 0, pa2); AT_PK4(p1, 8, pa3);
#undef AT_PK4
}
__device__ __forceinline__ void qkt(f32x16_t& p0, f32x16_t& p1, const LAS char* Ks, const bf16x8_t* qr, const LAS char* qpe, int r32, int hi) {
#pragma unroll
  for (int r = 0; r < 16; ++r) { p0[r] = 0.f; p1[r] = 0.f; }
#pragma unroll
  for (int d0 = 0; d0 < 12; ++d0) { const int cb = (d0 * 16 + hi * 8) * 2;
    const bf16x8_t b0 = *(const LAS bf16x8_t*)(Ks + AT_KSWZ(r32, cb));
    const bf16x8_t b1 = *(const LAS bf16x8_t*)(Ks + AT_KSWZ(32 + r32, cb));
    const bf16x8_t qf = d0 < NQR ? qr[d0 < NQR ? d0 : 0] : *(const LAS bf16x8_t*)(qpe + (d0 - NQR) * 1024);
    p0 = __builtin_amdgcn_mfma_f32_32x32x16_bf16(b0, qf, p0, 0, 0, 0);
    p1 = __builtin_amdgcn_mfma_f32_32x32x16_bf16(b1, qf, p1, 0, 0, 0);
    if ((d0 & 3) == 3) AT_SBAR(); }
}
__device__ __forceinline__ int v_st(int k, int c) { const int kk = (k & ~0xC) | ((k & 4) << 1) | ((k & 8) >> 1); return ((kk >> 3) * 4 + (c >> 5)) * 512 + ((kk & 7) * 32 + (c & 31)) * 2; }
__device__ __forceinline__ int v_rd_base(int lane) { return ((lane & 3) << 3) | (((lane >> 2) & 3) << 6) | (((lane >> 4) & 1) << 5) | (((lane >> 5) & 1) << 8); }
constexpr int v_rd_off(int d0, int ks, int half) { return d0 * 512 + ks * 4096 + half * 2048; }
template <int OFF> __device__ __forceinline__ s16x4 tr_read(int vb) {
  s16x4 r; asm volatile("ds_read_b64_tr_b16 %0, %1 offset:%2" : "=&v"(r) : "v"(vb), "i"(OFF) : "memory"); return r;
}
template <int D0> __device__ __forceinline__ void pv_one(f32x16_t& od, int vb, bf16x8_t pa0, bf16x8_t pa1, bf16x8_t pa2, bf16x8_t pa3) {
  const s16x4 l0 = tr_read<v_rd_off(D0, 0, 0)>(vb), h0 = tr_read<v_rd_off(D0, 0, 1)>(vb), l1 = tr_read<v_rd_off(D0, 1, 0)>(vb), h1 = tr_read<v_rd_off(D0, 1, 1)>(vb);
  const s16x4 l2 = tr_read<v_rd_off(D0, 2, 0)>(vb), h2 = tr_read<v_rd_off(D0, 2, 1)>(vb), l3 = tr_read<v_rd_off(D0, 3, 0)>(vb), h3 = tr_read<v_rd_off(D0, 3, 1)>(vb);
  asm volatile("s_waitcnt lgkmcnt(0)" ::: "memory"); AT_SBAR();
#define AT_PK(L, H) (bf16x8_t){L[0], L[1], L[2], L[3], H[0], H[1], H[2], H[3]}
  od = __builtin_amdgcn_mfma_f32_32x32x16_bf16(pa0, AT_PK(l0, h0), od, 0, 0, 0);
  od = __builtin_amdgcn_mfma_f32_32x32x16_bf16(pa1, AT_PK(l1, h1), od, 0, 0, 0);
  od = __builtin_amdgcn_mfma_f32_32x32x16_bf16(pa2, AT_PK(l2, h2), od, 0, 0, 0);
  od = __builtin_amdgcn_mfma_f32_32x32x16_bf16(pa3, AT_PK(l3, h3), od, 0, 0, 0);
#undef AT_PK
}
__device__ __forceinline__ void pv_d0(f32x16_t* o, int vb, bf16x8_t pa0, bf16x8_t pa1, bf16x8_t pa2, bf16x8_t pa3) {
  pv_one<0>(o[0], vb, pa0, pa1, pa2, pa3); pv_one<1>(o[1], vb, pa0, pa1, pa2, pa3); pv_one<2>(o[2], vb, pa0, pa1, pa2, pa3); pv_one<3>(o[3], vb, pa0, pa1, pa2, pa3);
}
__device__ __forceinline__ void attn_unit(int tid, const bf16* __restrict__ Qb, const bf16* __restrict__ Kn, const bf16* __restrict__ Kp, const bf16* __restrict__ Vh,
                                          bf16* __restrict__ Ob, LAS char* lds) {
  (void)Vh;
  const int wid = tid >> 6, lane = tid & 63, r32 = lane & 31, hi = lane >> 5;
  LAS char* V_lds = lds; LAS char* K_lds = lds + 2 * SHM_V;
  LAS float* wsx = (LAS float*)(lds + 2 * SHM_V + 2 * SHM_K) + wid * 64; LAS float* li_l = wsx; LAS float* al_l = wsx + 32;
  float m_reg = -1e30f, l_reg = 0;
  f32x16_t o[4];
#pragma unroll
  for (int d = 0; d < 4; ++d)
#pragma unroll
    for (int r = 0; r < 16; ++r) o[d][r] = 0.f;
  bf16x8_t qr[NQR];
  LAS char* qpe = lds + 2 * SHM_V + 2 * SHM_K + 2048 + wid * ((12 - NQR) * 1024) + lane * 16;
  const unsigned qoff = (unsigned)((wid * 32 + r32) * 1536 + hi * 8);
#pragma unroll
  for (int d0 = 0; d0 < NQR; ++d0) qr[d0] = *(const bf16x8_t*)(Qb + (qoff + (unsigned)(d0 * 16)));
#pragma unroll
  for (int d0 = NQR; d0 < 12; ++d0) *(LAS bf16x8_t*)(qpe + (d0 - NQR) * 1024) = *(const bf16x8_t*)(Qb + (qoff + (unsigned)(d0 * 16)));
  const int sr = tid >> 4, sc = (tid & 15) * 8, vst0 = v_st(sr, sc), vst1 = v_st(32 + sr, sc);
  const int rk = tid >> 3, ck = (tid & 7) * 8;
  const int vb0 = (int)(unsigned)(size_t)V_lds + v_rd_base(lane);
  bf16x8_t vs0, vs1, ks0, ks1, kp0;
  const unsigned okv = (unsigned)(sr * 2048 + sc), okp = (unsigned)(rk * 64 + ck);
#define AT_SLOAD(k0) do { const unsigned t0_ = (unsigned)(k0) * 2048u + okv, t1_ = t0_ + 32u * 2048u; \
    ks0 = *(const bf16x8_t*)(Kn + t0_); vs0 = *(const bf16x8_t*)(Kn + t0_ + 128u); ks1 = *(const bf16x8_t*)(Kn + t1_); vs1 = *(const bf16x8_t*)(Kn + t1_ + 128u); \
    kp0 = *(const bf16x8_t*)(Kp + (unsigned)(k0) * 64u + okp); } while (0)
#define AT_SWRITE(b) do { *(LAS bf16x8_t*)(V_lds + (b) * SHM_V + vst0) = vs0; *(LAS bf16x8_t*)(V_lds + (b) * SHM_V + vst1) = vs1; \
    *(LAS bf16x8_t*)(K_lds + (b) * SHM_K + AT_KSWZ(sr, sc * 2)) = ks0; *(LAS bf16x8_t*)(K_lds + (b) * SHM_K + AT_KSWZ(32 + sr, sc * 2)) = ks1; \
    *(LAS bf16x8_t*)(K_lds + (b) * SHM_K + AT_KSWZ(rk, 256 + ck * 2)) = kp0; } while (0)
#define AT_SWAIT() asm volatile("s_waitcnt vmcnt(0)" ::: "memory")
#define AT_RESC(a) do { if (__any((a) < 1.f)) { if (hi == 0) al_l[r32] = (a); asm volatile("s_waitcnt lgkmcnt(0)" ::: "memory"); \
    _Pragma("unroll") for (int d = 0; d < 4; ++d) _Pragma("unroll") for (int r = 0; r < 16; ++r) o[d][r] *= al_l[crow(r, hi)]; } } while (0)
  f32x16_t pA0, pA1, pB0, pB1; float mnA, mnB, alA, alB; bf16x8_t pa0, pa1, pa2, pa3; constexpr int NT = SEQ / 64;
  AT_SLOAD(0); AT_SWAIT(); AT_SWRITE(0); __syncthreads();
  qkt(pA0, pA1, K_lds, qr, qpe, r32, hi); partialSM(pA0, pA1, m_reg, mnA, alA);
  AT_SLOAD(64);
  AT_SWAIT(); AT_SWRITE(1); __syncthreads();
  for (int j = 1; j + 1 < NT; j += 2) {
    AT_SBAR(); AT_SLOAD((j + 1) * 64); AT_SBAR();
    qkt(pB0, pB1, K_lds + SHM_K, qr, qpe, r32, hi);
    finishSM(pA0, pA1, alA, l_reg, pa0, pa1, pa2, pa3); AT_SBAR();
    pv_d0(o, vb0, pa0, pa1, pa2, pa3); partialSM(pB0, pB1, m_reg, mnB, alB);
    __syncthreads(); AT_SWAIT(); AT_SWRITE(0);
    AT_RESC(alB); __syncthreads();
    AT_SBAR(); AT_SLOAD((j + 2) * 64); AT_SBAR();
    qkt(pA0, pA1, K_lds, qr, qpe, r32, hi);
    finishSM(pB0, pB1, alB, l_reg, pa0, pa1, pa2, pa3); AT_SBAR();
    pv_d0(o, vb0 + SHM_V, pa0, pa1, pa2, pa3); partialSM(pA0, pA1, m_reg, mnA, alA);
    __syncthreads(); AT_SWAIT(); AT_SWRITE(1);
    AT_RESC(alA); __syncthreads();
  }
  AT_SBAR(); qkt(pB0, pB1, K_lds + SHM_K, qr, qpe, r32, hi);
  finishSM(pA0, pA1, alA, l_reg, pa0, pa1, pa2, pa3); AT_SBAR();
  pv_d0(o, vb0, pa0, pa1, pa2, pa3); partialSM(pB0, pB1, m_reg, mnB, alB);
  __syncthreads(); AT_RESC(alB);
  finishSM(pB0, pB1, alB, l_reg, pa0, pa1, pa2, pa3); AT_SBAR();
  pv_d0(o, vb0 + SHM_V, pa0, pa1, pa2, pa3);
  if (hi == 0) li_l[r32] = l_reg;
  asm volatile("s_waitcnt lgkmcnt(0)" ::: "memory");
  float rli[16];
#pragma unroll
  for (int r = 0; r < 16; ++r) rli[r] = __builtin_amdgcn_rcpf(li_l[crow(r, hi)]);
  bf16* Ow = Ob + (size_t)(wid * 32) * 1024 + (hi * 4) * 1024 + r32;
#pragma unroll
  for (int r = 0; r < 16; ++r) {
#pragma unroll
    for (int d0 = 0; d0 < 4; ++d0) Ow[((r & 3) + 8 * (r >> 2)) * 1024 + d0 * 32] = (bf16)f2bf(o[d0][r] * rli[r]); }
#undef AT_SLOAD
#undef AT_SWRITE
#undef AT_SWAIT
#undef AT_RESC
}

constexpr int DK0 = 0, DV0 = 2 * SHM_K, DWS = DV0 + 3 * SHM_V, DQ = DWS + 2048;
__device__ __forceinline__ void glds16(const void* gsrc, unsigned lds_dst) { unsigned keep;
  asm volatile("s_mov_b32 %0, m0\n\ts_mov_b32 m0, %2\n\ts_nop 0\n\tglobal_load_lds_dwordx4 %1, off\n\ts_mov_b32 m0, %0" : "=&s"(keep) : "v"(gsrc), "s"(lds_dst) : "memory"); }
#define AT_VMWAIT() asm volatile("s_waitcnt vmcnt(0)" ::: "memory")
__device__ __forceinline__ void attn_unit_dma(int tid, const bf16* __restrict__ Qb, const bf16* __restrict__ Kn, const bf16* __restrict__ Kp, bf16* __restrict__ Ob, LAS char* lds) {
  const int wid = __builtin_amdgcn_readfirstlane(tid >> 6), lane = tid & 63, r32 = lane & 31, hi = lane >> 5;
  LAS char* K_lds = lds + DK0; LAS char* V_lds = lds + DV0;
  LAS float* wsx = (LAS float*)(lds + DWS) + wid * 64; LAS float* li_l = wsx; LAS float* al_l = wsx + 32;
  float m_reg = -1e30f, l_reg = 0;
  f32x16_t o[4];
#pragma unroll
  for (int d = 0; d < 4; ++d)
#pragma unroll
    for (int r = 0; r < 16; ++r) o[d][r] = 0.f;
  bf16x8_t qr[NQR];
  LAS char* qpe = lds + DQ + wid * ((12 - NQR) * 1024) + lane * 16;
  const unsigned qoff = (unsigned)((wid * 32 + r32) * 1536 + hi * 8);
#pragma unroll
  for (int d0 = 0; d0 < NQR; ++d0) qr[d0] = *(const bf16x8_t*)(Qb + (qoff + (unsigned)(d0 * 16)));
#pragma unroll
  for (int d0 = NQR; d0 < 12; ++d0) *(LAS bf16x8_t*)(qpe + (d0 - NQR) * 1024) = *(const bf16x8_t*)(Qb + (qoff + (unsigned)(d0 * 16)));
  unsigned ksrc[3]; bool kpe[3]; unsigned vsrc[2];
#pragma unroll
  for (int i = 0; i < 3; ++i) { const int p = (3 * wid + i) * 64 + lane, row = p / 24, chp = p - row * 24, c = chp ^ (row & 7);
    kpe[i] = c >= 16; ksrc[i] = kpe[i] ? (unsigned)(row * 64 + (c - 16) * 8) : (unsigned)(row * 2048 + c * 8); }
#pragma unroll
  for (int i = 0; i < 2; ++i) { const int p = (2 * wid + i) * 64 + lane, sub = p >> 5, kk = (sub >> 2) * 8 + ((p >> 2) & 7), c = (sub & 3) * 32 + (p & 3) * 8;
    const int k = (kk & ~0xC) | ((kk & 4) << 1) | ((kk & 8) >> 1);
    vsrc[i] = (unsigned)(k * 2048 + c + 128); }
  const unsigned ldsb = (unsigned)(size_t)lds;
  const unsigned kdst = ldsb + DK0 + (unsigned)(3 * wid) * 1024u, vdst = ldsb + DV0 + (unsigned)(2 * wid) * 1024u;
#define AT_DMA(k0, ks, vs) do { const unsigned tk_ = (unsigned)(k0) * 2048u, tp_ = (unsigned)(k0) * 64u; \
    _Pragma("unroll") for (int i_ = 0; i_ < 3; ++i_) glds16(kpe[i_] ? (const void*)(Kp + (tp_ + ksrc[i_])) : (const void*)(Kn + (tk_ + ksrc[i_])), kdst + (unsigned)(ks) * SHM_K + i_ * 1024u); \
    _Pragma("unroll") for (int i_ = 0; i_ < 2; ++i_) glds16((const void*)(Kn + (tk_ + vsrc[i_])), vdst + (unsigned)(vs) * SHM_V + i_ * 1024u); } while (0)
#define AT_RESC(a) do { if (__any((a) < 1.f)) { if (hi == 0) al_l[r32] = (a); asm volatile("s_waitcnt lgkmcnt(0)" ::: "memory"); \
    _Pragma("unroll") for (int d = 0; d < 4; ++d) _Pragma("unroll") for (int r = 0; r < 16; ++r) o[d][r] *= al_l[crow(r, hi)]; } } while (0)
  const int vbb = (int)(ldsb + DV0) + v_rd_base(lane);
  f32x16_t pA0, pA1, pB0, pB1; float mnA, mnB, alA, alB; bf16x8_t pa0, pa1, pa2, pa3; constexpr int NT = SEQ / 64;
  AT_DMA(0, 0, 0); AT_VMWAIT(); __syncthreads();
  AT_DMA(64, 1, 1);
  qkt(pA0, pA1, K_lds, qr, qpe, r32, hi); partialSM(pA0, pA1, m_reg, mnA, alA);
  AT_VMWAIT(); __syncthreads();
  int vprev = 0;
#pragma unroll 1
  for (int j = 1; j + 1 < NT; j += 2) {
    const int v1 = vprev == 2 ? 0 : vprev + 1, v2 = v1 == 2 ? 0 : v1 + 1, v3 = v2 == 2 ? 0 : v2 + 1;
    AT_DMA((j + 1) * 64, 0, v2);
    AT_SBAR(); qkt(pB0, pB1, K_lds + SHM_K, qr, qpe, r32, hi);
    finishSM(pA0, pA1, alA, l_reg, pa0, pa1, pa2, pa3); AT_SBAR();
    pv_d0(o, vbb + vprev * SHM_V, pa0, pa1, pa2, pa3); partialSM(pB0, pB1, m_reg, mnB, alB);
    AT_RESC(alB);
    AT_VMWAIT(); __syncthreads();
    AT_DMA((j + 2) * 64, 1, v3);
    AT_SBAR(); qkt(pA0, pA1, K_lds, qr, qpe, r32, hi);
    finishSM(pB0, pB1, alB, l_reg, pa0, pa1, pa2, pa3); AT_SBAR();
    pv_d0(o, vbb + v1 * SHM_V, pa0, pa1, pa2, pa3); partialSM(pA0, pA1, m_reg, mnA, alA);
    AT_RESC(alA);
    AT_VMWAIT(); __syncthreads();
    vprev = v2;
  }
  {
    const int v1 = vprev == 2 ? 0 : vprev + 1;
    AT_SBAR(); qkt(pB0, pB1, K_lds + SHM_K, qr, qpe, r32, hi);
    finishSM(pA0, pA1, alA, l_reg, pa0, pa1, pa2, pa3); AT_SBAR();
    pv_d0(o, vbb + vprev * SHM_V, pa0, pa1, pa2, pa3); partialSM(pB0, pB1, m_reg, mnB, alB);
    AT_RESC(alB);
    finishSM(pB0, pB1, alB, l_reg, pa0, pa1, pa2, pa3); AT_SBAR();
    pv_d0(o, vbb + v1 * SHM_V, pa0, pa1, pa2, pa3);
  }
  if (hi == 0) li_l[r32] = l_reg;
  asm volatile("s_waitcnt lgkmcnt(0)" ::: "memory");
  float rli[16];
#pragma unroll
  for (int r = 0; r < 16; ++r) rli[r] = __builtin_amdgcn_rcpf(li_l[crow(r, hi)]);
  bf16* Ow = Ob + (size_t)(wid * 32) * 1024 + (hi * 4) * 1024 + r32;
#pragma unroll
  for (int r = 0; r < 16; ++r) {
#pragma unroll
    for (int d0 = 0; d0 < 4; ++d0) Ow[((r & 3) + 8 * (r >> 2)) * 1024 + d0 * 32] = (bf16)f2bf(o[d0][r] * rli[r]); }
#undef AT_DMA
#undef AT_RESC
}

constexpr int SHM_K8 = 64 * 192;
constexpr int EK0 = 0, EV0 = 2 * SHM_K8, EWS = EV0 + 3 * SHM_V;
typedef int v8i32a_t __attribute__((ext_vector_type(8)));
typedef int v4i32a_t __attribute__((ext_vector_type(4)));
__device__ __forceinline__ v8i32a_t cat8a(v4i32a_t a, v4i32a_t b) { return __builtin_shufflevector(a, b, 0, 1, 2, 3, 4, 5, 6, 7); }
__device__ __forceinline__ void qkt8(f32x16_t& p0, f32x16_t& p1, const LAS char* Ks, const v8i32a_t* q8, int r32, int hi) {
#pragma unroll
  for (int r = 0; r < 16; ++r) { p0[r] = 0.f; p1[r] = 0.f; }
  const int f0 = (r32 >> 2) & 3;
#pragma unroll
  for (int ks = 0; ks < 3; ++ks) {
    const int L0 = 4 * ks + 2 * hi;
    const LAS char* ra = Ks + r32 * 192; const LAS char* rb = Ks + (32 + r32) * 192;
    const v8i32a_t ka = cat8a(*(const LAS v4i32a_t*)(ra + ((L0 ^ f0) << 4)), *(const LAS v4i32a_t*)(ra + (((L0 + 1) ^ f0) << 4)));
    const v8i32a_t kb = cat8a(*(const LAS v4i32a_t*)(rb + ((L0 ^ f0) << 4)), *(const LAS v4i32a_t*)(rb + (((L0 + 1) ^ f0) << 4)));
    p0 = __builtin_amdgcn_mfma_scale_f32_32x32x64_f8f6f4(ka, q8[ks], p0, 0, 0, 0, 0x7f7f7f7f, 0, 0x7f7f7f7f);
    p1 = __builtin_amdgcn_mfma_scale_f32_32x32x64_f8f6f4(kb, q8[ks], p1, 0, 0, 0, 0x7f7f7f7f, 0, 0x7f7f7f7f);
  }
}
__device__ __forceinline__ void attn_unit_dma8(int tid, const unsigned char* __restrict__ Q8, const unsigned char* __restrict__ K8, const unsigned char* __restrict__ Kp8,
                                               const bf16* __restrict__ Vb, bf16* __restrict__ Ob, LAS char* lds) {
  const int wid = __builtin_amdgcn_readfirstlane(tid >> 6), lane = tid & 63, r32 = lane & 31, hi = lane >> 5;
  LAS char* K_lds = lds + EK0;
  LAS float* wsx = (LAS float*)(lds + EWS) + wid * 64; LAS float* li_l = wsx; LAS float* al_l = wsx + 32;
  float m_reg = -1e30f, l_reg = 0;
  f32x16_t o[4];
#pragma unroll
  for (int d = 0; d < 4; ++d)
#pragma unroll
    for (int r = 0; r < 16; ++r) o[d][r] = 0.f;
  v8i32a_t q8[3];
  { const unsigned qoff = (unsigned)((wid * 32 + r32) * 1536 + hi * 32);
#pragma unroll
    for (int ks = 0; ks < 3; ++ks) q8[ks] = cat8a(*(const v4i32a_t*)(Q8 + qoff + ks * 64), *(const v4i32a_t*)(Q8 + qoff + ks * 64 + 16)); }
  unsigned ksrc[2]; bool kpe[2]; unsigned vsrc[2];
#pragma unroll
  for (int i = 0; i < 2; ++i) { const int p = (8 * i + wid) * 64 + lane, row = p / 12, chp = p - row * 12, c = chp ^ ((row >> 2) & 3);
    kpe[i] = c >= 8; ksrc[i] = kpe[i] ? (unsigned)(row * 64 + (c - 8) * 16) : (unsigned)(row * 1024 + c * 16); }
#pragma unroll
  for (int i = 0; i < 2; ++i) { const int p = (2 * wid + i) * 64 + lane, sub = p >> 5, kk = (sub >> 2) * 8 + ((p >> 2) & 7), c = (sub & 3) * 32 + (p & 3) * 8;
    const int k = (kk & ~0xC) | ((kk & 4) << 1) | ((kk & 8) >> 1);
    vsrc[i] = (unsigned)(k * 2048 + c); }
  const unsigned ldsb = (unsigned)(size_t)lds;
  const unsigned kdst = ldsb + EK0 + (unsigned)wid * 1024u, vdst = ldsb + EV0 + (unsigned)(2 * wid) * 1024u;
#define AT_DMA8(k0, ks, vs) do { const unsigned tk_ = (unsigned)(k0) * 1024u, tp_ = (unsigned)(k0) * 64u, tv_ = (unsigned)(k0) * 2048u; \
    glds16(kpe[0] ? (const void*)(Kp8 + (tp_ + ksrc[0])) : (const void*)(K8 + (tk_ + ksrc[0])), kdst + (unsigned)(ks) * SHM_K8); \
    if (wid < 4) glds16(kpe[1] ? (const void*)(Kp8 + (tp_ + ksrc[1])) : (const void*)(K8 + (tk_ + ksrc[1])), kdst + (unsigned)(ks) * SHM_K8 + 8192u); \
    _Pragma("unroll") for (int i_ = 0; i_ < 2; ++i_) glds16((const void*)(Vb + (tv_ + vsrc[i_])), vdst + (unsigned)(vs) * SHM_V + i_ * 1024u); } while (0)
#define AT_RESC(a) do { if (__any((a) < 1.f)) { if (hi == 0) al_l[r32] = (a); asm volatile("s_waitcnt lgkmcnt(0)" ::: "memory"); \
    _Pragma("unroll") for (int d = 0; d < 4; ++d) _Pragma("unroll") for (int r = 0; r < 16; ++r) o[d][r] *= al_l[crow(r, hi)]; } } while (0)
  const int vbb = (int)(ldsb + EV0) + v_rd_base(lane);
  f32x16_t pA0, pA1, pB0, pB1; float mnA, mnB, alA, alB; bf16x8_t pa0, pa1, pa2, pa3; constexpr int NT = SEQ / 64;
  AT_DMA8(0, 0, 0); AT_VMWAIT(); __syncthreads();
  AT_DMA8(64, 1, 1);
  qkt8(pA0, pA1, K_lds, q8, r32, hi); partialSM(pA0, pA1, m_reg, mnA, alA);
  AT_VMWAIT(); __syncthreads();
  int vprev = 0;
#pragma unroll 1
  for (int j = 1; j + 1 < NT; j += 2) {
    const int v1 = vprev == 2 ? 0 : vprev + 1, v2 = v1 == 2 ? 0 : v1 + 1, v3 = v2 == 2 ? 0 : v2 + 1;
    AT_DMA8((j + 1) * 64, 0, v2);
    AT_SBAR(); qkt8(pB0, pB1, K_lds + SHM_K8, q8, r32, hi);
    finishSM(pA0, pA1, alA, l_reg, pa0, pa1, pa2, pa3); AT_SBAR();
    pv_d0(o, vbb + vprev * SHM_V, pa0, pa1, pa2, pa3); partialSM(pB0, pB1, m_reg, mnB, alB);
    AT_RESC(alB);
    AT_VMWAIT(); __syncthreads();
    AT_DMA8((j + 2) * 64, 1, v3);
    AT_SBAR(); qkt8(pA0, pA1, K_lds, q8, r32, hi);
    finishSM(pB0, pB1, alB, l_reg, pa0, pa1, pa2, pa3); AT_SBAR();
    pv_d0(o, vbb + v1 * SHM_V, pa0, pa1, pa2, pa3); partialSM(pA0, pA1, m_reg, mnA, alA);
    AT_RESC(alA);
    AT_VMWAIT(); __syncthreads();
    vprev = v2;
  }
  {
    const int v1 = vprev == 2 ? 0 : vprev + 1;
    AT_SBAR(); qkt8(pB0, pB1, K_lds + SHM_K8, q8, r32, hi);
    finishSM(pA0, pA1, alA, l_reg, pa0, pa1, pa2, pa3); AT_SBAR();
    pv_d0(o, vbb + vprev * SHM_V, pa0, pa1, pa2, pa3); partialSM(pB0, pB1, m_reg, mnB, alB);
    AT_RESC(alB);
    finishSM(pB0, pB1, alB, l_reg, pa0, pa1, pa2, pa3); AT_SBAR();
    pv_d0(o, vbb + v1 * SHM_V, pa0, pa1, pa2, pa3);
  }
  if (hi == 0) li_l[r32] = l_reg;
  asm volatile("s_waitcnt lgkmcnt(0)" ::: "memory");
  float rli[16];
#pragma unroll
  for (int r = 0; r < 16; ++r) rli[r] = __builtin_amdgcn_rcpf(li_l[crow(r, hi)]);
  bf16* Ow = Ob + (size_t)(wid * 32) * 1024 + (hi * 4) * 1024 + r32;
#pragma unroll
  for (int r = 0; r < 16; ++r) {
#pragma unroll
    for (int d0 = 0; d0 < 4; ++d0) Ow[((r & 3) + 8 * (r >> 2)) * 1024 + d0 * 32] = (bf16)f2bf(o[d0][r] * rli[r]); }
#undef AT_DMA8
#undef AT_RESC
}

constexpr int SHM_V8 = 128 * 64;
constexpr int FK0 = 0, FV0 = 2 * SHM_K8, FWS = FV0 + 3 * SHM_V8;
constexpr float THRL8 = 8.0f;
__device__ __forceinline__ unsigned pk4f8(float a, float b, float c, float d) { int p = __builtin_amdgcn_cvt_pk_fp8_f32(a, b, 0, false); p = __builtin_amdgcn_cvt_pk_fp8_f32(c, d, p, true); return (unsigned)p; }
__device__ __forceinline__ void partialSM8(f32x16_t& p0, f32x16_t& p1, float& m_reg, float& mn, float& alpha) {
  float pmax = p0[0];
#pragma unroll
  for (int r = 1; r < 16; ++r) pmax = fmaxf(pmax, p0[r]);
#pragma unroll
  for (int r = 0; r < 16; ++r) pmax = fmaxf(pmax, p1[r]);
  { auto rr = __builtin_amdgcn_permlane32_swap(__float_as_uint(pmax), __float_as_uint(pmax), false, false);
    pmax = fmaxf(__uint_as_float(rr[0]), __uint_as_float(rr[1])); }
  if (__builtin_expect(__all(pmax - m_reg <= THRL8), 1)) { mn = m_reg; alpha = 1.f; }
  else { mn = fmaxf(m_reg, pmax); alpha = __builtin_amdgcn_exp2f(m_reg - mn); m_reg = mn; }
#pragma unroll
  for (int r = 0; r < 16; ++r) p0[r] = p0[r] - mn;
#pragma unroll
  for (int r = 0; r < 16; ++r) p1[r] = p1[r] - mn;
#pragma unroll
  for (int r = 0; r < 16; ++r) p0[r] = __builtin_amdgcn_exp2f(p0[r]);
}
__device__ __forceinline__ void finishSM8(f32x16_t& p0, f32x16_t& p1, float alpha, float& l_reg, v8i32a_t& pa) {
#pragma unroll
  for (int r = 0; r < 16; ++r) p1[r] = __builtin_amdgcn_exp2f(p1[r]);
  float ps = 0;
#pragma unroll
  for (int r = 0; r < 16; ++r) ps += p0[r];
#pragma unroll
  for (int r = 0; r < 16; ++r) ps += p1[r];
  { auto rr = __builtin_amdgcn_permlane32_swap(__float_as_uint(ps), __float_as_uint(ps), false, false);
    ps = __uint_as_float(rr[0]) + __uint_as_float(rr[1]); }
  l_reg = l_reg * alpha + ps;
  pa[0] = (int)pk4f8(p0[0], p0[1], p0[2], p0[3]);   pa[1] = (int)pk4f8(p0[4], p0[5], p0[6], p0[7]);
  pa[2] = (int)pk4f8(p0[8], p0[9], p0[10], p0[11]); pa[3] = (int)pk4f8(p0[12], p0[13], p0[14], p0[15]);
  pa[4] = (int)pk4f8(p1[0], p1[1], p1[2], p1[3]);   pa[5] = (int)pk4f8(p1[4], p1[5], p1[6], p1[7]);
  pa[6] = (int)pk4f8(p1[8], p1[9], p1[10], p1[11]); pa[7] = (int)pk4f8(p1[12], p1[13], p1[14], p1[15]);
}
__device__ __forceinline__ void pv8(f32x16_t* o, const LAS char* Vs, v8i32a_t pa, int r32, int hi) {
#pragma unroll
  for (int d0 = 0; d0 < 4; ++d0) {
    const int d = 32 * d0 + r32, f = (d >> 2) & 3;
    const LAS char* rp = Vs + d * 64;
    const v8i32a_t vf = cat8a(*(const LAS v4i32a_t*)(rp + (((2 * hi) ^ f) << 4)), *(const LAS v4i32a_t*)(rp + (((2 * hi + 1) ^ f) << 4)));
    o[d0] = __builtin_amdgcn_mfma_scale_f32_32x32x64_f8f6f4(pa, vf, o[d0], 0, 0, 0, 0x7f7f7f7f, 0, 0x7f7f7f7f);
  }
}
__device__ __forceinline__ void attn_unit_f8(int tid, const unsigned char* __restrict__ Q8, const unsigned char* __restrict__ K8, const unsigned char* __restrict__ Kp8,
                                             const unsigned char* __restrict__ V8T, bf16* __restrict__ Ob, LAS char* lds) {
  const int wid = __builtin_amdgcn_readfirstlane(tid >> 6), lane = tid & 63, r32 = lane & 31, hi = lane >> 5;
  LAS char* K_lds = lds + FK0; LAS char* V_lds = lds + FV0;
  LAS float* wsx = (LAS float*)(lds + FWS) + wid * 64; LAS float* li_l = wsx; LAS float* al_l = wsx + 32;
  float m_reg = -1e30f, l_reg = 0;
  f32x16_t o[4];
#pragma unroll
  for (int d = 0; d < 4; ++d)
#pragma unroll
    for (int r = 0; r < 16; ++r) o[d][r] = 0.f;
  v8i32a_t q8[3];
  { const unsigned qoff = (unsigned)((wid * 32 + r32) * 1536 + hi * 32);
#pragma unroll
    for (int ks = 0; ks < 3; ++ks) q8[ks] = cat8a(*(const v4i32a_t*)(Q8 + qoff + ks * 64), *(const v4i32a_t*)(Q8 + qoff + ks * 64 + 16)); }
  unsigned ksrc[2]; bool kpe[2]; unsigned vsrc;
#pragma unroll
  for (int i = 0; i < 2; ++i) { const int p = (8 * i + wid) * 64 + lane, row = p / 12, chp = p - row * 12, c = chp ^ ((row >> 2) & 3);
    kpe[i] = c >= 8; ksrc[i] = kpe[i] ? (unsigned)(row * 64 + (c - 8) * 16) : (unsigned)(row * 1024 + c * 16); }
  { const int p = wid * 64 + lane, d = p >> 2, c = (p & 3) ^ ((d >> 2) & 3); vsrc = (unsigned)(d * 64 + c * 16); }
  const unsigned ldsb = (unsigned)(size_t)lds;
  const unsigned kdst = ldsb + FK0 + (unsigned)wid * 1024u, vdst = ldsb + FV0 + (unsigned)wid * 1024u;
#define AT_DMAF(k0, ks, vs) do { const unsigned tk_ = (unsigned)(k0) * 1024u, tp_ = (unsigned)(k0) * 64u, tv_ = (unsigned)(k0) * 128u; \
    glds16(kpe[0] ? (const void*)(Kp8 + (tp_ + ksrc[0])) : (const void*)(K8 + (tk_ + ksrc[0])), kdst + (unsigned)(ks) * SHM_K8); \
    if (wid < 4) glds16(kpe[1] ? (const void*)(Kp8 + (tp_ + ksrc[1])) : (const void*)(K8 + (tk_ + ksrc[1])), kdst + (unsigned)(ks) * SHM_K8 + 8192u); \
    glds16((const void*)(V8T + (tv_ + vsrc)), vdst + (unsigned)(vs) * SHM_V8); } while (0)
#define AT_RESC(a) do { if (__any((a) < 1.f)) { if (hi == 0) al_l[r32] = (a); asm volatile("s_waitcnt lgkmcnt(0)" ::: "memory"); \
    _Pragma("unroll") for (int d = 0; d < 4; ++d) _Pragma("unroll") for (int r = 0; r < 16; ++r) o[d][r] *= al_l[crow(r, hi)]; } } while (0)
  f32x16_t pA0, pA1, pB0, pB1; float mnA, mnB, alA, alB; v8i32a_t pa; constexpr int NT = SEQ / 64;
  AT_DMAF(0, 0, 0); AT_VMWAIT(); __syncthreads();
  AT_DMAF(64, 1, 1);
  qkt8(pA0, pA1, K_lds, q8, r32, hi); partialSM8(pA0, pA1, m_reg, mnA, alA);
  AT_VMWAIT(); __syncthreads();
  int vprev = 0;
#pragma unroll 1
  for (int j = 1; j + 1 < NT; j += 2) {
    const int v1 = vprev == 2 ? 0 : vprev + 1, v2 = v1 == 2 ? 0 : v1 + 1, v3 = v2 == 2 ? 0 : v2 + 1;
    AT_DMAF((j + 1) * 64, 0, v2);
    AT_SBAR(); qkt8(pB0, pB1, K_lds + SHM_K8, q8, r32, hi);
    finishSM8(pA0, pA1, alA, l_reg, pa); AT_SBAR();
    pv8(o, V_lds + vprev * SHM_V8, pa, r32, hi); partialSM8(pB0, pB1, m_reg, mnB, alB);
    AT_RESC(alB);
    AT_VMWAIT(); __syncthreads();
    AT_DMAF((j + 2) * 64, 1, v3);
    AT_SBAR(); qkt8(pA0, pA1, K_lds, q8, r32, hi);
    finishSM8(pB0, pB1, alB, l_reg, pa); AT_SBAR();
    pv8(o, V_lds + v1 * SHM_V8, pa, r32, hi); partialSM8(pA0, pA1, m_reg, mnA, alA);
    AT_RESC(alA);
    AT_VMWAIT(); __syncthreads();
    vprev = v2;
  }
  {
    const int v1 = vprev == 2 ? 0 : vprev + 1;
    AT_SBAR(); qkt8(pB0, pB1, K_lds + SHM_K8, q8, r32, hi);
    finishSM8(pA0, pA1, alA, l_reg, pa); AT_SBAR();
    pv8(o, V_lds + vprev * SHM_V8, pa, r32, hi); partialSM8(pB0, pB1, m_reg, mnB, alB);
    AT_RESC(alB);
    finishSM8(pB0, pB1, alB, l_reg, pa); AT_SBAR();
    pv8(o, V_lds + v1 * SHM_V8, pa, r32, hi);
  }
  if (hi == 0) li_l[r32] = l_reg;
  asm volatile("s_waitcnt lgkmcnt(0)" ::: "memory");
  float rli[16];
#pragma unroll
  for (int r = 0; r < 16; ++r) rli[r] = __builtin_amdgcn_rcpf(li_l[crow(r, hi)]);
  bf16* Ow = Ob + (size_t)(wid * 32) * 1024 + (hi * 4) * 1024 + r32;
#pragma unroll
  for (int r = 0; r < 16; ++r) {
#pragma unroll
    for (int d0 = 0; d0 < 4; ++d0) Ow[((r & 3) + 8 * (r >> 2)) * 1024 + d0 * 32] = (bf16)f2bf(o[d0][r] * rli[r]); }
#undef AT_DMAF
#undef AT_RESC
}
}
__device__ __forceinline__ const float* karg(int i) {
  unsigned long long p = (unsigned long long)__builtin_amdgcn_kernarg_segment_ptr();
  asm volatile("" : "+s"(p));
  return ((const float* const __attribute__((address_space(4)))*)p)[i];
}
#define x_in karg(0)
#define C_IN karg(1)
#define positions_f karg(2)
#define ada_w karg(3)
#define ada_b karg(4)
#define norm_mix_g karg(5)
#define norm_ffn_g karg(6)
#define hy_w_in karg(7)
#define hy_b_in karg(8)
#define hy_conv_w karg(9)
#define hy_conv_b karg(10)
#define hy_f_w1 karg(11)
#define hy_f_b1 karg(12)
#define hy_f_w2 karg(13)
#define hy_f_b2 karg(14)
#define hy_f_w3 karg(15)
#define hy_f_freq karg(16)
#define hy_f_bias karg(17)
#define hy_w_out karg(18)
#define hy_b_out karg(19)
#define mla_w_in karg(20)
#define mla_q_norm_g karg(21)
#define mla_w_qb karg(22)
#define mla_kv_norm_g karg(23)
#define mla_w_kvb karg(24)
#define mla_w_out karg(25)
#define moe_w_router karg(26)
#define moe_w_gate karg(27)
#define moe_w_up karg(28)
#define moe_w_down karg(29)
#define final_norm_g karg(30)
#define positions ((const int*)karg(2))
#define XRES ((float*)karg(31))
#define WSB ((unsigned char*)karg(32))
#define MiB ((size_t)1 << 20)
#define WhoT ((bf16*)(WSB + 24 * MiB))
#define WmoT ((bf16*)(WSB + 26 * MiB))
#define Ybf ((bf16*)(WSB + 512 * MiB))
#define ws ((float*)(WSB + 40 * MiB))
#define Wmoe ((bf16*)(WSB + 48 * MiB))
#define WmoeD ((bf16*)((unsigned char*)Wmoe + (size_t)NE * 2048 * 1024))
#define XNb ((bf16*)(WSB + 144 * MiB))
#define XSb ((bf16*)(WSB + 208 * MiB))
#define HIDb ((bf16*)(WSB + 336 * MiB))
#define WinT ((bf16*)(WSB + 28 * MiB))
#define Upre ((bf16*)(WSB + 208 * MiB))
#define UTb ((bf16*)(WSB + 208 * MiB))
#define XBb ((bf16*)(WSB + 400 * MiB))
#define zTb ((bf16*)(WSB + 400 * MiB))
#define ycTb ((bf16*)(WSB + 464 * MiB))
#define KRb ((unsigned char*)(WSB + 560 * MiB))
#define K0b ((float*)(WSB + 568 * MiB))
#define W3Tb ((bf16*)(WSB + 569 * MiB))
#define WaT ((bf16*)(WSB + 34 * MiB))
#define WqbT ((bf16*)(WSB + 35 * MiB))
#define WkvbT ((bf16*)(WSB + 36 * MiB))
#define Abuf ((bf16*)(WSB + 208 * MiB))
#define CQNb ((bf16*)(WSB + 240 * MiB))
#define CKVNb ((bf16*)(WSB + 256 * MiB))
#define KPEb ((bf16*)(WSB + 272 * MiB))
#define ROPEb ((float*)(WSB + 528 * MiB))
#define Qbuf ((bf16*)(WSB + 288 * MiB))
#define KVbuf ((bf16*)(WSB + 384 * MiB))
#define KPE8b ((unsigned char*)(WSB + 276 * MiB))
#define K8nb ((unsigned char*)(WSB + 336 * MiB))
#define V8Tb ((unsigned char*)(WSB + 208 * MiB))
#define idx_id ((int*)(WSB + 10 * MiB))
#define idx_row ((int*)(WSB + 8 * MiB))
#define gsel_row ((float*)(WSB + 9 * MiB))
#define ACT ((size_t)NTOK * DM)
#define mod (ws)
#define aff (mod + 2 * NB * 6 * DM)
#define gsel (aff + (size_t)NB * NE * SEQ)
#define idx ((int*)(gsel + (size_t)NB * NE * CAP))
#define slot_of (idx + (size_t)NB * NE * CAP)
#define RA ((float*)(slot_of + (size_t)NB * NE * SEQ))
#define RF (RA + ACT)
#define RU (RF + 2 * (size_t)SEQ * DM)
#define RC (RU + (size_t)SEQ * 3072)
#define RD (RC + ACT)

__device__ __forceinline__ void vtrans_phase(int tid_in, unsigned char* lds_, const bf16* KV, unsigned char* V8T) {
  const int tid = launder(tid_in);
  LAS unsigned char* tile = (LAS unsigned char*)lds_;
  const int key = tid & 63, dg = tid >> 6;
  const int a_ = key >> 5, k5 = key & 31, hi_ = (k5 >> 2) & 1, r_ = (k5 & 3) | ((k5 >> 3) << 2), pos = 32 * hi_ + 16 * a_ + r_;
  constexpr int NITEM = NB * 8 * (SEQ / 64);
  v4u ra[2], na[2];
  { const int item = bid(), t = item & 63, bh = item >> 6, b = bh >> 3, h = bh & 7;
    const bf16* src = KV + (size_t)(b * SEQ + t * 64 + key) * 2048 + h * 256 + 128 + dg * 16;
    ra[0] = *(const v4u*)src; ra[1] = *(const v4u*)(src + 8); }
  for (int item = bid(); item < NITEM; item += GRID) {
    { const int nitem = item + GRID < NITEM ? item + GRID : item, t = nitem & 63, bh = nitem >> 6, b = bh >> 3, h = bh & 7;
      const bf16* src = KV + (size_t)(b * SEQ + t * 64 + key) * 2048 + h * 256 + 128 + dg * 16;
      na[0] = *(const v4u*)src; na[1] = *(const v4u*)(src + 8); }
    float v[16];
    unpack8(ra[0], v); unpack8(ra[1], v + 8);
    __syncthreads();
#pragma unroll
    for (int q = 0; q < 4; ++q) { const unsigned w = pg8::pack4_fp8(v[4 * q], v[4 * q + 1], v[4 * q + 2], v[4 * q + 3]);
#pragma unroll
      for (int e = 0; e < 4; ++e) tile[(dg * 16 + 4 * q + e) * 80 + pos] = (unsigned char)(w >> (8 * e)); }
    __syncthreads();
    const int d = tid >> 2, c = tid & 3;
    const v4u o = *(const LAS v4u*)(tile + d * 80 + c * 16);
    *(v4u*)(V8T + (size_t)item * 8192 + d * 64 + c * 16) = o;
    ra[0] = na[0]; ra[1] = na[1];
  }
}
__device__ __forceinline__ void attn_phase(int tid_in, unsigned char* lds_) {
  const int tid = launder(tid_in);
  const int c = bid(), x = c & 7, s_ = c >> 3;
#pragma unroll 1
  for (int i = 0; i < 4; ++i) {
    const int bh = i * 16 + x * 2 + (s_ >> 4), qb = s_ & 15, b = bh >> 3, h = bh & 7;
    __syncthreads();
    att::attn_unit_f8(launder(tid), (const unsigned char*)Qbuf + (size_t)(b * SEQ + qb * 256) * 1536 + h * 192, K8nb + (size_t)(b * SEQ) * 1024 + h * 128, KPE8b + (size_t)(b * SEQ) * 64,
                      V8Tb + (size_t)bh * (64 * 8192), Ybf + (size_t)(b * SEQ + qb * 256) * 1024 + h * 128, (LAS char*)lds_);
  }
}
#define MODL (mod + (size_t)layer * NB * 6 * DM)
#define sh1 (MODL)
#define sc1 (MODL + DM)
#define g1 (MODL + 2 * DM)
#define sh2 (MODL + 3 * DM)
#define sc2 (MODL + 4 * DM)
#define g2 (MODL + 5 * DM)
__device__ __forceinline__ void moe_convert(int tid_in, unsigned char* lds_, int k0, int nk, const float* wg, const float* wu, const float* wd, unsigned char* wm) {
  const int t_ = launder(tid_in), wave = __builtin_amdgcn_readfirstlane(t_ >> 6), lane = t_ & 63;
  LAS float* scr = (LAS float*)((LAS unsigned char*)lds_ + wave * 16384);
  constexpr int I_W = (DM / 64) * (DM / 32);
  const size_t WSZ = (size_t)DM * DM;
  const int gw = bid() * 8 + wave;
#pragma unroll 1
  for (int k = k0; k < k0 + nk; ++k) {
    const int it = gw + k * (GRID * 8);
    const int e = it / (3 * I_W), r = it - e * 3 * I_W, which = r / I_W, item = r - which * I_W;
    if (which == 0) transpose_item_fp8<1>(wg + (size_t)e * WSZ, DM, DM, wm, e * 2048, scr, item, lane);
    else if (which == 1) transpose_item_fp8<1>(wu + (size_t)e * WSZ, DM, DM, wm, e * 2048 + 128, scr, item, lane);
    else transpose_item_fp8<0>(wd + (size_t)e * WSZ, DM, DM, wm + (size_t)NE * 2048 * 1024, e * 1024, scr, item, lane);
  }
}
constexpr int MOE_TA = 20480;
__global__ void __launch_bounds__(NTHR, 2) fwd_megakernel(Args args) {
  extern __shared__ __attribute__((aligned(16))) unsigned char lds[];
  const int tid = threadIdx.x;
  volatile LAS unsigned* misc = (volatile LAS unsigned*)((LAS unsigned char*)lds + (LDS_BYTES - 256));
  if (tid < 64) misc[tid] = 0u;
  __syncthreads();
  unsigned* ctl = (unsigned*)WSB;
  (void)xcd_barrier_post(ctl + 4096, misc + 8);

  mod_phase(tid, lds, C_IN, ada_w, ada_b, mod);
  {
    const int wave = __builtin_amdgcn_readfirstlane(tid >> 6), lane = tid & 63;
    LAS float* scr = (LAS float*)((LAS unsigned char*)lds + wave * 16384);
    const int gw = bid() * 8 + wave, NGW = GRID * 8;
    constexpr int I_O = (DM / 64) * (DM / 32);
    constexpr int I_IN = (DM / 64) * (3072 / 32);
    for (int it = gw; it < 2 * I_O + I_IN; it += NGW) {
      if (it < I_O) transpose_item<0>(hy_w_out, DM, DM, WhoT, 0, scr, it, lane);
      else if (it < 2 * I_O) transpose_item<0>(mla_w_out, DM, DM, WmoT, 0, scr, it - I_O, lane);
      else transpose_item<0>(hy_w_in, DM, 3072, WinT, 0, scr, it - 2 * I_O, lane);
    }
    constexpr int I_A = (DM / 64) * (448 / 32), I_Q = (256 / 64) * (1536 / 32);
    for (int it = gw; it < I_A + I_Q; it += NGW) {
      if (it < I_A) transpose_item<2>(mla_w_in, DM, 448, WaT, 0, scr, it, lane);
      else if (it < I_A + I_Q) transpose_item<3>(mla_w_qb, 256, 1536, WqbT, 0, scr, it - I_A, lane);
    }
    {
      const int gt = bid() * NTHR + launder(tid), NGT = GRID * NTHR;
      for (int q = gt; q < NTOK * 32; q += NGT) {
        const int row = q >> 5, i = q & 31;
        const float ang = (float)positions[row] * powf(10000.0f, -(float)(2 * i) / 64.0f);
        float sn, cs; sincosf(ang, &sn, &cs);
        *(float2*)(ROPEb + (size_t)row * 64 + 2 * i) = make_float2(cs, sn);
      }
    }
    { const int gt = bid() * NTHR + launder(tid); for (int q = gt; q < NE * NB * CAP; q += GRID * NTHR) idx_id[q] = q; }
    {
      const int gt = bid() * NTHR + launder(tid);
      for (int q = gt; q < 2048 * 16; q += GRID * NTHR) {
        const int n = q & 2047, k0 = (q >> 11) * 8, hh = n >> 8, wi = n & 255;
        float w[8];
#pragma unroll
        for (int e = 0; e < 8; ++e) w[e] = mla_w_kvb[(size_t)(k0 + e) * 2048 + n];
        v4u o; o.x = pk2(w[0], w[1]); o.y = pk2(w[2], w[3]); o.z = pk2(w[4], w[5]); o.w = pk2(w[6], w[7]);
        *(v4u*)(WkvbT + (size_t)((wi < 128 ? 0 : 1024) + hh * 128 + (wi & 127)) * 128 + k0) = o;
      }
    }
    {
      const int gt = bid() * NTHR + launder(tid);
      for (int q = gt; q < 2048 * 8; q += GRID * NTHR) {
        const int col = q & 2047, j0 = (q >> 11) * 8;
        float w[8];
#pragma unroll
        for (int e = 0; e < 8; ++e) w[e] = hy_f_w3[(size_t)(j0 + e) * 2048 + col];
        v4u o; o.x = pk2(w[0], w[1]); o.y = pk2(w[2], w[3]); o.z = pk2(w[4], w[5]); o.w = pk2(w[6], w[7]);
        *(v4u*)(W3Tb + (size_t)col * 64 + j0) = o;
      }
    }
    {
      const int gt = bid() * NTHR + launder(tid), NGT = GRID * NTHR;
      for (int q = gt; q < 64 * 1024 / 8; q += NGT) *(v4u*)(WaT + (size_t)448 * 1024 + (size_t)q * 8) = (v4u){0u, 0u, 0u, 0u};
    }
  }
  GBF(0, 0, 2);

  {
    constexpr int layer = 0;
      norm_rows_phase<false>(tid, lds, x_in, norm_mix_g, sh1, sc1, XNb, nullptr, nullptr);
      filter_phase(tid, lds, hy_f_w1, hy_f_b1, hy_f_w2, hy_f_b2, W3Tb, hy_f_freq, hy_f_bias, KRb, K0b);
      GBF(0, 2, 2);
      {
        pg8::Gemm g{WinT, XNb, 3 * DM, NTOK, DM}; pg8::StaticOrder S; S.init(3 * DM, NTOK, GRID, bid());
        pg8::EpiBf16BiasT E{UTb, NTOK, hy_b_in};
        pg8::gemm_phase<pg8::EpiBf16BiasT, pg8::StaticOrder, true, true>((LAS unsigned char*)lds, g, S, E);
      }
      GBF(0, 4, 2);
      longconv_phase(tid, lds, UTb, hy_conv_w, hy_conv_b, KRb, ycTb);
      GBF(0, 6, 2);
      {
        pg8::Gemm g{ycTb, WhoT, NTOK, DM, DM}; pg8::StaticOrder S; S.init(NTOK, DM, GRID, bid());
        pg8::EpiResidT<false, true> E{x_in, XBb, hy_b_out, g1};
        pg8::gemm_phase<pg8::EpiResidT<false, true>, pg8::StaticOrder, true, true, false, true>((LAS unsigned char*)lds, g, S, E);
      }
      GBF(0, 8, 2);
    norm_router_phase(tid, lds, XBb, norm_ffn_g + layer * DM, sh2, sc2, (unsigned char*)XNb, moe_w_router + (size_t)layer * DM * NE, aff);
    GBF(0, 10, 2);
    topk_phase(tid, lds, aff, idx_row, gsel_row, slot_of);
    GBF(1, 0, 2);
    {
      pg8::Gemm g{XNb, (bf16*)((unsigned char*)Wmoe + (size_t)layer * 48 * MiB), NE * NB * CAP, NE * 2048, DM / 2}; pg8::MoeOrder1 S{bid()};
      pg8::EpiSwiGLU E{HIDb, 1.0f, 1.0f / 32.0f};
      pg8::gemm_phase_gather<pg8::EpiSwiGLU, pg8::MoeOrder1, true>((LAS unsigned char*)lds, g, idx_row, S, E);
    }
    GBF(1, 2, 1);
    {
      pg8::Gemm g{HIDb, (bf16*)((unsigned char*)WmoeD + (size_t)layer * 48 * MiB), NE * NB * CAP, NE * 1024, DM / 2}; pg8::MoeOrder2 S{bid()};
      pg8::EpiRowScale E{XSb, gsel_row};
      pg8::gemm_phase_gather<pg8::EpiRowScale, pg8::MoeOrder2, true, DM / 2>((LAS unsigned char*)lds, g, idx_id, S, E);
    }
    GBF(1, 3, 1);
    combine_norm_phase<false>(tid, XBb, nullptr, XSb, slot_of, g2, norm_mix_g + DM, mod + (size_t)NB * 6 * DM, mod + (size_t)NB * 6 * DM + DM, XNb);
    GBF(1, 4, 1);
  }
  {
    constexpr int layer = 1;
      {
        pg8::Gemm g{XNb, WaT, NTOK, 512, DM}; pg8::StaticOrder S; S.init(NTOK, 512, GRID, bid());
        EpiMlaPrep E{mla_q_norm_g, mla_kv_norm_g, CQNb, CKVNb, KPEb, KPE8b, ROPEb};
        pg8::gemm_phase<EpiMlaPrep, pg8::StaticOrder, true, true>((LAS unsigned char*)lds, g, S, E);
      }
      GBF(1, 5, 1);
      {
        pg8::Gemm g{CQNb, WqbT, NTOK, 1536, 256}; pg8::StaticOrder S; S.init(NTOK, 1536, GRID, bid());
        pg8::EpiQRope E{Qbuf, ROPEb, 0.07216878364870323f * 1.4426950408889634f};
        pg8::gemm_phase<pg8::EpiQRope, pg8::StaticOrder, true, false>((LAS unsigned char*)lds, g, S, E);
      }
      {
        pg8::Gemm g{CKVNb, WkvbT, NTOK, 1024, 128}; pg8::StaticOrder S; S.init(NTOK, 1024, GRID, bid());
        pg8::EpiK8 E{K8nb};
        pg8::gemm_phase<pg8::EpiK8, pg8::StaticOrder, true, true>((LAS unsigned char*)lds, g, S, E);
      }
      {
        pg8::Gemm g{WkvbT + (size_t)1024 * 128, CKVNb, 1024, NTOK, 128}; pg8::StaticOrder S; S.init(1024, NTOK, GRID, bid());
        pg8::EpiVT E{V8Tb};
        pg8::gemm_phase<pg8::EpiVT, pg8::StaticOrder, true, true>((LAS unsigned char*)lds, g, S, E);
      }
      GBF(1, 6, 2);
      attn_phase(tid, lds);
      GBF(1, 8, 2);
      {
        pg8::Gemm g{Ybf, WmoT, NTOK, DM, DM}; pg8::StaticOrder S; S.init(NTOK, DM, GRID, bid());
        pg8::EpiResidT<true, true> E{XBb, XBb, nullptr, g1};
        pg8::gemm_phase<pg8::EpiResidT<true, true>, pg8::StaticOrder, true, true>((LAS unsigned char*)lds, g, S, E);
      }
      GBF(1, 10, 1);
    norm_router_phase(tid, lds, XBb, norm_ffn_g + layer * DM, sh2, sc2, (unsigned char*)XNb, moe_w_router + (size_t)layer * DM * NE, aff);
    GBF(1, 11, 1);
    topk_phase(tid, lds, aff, idx_row, gsel_row, slot_of);
    GB();
    {
      pg8::Gemm g{XNb, (bf16*)((unsigned char*)Wmoe + (size_t)layer * 48 * MiB), NE * NB * CAP, NE * 2048, DM / 2}; pg8::MoeOrder1 S{bid()};
      pg8::EpiSwiGLU E{HIDb, 1.0f, 1.0f / 32.0f};
      pg8::gemm_phase_gather<pg8::EpiSwiGLU, pg8::MoeOrder1, true>((LAS unsigned char*)lds, g, idx_row, S, E);
    }
    GB();
    {
      pg8::Gemm g{HIDb, (bf16*)((unsigned char*)WmoeD + (size_t)layer * 48 * MiB), NE * NB * CAP, NE * 1024, DM / 2}; pg8::MoeOrder2 S{bid()};
      pg8::EpiRowScale E{XSb, gsel_row};
      pg8::gemm_phase_gather<pg8::EpiRowScale, pg8::MoeOrder2, true, DM / 2>((LAS unsigned char*)lds, g, idx_id, S, E);
    }
    GB();
    combine_norm_phase<true>(tid, XBb, XRES, XSb, slot_of, g2, final_norm_g, nullptr, nullptr, nullptr);
  }
}

#undef x_in
#undef C_IN
#undef positions_f
#undef ada_w
#undef ada_b
#undef norm_mix_g
#undef norm_ffn_g
#undef hy_w_in
#undef hy_b_in
#undef hy_conv_w
#undef hy_conv_b
#undef hy_f_w1
#undef hy_f_b1
#undef hy_f_w2
#undef hy_f_b2
#undef hy_f_w3
#undef hy_f_freq
#undef hy_f_bias
#undef hy_w_out
#undef hy_b_out
#undef mla_w_in
#undef mla_q_norm_g
#undef mla_w_qb
#undef mla_kv_norm_g
#undef mla_w_kvb
#undef mla_w_out
#undef moe_w_router
#undef moe_w_gate
#undef moe_w_up
#undef moe_w_down
#undef final_norm_g
#undef positions
#undef XRES
#undef WSB
#undef MiB
#undef WhoT
#undef WmoT
#undef Ybf
#undef ws
#undef ACT
#undef mod
#undef aff
#undef gsel
#undef idx
#undef slot_of
#undef RA
#undef RF
#undef RU
#undef RC
#undef RD
#undef V8Tb
#undef K8nb
#undef KPE8b
#undef idx_id
#undef g2
#undef sc2
#undef sh2
#undef g1
#undef sc1
#undef sh1
#undef MODL
#undef KVbuf
#undef Qbuf
#undef ROPEb
#undef KPEb
#undef CKVNb
#undef CQNb
#undef Abuf
#undef WkvbT
#undef WqbT
#undef WaT
#undef KRb
#undef K0b
#undef W3Tb
#undef ycTb
#undef zTb
#undef XBb
#undef Upre
#undef UTb
#undef WinT
#undef gsel_row
#undef idx_row
#undef HIDb
#undef XSb
#undef XNb
#undef WmoeD
#undef Wmoe
extern "C" void kernel_launch(void* const* d_in, const int* in_sizes, int n_in, void* d_out, int out_size,
                              void* d_ws, size_t ws_size, hipStream_t stream) {
  static int grid = 0;
  if (grid == 0) {
    int dev = 0, cus = 0;
    if (hipGetDevice(&dev) != hipSuccess ||
        hipDeviceGetAttribute(&cus, hipDeviceAttributeMultiprocessorCount, dev) != hipSuccess) { grid = -1; return; }
    if (hipFuncSetAttribute((const void*)fwd_megakernel, hipFuncAttributeMaxDynamicSharedMemorySize, LDS_BYTES) != hipSuccess) {
      fprintf(stderr, "hipFuncSetAttribute failed\n"); grid = -1; return;
    }
    int per_cu = 0;
    (void)hipOccupancyMaxActiveBlocksPerMultiprocessor(&per_cu, (const void*)fwd_megakernel, NTHR, LDS_BYTES);
    (void)hipGetLastError();
    if (per_cu < 1) fprintf(stderr, "occupancy query says %d blocks/CU\n", per_cu);
    if (ws_size < (size_t)576 * 1024 * 1024) { fprintf(stderr, "kernel_launch: workspace too small: %zu bytes (needs 576 MiB); nothing launched\n", ws_size); grid = -1; return; }
    if (cus != GRID) fprintf(stderr, "device has %d CUs, kernel built for %d\n", cus, GRID);
    grid = GRID;
  }
  if (grid < 0) return;
  (void)in_sizes; (void)n_in; (void)out_size;
  (void)hipMemsetAsync(d_ws, 0, 1u << 20, stream);
  Args a;
  memset(&a, 0, sizeof(a));
  for (int i = 0; i < 31; ++i) a.in[i] = (const float*)d_in[i];
  a.out = (float*)d_out;
  a.ws = (unsigned char*)d_ws;
  hipLaunchKernelGGL(fwd_megakernel, dim3(grid), dim3(NTHR), LDS_BYTES, stream, a);
}
```

```cpp
#include <hip/hip_runtime.h>
#include <stdint.h>
#include <math.h>
#include <string.h>
#include <cstdio>

#define DM 1024
#define NB 8
#define SEQ 4096
#define NTOK (NB * SEQ)
#define NE 16
#define CAP 512
#define NTHR 512
#define GRID 256
#define LDS_BYTES 155648
#define HALF_LDS 40960

#define LAS __attribute__((address_space(3)))

#define XB_TMO      128
#define XB_XCNT(j)  (256  + 64 * (j))
#define XB_XSUB(j)  (1280 + 64 * (j))
#define XB_XGEN(j)  (2304 + 64 * (j))
#define XB_TOP      3328
#define XB_TOPGEN   3392
#define XCD_BAR_WORDS 3456
#define XB_SPIN_CAP (1u << 22)
__device__ __forceinline__ unsigned xb_ld(unsigned* p)              { return __hip_atomic_load(p, __ATOMIC_RELAXED, __HIP_MEMORY_SCOPE_AGENT); }
__device__ __forceinline__ unsigned xb_add(unsigned* p, unsigned v) { return __hip_atomic_fetch_add(p, v, __ATOMIC_RELAXED, __HIP_MEMORY_SCOPE_AGENT); }
__device__ __forceinline__ unsigned xb_xcc_id() { return (unsigned)__builtin_amdgcn_s_getreg((3 << 11) | 20) & 0xFu; }
#define XB_SPIN(cond, bar) do { unsigned _sp = 0; while (cond) { __builtin_amdgcn_s_sleep(1); \
    if ((++_sp & 255u) == 0u) { if (xb_ld(&(bar)[XB_TMO])) break; if (_sp > XB_SPIN_CAP) { atomicAdd(&(bar)[XB_TMO], 1u); break; } } } } while (0)
struct XcdBarrier { unsigned* bar; unsigned x; volatile LAS unsigned* st; };
__device__ __forceinline__ XcdBarrier xcd_barrier_post(unsigned* bar, volatile LAS unsigned* st) {
    XcdBarrier b; b.bar = bar; b.x = xb_xcc_id(); b.st = st;
    if (threadIdx.x == 0) (void)xb_add(&bar[XB_XCNT(b.x)], 1u);
    return b;
}
__device__ __forceinline__ void xcd_barrier_complete(unsigned* bar, unsigned x, unsigned& nloc, unsigned& nx) {
    const unsigned G = gridDim.x * gridDim.y * gridDim.z;
    unsigned sum, cnt, mine, sp = 0u;
    for (;;) {
        sum = 0u; cnt = 0u; mine = 0u;
#pragma unroll
        for (unsigned j = 0; j < 16; ++j) { const unsigned c = xb_ld(&bar[XB_XCNT(j)]); sum += c; cnt += (c > 0u) ? 1u : 0u; }
        if (sum == G) { mine = xb_ld(&bar[XB_XCNT(x)]); break; }
        __builtin_amdgcn_s_sleep(1);
        if ((++sp & 255u) == 0u) { if (xb_ld(&bar[XB_TMO])) break; if (sp > XB_SPIN_CAP) { atomicAdd(&bar[XB_TMO], 1u); break; } }
    }
    nloc = mine > 0u ? mine : 1u; nx = cnt > 0u ? cnt : 1u;
}
__device__ __forceinline__ void xcd_barrier(const XcdBarrier& b_in) {
    XcdBarrier b; { unsigned long long p = (unsigned long long)b_in.bar; asm volatile("" : "+s"(p)); b.bar = (unsigned*)p; unsigned xx = xb_xcc_id(); asm volatile("" : "+s"(xx)); b.x = xx; b.st = b_in.st; }
    asm volatile("s_waitcnt vmcnt(0)" ::: "memory");
    __syncthreads();
    if (threadIdx.x == 0) {
        unsigned* bar = b.bar;
        __builtin_amdgcn_s_waitcnt(0);
        unsigned nloc = b.st[0], nx = b.st[1];
        if (nloc == 0u) { xcd_barrier_complete(bar, b.x, nloc, nx); b.st[0] = nloc; b.st[1] = nx; }
        const unsigned old = xb_add(&bar[XB_XSUB(b.x)], 1u);
        const unsigned gen = old / nloc;
        if (old + 1u == (gen + 1u) * nloc) {
            __builtin_amdgcn_fence(__ATOMIC_RELEASE, "agent");
            asm volatile("s_waitcnt vmcnt(0)" ::: "memory");
            const unsigned og = xb_add(&bar[XB_TOP], 1u);
            const unsigned tg = og / nx;
            if (og + 1u == (tg + 1u) * nx) xb_add(&bar[XB_TOPGEN], 1u);
            else XB_SPIN(xb_ld(&bar[XB_TOPGEN]) == tg, bar);
            __builtin_amdgcn_fence(__ATOMIC_ACQUIRE, "agent");
            xb_add(&bar[XB_XGEN(b.x)], 1u);
            asm volatile("s_waitcnt vmcnt(0)" ::: "memory");
        } else {
            XB_SPIN(xb_ld(&bar[XB_XGEN(b.x)]) == gen, bar);
            __builtin_amdgcn_fence(__ATOMIC_ACQUIRE, "agent");
            asm volatile("s_waitcnt vmcnt(0)" ::: "memory");
        }
    }
    __syncthreads();
}

__device__ __forceinline__ void xcd_arrive(const XcdBarrier& b_in) {
    XcdBarrier b; { unsigned long long p = (unsigned long long)b_in.bar; asm volatile("" : "+s"(p)); b.bar = (unsigned*)p; unsigned xx = xb_xcc_id(); asm volatile("" : "+s"(xx)); b.x = xx; b.st = b_in.st; }
    asm volatile("s_waitcnt vmcnt(0)" ::: "memory");
    __syncthreads();
    if (threadIdx.x == 0) {
        unsigned* bar = b.bar;
        __builtin_amdgcn_s_waitcnt(0);
        unsigned nloc = b.st[0], nx = b.st[1];
        if (nloc == 0u) { xcd_barrier_complete(bar, b.x, nloc, nx); b.st[0] = nloc; b.st[1] = nx; }
        const unsigned old = xb_add(&bar[XB_XSUB(b.x)], 1u);
        const unsigned gen = old / nloc;
        unsigned last = 0u, og = 0u;
        if (old + 1u == (gen + 1u) * nloc) {
            __builtin_amdgcn_fence(__ATOMIC_RELEASE, "agent");
            asm volatile("s_waitcnt vmcnt(0)" ::: "memory");
            og = xb_add(&bar[XB_TOP], 1u); last = 1u;
        }
        b.st[2] = gen; b.st[3] = last; b.st[4] = og;
    }
}
__device__ __forceinline__ void xcd_wait(const XcdBarrier& b_in) {
    XcdBarrier b; { unsigned long long p = (unsigned long long)b_in.bar; asm volatile("" : "+s"(p)); b.bar = (unsigned*)p; unsigned xx = xb_xcc_id(); asm volatile("" : "+s"(xx)); b.x = xx; b.st = b_in.st; }
    asm volatile("s_waitcnt vmcnt(0)" ::: "memory");
    if (threadIdx.x == 0) {
        unsigned* bar = b.bar;
        const unsigned nx = b.st[1], gen = b.st[2], last = b.st[3], og = b.st[4];
        if (last) {
            const unsigned tg = og / nx;
            if (og + 1u == (tg + 1u) * nx) xb_add(&bar[XB_TOPGEN], 1u);
            else XB_SPIN(xb_ld(&bar[XB_TOPGEN]) == tg, bar);
            __builtin_amdgcn_fence(__ATOMIC_ACQUIRE, "agent");
            xb_add(&bar[XB_XGEN(b.x)], 1u);
            asm volatile("s_waitcnt vmcnt(0)" ::: "memory");
        } else {
            XB_SPIN(xb_ld(&bar[XB_XGEN(b.x)]) == gen, bar);
            __builtin_amdgcn_fence(__ATOMIC_ACQUIRE, "agent");
            asm volatile("s_waitcnt vmcnt(0)" ::: "memory");
        }
    }
    __syncthreads();
}

__device__ __forceinline__ int launder(int v) { asm volatile("" : "+v"(v)); return v; }
__device__ __forceinline__ int bid() { int b = (int)blockIdx.x; asm volatile("" : "+s"(b)); return b; }
namespace pg8 {
#define PG8_LAS __attribute__((address_space(3)))
typedef unsigned short bf16_t;
typedef short bf16x8 __attribute__((ext_vector_type(8)));
typedef float f32x4 __attribute__((ext_vector_type(4)));
typedef unsigned u32x4 __attribute__((ext_vector_type(4)));
constexpr int BM = 256, BK = 64, HALF = 128, HTB = HALF * BK * 2  , STAGE_BYTES = 8 * HTB, NXCD = 8, WGM = 2;

__host__ __device__ __forceinline__ int lds_byte(int r, int c) { const int st = (r >> 4) * 2 + (c >> 5), rr = r & 15, cc = c & 31, ob = rr * 64 + cc * 2; return st * 1024 + (ob ^ (((ob >> 9) & 1) << 5)); }
__host__ __device__ __forceinline__ void stage_rc(int b, int& R, int& C) { const int st = b / 1024, sb = b % 1024, swz = sb ^ (((sb >> 9) & 1) << 5); R = (st >> 1) * 16 + swz / 64; C = (st & 1) * 32 + (swz % 64) / 2; }
__host__ __device__ __forceinline__ int perm32(int rho) { const int n = rho >> 4, i = rho & 15; return 8 * (i >> 2) + 4 * n + (i & 3); }

struct Unit { int pm, pn; };
struct Gemm { const bf16_t* A; const bf16_t* Bt; int M, N, K; unsigned sa = 0x7f7f7f7fu, sb = 0x7f7f7f7fu; };

struct StaticOrder {
    int nM, nN, nwg, G, c;
    __host__ __device__ void init(int M, int N, int G_, int c_) { nM = M / BM; nN = N / BM; nwg = nM * nN; G = G_; c = c_; }
    __host__ __device__ bool next(int i, Unit& u) const {
        const long L = (long)i * G + c; if (L >= nwg) return false;
        int wgid = (int)L; { const int q = nwg / NXCD, r = nwg % NXCD, xcd = wgid % NXCD, off = wgid / NXCD; wgid = (xcd < r ? xcd * (q + 1) : r * (q + 1) + (xcd - r) * q) + off; }
        const int nig = WGM * nN, gid = wgid / nig, fm = gid * WGM, gsz = (nM - fm) < WGM ? (nM - fm) : WGM;
        u.pm = fm + ((wgid % nig) % gsz); u.pn = (wgid % nig) / gsz; return true;
    }
    __device__ __forceinline__ void a_ready(const Unit&) const {}
    __device__ __forceinline__ void done(const Unit&) const {}
};


__device__ __forceinline__ unsigned cvt_pk_bf16(float lo, float hi) { unsigned r; asm volatile("v_cvt_pk_bf16_f32 %0, %1, %2" : "=v"(r) : "v"(lo), "v"(hi)); return r; }
__device__ __forceinline__ unsigned pack4_fp8(float a, float b, float c, float d) { int p = __builtin_amdgcn_cvt_pk_fp8_f32(a, b, 0, false); p = __builtin_amdgcn_cvt_pk_fp8_f32(c, d, p, true); return (unsigned)p; }
template <bool IN_BF, bool OUT_BF>
struct EpiResidT {
    static constexpr bool PERM = false, AFTER_DRAIN = false;
    const void* base; void* out; const float* bias; const float* gate;
    __device__ __forceinline__ void operator()(const f32x4 (&acc)[2][2][4][2], const Unit& u, int wr, int wc, int fr, int fq) const {
        typedef unsigned u32x2r_ __attribute__((ext_vector_type(2)));
        const int col0 = u.pn * BM + wc * 32 + 4 * fq;
        const int b = (u.pm * BM) / SEQ;
        const float* gp = gate + (size_t)b * 6 * DM + col0;
        f32x4 bv[2][2], gv[2][2];
#pragma unroll
        for (int bj = 0; bj < 2; ++bj)
#pragma unroll
            for (int n = 0; n < 2; ++n) {
                bv[bj][n] = bias ? *(const f32x4*)(bias + col0 + bj * HALF + n * 16) : (f32x4){0.f, 0.f, 0.f, 0.f};
                gv[bj][n] = *(const f32x4*)(gp + bj * HALF + n * 16);
            }
#pragma unroll
        for (int ai = 0; ai < 2; ++ai)
#pragma unroll
            for (int m = 0; m < 4; ++m) {
                const size_t off = (size_t)(u.pm * BM + ai * HALF + wr * 64 + m * 16 + fr) * DM + col0;
#pragma unroll
                for (int bj = 0; bj < 2; ++bj)
#pragma unroll
                    for (int n = 0; n < 2; ++n) {
                        f32x4 xv;
                        if constexpr (IN_BF) { const u32x2r_ r = *(const u32x2r_*)((const bf16_t*)base + off + bj * HALF + n * 16);
                            xv = (f32x4){__builtin_bit_cast(float, r.x << 16), __builtin_bit_cast(float, r.x & 0xffff0000u), __builtin_bit_cast(float, r.y << 16), __builtin_bit_cast(float, r.y & 0xffff0000u)}; }
                        else xv = *(const f32x4*)((const float*)base + off + bj * HALF + n * 16);
                        const f32x4 o = xv + gv[bj][n] * (acc[ai][bj][m][n] + bv[bj][n]);
                        if constexpr (OUT_BF) { u32x2r_ w; w.x = cvt_pk_bf16(o[0], o[1]); w.y = cvt_pk_bf16(o[2], o[3]); *(u32x2r_*)((bf16_t*)out + off + bj * HALF + n * 16) = w; }
                        else *(f32x4*)((float*)out + off + bj * HALF + n * 16) = o;
                    }
            }
    }
};

struct EpiSwiGLU {
    static constexpr bool PERM = true, AFTER_DRAIN = false;
    bf16_t* O; float f8scale; float wscale;
    __device__ __forceinline__ void operator()(const f32x4 (&acc)[2][2][4][2], const Unit& u, int wr, int wc, int fr, int fq) const {
        const int row0 = u.pm * BM + wr * 64 + fr, col0 = (u.pn & 7) * 128 + wc * 32 + 8 * fq;
#pragma unroll
        for (int ai = 0; ai < 2; ++ai)
#pragma unroll
            for (int m = 0; m < 4; ++m) {
                bf16_t* rowp = O + (size_t)(row0 + ai * HALF + m * 16) * 1024 + col0;
                float h[8];
#pragma unroll
                for (int n = 0; n < 2; ++n)
#pragma unroll
                    for (int j = 0; j < 4; ++j) { const float g = acc[ai][0][m][n][j] * wscale, up = acc[ai][1][m][n][j] * wscale;
                        h[n * 4 + j] = __builtin_fminf(__builtin_fmaxf(g * __builtin_amdgcn_rcpf(1.0f + __builtin_amdgcn_exp2f(-1.4426950408889634f * g)) * up, -448.f), 448.f); }
                if (f8scale != 0.f) {
                    typedef unsigned u32x2_ __attribute__((ext_vector_type(2)));
                    u32x2_ w8; w8.x = pack4_fp8(h[0] * f8scale, h[1] * f8scale, h[2] * f8scale, h[3] * f8scale); w8.y = pack4_fp8(h[4] * f8scale, h[5] * f8scale, h[6] * f8scale, h[7] * f8scale);
                    *(u32x2_*)((unsigned char*)O + (size_t)(row0 + ai * HALF + m * 16) * 1024 + col0) = w8;
                } else {
                u32x4 w; w.x = cvt_pk_bf16(h[0], h[1]); w.y = cvt_pk_bf16(h[2], h[3]); w.z = cvt_pk_bf16(h[4], h[5]); w.w = cvt_pk_bf16(h[6], h[7]);
                *(u32x4*)rowp = w; }
            }
    }
};
struct EpiRowScale {
    static constexpr bool PERM = true, AFTER_DRAIN = false;
    bf16_t* O; const float* rs;
    static constexpr float wscale = 1.0f / 32.0f;
    __device__ __forceinline__ void operator()(const f32x4 (&acc)[2][2][4][2], const Unit& u, int wr, int wc, int fr, int fq) const {
        const int row0 = u.pm * BM + wr * 64 + fr, col0 = (u.pn & 3) * BM + wc * 32 + 8 * fq;
#pragma unroll
        for (int ai = 0; ai < 2; ++ai)
#pragma unroll
            for (int m = 0; m < 4; ++m) {
                const int row = row0 + ai * HALF + m * 16;
                const float sc = rs[row] * wscale * 16.0f;
                unsigned char* rowp = (unsigned char*)O + (size_t)row * 1024 + col0;
                typedef unsigned u32x2y_ __attribute__((ext_vector_type(2)));
#pragma unroll
                for (int bj = 0; bj < 2; ++bj) { f32x4 v0 = acc[ai][bj][m][0] * sc, v1 = acc[ai][bj][m][1] * sc;
#pragma unroll
                    for (int e = 0; e < 4; ++e) { v0[e] = __builtin_fminf(__builtin_fmaxf(v0[e], -448.f), 448.f); v1[e] = __builtin_fminf(__builtin_fmaxf(v1[e], -448.f), 448.f); }
                    u32x2y_ w; w.x = pack4_fp8(v0[0], v0[1], v0[2], v0[3]); w.y = pack4_fp8(v1[0], v1[1], v1[2], v1[3]);
                    *(u32x2y_*)(rowp + bj * HALF) = w; }
            }
    }
};

struct EpiBf16Bias {
    static constexpr bool PERM = true, AFTER_DRAIN = false;
    bf16_t* O; int ldc; const float* bias;
    __device__ __forceinline__ void operator()(const f32x4 (&acc)[2][2][4][2], const Unit& u, int wr, int wc, int fr, int fq) const {
        const int row0 = u.pm * BM + wr * 64 + fr, col0 = u.pn * BM + wc * 32 + 8 * fq;
        f32x4 bv[2][2];
#pragma unroll
        for (int bj = 0; bj < 2; ++bj)
#pragma unroll
            for (int n = 0; n < 2; ++n) bv[bj][n] = bias ? *(const f32x4*)(bias + col0 + bj * HALF + 4 * n) : (f32x4){0.f, 0.f, 0.f, 0.f};
#pragma unroll
        for (int ai = 0; ai < 2; ++ai)
#pragma unroll
            for (int m = 0; m < 4; ++m) { bf16_t* rowp = O + (size_t)(row0 + ai * HALF + m * 16) * ldc + col0;
#pragma unroll
                for (int bj = 0; bj < 2; ++bj) { const f32x4 v0 = acc[ai][bj][m][0] + bv[bj][0], v1 = acc[ai][bj][m][1] + bv[bj][1];
                    u32x4 w; w.x = cvt_pk_bf16(v0[0], v0[1]); w.y = cvt_pk_bf16(v0[2], v0[3]); w.z = cvt_pk_bf16(v1[0], v1[1]); w.w = cvt_pk_bf16(v1[2], v1[3]);
                    *(u32x4*)(rowp + bj * HALF) = w; } }
    }
};

struct EpiBf16BiasT {
    static constexpr bool PERM = true, AFTER_DRAIN = false;
    bf16_t* O; int ldc; const float* bias;
    __device__ __forceinline__ void operator()(const f32x4 (&acc)[2][2][4][2], const Unit& u, int wr, int wc, int fr, int fq) const {
        const int row0 = u.pm * BM + wr * 64 + fr, col0 = u.pn * BM + wc * 32 + 8 * fq;
#pragma unroll
        for (int ai = 0; ai < 2; ++ai)
#pragma unroll
            for (int m = 0; m < 4; ++m) { const int row = row0 + ai * HALF + m * 16; const float bb = bias[row]; bf16_t* rowp = O + (size_t)row * ldc + col0;
#pragma unroll
                for (int bj = 0; bj < 2; ++bj) { const f32x4 v0 = acc[ai][bj][m][0] + bb, v1 = acc[ai][bj][m][1] + bb;
                    u32x4 w; w.x = cvt_pk_bf16(v0[0], v0[1]); w.y = cvt_pk_bf16(v0[2], v0[3]); w.z = cvt_pk_bf16(v1[0], v1[1]); w.w = cvt_pk_bf16(v1[2], v1[3]);
                    *(u32x4*)(rowp + bj * HALF) = w; } }
    }
};

struct EpiQRope {
    static constexpr bool PERM = true, AFTER_DRAIN = false;
    bf16_t* O; const float* rope; float qscale;
    __device__ __forceinline__ void operator()(const f32x4 (&acc)[2][2][4][2], const Unit& u, int wr, int wc, int fr, int fq) const {
        const int row0 = u.pm * BM + wr * 64 + fr, col0 = u.pn * BM + wc * 32 + 8 * fq;
#pragma unroll
        for (int bj = 0; bj < 2; ++bj) {
            const int col = col0 + bj * HALF, hd = col / 192, d = col - hd * 192;
            const bool pe = d >= 128;
#pragma unroll
            for (int ai = 0; ai < 2; ++ai)
#pragma unroll
                for (int m = 0; m < 4; ++m) {
                    const unsigned row = (unsigned)(row0 + ai * HALF + m * 16);
                    f32x4 v0 = acc[ai][bj][m][0], v1 = acc[ai][bj][m][1];
                    if (pe) {
                        const unsigned ro = row * 64u + (unsigned)(d - 128);
                        const f32x4 r0 = *(const f32x4*)(rope + ro), r1 = *(const f32x4*)(rope + ro + 4u);
                        const f32x4 t0 = v0, t1 = v1;
                        v0[0] = t0[0] * r0[0] - t0[1] * r0[1]; v0[1] = t0[0] * r0[1] + t0[1] * r0[0];
                        v0[2] = t0[2] * r0[2] - t0[3] * r0[3]; v0[3] = t0[2] * r0[3] + t0[3] * r0[2];
                        v1[0] = t1[0] * r1[0] - t1[1] * r1[1]; v1[1] = t1[0] * r1[1] + t1[1] * r1[0];
                        v1[2] = t1[2] * r1[2] - t1[3] * r1[3]; v1[3] = t1[2] * r1[3] + t1[3] * r1[2];
                    }
                    v0 = v0 * qscale; v1 = v1 * qscale;
                    typedef unsigned u32x2q_ __attribute__((ext_vector_type(2)));
                    u32x2q_ w8; w8.x = pack4_fp8(v0[0], v0[1], v0[2], v0[3]); w8.y = pack4_fp8(v1[0], v1[1], v1[2], v1[3]);
                    *(u32x2q_*)((unsigned char*)O + (row * 1536u + (unsigned)col)) = w8;
                }
        }
    }
};

struct EpiKV {
    static constexpr bool PERM = true, AFTER_DRAIN = false;
    bf16_t* O; unsigned char* K8;
    __device__ __forceinline__ void operator()(const f32x4 (&acc)[2][2][4][2], const Unit& u, int wr, int wc, int fr, int fq) const {
        const int row0 = u.pm * BM + wr * 64 + fr, col0 = u.pn * BM + wc * 32 + 8 * fq;
#pragma unroll
        for (int ai = 0; ai < 2; ++ai)
#pragma unroll
            for (int m = 0; m < 4; ++m) { const unsigned row = (unsigned)(row0 + ai * HALF + m * 16); bf16_t* rowp = O + (size_t)row * 2048 + col0;
#pragma unroll
                for (int bj = 0; bj < 2; ++bj) { const f32x4 v0 = acc[ai][bj][m][0], v1 = acc[ai][bj][m][1];
                    u32x4 w; w.x = cvt_pk_bf16(v0[0], v0[1]); w.y = cvt_pk_bf16(v0[2], v0[3]); w.z = cvt_pk_bf16(v1[0], v1[1]); w.w = cvt_pk_bf16(v1[2], v1[3]);
                    *(u32x4*)(rowp + bj * HALF) = w;
                    if (bj == 0) { typedef unsigned u32x2k_ __attribute__((ext_vector_type(2)));
                        u32x2k_ w8; w8.x = pack4_fp8(v0[0], v0[1], v0[2], v0[3]); w8.y = pack4_fp8(v1[0], v1[1], v1[2], v1[3]);
                        *(u32x2k_*)(K8 + (row * 1024u + (unsigned)(u.pn * 128 + wc * 32 + 8 * fq))) = w8; } } }
    }
};
struct EpiK8 {
    static constexpr bool PERM = true, AFTER_DRAIN = false;
    unsigned char* K8;
    __device__ __forceinline__ void operator()(const f32x4 (&acc)[2][2][4][2], const Unit& u, int wr, int wc, int fr, int fq) const {
        const int row0 = u.pm * BM + wr * 64 + fr, col0 = u.pn * BM + wc * 32 + 8 * fq;
        typedef unsigned u32x2e_ __attribute__((ext_vector_type(2)));
#pragma unroll
        for (int ai = 0; ai < 2; ++ai)
#pragma unroll
            for (int m = 0; m < 4; ++m) { const unsigned row = (unsigned)(row0 + ai * HALF + m * 16);
#pragma unroll
                for (int bj = 0; bj < 2; ++bj) { const f32x4 v0 = acc[ai][bj][m][0], v1 = acc[ai][bj][m][1];
                    u32x2e_ w8; w8.x = pack4_fp8(v0[0], v0[1], v0[2], v0[3]); w8.y = pack4_fp8(v1[0], v1[1], v1[2], v1[3]);
                    *(u32x2e_*)(K8 + (row * 1024u + (unsigned)(col0 + bj * HALF))) = w8; } }
    }
};
struct EpiVT {
    static constexpr bool PERM = true, AFTER_DRAIN = false;
    unsigned char* V8T;
    __device__ __forceinline__ void operator()(const f32x4 (&acc)[2][2][4][2], const Unit& u, int wr, int wc, int fr, int fq) const {
        const int dg0 = u.pm * BM + wr * 64 + fr, n0 = u.pn * BM + wc * 32 + 8 * fq;
#pragma unroll
        for (int ai = 0; ai < 2; ++ai)
#pragma unroll
            for (int m = 0; m < 4; ++m) { const int dg = dg0 + ai * HALF + m * 16, h = dg >> 7, d = dg & 127;
#pragma unroll
                for (int bj = 0; bj < 2; ++bj) { const f32x4 v0 = acc[ai][bj][m][0], v1 = acc[ai][bj][m][1];
                    const int n = n0 + bj * HALF, b = n >> 12, key = n & 4095, j = key >> 6, kk0 = key & 63, pos0 = 16 * (kk0 >> 5) + 4 * ((kk0 >> 3) & 3);
                    unsigned char* p = V8T + ((size_t)((b * 8 + h) * 64 + j) * 8192 + (size_t)(d * 64 + pos0));
                    *(unsigned*)p = pack4_fp8(v0[0], v0[1], v0[2], v0[3]); *(unsigned*)(p + 32) = pack4_fp8(v1[0], v1[1], v1[2], v1[3]); } }
    }
};
struct MoeOrder1 { int c;
    __device__ __forceinline__ bool next(int i, Unit& u) const { if (i >= 8) return false; const int x = c & 7, s = c >> 3, e = 2 * i + (x >> 2); u.pm = e * 16 + 4 * (x & 3) + (s >> 3); u.pn = e * 8 + (s & 7); return true; }
    __device__ __forceinline__ void a_ready(const Unit&) const {}
    __device__ __forceinline__ void done(const Unit&) const {} };
struct MoeOrder2 { int c;
    __device__ __forceinline__ bool next(int i, Unit& u) const { if (i >= 4) return false; const int x = c & 7, s = c >> 3, e = 4 * i + (x >> 1); u.pm = e * 16 + 8 * (x & 1) + (s >> 2); u.pn = e * 4 + (s & 3); return true; }
    __device__ __forceinline__ void a_ready(const Unit&) const {}
    __device__ __forceinline__ void done(const Unit&) const {} };

typedef int v8i32_t __attribute__((ext_vector_type(8)));
typedef int v4i32_t __attribute__((ext_vector_type(4)));
typedef short v4i16_t __attribute__((ext_vector_type(4)));
__device__ __forceinline__ v8i32_t cat8(bf16x8 lo, bf16x8 hi) { const v4i32_t a = __builtin_bit_cast(v4i32_t, lo), b = __builtin_bit_cast(v4i32_t, hi); return __builtin_shufflevector(a, b, 0, 1, 2, 3, 4, 5, 6, 7); }
template <class Epi, class Sched, bool ALIGN_EPI = false, bool SP2 = false, bool FP8 = false, bool AT = false>
__device__ __forceinline__ void gemm_phase(PG8_LAS unsigned char* lds, const Gemm g, const Sched& S, const Epi& E) {
    int tid_ = threadIdx.x; asm volatile("" : "+v"(tid_));
    const int tid = tid_, wid = __builtin_amdgcn_readfirstlane(tid >> 6), lane = tid & 63, wr = wid >> 2, wc = wid & 3, fr = lane & 15, fq = lane >> 4;
    const int K = g.K, nt = K / BK;
    unsigned voffA[1], voffB[1];
    { int R, C; stage_rc(tid * 16, R, C); const int Rb = Epi::PERM ? ((R & ~31) + perm32(R & 31)) : R;
        voffA[0] = (unsigned)(R * K + C) * 2u; voffB[0] = (unsigned)(Rb * K + C) * 2u;
        if constexpr (AT) { const int k_ = (tid >> 2) & 63, j_ = tid & 3; voffA[0] = (unsigned)(k_ * g.M + (tid >> 8) * 32 + 8 * (j_ ^ (2 * ((k_ >> 3) & 1)))) * 2u; } }
    const size_t pstep = (size_t)64 * K * 2;
    const size_t kstep = (size_t)(BK * 2);
    const size_t hstep = (size_t)HALF * K * 2;
    const size_t tstep = 2 * hstep;
    const size_t pstepA = AT ? (size_t)128 : pstep, kstepA = AT ? (size_t)BK * g.M * 2 : kstep, hstepA = AT ? (size_t)256 : hstep, tstepA = AT ? (size_t)512 : tstep;
    const unsigned ldsw = (unsigned)wid * 1024u;
    const int aoff = lds_byte(wr * 64 + fr, fq * 8), boff = lds_byte(wc * 32 + fr, fq * 8);
    const int aoT0 = wr * 8192 + (8 * fq + (fr >> 2)) * 64 + ((fq & 1) * 32) + (fr & 3) * 8, aoT1 = aoT0 ^ 32;
#define PG8_SA(b, h) (((b) * 2 + (h)) * HTB)
#define PG8_SB(b, h) ((4 + (b) * 2 + (h)) * HTB)
#define PG8_STAGE(bufoff, gbase, voff) do { _Pragma("unroll") for (int _i = 0; _i < 2; ++_i) \
        __builtin_amdgcn_global_load_lds((const unsigned*)((const char*)(gbase) + _i * pstep + (voff)[0]), (PG8_LAS unsigned*)(lds + (bufoff) + ldsw + _i * 8192), 16, 0, 0); } while (0)
#define PG8_STAGEA(bufoff, gbase) do { _Pragma("unroll") for (int _i = 0; _i < 2; ++_i) \
        __builtin_amdgcn_global_load_lds((const unsigned*)((const char*)(gbase) + _i * pstepA + voffA[0]), (PG8_LAS unsigned*)(lds + (bufoff) + ldsw + _i * 8192), 16, 0, 0); } while (0)
#define PG8_TR(off_) __builtin_amdgcn_ds_read_tr16_b64_v4i16((PG8_LAS v4i16_t*)(lds + (off_)))
#define PG8_LDA(dst, b, h) do { if constexpr (AT) { _Pragma("unroll") for (int m = 0; m < 4; ++m) _Pragma("unroll") for (int k = 0; k < 2; ++k) { \
            const int o_ = PG8_SA(b, h) + ((m & 1) ? aoT1 : aoT0) + (m >> 1) * 4096 + k * 2048; const v4i16_t lo_ = PG8_TR(o_), hi_ = PG8_TR(o_ + 256); \
            dst[m][k] = __builtin_shufflevector(lo_, hi_, 0, 1, 2, 3, 4, 5, 6, 7); } } else _Pragma("unroll") for (int m = 0; m < 4; ++m) { if constexpr (FP8) dst##8[m] = cat8(*(const PG8_LAS bf16x8*)(lds + PG8_SA(b, h) + aoff + m * 2048), *(const PG8_LAS bf16x8*)(lds + PG8_SA(b, h) + aoff + m * 2048 + 1024)); \
        else { _Pragma("unroll") for (int k = 0; k < 2; ++k) dst[m][k] = *(const PG8_LAS bf16x8*)(lds + PG8_SA(b, h) + aoff + m * 2048 + k * 1024); } } } while (0)
#define PG8_LDB(dst, b, h) do { _Pragma("unroll") for (int n = 0; n < 2; ++n) { if constexpr (FP8) dst##8[n] = cat8(*(const PG8_LAS bf16x8*)(lds + PG8_SB(b, h) + boff + n * 2048), *(const PG8_LAS bf16x8*)(lds + PG8_SB(b, h) + boff + n * 2048 + 1024)); \
        else { _Pragma("unroll") for (int k = 0; k < 2; ++k) dst[n][k] = *(const PG8_LAS bf16x8*)(lds + PG8_SB(b, h) + boff + n * 2048 + k * 1024); } } } while (0)
#define PG8_MMA(ai, bj, At, Bt) do { __builtin_amdgcn_s_setprio(1);     \
        if constexpr (FP8) { _Pragma("unroll") for (int m = 0; m < 4; ++m) _Pragma("unroll") for (int n = 0; n < 2; ++n) \
            acc[ai][bj][m][n] = __builtin_amdgcn_mfma_scale_f32_16x16x128_f8f6f4(Bt##8[n], At##8[m], acc[ai][bj][m][n], 0, 0, 0, 0x7f7f7f7f, 0, 0x7f7f7f7f); } \
        else { _Pragma("unroll") for (int m = 0; m < 4; ++m) _Pragma("unroll") for (int n = 0; n < 2; ++n) _Pragma("unroll") for (int k = 0; k < 2; ++k) \
            acc[ai][bj][m][n] = __builtin_amdgcn_mfma_f32_16x16x32_bf16(Bt[n][k], At[m][k], acc[ai][bj][m][n], 0, 0, 0); } \
        __builtin_amdgcn_s_setprio(0); } while (0)
#define PG8_WAIT_V(n) asm volatile("s_waitcnt vmcnt(" #n ")" ::: "memory")
#define PG8_WAIT_L(n) asm volatile("s_waitcnt lgkmcnt(" #n ")" ::: "memory")
#define PG8_BAR __builtin_amdgcn_s_barrier()
#define PG8_SCHED __builtin_amdgcn_sched_barrier(0)
    Unit cur, nxt; int ui = 0;
    if (!S.next(0, cur)) return;
    f32x4 acc[2][2][4][2];
#pragma unroll
    for (int a = 0; a < 2; ++a)
#pragma unroll
        for (int b = 0; b < 2; ++b)
#pragma unroll
            for (int m = 0; m < 4; ++m)
#pragma unroll
                for (int n = 0; n < 2; ++n) { acc[a][b][m][n] = (f32x4){0.f, 0.f, 0.f, 0.f}; }
    bf16x8 At[4][2], B0[2][2], B1[2][2];
    v8i32_t At8[4], B08[2], B18[2];
    const char* cA = (const char*)g.A + (size_t)cur.pm * tstepA; const char* cB = (const char*)g.Bt + (size_t)cur.pn * tstep;
    S.a_ready(cur);
    if constexpr (SP2) {
        PG8_STAGE(PG8_SB(0, 0), cB, voffB); PG8_STAGE(PG8_SB(0, 1), cB + hstep, voffB); PG8_STAGEA(PG8_SA(0, 0), cA); PG8_STAGEA(PG8_SA(0, 1), cA + hstepA);
        if (wr == 1) PG8_BAR;
        PG8_WAIT_V(2); PG8_BAR;
        PG8_STAGE(PG8_SB(1, 0), cB + kstep, voffB); PG8_STAGEA(PG8_SA(1, 0), cA + kstepA); PG8_STAGE(PG8_SB(1, 1), cB + hstep + kstep, voffB);
        PG8_WAIT_V(6); PG8_BAR;
    } else {
        PG8_STAGE(PG8_SB(0, 0), cB, voffB); PG8_STAGEA(PG8_SA(0, 0), cA); PG8_STAGE(PG8_SB(0, 1), cB + hstep, voffB); PG8_STAGEA(PG8_SA(0, 1), cA + hstepA);
        if (wr == 1) PG8_BAR;
        PG8_WAIT_V(4); PG8_BAR;
        PG8_STAGE(PG8_SB(1, 0), cB + kstep, voffB); PG8_STAGEA(PG8_SA(1, 0), cA + kstepA); PG8_STAGE(PG8_SB(1, 1), cB + hstep + kstep, voffB);
        PG8_WAIT_V(6); PG8_BAR;
    }
    for (;;) {
        const bool has_next = S.next(ui + 1, nxt);
        const char* nA = has_next ? (const char*)g.A + (size_t)nxt.pm * tstepA : cA; const char* nB = has_next ? (const char*)g.Bt + (size_t)nxt.pn * tstep : cB;
#pragma unroll 1
        for (int t = 0; t < nt; t += 2) {
            const bool last = (t == nt - 2);
            const char* a1 = cA + (size_t)(t + 1) * kstepA;
            const char* a2 = last ? nA : cA + (size_t)(t + 2) * kstepA; const char* b2 = last ? nB : cB + (size_t)(t + 2) * kstep;
            const char* a3 = a2 + kstepA; const char* b3 = b2 + kstep;
            if (last && has_next) S.a_ready(nxt);
            if constexpr (SP2) {
            PG8_LDB(B0, 0, 0); PG8_LDB(B1, 0, 1); PG8_SCHED; PG8_LDA(At, 0, 0); PG8_STAGEA(PG8_SA(1, 1), a1 + hstepA);
            PG8_WAIT_V(8); PG8_WAIT_L(0); PG8_BAR; PG8_MMA(0, 0, At, B0); PG8_MMA(0, 1, At, B1); PG8_BAR; PG8_SCHED;
            PG8_LDA(At, 0, 1); PG8_STAGE(PG8_SB(0, 0), b2, voffB); PG8_STAGE(PG8_SB(0, 1), b2 + hstep, voffB); PG8_STAGEA(PG8_SA(0, 0), a2);
            PG8_WAIT_V(8); PG8_WAIT_L(0); PG8_BAR; PG8_MMA(1, 0, At, B0); PG8_MMA(1, 1, At, B1); PG8_BAR; PG8_SCHED;
            PG8_LDB(B0, 1, 0); PG8_LDB(B1, 1, 1); PG8_SCHED; PG8_LDA(At, 1, 0); PG8_STAGEA(PG8_SA(0, 1), a2 + hstepA);
            PG8_WAIT_V(8); PG8_WAIT_L(0); PG8_BAR; PG8_MMA(0, 0, At, B0); PG8_MMA(0, 1, At, B1); PG8_BAR; PG8_SCHED;
            PG8_LDA(At, 1, 1); PG8_STAGE(PG8_SB(1, 0), b3, voffB); PG8_STAGE(PG8_SB(1, 1), b3 + hstep, voffB); PG8_STAGEA(PG8_SA(1, 0), a3);
            PG8_WAIT_V(8); PG8_WAIT_L(0); PG8_BAR; PG8_MMA(1, 0, At, B0); PG8_MMA(1, 1, At, B1); PG8_BAR; PG8_SCHED;
            } else {
            PG8_LDB(B0, 0, 0); PG8_SCHED; PG8_LDA(At, 0, 0); PG8_STAGEA(PG8_SA(1, 1), a1 + hstepA);
            PG8_WAIT_L(8); PG8_BAR; PG8_WAIT_L(0); PG8_MMA(0, 0, At, B0); PG8_BAR; PG8_SCHED;
            PG8_LDB(B1, 0, 1); PG8_STAGE(PG8_SB(0, 0), b2, voffB);
            PG8_BAR; PG8_WAIT_L(0); PG8_MMA(0, 1, At, B1); PG8_BAR;
            PG8_LDA(At, 0, 1); PG8_STAGEA(PG8_SA(0, 0), a2);
            PG8_BAR; PG8_WAIT_L(0); PG8_MMA(1, 0, At, B0); PG8_BAR; PG8_SCHED;
            PG8_STAGE(PG8_SB(0, 1), b2 + hstep, voffB);
            PG8_WAIT_V(6); PG8_BAR; PG8_MMA(1, 1, At, B1); PG8_BAR;
            PG8_LDB(B0, 1, 0); PG8_SCHED; PG8_LDA(At, 1, 0); PG8_STAGEA(PG8_SA(0, 1), a2 + hstepA);
            PG8_WAIT_L(8); PG8_BAR; PG8_WAIT_L(0); PG8_MMA(0, 0, At, B0); PG8_BAR; PG8_SCHED;
            PG8_LDB(B1, 1, 1); PG8_STAGE(PG8_SB(1, 0), b3, voffB);
            PG8_BAR; PG8_WAIT_L(0); PG8_MMA(0, 1, At, B1); PG8_BAR;
            PG8_LDA(At, 1, 1); PG8_STAGEA(PG8_SA(1, 0), a3);
            PG8_BAR; PG8_WAIT_L(0); PG8_MMA(1, 0, At, B0); PG8_BAR; PG8_SCHED;
            PG8_STAGE(PG8_SB(1, 1), b3 + hstep, voffB);
            PG8_WAIT_V(6); PG8_BAR; PG8_MMA(1, 1, At, B1); PG8_BAR;
            }
        }
        if constexpr (ALIGN_EPI) { if (wr == 0) PG8_BAR; }
        if constexpr (!Epi::AFTER_DRAIN) { E(acc, cur, wr, wc, fr, fq); S.done(cur); }
        if (!has_next) break;
#pragma unroll
        for (int a = 0; a < 2; ++a)
#pragma unroll
            for (int b = 0; b < 2; ++b)
#pragma unroll
                for (int m = 0; m < 4; ++m)
#pragma unroll
                    for (int n = 0; n < 2; ++n) { acc[a][b][m][n] = (f32x4){0.f, 0.f, 0.f, 0.f}; }
        cur = nxt; cA = nA; cB = nB; ++ui;
        if constexpr (ALIGN_EPI) { if (wr == 1) PG8_BAR; }
    }
    PG8_WAIT_V(0);
    if constexpr (!ALIGN_EPI) { if (wr == 0) PG8_BAR; }
    PG8_BAR;
    if constexpr (Epi::AFTER_DRAIN) { E.fused(acc, cur, wr, wc, fr, fq, lds, wid, lane); S.done(cur); }
#undef PG8_SA
#undef PG8_SB
#undef PG8_STAGE
#undef PG8_STAGEA
#undef PG8_TR
#undef PG8_LDA
#undef PG8_LDB
#undef PG8_MMA
#undef PG8_WAIT_V
#undef PG8_WAIT_L
#undef PG8_BAR
#undef PG8_SCHED
}
__device__ __forceinline__ int tid_now_() { int t_ = threadIdx.x; asm volatile("" : "+v"(t_)); return t_; }
template <class Epi, class Sched, bool FP8 = false, int KC = 0>
__device__ __forceinline__ void gemm_phase_gather(PG8_LAS unsigned char* lds, const Gemm g, const int* arow, const Sched& S, const Epi& E) {
    constexpr bool ALIGN_EPI = true, SP2 = true;
    int tid_ = threadIdx.x; asm volatile("" : "+v"(tid_));
    const int tid = tid_, wid = __builtin_amdgcn_readfirstlane(tid >> 6), lane = tid & 63, wr = wid >> 2, wc = wid & 3, fr = lane & 15, fq = lane >> 4;
    const int K = KC > 0 ? KC : g.K, nt = K / BK;
    unsigned voffA[1], voffB[1];
    { int R, C; stage_rc(tid * 16, R, C); const int Rb = Epi::PERM ? ((R & ~31) + perm32(R & 31)) : R;
        voffA[0] = (unsigned)(R * K + C) * 2u; voffB[0] = (unsigned)(Rb * K + C) * 2u; }
    const size_t pstep = (size_t)64 * K * 2;
    const size_t kstep = (size_t)(BK * 2);
    const size_t hstep = (size_t)HALF * K * 2;
    const size_t tstep = 2 * hstep;
    const unsigned ldsw = (unsigned)wid * 1024u;
    const int aoff = lds_byte(wr * 64 + fr, fq * 8), boff = lds_byte(wc * 32 + fr, fq * 8);
#define PG8_SA(b, h) (((b) * 2 + (h)) * HTB)
#define PG8_SB(b, h) ((4 + (b) * 2 + (h)) * HTB)
#define PG8_STAGE(bufoff, gbase, voff) do { _Pragma("unroll") for (int _i = 0; _i < 2; ++_i) \
        __builtin_amdgcn_global_load_lds((const unsigned*)((const char*)(gbase) + _i * pstep + (voff)[0]), (PG8_LAS unsigned*)(lds + (bufoff) + ldsw + _i * 8192), 16, 0, 0); } while (0)
#define PG8_LDA(dst, b, h) do { _Pragma("unroll") for (int m = 0; m < 4; ++m) { if constexpr (FP8) dst##8[m] = cat8(*(const PG8_LAS bf16x8*)(lds + PG8_SA(b, h) + aoff + m * 2048), *(const PG8_LAS bf16x8*)(lds + PG8_SA(b, h) + aoff + m * 2048 + 1024)); \
        else { _Pragma("unroll") for (int k = 0; k < 2; ++k) dst[m][k] = *(const PG8_LAS bf16x8*)(lds + PG8_SA(b, h) + aoff + m * 2048 + k * 1024); } } } while (0)
#define PG8_LDB(dst, b, h) do { _Pragma("unroll") for (int n = 0; n < 2; ++n) { if constexpr (FP8) dst##8[n] = cat8(*(const PG8_LAS bf16x8*)(lds + PG8_SB(b, h) + boff + n * 2048), *(const PG8_LAS bf16x8*)(lds + PG8_SB(b, h) + boff + n * 2048 + 1024)); \
        else { _Pragma("unroll") for (int k = 0; k < 2; ++k) dst[n][k] = *(const PG8_LAS bf16x8*)(lds + PG8_SB(b, h) + boff + n * 2048 + k * 1024); } } } while (0)
#define PG8_MMA(ai, bj, At, Bt) do { __builtin_amdgcn_s_setprio(1);     \
        if constexpr (FP8) { _Pragma("unroll") for (int m = 0; m < 4; ++m) _Pragma("unroll") for (int n = 0; n < 2; ++n) \
            acc[ai][bj][m][n] = __builtin_amdgcn_mfma_scale_f32_16x16x128_f8f6f4(Bt##8[n], At##8[m], acc[ai][bj][m][n], 0, 0, 0, 0x7f7f7f7f, 0, 0x7f7f7f7f); } \
        else { _Pragma("unroll") for (int m = 0; m < 4; ++m) _Pragma("unroll") for (int n = 0; n < 2; ++n) _Pragma("unroll") for (int k = 0; k < 2; ++k) \
            acc[ai][bj][m][n] = __builtin_amdgcn_mfma_f32_16x16x32_bf16(Bt[n][k], At[m][k], acc[ai][bj][m][n], 0, 0, 0); } \
        __builtin_amdgcn_s_setprio(0); } while (0)
#define PG8_WAIT_V(n) asm volatile("s_waitcnt vmcnt(" #n ")" ::: "memory")
#define PG8_WAIT_L(n) asm volatile("s_waitcnt lgkmcnt(" #n ")" ::: "memory")
#define PG8_BAR __builtin_amdgcn_s_barrier()
#define PG8_SCHED __builtin_amdgcn_sched_barrier(0)
    Unit cur, nxt; int ui = 0;
    if (!S.next(0, cur)) return;
    f32x4 acc[2][2][4][2];
#pragma unroll
    for (int a = 0; a < 2; ++a)
#pragma unroll
        for (int b = 0; b < 2; ++b)
#pragma unroll
            for (int m = 0; m < 4; ++m)
#pragma unroll
                for (int n = 0; n < 2; ++n) { acc[a][b][m][n] = (f32x4){0.f, 0.f, 0.f, 0.f}; }
    bf16x8 At[4][2], B0[2][2], B1[2][2];
    v8i32_t At8[4], B08[2], B18[2];
    const char* cB = (const char*)g.Bt + (size_t)cur.pn * tstep;
    int R0_, C0_; stage_rc(tid * 16, R0_, C0_);
    const unsigned rowb = (unsigned)(K * 2), colb = (unsigned)(C0_ * 2);
#define ost ((PG8_LAS unsigned*)(lds + STAGE_BYTES) + tid_now_() * 8)
#define cbuf (ui & 1)
#pragma unroll
    for (int h = 0; h < 2; ++h)
#pragma unroll
        for (int i = 0; i < 2; ++i) ost[h * 2 + i] = (unsigned)arow[cur.pm * BM + h * HALF + 64 * i + R0_] * rowb + colb;
#define PG8_STAGE_A(bufoff, h, kb, nx) do { typedef unsigned u32x2s_ __attribute__((ext_vector_type(2))); \
        const u32x2s_ o_ = *(const PG8_LAS u32x2s_*)(ost + (((nx) ? (cbuf ^ 1) : cbuf) * 4 + (h) * 2)); _Pragma("unroll") for (int _i = 0; _i < 2; ++_i) \
        __builtin_amdgcn_global_load_lds((const unsigned*)((const char*)g.A + (size_t)(kb) + o_[_i]), (PG8_LAS unsigned*)(lds + (bufoff) + ldsw + _i * 8192), 16, 0, 0); } while (0)
    S.a_ready(cur);
    if constexpr (SP2) {
        PG8_STAGE(PG8_SB(0, 0), cB, voffB); PG8_STAGE(PG8_SB(0, 1), cB + hstep, voffB); PG8_STAGE_A(PG8_SA(0, 0), 0, 0, false); PG8_STAGE_A(PG8_SA(0, 1), 1, 0, false);
        if (wr == 1) PG8_BAR;
        PG8_WAIT_V(2); PG8_BAR;
        PG8_STAGE(PG8_SB(1, 0), cB + kstep, voffB); PG8_STAGE_A(PG8_SA(1, 0), 0, kstep, false); PG8_STAGE(PG8_SB(1, 1), cB + hstep + kstep, voffB);
        PG8_WAIT_V(6); PG8_BAR;
    }
    for (;;) {
        const bool has_next = S.next(ui + 1, nxt);
        const char* nB = has_next ? (const char*)g.Bt + (size_t)nxt.pn * tstep : cB;
        int tu_ = threadIdx.x; asm volatile("" : "+v"(tu_)); int R1_, C1_; stage_rc(tu_ * 16, R1_, C1_);
#pragma unroll
        for (int h = 0; h < 2; ++h)
#pragma unroll
            for (int i = 0; i < 2; ++i) ost[(cbuf ^ 1) * 4 + h * 2 + i] = has_next ? (unsigned)arow[nxt.pm * BM + h * HALF + 64 * i + R1_] * rowb + (unsigned)(C1_ * 2) : ost[cbuf * 4 + h * 2 + i];
#pragma unroll 1
        for (int t = 0; t < nt; t += 2) {
            const bool last = (t == nt - 2);
            const size_t k1 = (size_t)(t + 1) * kstep, k2 = last ? 0 : (size_t)(t + 2) * kstep, k3 = k2 + kstep;
            const char* b2 = last ? nB : cB + (size_t)(t + 2) * kstep; const char* b3 = b2 + kstep;
            if (last && has_next) S.a_ready(nxt);
            if constexpr (SP2) {
            PG8_LDB(B0, 0, 0); PG8_LDB(B1, 0, 1); PG8_SCHED; PG8_LDA(At, 0, 0); PG8_STAGE_A(PG8_SA(1, 1), 1, k1, false);
            PG8_WAIT_V(8); PG8_WAIT_L(0); PG8_BAR; PG8_MMA(0, 0, At, B0); PG8_MMA(0, 1, At, B1); PG8_BAR; PG8_SCHED;
            PG8_LDA(At, 0, 1); PG8_STAGE(PG8_SB(0, 0), b2, voffB); PG8_STAGE(PG8_SB(0, 1), b2 + hstep, voffB); PG8_STAGE_A(PG8_SA(0, 0), 0, k2, last);
            PG8_WAIT_V(8); PG8_WAIT_L(0); PG8_BAR; PG8_MMA(1, 0, At, B0); PG8_MMA(1, 1, At, B1); PG8_BAR; PG8_SCHED;
            PG8_LDB(B0, 1, 0); PG8_LDB(B1, 1, 1); PG8_SCHED; PG8_LDA(At, 1, 0); PG8_STAGE_A(PG8_SA(0, 1), 1, k2, last);
            PG8_WAIT_V(8); PG8_WAIT_L(0); PG8_BAR; PG8_MMA(0, 0, At, B0); PG8_MMA(0, 1, At, B1); PG8_BAR; PG8_SCHED;
            PG8_LDA(At, 1, 1); PG8_STAGE(PG8_SB(1, 0), b3, voffB); PG8_STAGE(PG8_SB(1, 1), b3 + hstep, voffB); PG8_STAGE_A(PG8_SA(1, 0), 0, k3, last);
            PG8_WAIT_V(8); PG8_WAIT_L(0); PG8_BAR; PG8_MMA(1, 0, At, B0); PG8_MMA(1, 1, At, B1); PG8_BAR; PG8_SCHED;
            }
        }
        if constexpr (ALIGN_EPI) { if (wr == 0) PG8_BAR; }
        if constexpr (!Epi::AFTER_DRAIN) { int te_ = threadIdx.x; asm volatile("" : "+v"(te_)); const int we_ = __builtin_amdgcn_readfirstlane(te_ >> 6);
            E(acc, cur, we_ >> 2, we_ & 3, te_ & 15, (te_ & 63) >> 4); S.done(cur); }
        if (!has_next) break;
#pragma unroll
        for (int a = 0; a < 2; ++a)
#pragma unroll
            for (int b = 0; b < 2; ++b)
#pragma unroll
                for (int m = 0; m < 4; ++m)
#pragma unroll
                    for (int n = 0; n < 2; ++n) { acc[a][b][m][n] = (f32x4){0.f, 0.f, 0.f, 0.f}; }
        cur = nxt; cB = nB; ++ui;
        if constexpr (ALIGN_EPI) { if (wr == 1) PG8_BAR; }
    }
    PG8_WAIT_V(0);
    if constexpr (!ALIGN_EPI) { if (wr == 0) PG8_BAR; }
    PG8_BAR;
    if constexpr (Epi::AFTER_DRAIN) { E.fused(acc, cur, wr, wc, fr, fq, lds, wid, lane); S.done(cur); }
#undef PG8_STAGE_A
#undef cbuf
#undef ost
#undef PG8_SA
#undef PG8_SB
#undef PG8_STAGE
#undef PG8_LDA
#undef PG8_LDB
#undef PG8_MMA
#undef PG8_WAIT_V
#undef PG8_WAIT_L
#undef PG8_BAR
#undef PG8_SCHED
}
}

typedef unsigned short bf16;
typedef unsigned v4u __attribute__((ext_vector_type(4)));
typedef unsigned v2u __attribute__((ext_vector_type(2)));
#define GAS __attribute__((address_space(1)))
#define LDS_WAIT() asm volatile("s_waitcnt lgkmcnt(0)" ::: "memory")
__device__ __forceinline__ unsigned f2bf(float f) { unsigned u = __builtin_bit_cast(unsigned, f); return (u + 0x7fffu + ((u >> 16) & 1u)) >> 16; }
__device__ __forceinline__ unsigned pk2(float lo, float hi) { return f2bf(lo) | (f2bf(hi) << 16); }
template <int MODE> __device__ __forceinline__ int tr_row(int n) {
    if (MODE == 1) return (n >> 7) * 256 + (n & 127);
    if (MODE == 2) { if (n < 384) return n; const int i = n - 384; return 384 + (i < 32 ? 2 * i : 2 * (i - 32) + 1); }
    if (MODE == 3) { const int h = n / 192, d = n - h * 192; if (d < 128) return n; const int i = d - 128; return h * 192 + 128 + (i < 32 ? 2 * i : 2 * (i - 32) + 1); }
    return n;
}
template <int MODE>
__device__ __forceinline__ void transpose_item(const float* W, int K, int N, bf16* WT, int row_off, LAS float* scr, int item, int lane, int ldk = 0) {
    if (ldk == 0) ldk = K;
    const int nblk = N / 32, kb = item / nblk, nb = item % nblk, k0 = 64 * kb, n0 = 32 * nb;
#pragma unroll 8
    for (int i = 0; i < 32; ++i) { const int kk = 2 * i + (lane >> 5); scr[kk * 33 + (lane & 31)] = W[(size_t)(k0 + kk) * N + n0 + (lane & 31)]; }
    LDS_WAIT(); asm volatile("" ::: "memory");
    const int c = lane & 7;
#pragma unroll
    for (int j = 0; j < 4; ++j) { const int n = (lane >> 3) + 8 * j; const LAS float* s = scr + (8 * c) * 33 + n;
        v4u o; o.x = pk2(s[0 * 33], s[1 * 33]); o.y = pk2(s[2 * 33], s[3 * 33]); o.z = pk2(s[4 * 33], s[5 * 33]); o.w = pk2(s[6 * 33], s[7 * 33]);
        *(GAS v4u*)(WT + (size_t)(row_off + tr_row<MODE>(n0 + n)) * ldk + k0 + 8 * c) = o; }
    LDS_WAIT(); asm volatile("" ::: "memory");
}
template <int MODE>
__device__ __forceinline__ void transpose_item_fp8(const float* W, int K, int N, unsigned char* WT, int row_off, LAS float* scr, int item, int lane) {
    const int nblk = N / 32, kb = item / nblk, nb = item % nblk, k0 = 64 * kb, n0 = 32 * nb;
    { float v_[32];
      const float* wp_ = W + (size_t)(k0 + (lane >> 5)) * N + n0 + (lane & 31);
#pragma unroll
      for (int i = 0; i < 32; ++i) v_[i] = wp_[(size_t)(2 * i) * N];
#pragma unroll
      for (int i = 0; i < 32; ++i) scr[(2 * i + (lane >> 5)) * 33 + (lane & 31)] = v_[i]; }
    LDS_WAIT(); asm volatile("" ::: "memory");
    const int c = lane & 7;
#pragma unroll
    for (int j = 0; j < 4; ++j) { const int n = (lane >> 3) + 8 * j; const LAS float* s = scr + (8 * c) * 33 + n;
        v2u o; o.x = pg8::pack4_fp8(s[0 * 33] * 32.f, s[1 * 33] * 32.f, s[2 * 33] * 32.f, s[3 * 33] * 32.f); o.y = pg8::pack4_fp8(s[4 * 33] * 32.f, s[5 * 33] * 32.f, s[6 * 33] * 32.f, s[7 * 33] * 32.f);
        *(GAS v2u*)(WT + (size_t)(row_off + tr_row<MODE>(n0 + n)) * K + k0 + 8 * c) = o; }
    LDS_WAIT(); asm volatile("" ::: "memory");
}
__device__ __forceinline__ void mod_phase(int tid_in, unsigned char* lds_, const float* c, const float* ada_w, const float* ada_b, float* modp) {
  const int tid = launder(tid_in), wave = __builtin_amdgcn_readfirstlane(tid >> 6), lane = tid & 63;
  LAS float* cs = (LAS float*)lds_;
  LAS float* part = cs + NB * DM;
  __syncthreads();
  for (int q = tid; q < NB * DM; q += NTHR) { const float v = c[q]; cs[q] = v / (1.f + expf(-v)); }
  __syncthreads();
  const int col0 = bid() * 48, i = col0 / (6 * DM), j0 = col0 - i * 6 * DM;
  float acc[NB];
#pragma unroll
  for (int b = 0; b < NB; ++b) acc[b] = 0.f;
  if (lane < 48) {
    const float* w = ada_w + (size_t)i * DM * 6 * DM + j0 + lane;
#pragma unroll 8
    for (int kk = 0; kk < 128; ++kk) {
      const int k = wave * 128 + kk;
      const float wv = w[(size_t)k * 6 * DM];
#pragma unroll
      for (int b = 0; b < NB; ++b) acc[b] += cs[b * DM + k] * wv;
    }
#pragma unroll
    for (int b = 0; b < NB; ++b) part[(wave * NB + b) * 48 + lane] = acc[b];
  }
  __syncthreads();
  if (tid < NB * 48) {
    const int b = tid / 48, j = tid - b * 48;
    float sacc = ada_b[i * 6 * DM + j0 + j];
#pragma unroll
    for (int w8 = 0; w8 < 8; ++w8) sacc += part[(w8 * NB + b) * 48 + j];
    modp[(size_t)(i * NB + b) * 6 * DM + j0 + j] = sacc;
  }
  __syncthreads();
}

struct Args { const float* in[31]; float* out; unsigned char* ws; };

#define FOR_VB(n) for (int vb = bid() * 2 + (launder(tid) >> 8); vb < (n); vb += GRID * 2) \
    if (const int t = launder(tid) & 255; true) if (float* sm = (float*)(lds + (launder(tid) >> 8) * HALF_LDS); true)
#define GBF(LAYER_, K0_, NK_) do { XcdBarrier b_; b_.bar = (unsigned*)WSB + 4096; b_.x = 0; b_.st = (volatile LAS unsigned*)((LAS unsigned char*)lds + (LDS_BYTES - 256)) + 8; xcd_arrive(b_); \
    moe_convert(tid, lds, K0_, NK_, moe_w_gate + (size_t)(LAYER_) * NE * DM * DM, moe_w_up + (size_t)(LAYER_) * NE * DM * DM, moe_w_down + (size_t)(LAYER_) * NE * DM * DM, (unsigned char*)Wmoe + (size_t)(LAYER_) * 48 * MiB); \
    xcd_wait(b_); } while (0)
#define GB() do { XcdBarrier b_; b_.bar = (unsigned*)WSB + 4096; b_.x = 0; b_.st = (volatile LAS unsigned*)((LAS unsigned char*)lds + (LDS_BYTES - 256)) + 8; xcd_barrier(b_); } while (0)

typedef float f32x4_t __attribute__((ext_vector_type(4)));

template <int M> __device__ __forceinline__ float swz_xor(float v) { return __uint_as_float((unsigned)__builtin_amdgcn_ds_swizzle((int)__float_as_uint(v), (M << 10) | 0x1f)); }
__device__ __forceinline__ float sum_x32(float v) { auto rr = __builtin_amdgcn_permlane32_swap(__float_as_uint(v), __float_as_uint(v), false, false); return __uint_as_float(rr[0]) + __uint_as_float(rr[1]); }
__device__ __forceinline__ float max_x32(float v) { auto rr = __builtin_amdgcn_permlane32_swap(__float_as_uint(v), __float_as_uint(v), false, false); return fmaxf(__uint_as_float(rr[0]), __uint_as_float(rr[1])); }
__device__ __forceinline__ float get_x32(float v, bool hi) { auto rr = __builtin_amdgcn_permlane32_swap(__float_as_uint(v), __float_as_uint(v), false, false); return hi ? __uint_as_float(rr[0]) : __uint_as_float(rr[1]); }
__device__ __forceinline__ float wsum64(float v) {
  v += swz_xor<1>(v); v += swz_xor<2>(v); v += swz_xor<4>(v); v += swz_xor<8>(v); v += swz_xor<16>(v);
  return sum_x32(v);
}
__device__ __forceinline__ float router_reduce(const float* acc, int lane) {
  float a8[8], a4[4], a2[2], a1;
  { const bool hi = (lane & 32) != 0;
#pragma unroll
    for (int i = 0; i < 8; ++i) { const float keep = hi ? acc[i + 8] : acc[i], send = hi ? acc[i] : acc[i + 8]; a8[i] = keep + get_x32(send, hi); } }
  { const bool hi = (lane & 16) != 0;
#pragma unroll
    for (int i = 0; i < 4; ++i) { const float keep = hi ? a8[i + 4] : a8[i], send = hi ? a8[i] : a8[i + 4]; a4[i] = keep + swz_xor<16>(send); } }
  { const bool hi = (lane & 8) != 0;
#pragma unroll
    for (int i = 0; i < 2; ++i) { const float keep = hi ? a4[i + 2] : a4[i], send = hi ? a4[i] : a4[i + 2]; a2[i] = keep + swz_xor<8>(send); } }
  { const bool hi = (lane & 4) != 0; const float keep = hi ? a2[1] : a2[0], send = hi ? a2[0] : a2[1]; a1 = keep + swz_xor<4>(send); }
  a1 += swz_xor<1>(a1); a1 += swz_xor<2>(a1);
  return a1;
}
template <bool ROUTER>
__device__ __forceinline__ void norm_rows_phase(int tid_in, unsigned char* lds, const float* xin, const float* gnorm, const float* sh, const float* sc,
                                                bf16* XN, const float* wr, float* aff) {
  const int tid = launder(tid_in), wave = __builtin_amdgcn_readfirstlane(tid >> 6), lane = tid & 63;
  LAS float* wl = (LAS float*)lds;
  constexpr int NR = ROUTER ? 4 : 2;
  if (ROUTER) {
    __syncthreads();
    for (int q = tid; q < DM * NE / 4; q += NTHR) { const f32x4_t w4 = ((const f32x4_t*)wr)[q]; const int k = q >> 2, e0 = (q & 3) * 4;
      wl[(e0 + 0) * DM + k] = w4.x; wl[(e0 + 1) * DM + k] = w4.y; wl[(e0 + 2) * DM + k] = w4.z; wl[(e0 + 3) * DM + k] = w4.w; }
    __syncthreads();
  }
  for (int rp = bid() * 8 + wave; rp < NTOK / NR; rp += GRID * 8) {
    const int row0 = NR * rp, b = row0 / SEQ;
    float rs[NR];
#pragma unroll
    for (int r = 0; r < NR; ++r) {
      const f32x4_t* xr = (const f32x4_t*)(xin + (size_t)(row0 + r) * DM) + lane; float ss = 0.f;
#pragma unroll
      for (int j = 0; j < 4; ++j) { const f32x4_t v = xr[64 * j]; ss += (v.x * v.x + v.y * v.y) + (v.z * v.z + v.w * v.w); }
      rs[r] = rsqrtf(wsum64(ss) * (1.f / DM) + 1e-6f);
    }
    float acc[NR][NE];
#pragma unroll
    for (int r = 0; r < NR; ++r)
#pragma unroll
      for (int e = 0; e < NE; ++e) acc[r][e] = 0.f;
#pragma unroll 1
    for (int j = 0; j < 4; ++j) {
      const int cj = launder(lane + 64 * j);
      const f32x4_t gg = ((const f32x4_t*)gnorm)[cj];
      const f32x4_t s1 = ((const f32x4_t*)(sc + (size_t)b * 6 * DM))[cj];
      const f32x4_t s0 = ((const f32x4_t*)(sh + (size_t)b * 6 * DM))[cj];
      f32x4_t y[NR];
#pragma unroll
      for (int r = 0; r < NR; ++r) {
        y[r] = ((const f32x4_t*)(xin + (size_t)(row0 + r) * DM))[cj] * rs[r] * gg * (s1 + 1.0f) + s0;
        if (ROUTER) ((unsigned*)((unsigned char*)XN + (size_t)(row0 + r) * DM))[cj] = pg8::pack4_fp8(y[r].x, y[r].y, y[r].z, y[r].w);
        else { uint2 w; w.x = pk2(y[r].x, y[r].y); w.y = pk2(y[r].z, y[r].w);
        ((uint2*)(XN + (size_t)(row0 + r) * DM))[cj] = w; }
      }
      if (ROUTER) {
        const unsigned wofs = (unsigned)cj * 16u;
#pragma unroll
        for (int e = 0; e < NE; ++e) {
          const f32x4_t w4 = *(const LAS f32x4_t*)((LAS unsigned char*)wl + wofs + e * (DM * 4));
#pragma unroll
          for (int r = 0; r < NR; ++r) acc[r][e] += (y[r].x * w4.x + y[r].y * w4.y) + (y[r].z * w4.z + y[r].w * w4.w);
        }
      }
    }
    if (ROUTER) {
#pragma unroll
      for (int r = 0; r < NR; ++r) {
        const float a1 = router_reduce(acc[r], lane);
        float mx = a1;
        mx = fmaxf(mx, swz_xor<4>(mx)); mx = fmaxf(mx, swz_xor<8>(mx)); mx = fmaxf(mx, swz_xor<16>(mx)); mx = max_x32(mx);
        const float p = expf(a1 - mx);
        float sm_ = p;
        sm_ += swz_xor<4>(sm_); sm_ += swz_xor<8>(sm_); sm_ += swz_xor<16>(sm_); sm_ = sum_x32(sm_);
        if ((lane & 3) == 0) aff[((size_t)b * NE + (lane >> 2)) * SEQ + (row0 + r - b * SEQ)] = p / sm_;
      }
    }
  }
}

__device__ __forceinline__ void topk_phase(int tid_in, unsigned char* lds, const float* aff, int* idx_row, float* gsel_row, int* slot_of) {
  const int tid = launder(tid_in), wave = __builtin_amdgcn_readfirstlane(tid >> 6), lane = tid & 63;
  LAS unsigned* hist = (LAS unsigned*)lds;
  LAS unsigned* bc = hist + 256;
  LAS unsigned* wtot = hist + 272;
  for (int be = bid(); be < NB * NE; be += GRID) {
    const int b = be / NE, e = be % NE;
    unsigned v[8];
    { const uint4* src = (const uint4*)(aff + (size_t)be * SEQ) + 2 * tid; const uint4 p0 = src[0], p1 = src[1];
      v[0] = p0.x; v[1] = p0.y; v[2] = p0.z; v[3] = p0.w; v[4] = p1.x; v[5] = p1.y; v[6] = p1.z; v[7] = p1.w; }
    unsigned prefix = 0u, need = CAP;
#pragma unroll 1
    for (int pass = 0; pass < 4; ++pass) {
      const int shift = 24 - 8 * pass;
      __syncthreads();
      if (tid < 256) hist[tid] = 0u;
      __syncthreads();
#pragma unroll
      for (int i = 0; i < 8; ++i) {
        const bool match = (pass == 0) || ((v[i] >> (shift + 8)) == prefix);
        if (match) __hip_atomic_fetch_add(&hist[(v[i] >> shift) & 255u], 1u, __ATOMIC_RELAXED, __HIP_MEMORY_SCOPE_WORKGROUP);
      }
      __syncthreads();
      if (wave == 0) {
        const unsigned c0 = hist[4 * lane], c1 = hist[4 * lane + 1], c2 = hist[4 * lane + 2], c3 = hist[4 * lane + 3];
        const unsigned cs = c0 + c1 + c2 + c3;
        unsigned suf = cs;
#pragma unroll
        for (int o = 1; o < 64; o <<= 1) { const unsigned t2 = (unsigned)__builtin_amdgcn_ds_bpermute(((lane + o) & 63) << 2, (int)suf); if (lane + o < 64) suf += t2; }
        const unsigned above = suf - cs;
        if (suf >= need && above < need) {
          unsigned ab = above, bin;
          if (ab + c3 >= need) bin = 3; else { ab += c3; if (ab + c2 >= need) bin = 2; else { ab += c2; if (ab + c1 >= need) bin = 1; else { ab += c1; bin = 0; } } }
          bc[0] = 4 * lane + bin; bc[1] = ab;
        }
      }
      __syncthreads();
      prefix = (prefix << 8) | bc[0];
      need -= bc[1];
    }
    unsigned cg = 0u, ce = 0u;
#pragma unroll
    for (int i = 0; i < 8; ++i) { cg += (v[i] > prefix) ? 1u : 0u; ce += (v[i] == prefix) ? 1u : 0u; }
    unsigned pk = cg | (ce << 16), inc = pk;
#pragma unroll
    for (int o = 1; o < 64; o <<= 1) { const unsigned t2 = (unsigned)__builtin_amdgcn_ds_bpermute(((lane - o) & 63) << 2, (int)inc); if (lane >= o) inc += t2; }
    __syncthreads();
    if (lane == 63) wtot[wave] = inc;
    __syncthreads();
    unsigned base = 0u;
#pragma unroll
    for (int w = 0; w < 8; ++w) if (w < wave) base += wtot[w];
    unsigned ex = base + inc - pk;
    unsigned gtb = ex & 0xffffu, eqb = ex >> 16;
#pragma unroll
    for (int i = 0; i < 8; ++i) {
      const int t = 8 * tid + i;
      const bool gt = v[i] > prefix, eq = v[i] == prefix;
      const bool sel = gt || (eq && eqb < need);
      const unsigned slot = gtb + (eqb < need ? eqb : need);
      if (sel) { const size_t r = (size_t)e * (NB * CAP) + b * CAP + slot; idx_row[r] = b * SEQ + t; gsel_row[r] = __uint_as_float(v[i]); }
      slot_of[(size_t)be * SEQ + t] = sel ? (int)slot : -1;
      gtb += gt ? 1u : 0u; eqb += eq ? 1u : 0u;
    }
  }
}

__device__ __forceinline__ void gather_phase(int tid_in, const bf16* XN, const int* idx_row, bf16* XS) {
  const int tid = launder(tid_in), wave = __builtin_amdgcn_readfirstlane(tid >> 6), lane = tid & 63;
  for (int r = bid() * 8 + wave; r < NE * NB * CAP; r += GRID * 8) {
    const int src = idx_row[r];
    const uint4* s = (const uint4*)(XN + (size_t)src * DM) + lane;
    uint4* d = (uint4*)(XS + (size_t)r * DM) + lane;
    const uint4 a = s[0], c = s[64];
    d[0] = a; d[64] = c;
  }
}

template <bool FINAL>
__device__ __forceinline__ void combine_norm_phase(int tid_in, bf16* xb, float* xfin, const bf16* ye, const int* slot_of, const float* g2, const float* gnext, const float* sh, const float* sc, bf16* XN) {
  const int tid = launder(tid_in), wave = __builtin_amdgcn_readfirstlane(tid >> 6), lane = tid & 63;
  for (int row = bid() * 8 + wave; row < NTOK; row += GRID * 8) {
    const int b = row / SEQ, t = row - b * SEQ;
    const int myslot = slot_of[((size_t)b * NE + (lane & 15)) * SEQ + t];
    uint2* xr = (uint2*)(xb + (size_t)row * DM) + lane;
    uint2 xw[4];
#pragma unroll
    for (int j = 0; j < 4; ++j) xw[j] = xr[64 * j];
    unsigned long long m = __ballot(myslot >= 0) & 0xffffull;
    f32x4_t acc[4];
#pragma unroll
    for (int j = 0; j < 4; ++j) acc[j] = (f32x4_t){0.f, 0.f, 0.f, 0.f};
    while (m) {
      const int e0 = __builtin_ctzll(m); m &= m - 1;
      const int e1 = m ? __builtin_ctzll(m) : -1; if (m) m &= m - 1;
      const int s0 = __builtin_amdgcn_readlane(myslot, e0);
      const unsigned* y0 = (const unsigned*)((const unsigned char*)ye + ((size_t)e0 * (NB * CAP) + b * CAP + s0) * DM) + lane;
      unsigned w0[4], w1[4];
#pragma unroll
      for (int j = 0; j < 4; ++j) w0[j] = y0[64 * j];
      if (e1 >= 0) {
        const int s1 = __builtin_amdgcn_readlane(myslot, e1);
        const unsigned* y1 = (const unsigned*)((const unsigned char*)ye + ((size_t)e1 * (NB * CAP) + b * CAP + s1) * DM) + lane;
#pragma unroll
        for (int j = 0; j < 4; ++j) w1[j] = y1[64 * j];
      } else {
#pragma unroll
        for (int j = 0; j < 4; ++j) w1[j] = 0u;
      }
#pragma unroll
      for (int j = 0; j < 4; ++j) {
        const auto a0 = __builtin_amdgcn_cvt_pk_f32_fp8((int)w0[j], false), a1 = __builtin_amdgcn_cvt_pk_f32_fp8((int)w0[j], true);
        const auto b0 = __builtin_amdgcn_cvt_pk_f32_fp8((int)w1[j], false), b1 = __builtin_amdgcn_cvt_pk_f32_fp8((int)w1[j], true);
        acc[j].x += a0[0] + b0[0]; acc[j].y += a0[1] + b0[1]; acc[j].z += a1[0] + b1[0]; acc[j].w += a1[1] + b1[1]; }
    }
    float ss = 0.f;
#pragma unroll
    for (int j = 0; j < 4; ++j) { const f32x4_t gv = ((const f32x4_t*)(g2 + (size_t)b * 6 * DM))[lane + 64 * j] * (1.f / 16.f);
      const f32x4_t xv = {__uint_as_float(xw[j].x << 16), __uint_as_float(xw[j].x & 0xffff0000u), __uint_as_float(xw[j].y << 16), __uint_as_float(xw[j].y & 0xffff0000u)}; acc[j] = xv + gv * acc[j];
      ss += (acc[j].x * acc[j].x + acc[j].y * acc[j].y) + (acc[j].z * acc[j].z + acc[j].w * acc[j].w); }
    const float r = rsqrtf(wsum64(ss) * (1.f / DM) + 1e-6f);
#pragma unroll
    for (int j = 0; j < 4; ++j) {
      const f32x4_t gg = ((const f32x4_t*)gnext)[lane + 64 * j];
      if (FINAL) ((f32x4_t*)(xfin + (size_t)row * DM) + lane)[64 * j] = acc[j] * r * gg;
      else {
        { uint2 w; w.x = pk2(acc[j].x, acc[j].y); w.y = pk2(acc[j].z, acc[j].w); xr[64 * j] = w; }
        const f32x4_t s1 = ((const f32x4_t*)(sc + (size_t)b * 6 * DM))[lane + 64 * j], s0 = ((const f32x4_t*)(sh + (size_t)b * 6 * DM))[lane + 64 * j];
        const f32x4_t y = acc[j] * r * gg * (s1 + 1.0f) + s0;
        uint2 w; w.x = pk2(y.x, y.y); w.y = pk2(y.z, y.w);
        ((uint2*)(XN + (size_t)row * DM) + lane)[64 * j] = w;
      }
    }
  }
}

typedef short bf16x8_t __attribute__((ext_vector_type(8)));
typedef float f32x16_t __attribute__((ext_vector_type(16)));
__device__ __forceinline__ float bflo(unsigned w) { return __uint_as_float(w << 16); }
__device__ __forceinline__ float bfhi(unsigned w) { return __uint_as_float(w & 0xffff0000u); }
__device__ __forceinline__ void unpack8(const v4u v, float* f) { f[0] = bflo(v.x); f[1] = bfhi(v.x); f[2] = bflo(v.y); f[3] = bfhi(v.y); f[4] = bflo(v.z); f[5] = bfhi(v.z); f[6] = bflo(v.w); f[7] = bfhi(v.w); }

__device__ __forceinline__ void norm_router_phase(int tid_in, unsigned char* lds_, const bf16* xin, const float* gnorm, const float* sh, const float* sc,
                                                  unsigned char* XN8, const float* wr, float* aff) {
  const int tid = launder(tid_in), wave = __builtin_amdgcn_readfirstlane(tid >> 6), lane = tid & 63, r = lane & 15, kg = lane >> 4;
  LAS unsigned char* lds = (LAS unsigned char*)lds_;
  constexpr int O_A = 0, O_S0 = 4096, O_SS = 8192, O_LP = 9216, O_CP = 25600;
  const int b = bid() / (SEQ / 128), rowW = bid() * 128, c0 = wave * 128 + kg * 8;
  __syncthreads();
  for (int k = tid; k < DM; k += NTHR) {
    *(LAS float*)(lds + O_A + k * 4) = gnorm[k] * (sc[(size_t)b * 6 * DM + k] + 1.0f); *(LAS float*)(lds + O_S0 + k * 4) = sh[(size_t)b * 6 * DM + k]; }
  bf16x8_t bh[4], bl[4];
  { float cpart = 0.f;
#pragma unroll
    for (int ks = 0; ks < 4; ++ks) {
      float wv[8];
#pragma unroll
      for (int j = 0; j < 8; ++j) wv[j] = wr[(size_t)(c0 + 32 * ks + j) * NE + r];
      const f32x4_t s0 = *(const f32x4_t*)(sh + (size_t)b * 6 * DM + c0 + 32 * ks), s1 = *(const f32x4_t*)(sh + (size_t)b * 6 * DM + c0 + 32 * ks + 4);
      cpart += (s0.x * wv[0] + s0.y * wv[1]) + (s0.z * wv[2] + s0.w * wv[3]) + (s1.x * wv[4] + s1.y * wv[5]) + (s1.z * wv[6] + s1.w * wv[7]);
      unsigned h[4], l[4];
#pragma unroll
      for (int j = 0; j < 4; ++j) { h[j] = pg8::cvt_pk_bf16(wv[2 * j], wv[2 * j + 1]);
        l[j] = pg8::cvt_pk_bf16(wv[2 * j] - __uint_as_float(h[j] << 16), wv[2 * j + 1] - __uint_as_float(h[j] & 0xffff0000u)); }
      const v4u hu = {h[0], h[1], h[2], h[3]}, lu = {l[0], l[1], l[2], l[3]};
      bh[ks] = __builtin_bit_cast(bf16x8_t, hu); bl[ks] = __builtin_bit_cast(bf16x8_t, lu);
    }
    cpart += swz_xor<16>(cpart); cpart = sum_x32(cpart);
    if (kg == 0) *(LAS float*)(lds + O_CP + (wave * 16 + r) * 4) = cpart;
  }
  __syncthreads();
  float csum = 0.f;
#pragma unroll
  for (int w = 0; w < 8; ++w) csum += *(const LAS float*)(lds + O_CP + (w * 16 + (tid & 15)) * 4);
  const bf16* xp = xin + (size_t)(rowW + r) * DM + c0;
  unsigned char* xo = XN8 + (size_t)(rowW + r) * DM + c0;
  unsigned aoff = (unsigned)(O_A + c0 * 4), soff = (unsigned)(O_S0 + c0 * 4);
  asm volatile("" : "+v"(aoff), "+v"(soff));
#define NR_LOAD(V, G) do { _Pragma("unroll") for (int ks = 0; ks < 4; ++ks) { const v4u r_ = *(const v4u*)(xp + (size_t)(G) * 16 * DM + 32 * ks); \
      V[2 * ks] = (f32x4_t){__uint_as_float(r_.x << 16), __uint_as_float(r_.x & 0xffff0000u), __uint_as_float(r_.y << 16), __uint_as_float(r_.y & 0xffff0000u)}; \
      V[2 * ks + 1] = (f32x4_t){__uint_as_float(r_.z << 16), __uint_as_float(r_.z & 0xffff0000u), __uint_as_float(r_.w << 16), __uint_as_float(r_.w & 0xffff0000u)}; } } while (0)
#define NR_PROC(V, G, BUF) do { \
    f32x4_t acc = {0.f, 0.f, 0.f, 0.f}; float ss = 0.f; \
    _Pragma("unroll") for (int ks = 0; ks < 4; ++ks) { \
      const f32x4_t a0 = *(const LAS f32x4_t*)(lds + aoff + 128 * ks), a1 = *(const LAS f32x4_t*)(lds + aoff + 128 * ks + 16); \
      const f32x4_t v0 = V[2 * ks], v1 = V[2 * ks + 1]; \
      ss += (v0.x * v0.x + v0.y * v0.y) + (v0.z * v0.z + v0.w * v0.w) + (v1.x * v1.x + v1.y * v1.y) + (v1.z * v1.z + v1.w * v1.w); \
      const f32x4_t y0 = v0 * a0, y1 = v1 * a1; V[2 * ks] = y0; V[2 * ks + 1] = y1; \
      const unsigned h0 = pg8::cvt_pk_bf16(y0.x, y0.y), h1 = pg8::cvt_pk_bf16(y0.z, y0.w), h2 = pg8::cvt_pk_bf16(y1.x, y1.y), h3 = pg8::cvt_pk_bf16(y1.z, y1.w); \
      const unsigned l0 = pg8::cvt_pk_bf16(y0.x - __uint_as_float(h0 << 16), y0.y - __uint_as_float(h0 & 0xffff0000u)), l1 = pg8::cvt_pk_bf16(y0.z - __uint_as_float(h1 << 16), y0.w - __uint_as_float(h1 & 0xffff0000u)); \
      const unsigned l2 = pg8::cvt_pk_bf16(y1.x - __uint_as_float(h2 << 16), y1.y - __uint_as_float(h2 & 0xffff0000u)), l3 = pg8::cvt_pk_bf16(y1.z - __uint_as_float(h3 << 16), y1.w - __uint_as_float(h3 & 0xffff0000u)); \
      const v4u ahu = {h0, h1, h2, h3}, alu = {l0, l1, l2, l3}; \
      const bf16x8_t ah = __builtin_bit_cast(bf16x8_t, ahu), al = __builtin_bit_cast(bf16x8_t, alu); \
      acc = __builtin_amdgcn_mfma_f32_16x16x32_bf16(ah, bh[ks], acc, 0, 0, 0); \
      acc = __builtin_amdgcn_mfma_f32_16x16x32_bf16(al, bh[ks], acc, 0, 0, 0); \
      acc = __builtin_amdgcn_mfma_f32_16x16x32_bf16(ah, bl[ks], acc, 0, 0, 0); } \
    ss += swz_xor<16>(ss); ss = sum_x32(ss); \
    if (kg == 0) *(LAS float*)(lds + O_SS + ((BUF) * 128 + wave * 16 + r) * 4) = ss; \
    _Pragma("unroll") for (int j = 0; j < 4; ++j) *(LAS float*)(lds + O_LP + ((BUF) * 2048 + wave * 256 + (4 * kg + j) * 16 + r) * 4) = acc[j]; \
    __syncthreads(); \
    { float st = 0.f; _Pragma("unroll") for (int w = 0; w < 8; ++w) st += *(const LAS float*)(lds + O_SS + ((BUF) * 128 + w * 16 + r) * 4); \
      const float rs = rsqrtf(st * (1.f / DM) + 1e-6f); \
      _Pragma("unroll") for (int ks = 0; ks < 4; ++ks) { \
        const f32x4_t s0 = *(const LAS f32x4_t*)(lds + soff + 128 * ks), s1 = *(const LAS f32x4_t*)(lds + soff + 128 * ks + 16); \
        const f32x4_t y0 = V[2 * ks] * rs + s0, y1 = V[2 * ks + 1] * rs + s1; \
        v2u o; o.x = pg8::pack4_fp8(y0.x, y0.y, y0.z, y0.w); o.y = pg8::pack4_fp8(y1.x, y1.y, y1.z, y1.w); \
        *(v2u*)(xo + (size_t)(G) * 16 * DM + 32 * ks) = o; } } \
    if (tid < 256) { const int row = tid >> 4, e = tid & 15; float st = 0.f, lg = 0.f; \
      _Pragma("unroll") for (int w = 0; w < 8; ++w) { st += *(const LAS float*)(lds + O_SS + ((BUF) * 128 + w * 16 + row) * 4); lg += *(const LAS float*)(lds + O_LP + ((BUF) * 2048 + w * 256 + tid) * 4); } \
      const float a1 = lg * rsqrtf(st * (1.f / DM) + 1e-6f) + csum; \
      float mx = a1; mx = fmaxf(mx, swz_xor<1>(mx)); mx = fmaxf(mx, swz_xor<2>(mx)); mx = fmaxf(mx, swz_xor<4>(mx)); mx = fmaxf(mx, swz_xor<8>(mx)); \
      const float p = expf(a1 - mx); \
      float sm_ = p; sm_ += swz_xor<1>(sm_); sm_ += swz_xor<2>(sm_); sm_ += swz_xor<4>(sm_); sm_ += swz_xor<8>(sm_); \
      aff[((size_t)b * NE + e) * SEQ + (rowW + (G) * 16 + row - b * SEQ)] = p / sm_; } \
  } while (0)
  f32x4_t va[8], vb[8];
  NR_LOAD(va, 0);
#pragma unroll 1
  for (int gi = 0; gi < 8; gi += 2) {
    NR_LOAD(vb, gi + 1);
    NR_PROC(va, gi, 0);
    if (gi + 2 < 8) NR_LOAD(va, gi + 2);
    NR_PROC(vb, gi + 1, 1);
  }
#undef NR_LOAD
#undef NR_PROC
}
__device__ __forceinline__ void filter_phase(int tid_in, unsigned char* lds_, const float* w1, const float* b1, const float* w2, const float* b2,
                                             const bf16* W3T, const float* freq, const float* fbias, unsigned char* KR8, float* K0) {
  const int tid = launder(tid_in);
  LAS float* zf = (LAS float*)lds_;
  LAS float* h1 = zf + 16 * 36;
  LAS float* h2 = h1 + 16 * 64;
  LAS float* w1l = h2 + 64 * 16;
  LAS float* w2l = w1l + 33 * 64;
  __syncthreads();
  for (int q = tid; q < 33 * 64; q += NTHR) w1l[q] = w1[q];
  for (int q = tid; q < 64 * 64; q += NTHR) w2l[q] = w2[q];
  for (int item = bid(); item < SEQ / 16; item += GRID) {
    const int l0 = item * 16;
    __syncthreads();
    if (tid < 16 * 17) {
      const int li = tid / 17, f = tid - li * 17, l = l0 + li;
      if (f == 0) zf[li * 36] = (float)l / (float)(SEQ - 1);
      else {
        const int j = f - 1;
        const float wv = 2.0f * 3.14159265358979323846f * (float)l / (float)SEQ;
        const float fr = 1e-4f + (float)j * ((15.0f - 1e-4f) / 15.0f);
        const float ang = fr * wv;
        zf[li * 36 + 1 + j] = cosf(ang);
        zf[li * 36 + 17 + j] = -sinf(ang);
      }
    }
    __syncthreads();
    for (int o = tid; o < 1024; o += NTHR) {
      const int li = o >> 6, j = o & 63;
      float a = b1[j];
#pragma unroll
      for (int i = 0; i < 33; ++i) a += zf[li * 36 + i] * w1l[i * 64 + j];
      h1[li * 64 + j] = sinf(freq[j] * a);
    }
    __syncthreads();
    for (int o = tid; o < 1024; o += NTHR) {
      const int li = o >> 6, j = o & 63;
      float a = b2[j];
#pragma unroll 16
      for (int i = 0; i < 64; ++i) a += h1[li * 64 + i] * w2l[i * 64 + j];
      ((LAS unsigned short*)h2)[li * 64 + j] = (unsigned short)f2bf(sinf(freq[j] * a));
    }
    __syncthreads();
    const float min_decay = logf(1e-2f) / 0.3f, max_decay = logf(1e-2f) / 1.5f;
    {
      const int wave = __builtin_amdgcn_readfirstlane(tid >> 6), lane = tid & 63, cn = lane & 15, g = lane >> 4;
      const bf16x8_t a0 = *(const LAS bf16x8_t*)((LAS unsigned char*)h2 + cn * 128 + g * 16), a1 = *(const LAS bf16x8_t*)((LAS unsigned char*)h2 + cn * 128 + 64 + g * 16);
#pragma unroll 1
      for (int tb = 0; tb < 16; tb += 8) {
        bf16x8_t b0[8], b1[8];
#pragma unroll
        for (int t = 0; t < 8; ++t) { const bf16* wp = W3T + (size_t)(wave * 256 + (tb + t) * 16 + cn) * 64 + g * 8;
          b0[t] = *(const bf16x8_t*)wp; b1[t] = *(const bf16x8_t*)(wp + 32); }
#pragma unroll
        for (int t = 0; t < 8; ++t) {
          f32x4_t acc = {0.f, 0.f, 0.f, 0.f};
          acc = __builtin_amdgcn_mfma_f32_16x16x32_bf16(a0, b0[t], acc, 0, 0, 0);
          acc = __builtin_amdgcn_mfma_f32_16x16x32_bf16(a1, b1[t], acc, 0, 0, 0);
          const int col = wave * 256 + (tb + t) * 16 + cn, d = col & 1023, lb = l0 + 4 * g;
          const float delta = min_decay + (float)d * ((max_decay - min_decay) / (float)(DM - 1));
          unsigned char* kr = KR8 + (size_t)d * 8192;
          float h[4];
#pragma unroll
          for (int e = 0; e < 4; ++e) {
            const int l = lb + e;
            const float tl = (float)l / (float)(SEQ - 1);
            float v = acc[e] * expf(-tl * fabsf(delta));
            if (wave < 4 && l == 0) v += fbias[d];
            h[e] = fminf(fmaxf(v * 32.f, -448.f), 448.f);
          }
          if (wave < 4) {
            unsigned char* cb_ = kr + 4092 - lb;
            const unsigned pa = pg8::pack4_fp8(h[0], h[3], h[2], h[1]);
            cb_[4] = (unsigned char)pa;
            cb_[1] = (unsigned char)(pa >> 8);
            *(unsigned short*)(cb_ + 2) = (unsigned short)(pa >> 16);
            if (lb == 4092) cb_[0] = 0;
          } else {
            const unsigned w0 = pg8::pack4_fp8(h[0], h[1], h[2], h[3]);
            if (lb == 0) { kr[4097] = (unsigned char)(w0 >> 8); *(unsigned short*)(kr + 4098) = (unsigned short)(w0 >> 16); }
            else *(unsigned*)(kr + 4096 + lb) = w0;
          }
        }
      }
    }
  }
}

template <int LD> __device__ __forceinline__ void sconv8_load(const bf16* up, int col, int t, v4u* r) {
  const v4u z4 = (v4u){0u, 0u, 0u, 0u};
  r[0] = t > 0 ? *(const v4u*)(up - LD + col) : z4;
  r[1] = *(const v4u*)(up + col);
  r[2] = t < SEQ - 1 ? *(const v4u*)(up + LD + col) : z4;
}
__device__ __forceinline__ void sconv8_calc(const v4u* r, int col, const float* cw, const float* cb, float* out) {
  float um[8], u0[8], u1[8];
  unpack8(r[0], um); unpack8(r[1], u0); unpack8(r[2], u1);
#pragma unroll
  for (int h = 0; h < 2; ++h) {
    const f32x4_t w0 = *(const f32x4_t*)(cw + col + 4 * h), w1 = *(const f32x4_t*)(cw + 3072 + col + 4 * h), w2 = *(const f32x4_t*)(cw + 6144 + col + 4 * h), bb = *(const f32x4_t*)(cb + col + 4 * h);
#pragma unroll
    for (int k = 0; k < 4; ++k) out[4 * h + k] = bb[k] + w0[k] * um[4 * h + k] + w1[k] * u0[4 * h + k] + w2[k] * u1[4 * h + k];
  }
}
__device__ __forceinline__ void gateT_phase(int tid_in, unsigned char* lds_, const bf16* U, const float* cw, const float* cb, const bf16* ycT, bf16* Yg) {
  const int tid = launder(tid_in), cch = tid & 7, tl = tid >> 3;
  LAS bf16* tile = (LAS bf16*)lds_;
  constexpr int NITEM = NB * 64 * 16;
  const int rowc = tid >> 3, chunk = tid & 7;
  v4u ra[3], na[3], yv, nyv;
  {
    const int item = bid(), cbk = item & 15, r = item >> 4, tb = r & 63, b = r >> 6, c0 = cbk * 64 + cch * 8, t = tb * 64 + tl;
    yv = *(const v4u*)(ycT + ((size_t)(cbk * 64 + rowc) * NB + b) * SEQ + tb * 64 + chunk * 8);
    sconv8_load<DM>(U + (size_t)(b * SEQ + t) * DM, c0, t, ra);
  }
  for (int item = bid(); item < NITEM; item += GRID) {
    const int cbk = item & 15, r = item >> 4, tb = r & 63, b = r >> 6;
    const int c0 = cbk * 64 + cch * 8, t = tb * 64 + tl;
    {
      const int nitem = item + GRID < NITEM ? item + GRID : item, nr = nitem >> 4, ntb = nr & 63, nbb = nr >> 6, nt = ntb * 64 + tl;
      nyv = *(const v4u*)(ycT + ((size_t)(cbk * 64 + rowc) * NB + nbb) * SEQ + ntb * 64 + chunk * 8);
      sconv8_load<DM>(U + (size_t)(nbb * SEQ + nt) * DM, c0, nt, na);
    }
    float a0[8];
    sconv8_calc(ra, c0, cw, cb, a0);
    __syncthreads();
    *(LAS v4u*)(tile + rowc * 72 + chunk * 8) = yv;
    __syncthreads();
    float y[8];
#pragma unroll
    for (int k = 0; k < 8; ++k) y[k] = __uint_as_float((unsigned)tile[(cch * 8 + k) * 72 + tl] << 16) * a0[k];
    v4u o; o.x = pk2(y[0], y[1]); o.y = pk2(y[2], y[3]); o.z = pk2(y[4], y[5]); o.w = pk2(y[6], y[7]);
    *(v4u*)(Yg + (size_t)(b * SEQ + t) * DM + c0) = o;
#pragma unroll
    for (int k = 0; k < 3; ++k) ra[k] = na[k];
    yv = nyv;
  }
}

#define LC8_ZB 34816
#define LC8_FS 4208
#define LC8_ZF (LC8_ZB + 16 * LC8_FS)
typedef int lc_v4i __attribute__((ext_vector_type(4)));
typedef int lc_v8i __attribute__((ext_vector_type(8)));
__device__ __forceinline__ unsigned lc8_zslot(int Jp, int e, int b) { return (unsigned)((((Jp >> 1) * 4 + e * 2 + (Jp & 1)) * 8 + b) * 16); }
__device__ __forceinline__ lc_v8i lc_cat(lc_v4i a, lc_v4i b) { return __builtin_shufflevector(a, b, 0, 1, 2, 3, 4, 5, 6, 7); }
__device__ __forceinline__ void longconv_phase(int tid_in, unsigned char* lds_, const bf16* UT, const float* cw, const float* cb, const unsigned char* KR8, bf16* ycT) {
  LAS unsigned char* lds = (LAS unsigned char*)lds_;
  for (int c = bid(); c < DM; c += GRID) {
    const int tid = launder(tid_in), wave = __builtin_amdgcn_readfirstlane(tid >> 6), lane = tid & 63;
    const int n = lane & 31, half = lane >> 5, q = n >> 3, bb = n & 7, sigma = n >> 4, rho = n & 15;
    const int IL = 8 * wave, IH = 120 - 8 * wave;
    __syncthreads();
    if (tid >= 128 && tid < 132) *(LAS v4u*)(lds + LC8_ZF + (tid - 128) * 16) = (v4u){0u, 0u, 0u, 0u};
    if (tid < 128) {
      const int b = tid & 7, e = (tid >> 3) & 1, jb = tid >> 4, Jp = jb < 4 ? jb : 128 + jb;
      *(LAS v4u*)(lds + lc8_zslot(Jp, e, b)) = (v4u){0u, 0u, 0u, 0u};
    }
    {
      const float w10 = cw[1024 + c], w11 = cw[3072 + 1024 + c], w12 = cw[6144 + 1024 + c], b1_ = cb[1024 + c];
      const float w20 = cw[2048 + c], w21 = cw[3072 + 2048 + c], w22 = cw[6144 + 2048 + c], b2_ = cb[2048 + c];
      const bf16* x1r = UT + (size_t)(1024 + c) * NTOK; const bf16* vr = UT + (size_t)(2048 + c) * NTOK;
      v4u xa[4], xb[4], va[4], vb[4]; unsigned xm[4], xn[4], vm[4], vn[4];
#pragma unroll
      for (int k = 0; k < 4; ++k) {
        const int s_ = tid + NTHR * k, b = s_ >> 8, ch = s_ & 255, t0 = ch * 16;
        const bf16* xp = x1r + b * SEQ + t0; const bf16* vp = vr + b * SEQ + t0;
        xa[k] = *(const v4u*)xp; xb[k] = *(const v4u*)(xp + 8); va[k] = *(const v4u*)vp; vb[k] = *(const v4u*)(vp + 8);
        xm[k] = t0 > 0 ? (unsigned)xp[-1] : 0u; xn[k] = t0 + 16 < SEQ ? (unsigned)xp[16] : 0u; vm[k] = t0 > 0 ? (unsigned)vp[-1] : 0u; vn[k] = t0 + 16 < SEQ ? (unsigned)vp[16] : 0u;
      }
#pragma unroll
      for (int k = 0; k < 4; ++k) {
        const int s_ = tid + NTHR * k, b = s_ >> 8, ch = s_ & 255;
        float x[18], v[18];
        x[0] = __uint_as_float(xm[k] << 16); x[17] = __uint_as_float(xn[k] << 16); v[0] = __uint_as_float(vm[k] << 16); v[17] = __uint_as_float(vn[k] << 16);
        { const unsigned dx[8] = {xa[k].x, xa[k].y, xa[k].z, xa[k].w, xb[k].x, xb[k].y, xb[k].z, xb[k].w}, dv[8] = {va[k].x, va[k].y, va[k].z, va[k].w, vb[k].x, vb[k].y, vb[k].z, vb[k].w};
#pragma unroll
          for (int e = 0; e < 8; ++e) { x[1 + 2 * e] = __uint_as_float(dx[e] << 16); x[2 + 2 * e] = __uint_as_float(dx[e] & 0xffff0000u); v[1 + 2 * e] = __uint_as_float(dv[e] << 16); v[2 + 2 * e] = __uint_as_float(dv[e] & 0xffff0000u); } }
        float f[16];
#pragma unroll
        for (int e = 0; e < 16; ++e) { const float c1 = b1_ + w10 * x[e] + w11 * x[e + 1] + w12 * x[e + 2], c2 = b2_ + w20 * v[e] + w21 * v[e + 1] + w22 * v[e + 2];
          f[e] = fminf(fmaxf(c1 * c2 * 4.f, -448.f), 448.f); }
        v4u o; o.x = pg8::pack4_fp8(f[0], f[1], f[2], f[3]); o.y = pg8::pack4_fp8(f[4], f[5], f[6], f[7]); o.z = pg8::pack4_fp8(f[8], f[9], f[10], f[11]); o.w = pg8::pack4_fp8(f[12], f[13], f[14], f[15]);
        *(LAS v4u*)(lds + lc8_zslot((ch >> 1) + 4, ch & 1, b)) = o;
        __builtin_amdgcn_sched_barrier(0);
      }
    }
    f32x16_t acc[4];
#pragma unroll
    for (int tau = 0; tau < 4; ++tau)
#pragma unroll
      for (int r = 0; r < 16; ++r) acc[tau][r] = 0.f;
    const unsigned char* krc = KR8 + (size_t)c * 8192;
#pragma unroll 1
    for (int pass = 0; pass < 2; ++pass) {
      __syncthreads();
      for (int a = tid; a < 263; a += NTHR) {
        const int cl = a + (pass ? 255 : -3);
        const v4u lo = (cl >= 0 && cl < 512) ? *(const v4u*)(krc + (size_t)cl * 16) : (v4u){0u, 0u, 0u, 0u};
        const v4u hi = (cl >= -1 && cl < 511) ? *(const v4u*)(krc + (size_t)(cl + 1) * 16) : (v4u){0u, 0u, 0u, 0u};
        const unsigned d[8] = {lo.x, lo.y, lo.z, lo.w, hi.x, hi.y, hi.z, hi.w};
#pragma unroll
        for (int rh = 0; rh < 16; ++rh) {
          const int o_ = 16 - rh, j0 = o_ >> 2, sh = o_ & 3;
          v4u o;
          if (sh == 0) { o.x = d[j0]; o.y = d[j0 + 1]; o.z = d[j0 + 2]; o.w = d[j0 + 3]; }
          else { o.x = __builtin_amdgcn_alignbyte(d[j0 + 1], d[j0], sh); o.y = __builtin_amdgcn_alignbyte(d[j0 + 2], d[j0 + 1], sh);
                 o.z = __builtin_amdgcn_alignbyte(d[j0 + 3], d[j0 + 2], sh); o.w = __builtin_amdgcn_alignbyte(d[(j0 + 4) & 7], d[j0 + 3], sh); }
          *(LAS v4u*)(lds + LC8_ZB + rh * LC8_FS + a * 16) = o;
        }
      }
      __syncthreads();
      const int Dlo = pass ? -128 : 0, Dhi = pass ? -2 : 128, Ca = pass ? 0 : 258;
      const unsigned fbaseu = (unsigned)(LC8_ZB + rho * LC8_FS + (2 * half - sigma + Ca) * 16);
      const unsigned zfragu = (unsigned)LC8_ZF;
      lc_v8i P, Q, R, S, Bf;
#define LC_LDA(X, PTR, D_) do { const unsigned fa_ = ((D_) >= Dlo && (D_) <= Dhi) ? (PTR) : zfragu; X = lc_cat(*(const LAS lc_v4i*)(lds + fa_), *(const LAS lc_v4i*)(lds + fa_ + 16)); } while (0)
#define LC_MMA(A_, C_) C_ = __builtin_amdgcn_mfma_scale_f32_32x32x64_f8f6f4(A_, Bf, C_, 0, 0, 0, 0x7f7f7f7f, 0, 0x7f7f7f7f)
#define LC_STEP(DOL, DOH, T0, T1, T2, T3) do { \
        if (DOL) LC_LDA(T0, pl_, IL - J0); if (DOH) LC_LDA(T2, ph_, IH - J0); \
        Bf = lc_cat(*(const LAS lc_v4i*)(lds + pb_), *(const LAS lc_v4i*)(lds + pb_ + 256)); \
        if (DOL) { LC_MMA(T0, acc[0]); LC_MMA(T1, acc[1]); } \
        if (DOH) { LC_MMA(T2, acc[2]); LC_MMA(T3, acc[3]); } \
        J0 += 4; pl_ += 128u; ph_ += 128u; pb_ += 1024u; } while (0)
#define LC_RUN(DOL, DOH, JLO, JHI) do { \
        int J0 = (JLO) + (((r - (JLO)) % 4) + 4) % 4; const int jhi_ = (JHI); \
        unsigned pl_ = fbaseu + (unsigned)(32 * (J0 - IL)), ph_ = fbaseu + (unsigned)(32 * (J0 - IH)), pb_ = lc8_zslot(J0 + q + half + 4, 0, bb); \
        asm volatile("" : "+v"(pl_), "+v"(ph_), "+v"(pb_)); \
        if (DOL) LC_LDA(Q, pl_ - 128u, IL + 4 - J0); if (DOH) LC_LDA(S, ph_ - 128u, IH + 4 - J0); \
        _Pragma("unroll 1") while (J0 <= jhi_) { \
          LC_STEP(DOL, DOH, P, Q, R, S); if (J0 > jhi_) break; \
          LC_STEP(DOL, DOH, Q, P, S, R); } } while (0)
#pragma unroll 1
      for (int r = 0; r < 4; r += 2) {
        if (pass == 0) {
          LC_RUN(1, 1, -4, IL + 4);
          LC_RUN(0, 1, IL + 5, IH + 4);
        } else {
          LC_RUN(1, 0, IL + 1, IH);
          LC_RUN(1, 1, IH + 1, 126);
        }
      }
#undef LC_RUN
#undef LC_LDA
#undef LC_MMA
#undef LC_STEP
    }
    __syncthreads();
#pragma unroll
    for (int tau = 0; tau < 4; ++tau)
#pragma unroll
      for (int g = 0; g < 4; ++g) {
        const int t = 32 * ((tau < 2 ? IL : IH) + 4 * (tau & 1) + q) + 8 * g + 4 * half;
        v2u w; w.x = pk2(acc[tau][4 * g] * (1.f / 128.f), acc[tau][4 * g + 1] * (1.f / 128.f)); w.y = pk2(acc[tau][4 * g + 2] * (1.f / 128.f), acc[tau][4 * g + 3] * (1.f / 128.f));
        *(LAS v2u*)(lds + bb * 8208 + t * 2) = w;
      }
    {
      const float w0 = cw[c], w1 = cw[3072 + c], w2 = cw[6144 + c], b0_ = cb[c];
      const bf16* x0r = UT + (size_t)c * NTOK;
      v4u xg[8]; unsigned xm[8], xn[8];
#pragma unroll
      for (int k = 0; k < 8; ++k) {
        const int s_ = tid + NTHR * k, b = s_ >> 9, ch = s_ & 511, t0 = ch * 8; const bf16* xp = x0r + b * SEQ + t0;
        xg[k] = *(const v4u*)xp; xm[k] = t0 > 0 ? (unsigned)xp[-1] : 0u; xn[k] = t0 + 8 < SEQ ? (unsigned)xp[8] : 0u;
      }
      __syncthreads();
#pragma unroll
      for (int k = 0; k < 8; ++k) {
        const int s_ = tid + NTHR * k, b = s_ >> 9, ch = s_ & 511;
        const v4u yv = *(const LAS v4u*)(lds + b * 8208 + ch * 16);
        float x[10], y[8];
        x[0] = __uint_as_float(xm[k] << 16); x[9] = __uint_as_float(xn[k] << 16);
        { const unsigned dx[4] = {xg[k].x, xg[k].y, xg[k].z, xg[k].w};
#pragma unroll
          for (int e = 0; e < 4; ++e) { x[1 + 2 * e] = __uint_as_float(dx[e] << 16); x[2 + 2 * e] = __uint_as_float(dx[e] & 0xffff0000u); } }
        unpack8(yv, y);
#pragma unroll
        for (int e = 0; e < 8; ++e) y[e] *= b0_ + w0 * x[e] + w1 * x[e + 1] + w2 * x[e + 2];
        v4u o; o.x = pk2(y[0], y[1]); o.y = pk2(y[2], y[3]); o.z = pk2(y[4], y[5]); o.w = pk2(y[6], y[7]);
        *(v4u*)(ycT + ((size_t)c * NB + b) * SEQ + ch * 8) = o;
      }
    }
  }
}

__device__ __forceinline__ void mla_prep_phase(int tid_in, const bf16* A, const int* pos, const float* qg, const float* kvg, bf16* CQN, bf16* CKVN, bf16* KPE, unsigned char* KPE8, const float* ROPE) {
  const int tid = launder(tid_in), wave = __builtin_amdgcn_readfirstlane(tid >> 6), lane = tid & 63;
  for (int row4 = (bid() * 8 + wave) * 4; row4 < NTOK; row4 += GRID * 8 * 4) {
    v4u raw[4];
#pragma unroll
    for (int rr = 0; rr < 4; ++rr) raw[rr] = *(const v4u*)(A + (size_t)(row4 + rr) * 512 + lane * 8);
#pragma unroll
    for (int rr = 0; rr < 4; ++rr) {
    const int row = row4 + rr;
    float v[8];
    unpack8(raw[rr], v);
    float ss = 0.f;
#pragma unroll
    for (int k = 0; k < 8; ++k) ss += v[k] * v[k];
    const float ssq = wsum64(lane < 32 ? ss : 0.f), sskv = wsum64((lane >= 32 && lane < 48) ? ss : 0.f);
    if (lane < 32) {
      const float r = rsqrtf(ssq * (1.f / 256.f) + 1e-6f);
      const f32x4_t g0 = *(const f32x4_t*)(qg + lane * 8), g1 = *(const f32x4_t*)(qg + lane * 8 + 4);
      v4u o; o.x = pk2(v[0] * r * g0.x, v[1] * r * g0.y); o.y = pk2(v[2] * r * g0.z, v[3] * r * g0.w); o.z = pk2(v[4] * r * g1.x, v[5] * r * g1.y); o.w = pk2(v[6] * r * g1.z, v[7] * r * g1.w);
      *(v4u*)(CQN + (size_t)row * 256 + lane * 8) = o;
    } else if (lane < 48) {
      const int l = lane - 32;
      const float r = rsqrtf(sskv * (1.f / 128.f) + 1e-6f);
      const f32x4_t g0 = *(const f32x4_t*)(kvg + l * 8), g1 = *(const f32x4_t*)(kvg + l * 8 + 4);
      v4u o; o.x = pk2(v[0] * r * g0.x, v[1] * r * g0.y); o.y = pk2(v[2] * r * g0.z, v[3] * r * g0.w); o.z = pk2(v[4] * r * g1.x, v[5] * r * g1.y); o.w = pk2(v[6] * r * g1.z, v[7] * r * g1.w);
      *(v4u*)(CKVN + (size_t)row * 128 + l * 8) = o;
    } else {
      if (lane < 56) {
        const int l = lane - 48;
        const float* rp = ROPE + (size_t)row * 64 + l * 8;
        const f32x4_t r0 = *(const f32x4_t*)rp, r1 = *(const f32x4_t*)(rp + 4);
        const float cs[4] = {r0.x, r0.z, r1.x, r1.z}, sn[4] = {r0.y, r0.w, r1.y, r1.w};
        float o1[4], o2[4];
#pragma unroll
        for (int k = 0; k < 4; ++k) {
          o1[k] = v[2 * k] * cs[k] - v[2 * k + 1] * sn[k];
          o2[k] = v[2 * k] * sn[k] + v[2 * k + 1] * cs[k];
        }
        v4u o; o.x = pk2(o1[0], o2[0]); o.y = pk2(o1[1], o2[1]); o.z = pk2(o1[2], o2[2]); o.w = pk2(o1[3], o2[3]);
        *(v4u*)(KPE + (size_t)row * 64 + l * 8) = o;
        { v2u o8; o8.x = pg8::pack4_fp8(o1[0], o2[0], o1[1], o2[1]); o8.y = pg8::pack4_fp8(o1[2], o2[2], o1[3], o2[3]); *(v2u*)(KPE8 + (size_t)row * 64 + l * 8) = o8; }
      }
    }
    }
  }
}

struct EpiMlaPrep {
    static constexpr bool PERM = true, AFTER_DRAIN = true;
    const float* qg; const float* kvg; bf16* CQN; bf16* CKVN; bf16* KPE; unsigned char* KPE8; const float* ROPE;
    __device__ __forceinline__ void fused(const pg8::f32x4 (&acc)[2][2][4][2], const pg8::Unit& u, int wr, int wc, int fr, int fq, PG8_LAS unsigned char* lds, int wid, int lane) const {
        constexpr int RS = 528;
#pragma unroll
        for (int ai = 0; ai < 2; ++ai)
#pragma unroll
            for (int m = 0; m < 4; ++m) { const int rl = wr * 64 + fr + ai * pg8::HALF + m * 16;
#pragma unroll
                for (int bj = 0; bj < 2; ++bj) { const pg8::f32x4 v0 = acc[ai][bj][m][0], v1 = acc[ai][bj][m][1];
                    v4u w; w.x = pg8::cvt_pk_bf16(v0[0], v0[1]); w.y = pg8::cvt_pk_bf16(v0[2], v0[3]); w.z = pg8::cvt_pk_bf16(v1[0], v1[1]); w.w = pg8::cvt_pk_bf16(v1[2], v1[3]);
                    *(PG8_LAS v4u*)(lds + rl * RS + (wc * 32 + 8 * fq + bj * pg8::HALF) * 2) = w; } }
        __syncthreads();
        const int l = lane & 31;
#pragma unroll 1
        for (int p = 0; p < 16; ++p) {
            const int rl = wid * 32 + 2 * p + (lane >> 5); const size_t row = (size_t)u.pm * pg8::BM + rl;
            if (u.pn == 0) {
                float v[8]; unpack8(*(const PG8_LAS v4u*)(lds + rl * RS + l * 16), v);
                float ss = 0.f;
#pragma unroll
                for (int k = 0; k < 8; ++k) ss += v[k] * v[k];
                ss += swz_xor<1>(ss); ss += swz_xor<2>(ss); ss += swz_xor<4>(ss); ss += swz_xor<8>(ss); ss += swz_xor<16>(ss);
                const float r = rsqrtf(ss * (1.f / 256.f) + 1e-6f);
                const f32x4_t g0 = *(const f32x4_t*)(qg + l * 8), g1 = *(const f32x4_t*)(qg + l * 8 + 4);
                v4u o; o.x = pk2(v[0] * r * g0.x, v[1] * r * g0.y); o.y = pk2(v[2] * r * g0.z, v[3] * r * g0.w); o.z = pk2(v[4] * r * g1.x, v[5] * r * g1.y); o.w = pk2(v[6] * r * g1.z, v[7] * r * g1.w);
                *(v4u*)(CQN + row * 256 + l * 8) = o;
            } else {
                float v[8]; unpack8(*(const PG8_LAS v4u*)(lds + rl * RS + (l < 24 ? l : 0) * 16), v);
                float ss = 0.f;
#pragma unroll
                for (int k = 0; k < 8; ++k) ss += v[k] * v[k];
                ss += swz_xor<1>(ss); ss += swz_xor<2>(ss); ss += swz_xor<4>(ss); ss += swz_xor<8>(ss);
                if (l < 16) {
                    const float r = rsqrtf(ss * (1.f / 128.f) + 1e-6f);
                    const f32x4_t g0 = *(const f32x4_t*)(kvg + l * 8), g1 = *(const f32x4_t*)(kvg + l * 8 + 4);
                    v4u o; o.x = pk2(v[0] * r * g0.x, v[1] * r * g0.y); o.y = pk2(v[2] * r * g0.z, v[3] * r * g0.w); o.z = pk2(v[4] * r * g1.x, v[5] * r * g1.y); o.w = pk2(v[6] * r * g1.z, v[7] * r * g1.w);
                    *(v4u*)(CKVN + row * 128 + l * 8) = o;
                } else if (l < 24) {
                    const int lp = l - 16;
                    const float* rp = ROPE + row * 64 + lp * 8;
                    const f32x4_t r0 = *(const f32x4_t*)rp, r1 = *(const f32x4_t*)(rp + 4);
                    const float cs[4] = {r0.x, r0.z, r1.x, r1.z}, sn[4] = {r0.y, r0.w, r1.y, r1.w};
                    float o1[4], o2[4];
#pragma unroll
                    for (int k = 0; k < 4; ++k) { o1[k] = v[2 * k] * cs[k] - v[2 * k + 1] * sn[k]; o2[k] = v[2 * k] * sn[k] + v[2 * k + 1] * cs[k]; }
                    v4u o; o.x = pk2(o1[0], o2[0]); o.y = pk2(o1[1], o2[1]); o.z = pk2(o1[2], o2[2]); o.w = pk2(o1[3], o2[3]);
                    *(v4u*)(KPE + row * 64 + lp * 8) = o;
                    { v2u o8; o8.x = pg8::pack4_fp8(o1[0], o2[0], o1[1], o2[1]); o8.y = pg8::pack4_fp8(o1[2], o2[2], o1[3], o2[3]); *(v2u*)(KPE8 + row * 64 + lp * 8) = o8; }
                }
            }
        }
    }
};

namespace att {
typedef short s16x4 __attribute__((ext_vector_type(4)));
typedef unsigned u32x4_ __attribute__((ext_vector_type(4)));
constexpr int SHM_V = 64 * 128 * 2, SHM_K = 64 * 192 * 2;
constexpr float THRL = 8.f * 1.4426950408889634f;
constexpr int NQR = 12;
#define AT_KSWZ(row, colB) ((row) * 384 + ((colB) ^ (((row) & 7) << 4)))
#define AT_SBAR() __builtin_amdgcn_sched_barrier(0)
__device__ __forceinline__ int crow(int r, int hi) { return (r & 3) + 8 * (r >> 2) + 4 * hi; }
__device__ __forceinline__ unsigned cvtpk(float lo, float hi) { unsigned r; asm volatile("v_cvt_pk_bf16_f32 %0, %1, %2" : "=v"(r) : "v"(lo), "v"(hi)); return r; }
__device__ __forceinline__ void partialSM(f32x16_t& p0, f32x16_t& p1, float& m_reg, float& mn, float& alpha) {
  float pmax = p0[0];
#pragma unroll
  for (int r = 1; r < 16; ++r) pmax = fmaxf(pmax, p0[r]);
#pragma unroll
  for (int r = 0; r < 16; ++r) pmax = fmaxf(pmax, p1[r]);
  { auto rr = __builtin_amdgcn_permlane32_swap(__float_as_uint(pmax), __float_as_uint(pmax), false, false);
    pmax = fmaxf(__uint_as_float(rr[0]), __uint_as_float(rr[1])); }
  if (__builtin_expect(__all(pmax - m_reg <= THRL), 1)) { mn = m_reg; alpha = 1.f; }
  else { mn = fmaxf(m_reg, pmax); alpha = __builtin_amdgcn_exp2f(m_reg - mn); m_reg = mn; }
#pragma unroll
  for (int r = 0; r < 16; ++r) p0[r] = p0[r] - mn;
#pragma unroll
  for (int r = 0; r < 16; ++r) p1[r] = p1[r] - mn;
#pragma unroll
  for (int r = 0; r < 16; ++r) p0[r] = __builtin_amdgcn_exp2f(p0[r]);
}
__device__ __forceinline__ void finishSM(f32x16_t& p0, f32x16_t& p1, float alpha, float& l_reg, bf16x8_t& pa0, bf16x8_t& pa1, bf16x8_t& pa2, bf16x8_t& pa3) {
#pragma unroll
  for (int r = 0; r < 16; ++r) p1[r] = __builtin_amdgcn_exp2f(p1[r]);
  float ps = 0;
#pragma unroll
  for (int r = 0; r < 16; ++r) ps += p0[r];
#pragma unroll
  for (int r = 0; r < 16; ++r) ps += p1[r];
  { auto rr = __builtin_amdgcn_permlane32_swap(__float_as_uint(ps), __float_as_uint(ps), false, false);
    ps = __uint_as_float(rr[0]) + __uint_as_float(rr[1]); }
  l_reg = l_reg * alpha + ps;
#define AT_PK4(P, BASE, OUT) do { unsigned a0 = cvtpk(P[BASE + 0], P[BASE + 1]), a1 = cvtpk(P[BASE + 2], P[BASE + 3]);   \
    unsigned b0 = cvtpk(P[BASE + 4], P[BASE + 5]), b1 = cvtpk(P[BASE + 6], P[BASE + 7]);                              \
    auto r0 = __builtin_amdgcn_permlane32_swap(a0, b0, false, false); auto r1 = __builtin_amdgcn_permlane32_swap(a1, b1, false, false); \
    u32x4_ w = {r0[0], r1[0], r0[1], r1[1]}; OUT = __builtin_bit_cast(bf16x8_t, w); } while (0)
  AT_PK4(p0, 0, pa0); AT_PK4(p0, 8, pa1); AT_PK4(p1, 0, pa2); AT_PK4(p1, 8, pa3);
#undef AT_PK4
}
__device__ __forceinline__ void qkt(f32x16_t& p0, f32x16_t& p1, const LAS char* Ks, const bf16x8_t* qr, const LAS char* qpe, int r32, int hi) {
#pragma unroll
  for (int r = 0; r < 16; ++r) { p0[r] = 0.f; p1[r] = 0.f; }
#pragma unroll
  for (int d0 = 0; d0 < 12; ++d0) { const int cb = (d0 * 16 + hi * 8) * 2;
    const bf16x8_t b0 = *(const LAS bf16x8_t*)(Ks + AT_KSWZ(r32, cb));
    const bf16x8_t b1 = *(const LAS bf16x8_t*)(Ks + AT_KSWZ(32 + r32, cb));
    const bf16x8_t qf = d0 < NQR ? qr[d0 < NQR ? d0 : 0] : *(const LAS bf16x8_t*)(qpe + (d0 - NQR) * 1024);
    p0 = __builtin_amdgcn_mfma_f32_32x32x16_bf16(b0, qf, p0, 0, 0, 0);
    p1 = __builtin_amdgcn_mfma_f32_32x32x16_bf16(b1, qf, p1, 0, 0, 0);
    if ((d0 & 3) == 3) AT_SBAR(); }
}
__device__ __forceinline__ int v_st(int k, int c) { const int kk = (k & ~0xC) | ((k & 4) << 1) | ((k & 8) >> 1); return ((kk >> 3) * 4 + (c >> 5)) * 512 + ((kk & 7) * 32 + (c & 31)) * 2; }
__device__ __forceinline__ int v_rd_base(int lane) { return ((lane & 3) << 3) | (((lane >> 2) & 3) << 6) | (((lane >> 4) & 1) << 5) | (((lane >> 5) & 1) << 8); }
constexpr int v_rd_off(int d0, int ks, int half) { return d0 * 512 + ks * 4096 + half * 2048; }
template <int OFF> __device__ __forceinline__ s16x4 tr_read(int vb) {
  s16x4 r; asm volatile("ds_read_b64_tr_b16 %0, %1 offset:%2" : "=&v"(r) : "v"(vb), "i"(OFF) : "memory"); return r;
}
template <int D0> __device__ __forceinline__ void pv_one(f32x16_t& od, int vb, bf16x8_t pa0, bf16x8_t pa1, bf16x8_t pa2, bf16x8_t pa3) {
  const s16x4 l0 = tr_read<v_rd_off(D0, 0, 0)>(vb), h0 = tr_read<v_rd_off(D0, 0, 1)>(vb), l1 = tr_read<v_rd_off(D0, 1, 0)>(vb), h1 = tr_read<v_rd_off(D0, 1, 1)>(vb);
  const s16x4 l2 = tr_read<v_rd_off(D0, 2, 0)>(vb), h2 = tr_read<v_rd_off(D0, 2, 1)>(vb), l3 = tr_read<v_rd_off(D0, 3, 0)>(vb), h3 = tr_read<v_rd_off(D0, 3, 1)>(vb);
  asm volatile("s_waitcnt lgkmcnt(0)" ::: "memory"); AT_SBAR();
#define AT_PK(L, H) (bf16x8_t){L[0], L[1], L[2], L[3], H[0], H[1], H[2], H[3]}
  od = __builtin_amdgcn_mfma_f32_32x32x16_bf16(pa0, AT_PK(l0, h0), od, 0, 0, 0);
  od = __builtin_amdgcn_mfma_f32_32x32x16_bf16(pa1, AT_PK(l1, h1), od, 0, 0, 0);
  od = __builtin_amdgcn_mfma_f32_32x32x16_bf16(pa2, AT_PK(l2, h2), od, 0, 0, 0);
  od = __builtin_amdgcn_mfma_f32_32x32x16_bf16(pa3, AT_PK(l3, h3), od, 0, 0, 0);
#undef AT_PK
}
__device__ __forceinline__ void pv_d0(f32x16_t* o, int vb, bf16x8_t pa0, bf16x8_t pa1, bf16x8_t pa2, bf16x8_t pa3) {
  pv_one<0>(o[0], vb, pa0, pa1, pa2, pa3); pv_one<1>(o[1], vb, pa0, pa1, pa2, pa3); pv_one<2>(o[2], vb, pa0, pa1, pa2, pa3); pv_one<3>(o[3], vb, pa0, pa1, pa2, pa3);
}
__device__ __forceinline__ void attn_unit(int tid, const bf16* __restrict__ Qb, const bf16* __restrict__ Kn, const bf16* __restrict__ Kp, const bf16* __restrict__ Vh,
                                          bf16* __restrict__ Ob, LAS char* lds) {
  (void)Vh;
  const int wid = tid >> 6, lane = tid & 63, r32 = lane & 31, hi = lane >> 5;
  LAS char* V_lds = lds; LAS char* K_lds = lds + 2 * SHM_V;
  LAS float* wsx = (LAS float*)(lds + 2 * SHM_V + 2 * SHM_K) + wid * 64; LAS float* li_l = wsx; LAS float* al_l = wsx + 32;
  float m_reg = -1e30f, l_reg = 0;
  f32x16_t o[4];
#pragma unroll
  for (int d = 0; d < 4; ++d)
#pragma unroll
    for (int r = 0; r < 16; ++r) o[d][r] = 0.f;
  bf16x8_t qr[NQR];
  LAS char* qpe = lds + 2 * SHM_V + 2 * SHM_K + 2048 + wid * ((12 - NQR) * 1024) + lane * 16;
  const unsigned qoff = (unsigned)((wid * 32 + r32) * 1536 + hi * 8);
#pragma unroll
  for (int d0 = 0; d0 < NQR; ++d0) qr[d0] = *(const bf16x8_t*)(Qb + (qoff + (unsigned)(d0 * 16)));
#pragma unroll
  for (int d0 = NQR; d0 < 12; ++d0) *(LAS bf16x8_t*)(qpe + (d0 - NQR) * 1024) = *(const bf16x8_t*)(Qb + (qoff + (unsigned)(d0 * 16)));
  const int sr = tid >> 4, sc = (tid & 15) * 8, vst0 = v_st(sr, sc), vst1 = v_st(32 + sr, sc);
  const int rk = tid >> 3, ck = (tid & 7) * 8;
  const int vb0 = (int)(unsigned)(size_t)V_lds + v_rd_base(lane);
  bf16x8_t vs0, vs1, ks0, ks1, kp0;
  const unsigned okv = (unsigned)(sr * 2048 + sc), okp = (unsigned)(rk * 64 + ck);
#define AT_SLOAD(k0) do { const unsigned t0_ = (unsigned)(k0) * 2048u + okv, t1_ = t0_ + 32u * 2048u; \
    ks0 = *(const bf16x8_t*)(Kn + t0_); vs0 = *(const bf16x8_t*)(Kn + t0_ + 128u); ks1 = *(const bf16x8_t*)(Kn + t1_); vs1 = *(const bf16x8_t*)(Kn + t1_ + 128u); \
    kp0 = *(const bf16x8_t*)(Kp + (unsigned)(k0) * 64u + okp); } while (0)
#define AT_SWRITE(b) do { *(LAS bf16x8_t*)(V_lds + (b) * SHM_V + vst0) = vs0; *(LAS bf16x8_t*)(V_lds + (b) * SHM_V + vst1) = vs1; \
    *(LAS bf16x8_t*)(K_lds + (b) * SHM_K + AT_KSWZ(sr, sc * 2)) = ks0; *(LAS bf16x8_t*)(K_lds + (b) * SHM_K + AT_KSWZ(32 + sr, sc * 2)) = ks1; \
    *(LAS bf16x8_t*)(K_lds + (b) * SHM_K + AT_KSWZ(rk, 256 + ck * 2)) = kp0; } while (0)
#define AT_SWAIT() asm volatile("s_waitcnt vmcnt(0)" ::: "memory")
#define AT_RESC(a) do { if (__any((a) < 1.f)) { if (hi == 0) al_l[r32] = (a); asm volatile("s_waitcnt lgkmcnt(0)" ::: "memory"); \
    _Pragma("unroll") for (int d = 0; d < 4; ++d) _Pragma("unroll") for (int r = 0; r < 16; ++r) o[d][r] *= al_l[crow(r, hi)]; } } while (0)
  f32x16_t pA0, pA1, pB0, pB1; float mnA, mnB, alA, alB; bf16x8_t pa0, pa1, pa2, pa3; constexpr int NT = SEQ / 64;
  AT_SLOAD(0); AT_SWAIT(); AT_SWRITE(0); __syncthreads();
  qkt(pA0, pA1, K_lds, qr, qpe, r32, hi); partialSM(pA0, pA1, m_reg, mnA, alA);
  AT_SLOAD(64);
  AT_SWAIT(); AT_SWRITE(1); __syncthreads();
  for (int j = 1; j + 1 < NT; j += 2) {
    AT_SBAR(); AT_SLOAD((j + 1) * 64); AT_SBAR();
    qkt(pB0, pB1, K_lds + SHM_K, qr, qpe, r32, hi);
    finishSM(pA0, pA1, alA, l_reg, pa0, pa1, pa2, pa3); AT_SBAR();
    pv_d0(o, vb0, pa0, pa1, pa2, pa3); partialSM(pB0, pB1, m_reg, mnB, alB);
    __syncthreads(); AT_SWAIT(); AT_SWRITE(0);
    AT_RESC(alB); __syncthreads();
    AT_SBAR(); AT_SLOAD((j + 2) * 64); AT_SBAR();
    qkt(pA0, pA1, K_lds, qr, qpe, r32, hi);
    finishSM(pB0, pB1, alB, l_reg, pa0, pa1, pa2, pa3); AT_SBAR();
    pv_d0(o, vb0 + SHM_V, pa0, pa1, pa2, pa3); partialSM(pA0, pA1, m_reg, mnA, alA);
    __syncthreads(); AT_SWAIT(); AT_SWRITE(1);
    AT_RESC(alA); __syncthreads();
  }
  AT_SBAR(); qkt(pB0, pB1, K_lds + SHM_K, qr, qpe, r32, hi);
  finishSM(pA0, pA1, alA, l_reg, pa0, pa1, pa2, pa3); AT_SBAR();
  pv_d0(o, vb0, pa0, pa1, pa2, pa3); partialSM(pB0, pB1, m_reg, mnB, alB);
  __syncthreads(); AT_RESC(alB);
  finishSM(pB0, pB1, alB, l_reg, pa0, pa1, pa2, pa3); AT_SBAR();
  pv_d0(o, vb0 + SHM_V, pa0, pa1, pa2, pa3);
  if (hi == 0) li_l[r32] = l_reg;
  asm volatile("s_waitcnt lgkmcnt(0)" ::: "memory");
  float rli[16];
#pragma unroll
  for (int r = 0; r < 16; ++r) rli[r] = __builtin_amdgcn_rcpf(li_l[crow(r, hi)]);
  bf16* Ow = Ob + (size_t)(wid * 32) * 1024 + (hi * 4) * 1024 + r32;
#pragma unroll
  for (int r = 0; r < 16; ++r) {
#pragma unroll
    for (int d0 = 0; d0 < 4; ++d0) Ow[((r & 3) + 8 * (r >> 2)) * 1024 + d0 * 32] = (bf16)f2bf(o[d0][r] * rli[r]); }
#undef AT_SLOAD
#undef AT_SWRITE
#undef AT_SWAIT
#undef AT_RESC
}

constexpr int DK0 = 0, DV0 = 2 * SHM_K, DWS = DV0 + 3 * SHM_V, DQ = DWS + 2048;
__device__ __forceinline__ void glds16(const void* gsrc, unsigned lds_dst) { unsigned keep;
  asm volatile("s_mov_b32 %0, m0\n\ts_mov_b32 m0, %2\n\ts_nop 0\n\tglobal_load_lds_dwordx4 %1, off\n\ts_mov_b32 m0, %0" : "=&s"(keep) : "v"(gsrc), "s"(lds_dst) : "memory"); }
#define AT_VMWAIT() asm volatile("s_waitcnt vmcnt(0)" ::: "memory")
__device__ __forceinline__ void attn_unit_dma(int tid, const bf16* __restrict__ Qb, const bf16* __restrict__ Kn, const bf16* __restrict__ Kp, bf16* __restrict__ Ob, LAS char* lds) {
  const int wid = __builtin_amdgcn_readfirstlane(tid >> 6), lane = tid & 63, r32 = lane & 31, hi = lane >> 5;
  LAS char* K_lds = lds + DK0; LAS char* V_lds = lds + DV0;
  LAS float* wsx = (LAS float*)(lds + DWS) + wid * 64; LAS float* li_l = wsx; LAS float* al_l = wsx + 32;
  float m_reg = -1e30f, l_reg = 0;
  f32x16_t o[4];
#pragma unroll
  for (int d = 0; d < 4; ++d)
#pragma unroll
    for (int r = 0; r < 16; ++r) o[d][r] = 0.f;
  bf16x8_t qr[NQR];
  LAS char* qpe = lds + DQ + wid * ((12 - NQR) * 1024) + lane * 16;
  const unsigned qoff = (unsigned)((wid * 32 + r32) * 1536 + hi * 8);
#pragma unroll
  for (int d0 = 0; d0 < NQR; ++d0) qr[d0] = *(const bf16x8_t*)(Qb + (qoff + (unsigned)(d0 * 16)));
#pragma unroll
  for (int d0 = NQR; d0 < 12; ++d0) *(LAS bf16x8_t*)(qpe + (d0 - NQR) * 1024) = *(const bf16x8_t*)(Qb + (qoff + (unsigned)(d0 * 16)));
  unsigned ksrc[3]; bool kpe[3]; unsigned vsrc[2];
#pragma unroll
  for (int i = 0; i < 3; ++i) { const int p = (3 * wid + i) * 64 + lane, row = p / 24, chp = p - row * 24, c = chp ^ (row & 7);
    kpe[i] = c >= 16; ksrc[i] = kpe[i] ? (unsigned)(row * 64 + (c - 16) * 8) : (unsigned)(row * 2048 + c * 8); }
#pragma unroll
  for (int i = 0; i < 2; ++i) { const int p = (2 * wid + i) * 64 + lane, sub = p >> 5, kk = (sub >> 2) * 8 + ((p >> 2) & 7), c = (sub & 3) * 32 + (p & 3) * 8;
    const int k = (kk & ~0xC) | ((kk & 4) << 1) | ((kk & 8) >> 1);
    vsrc[i] = (unsigned)(k * 2048 + c + 128); }
  const unsigned ldsb = (unsigned)(size_t)lds;
  const unsigned kdst = ldsb + DK0 + (unsigned)(3 * wid) * 1024u, vdst = ldsb + DV0 + (unsigned)(2 * wid) * 1024u;
#define AT_DMA(k0, ks, vs) do { const unsigned tk_ = (unsigned)(k0) * 2048u, tp_ = (unsigned)(k0) * 64u; \
    _Pragma("unroll") for (int i_ = 0; i_ < 3; ++i_) glds16(kpe[i_] ? (const void*)(Kp + (tp_ + ksrc[i_])) : (const void*)(Kn + (tk_ + ksrc[i_])), kdst + (unsigned)(ks) * SHM_K + i_ * 1024u); \
    _Pragma("unroll") for (int i_ = 0; i_ < 2; ++i_) glds16((const void*)(Kn + (tk_ + vsrc[i_])), vdst + (unsigned)(vs) * SHM_V + i_ * 1024u); } while (0)
#define AT_RESC(a) do { if (__any((a) < 1.f)) { if (hi == 0) al_l[r32] = (a); asm volatile("s_waitcnt lgkmcnt(0)" ::: "memory"); \
    _Pragma("unroll") for (int d = 0; d < 4; ++d) _Pragma("unroll") for (int r = 0; r < 16; ++r) o[d][r] *= al_l[crow(r, hi)]; } } while (0)
  const int vbb = (int)(ldsb + DV0) + v_rd_base(lane);
  f32x16_t pA0, pA1, pB0, pB1; float mnA, mnB, alA, alB; bf16x8_t pa0, pa1, pa2, pa3; constexpr int NT = SEQ / 64;
  AT_DMA(0, 0, 0); AT_VMWAIT(); __syncthreads();
  AT_DMA(64, 1, 1);
  qkt(pA0, pA1, K_lds, qr, qpe, r32, hi); partialSM(pA0, pA1, m_reg, mnA, alA);
  AT_VMWAIT(); __syncthreads();
  int vprev = 0;
#pragma unroll 1
  for (int j = 1; j + 1 < NT; j += 2) {
    const int v1 = vprev == 2 ? 0 : vprev + 1, v2 = v1 == 2 ? 0 : v1 + 1, v3 = v2 == 2 ? 0 : v2 + 1;
    AT_DMA((j + 1) * 64, 0, v2);
    AT_SBAR(); qkt(pB0, pB1, K_lds + SHM_K, qr, qpe, r32, hi);
    finishSM(pA0, pA1, alA, l_reg, pa0, pa1, pa2, pa3); AT_SBAR();
    pv_d0(o, vbb + vprev * SHM_V, pa0, pa1, pa2, pa3); partialSM(pB0, pB1, m_reg, mnB, alB);
    AT_RESC(alB);
    AT_VMWAIT(); __syncthreads();
    AT_DMA((j + 2) * 64, 1, v3);
    AT_SBAR(); qkt(pA0, pA1, K_lds, qr, qpe, r32, hi);
    finishSM(pB0, pB1, alB, l_reg, pa0, pa1, pa2, pa3); AT_SBAR();
    pv_d0(o, vbb + v1 * SHM_V, pa0, pa1, pa2, pa3); partialSM(pA0, pA1, m_reg, mnA, alA);
    AT_RESC(alA);
    AT_VMWAIT(); __syncthreads();
    vprev = v2;
  }
  {
    const int v1 = vprev == 2 ? 0 : vprev + 1;
    AT_SBAR(); qkt(pB0, pB1, K_lds + SHM_K, qr, qpe, r32, hi);
    finishSM(pA0, pA1, alA, l_reg, pa0, pa1, pa2, pa3); AT_SBAR();
    pv_d0(o, vbb + vprev * SHM_V, pa0, pa1, pa2, pa3); partialSM(pB0, pB1, m_reg, mnB, alB);
    AT_RESC(alB);
    finishSM(pB0, pB1, alB, l_reg, pa0, pa1, pa2, pa3); AT_SBAR();
    pv_d0(o, vbb + v1 * SHM_V, pa0, pa1, pa2, pa3);
  }
  if (hi == 0) li_l[r32] = l_reg;
  asm volatile("s_waitcnt lgkmcnt(0)" ::: "memory");
  float rli[16];
#pragma unroll
  for (int r = 0; r < 16; ++r) rli[r] = __builtin_amdgcn_rcpf(li_l[crow(r, hi)]);
  bf16* Ow = Ob + (size_t)(wid * 32) * 1024 + (hi * 4) * 1024 + r32;
#pragma unroll
  for (int r = 0; r < 16; ++r) {
#pragma unroll
    for (int d0 = 0; d0 < 4; ++d0) Ow[((r & 3) + 8 * (r >> 2)) * 1024 + d0 * 32] = (bf16)f2bf(o[d0][r] * rli[r]); }
#undef AT_DMA
#undef AT_RESC
}

constexpr int SHM_K8 = 64 * 192;
constexpr int EK0 = 0, EV0 = 2 * SHM_K8, EWS = EV0 + 3 * SHM_V;
typedef int v8i32a_t __attribute__((ext_vector_type(8)));
typedef int v4i32a_t __attribute__((ext_vector_type(4)));
__device__ __forceinline__ v8i32a_t cat8a(v4i32a_t a, v4i32a_t b) { return __builtin_shufflevector(a, b, 0, 1, 2, 3, 4, 5, 6, 7); }
__device__ __forceinline__ void qkt8(f32x16_t& p0, f32x16_t& p1, const LAS char* Ks, const v8i32a_t* q8, int r32, int hi) {
#pragma unroll
  for (int r = 0; r < 16; ++r) { p0[r] = 0.f; p1[r] = 0.f; }
  const int f0 = (r32 >> 2) & 3;
#pragma unroll
  for (int ks = 0; ks < 3; ++ks) {
    const int L0 = 4 * ks + 2 * hi;
    const LAS char* ra = Ks + r32 * 192; const LAS char* rb = Ks + (32 + r32) * 192;
    const v8i32a_t ka = cat8a(*(const LAS v4i32a_t*)(ra + ((L0 ^ f0) << 4)), *(const LAS v4i32a_t*)(ra + (((L0 + 1) ^ f0) << 4)));
    const v8i32a_t kb = cat8a(*(const LAS v4i32a_t*)(rb + ((L0 ^ f0) << 4)), *(const LAS v4i32a_t*)(rb + (((L0 + 1) ^ f0) << 4)));
    p0 = __builtin_amdgcn_mfma_scale_f32_32x32x64_f8f6f4(ka, q8[ks], p0, 0, 0, 0, 0x7f7f7f7f, 0, 0x7f7f7f7f);
    p1 = __builtin_amdgcn_mfma_scale_f32_32x32x64_f8f6f4(kb, q8[ks], p1, 0, 0, 0, 0x7f7f7f7f, 0, 0x7f7f7f7f);
  }
}
__device__ __forceinline__ void attn_unit_dma8(int tid, const unsigned char* __restrict__ Q8, const unsigned char* __restrict__ K8, const unsigned char* __restrict__ Kp8,
                                               const bf16* __restrict__ Vb, bf16* __restrict__ Ob, LAS char* lds) {
  const int wid = __builtin_amdgcn_readfirstlane(tid >> 6), lane = tid & 63, r32 = lane & 31, hi = lane >> 5;
  LAS char* K_lds = lds + EK0;
  LAS float* wsx = (LAS float*)(lds + EWS) + wid * 64; LAS float* li_l = wsx; LAS float* al_l = wsx + 32;
  float m_reg = -1e30f, l_reg = 0;
  f32x16_t o[4];
#pragma unroll
  for (int d = 0; d < 4; ++d)
#pragma unroll
    for (int r = 0; r < 16; ++r) o[d][r] = 0.f;
  v8i32a_t q8[3];
  { const unsigned qoff = (unsigned)((wid * 32 + r32) * 1536 + hi * 32);
#pragma unroll
    for (int ks = 0; ks < 3; ++ks) q8[ks] = cat8a(*(const v4i32a_t*)(Q8 + qoff + ks * 64), *(const v4i32a_t*)(Q8 + qoff + ks * 64 + 16)); }
  unsigned ksrc[2]; bool kpe[2]; unsigned vsrc[2];
#pragma unroll
  for (int i = 0; i < 2; ++i) { const int p = (8 * i + wid) * 64 + lane, row = p / 12, chp = p - row * 12, c = chp ^ ((row >> 2) & 3);
    kpe[i] = c >= 8; ksrc[i] = kpe[i] ? (unsigned)(row * 64 + (c - 8) * 16) : (unsigned)(row * 1024 + c * 16); }
#pragma unroll
  for (int i = 0; i < 2; ++i) { const int p = (2 * wid + i) * 64 + lane, sub = p >> 5, kk = (sub >> 2) * 8 + ((p >> 2) & 7), c = (sub & 3) * 32 + (p & 3) * 8;
    const int k = (kk & ~0xC) | ((kk & 4) << 1) | ((kk & 8) >> 1);
    vsrc[i] = (unsigned)(k * 2048 + c); }
  const unsigned ldsb = (unsigned)(size_t)lds;
  const unsigned kdst = ldsb + EK0 + (unsigned)wid * 1024u, vdst = ldsb + EV0 + (unsigned)(2 * wid) * 1024u;
#define AT_DMA8(k0, ks, vs) do { const unsigned tk_ = (unsigned)(k0) * 1024u, tp_ = (unsigned)(k0) * 64u, tv_ = (unsigned)(k0) * 2048u; \
    glds16(kpe[0] ? (const void*)(Kp8 + (tp_ + ksrc[0])) : (const void*)(K8 + (tk_ + ksrc[0])), kdst + (unsigned)(ks) * SHM_K8); \
    if (wid < 4) glds16(kpe[1] ? (const void*)(Kp8 + (tp_ + ksrc[1])) : (const void*)(K8 + (tk_ + ksrc[1])), kdst + (unsigned)(ks) * SHM_K8 + 8192u); \
    _Pragma("unroll") for (int i_ = 0; i_ < 2; ++i_) glds16((const void*)(Vb + (tv_ + vsrc[i_])), vdst + (unsigned)(vs) * SHM_V + i_ * 1024u); } while (0)
#define AT_RESC(a) do { if (__any((a) < 1.f)) { if (hi == 0) al_l[r32] = (a); asm volatile("s_waitcnt lgkmcnt(0)" ::: "memory"); \
    _Pragma("unroll") for (int d = 0; d < 4; ++d) _Pragma("unroll") for (int r = 0; r < 16; ++r) o[d][r] *= al_l[crow(r, hi)]; } } while (0)
  const int vbb = (int)(ldsb + EV0) + v_rd_base(lane);
  f32x16_t pA0, pA1, pB0, pB1; float mnA, mnB, alA, alB; bf16x8_t pa0, pa1, pa2, pa3; constexpr int NT = SEQ / 64;
  AT_DMA8(0, 0, 0); AT_VMWAIT(); __syncthreads();
  AT_DMA8(64, 1, 1);
  qkt8(pA0, pA1, K_lds, q8, r32, hi); partialSM(pA0, pA1, m_reg, mnA, alA);
  AT_VMWAIT(); __syncthreads();
  int vprev = 0;
#pragma unroll 1
  for (int j = 1; j + 1 < NT; j += 2) {
    const int v1 = vprev == 2 ? 0 : vprev + 1, v2 = v1 == 2 ? 0 : v1 + 1, v3 = v2 == 2 ? 0 : v2 + 1;
    AT_DMA8((j + 1) * 64, 0, v2);
    AT_SBAR(); qkt8(pB0, pB1, K_lds + SHM_K8, q8, r32, hi);
    finishSM(pA0, pA1, alA, l_reg, pa0, pa1, pa2, pa3); AT_SBAR();
    pv_d0(o, vbb + vprev * SHM_V, pa0, pa1, pa2, pa3); partialSM(pB0, pB1, m_reg, mnB, alB);
    AT_RESC(alB);
    AT_VMWAIT(); __syncthreads();
    AT_DMA8((j + 2) * 64, 1, v3);
    AT_SBAR(); qkt8(pA0, pA1, K_lds, q8, r32, hi);
    finishSM(pB0, pB1, alB, l_reg, pa0, pa1, pa2, pa3); AT_SBAR();
    pv_d0(o, vbb + v1 * SHM_V, pa0, pa1, pa2, pa3); partialSM(pA0, pA1, m_reg, mnA, alA);
    AT_RESC(alA);
    AT_VMWAIT(); __syncthreads();
    vprev = v2;
  }
  {
    const int v1 = vprev == 2 ? 0 : vprev + 1;
    AT_SBAR(); qkt8(pB0, pB1, K_lds + SHM_K8, q8, r32, hi);
    finishSM(pA0, pA1, alA, l_reg, pa0, pa1, pa2, pa3); AT_SBAR();
    pv_d0(o, vbb + vprev * SHM_V, pa0, pa1, pa2, pa3); partialSM(pB0, pB1, m_reg, mnB, alB);
    AT_RESC(alB);
    finishSM(pB0, pB1, alB, l_reg, pa0, pa1, pa2, pa3); AT_SBAR();
    pv_d0(o, vbb + v1 * SHM_V, pa0, pa1, pa2, pa3);
  }
  if (hi == 0) li_l[r32] = l_reg;
  asm volatile("s_waitcnt lgkmcnt(0)" ::: "memory");
  float rli[16];
#pragma unroll
  for (int r = 0; r < 16; ++r) rli[r] = __builtin_amdgcn_rcpf(li_l[crow(r, hi)]);
  bf16* Ow = Ob + (size_t)(wid * 32) * 1024 + (hi * 4) * 1024 + r32;
#pragma unroll
  for (int r = 0; r < 16; ++r) {
#pragma unroll
    for (int d0 = 0; d0 < 4; ++d0) Ow[((r & 3) + 8 * (r >> 2)) * 1024 + d0 * 32] = (bf16)f2bf(o[d0][r] * rli[r]); }
#undef AT_DMA8
#undef AT_RESC
}

constexpr int SHM_V8 = 128 * 64;
constexpr int FK0 = 0, FV0 = 2 * SHM_K8, FWS = FV0 + 3 * SHM_V8;
constexpr float THRL8 = 8.0f;
__device__ __forceinline__ unsigned pk4f8(float a, float b, float c, float d) { int p = __builtin_amdgcn_cvt_pk_fp8_f32(a, b, 0, false); p = __builtin_amdgcn_cvt_pk_fp8_f32(c, d, p, true); return (unsigned)p; }
__device__ __forceinline__ void partialSM8(f32x16_t& p0, f32x16_t& p1, float& m_reg, float& mn, float& alpha) {
  float pmax = p0[0];
#pragma unroll
  for (int r = 1; r < 16; ++r) pmax = fmaxf(pmax, p0[r]);
#pragma unroll
  for (int r = 0; r < 16; ++r) pmax = fmaxf(pmax, p1[r]);
  { auto rr = __builtin_amdgcn_permlane32_swap(__float_as_uint(pmax), __float_as_uint(pmax), false, false);
    pmax = fmaxf(__uint_as_float(rr[0]), __uint_as_float(rr[1])); }
  if (__builtin_expect(__all(pmax - m_reg <= THRL8), 1)) { mn = m_reg; alpha = 1.f; }
  else { mn = fmaxf(m_reg, pmax); alpha = __builtin_amdgcn_exp2f(m_reg - mn); m_reg = mn; }
#pragma unroll
  for (int r = 0; r < 16; ++r) p0[r] = p0[r] - mn;
#pragma unroll
  for (int r = 0; r < 16; ++r) p1[r] = p1[r] - mn;
#pragma unroll
  for (int r = 0; r < 16; ++r) p0[r] = __builtin_amdgcn_exp2f(p0[r]);
}
__device__ __forceinline__ void finishSM8(f32x16_t& p0, f32x16_t& p1, float alpha, float& l_reg, v8i32a_t& pa) {
#pragma unroll
  for (int r = 0; r < 16; ++r) p1[r] = __builtin_amdgcn_exp2f(p1[r]);
  float ps = 0;
#pragma unroll
  for (int r = 0; r < 16; ++r) ps += p0[r];
#pragma unroll
  for (int r = 0; r < 16; ++r) ps += p1[r];
  { auto rr = __builtin_amdgcn_permlane32_swap(__float_as_uint(ps), __float_as_uint(ps), false, false);
    ps = __uint_as_float(rr[0]) + __uint_as_float(rr[1]); }
  l_reg = l_reg * alpha + ps;
  pa[0] = (int)pk4f8(p0[0], p0[1], p0[2], p0[3]);   pa[1] = (int)pk4f8(p0[4], p0[5], p0[6], p0[7]);
  pa[2] = (int)pk4f8(p0[8], p0[9], p0[10], p0[11]); pa[3] = (int)pk4f8(p0[12], p0[13], p0[14], p0[15]);
  pa[4] = (int)pk4f8(p1[0], p1[1], p1[2], p1[3]);   pa[5] = (int)pk4f8(p1[4], p1[5], p1[6], p1[7]);
  pa[6] = (int)pk4f8(p1[8], p1[9], p1[10], p1[11]); pa[7] = (int)pk4f8(p1[12], p1[13], p1[14], p1[15]);
}
__device__ __forceinline__ void pv8(f32x16_t* o, const LAS char* Vs, v8i32a_t pa, int r32, int hi) {
#pragma unroll
  for (int d0 = 0; d0 < 4; ++d0) {
    const int d = 32 * d0 + r32, f = (d >> 2) & 3;
    const LAS char* rp = Vs + d * 64;
    const v8i32a_t vf = cat8a(*(const LAS v4i32a_t*)(rp + (((2 * hi) ^ f) << 4)), *(const LAS v4i32a_t*)(rp + (((2 * hi + 1) ^ f) << 4)));
    o[d0] = __builtin_amdgcn_mfma_scale_f32_32x32x64_f8f6f4(pa, vf, o[d0], 0, 0, 0, 0x7f7f7f7f, 0, 0x7f7f7f7f);
  }
}
__device__ __forceinline__ void attn_unit_f8(int tid, const unsigned char* __restrict__ Q8, const unsigned char* __restrict__ K8, const unsigned char* __restrict__ Kp8,
                                             const unsigned char* __restrict__ V8T, bf16* __restrict__ Ob, LAS char* lds) {
  const int wid = __builtin_amdgcn_readfirstlane(tid >> 6), lane = tid & 63, r32 = lane & 31, hi = lane >> 5;
  LAS char* K_lds = lds + FK0; LAS char* V_lds = lds + FV0;
  LAS float* wsx = (LAS float*)(lds + FWS) + wid * 64; LAS float* li_l = wsx; LAS float* al_l = wsx + 32;
  float m_reg = -1e30f, l_reg = 0;
  f32x16_t o[4];
#pragma unroll
  for (int d = 0; d < 4; ++d)
#pragma unroll
    for (int r = 0; r < 16; ++r) o[d][r] = 0.f;
  v8i32a_t q8[3];
  { const unsigned qoff = (unsigned)((wid * 32 + r32) * 1536 + hi * 32);
#pragma unroll
    for (int ks = 0; ks < 3; ++ks) q8[ks] = cat8a(*(const v4i32a_t*)(Q8 + qoff + ks * 64), *(const v4i32a_t*)(Q8 + qoff + ks * 64 + 16)); }
  unsigned ksrc[2]; bool kpe[2]; unsigned vsrc;
#pragma unroll
  for (int i = 0; i < 2; ++i) { const int p = (8 * i + wid) * 64 + lane, row = p / 12, chp = p - row * 12, c = chp ^ ((row >> 2) & 3);
    kpe[i] = c >= 8; ksrc[i] = kpe[i] ? (unsigned)(row * 64 + (c - 8) * 16) : (unsigned)(row * 1024 + c * 16); }
  { const int p = wid * 64 + lane, d = p >> 2, c = (p & 3) ^ ((d >> 2) & 3); vsrc = (unsigned)(d * 64 + c * 16); }
  const unsigned ldsb = (unsigned)(size_t)lds;
  const unsigned kdst = ldsb + FK0 + (unsigned)wid * 1024u, vdst = ldsb + FV0 + (unsigned)wid * 1024u;
#define AT_DMAF(k0, ks, vs) do { const unsigned tk_ = (unsigned)(k0) * 1024u, tp_ = (unsigned)(k0) * 64u, tv_ = (unsigned)(k0) * 128u; \
    glds16(kpe[0] ? (const void*)(Kp8 + (tp_ + ksrc[0])) : (const void*)(K8 + (tk_ + ksrc[0])), kdst + (unsigned)(ks) * SHM_K8); \
    if (wid < 4) glds16(kpe[1] ? (const void*)(Kp8 + (tp_ + ksrc[1])) : (const void*)(K8 + (tk_ + ksrc[1])), kdst + (unsigned)(ks) * SHM_K8 + 8192u); \
    glds16((const void*)(V8T + (tv_ + vsrc)), vdst + (unsigned)(vs) * SHM_V8); } while (0)
#define AT_RESC(a) do { if (__any((a) < 1.f)) { if (hi == 0) al_l[r32] = (a); asm volatile("s_waitcnt lgkmcnt(0)" ::: "memory"); \
    _Pragma("unroll") for (int d = 0; d < 4; ++d) _Pragma("unroll") for (int r = 0; r < 16; ++r) o[d][r] *= al_l[crow(r, hi)]; } } while (0)
  f32x16_t pA0, pA1, pB0, pB1; float mnA, mnB, alA, alB; v8i32a_t pa; constexpr int NT = SEQ / 64;
  AT_DMAF(0, 0, 0); AT_VMWAIT(); __syncthreads();
  AT_DMAF(64, 1, 1);
  qkt8(pA0, pA1, K_lds, q8, r32, hi); partialSM8(pA0, pA1, m_reg, mnA, alA);
  AT_VMWAIT(); __syncthreads();
  int vprev = 0;
#pragma unroll 1
  for (int j = 1; j + 1 < NT; j += 2) {
    const int v1 = vprev == 2 ? 0 : vprev + 1, v2 = v1 == 2 ? 0 : v1 + 1, v3 = v2 == 2 ? 0 : v2 + 1;
    AT_DMAF((j + 1) * 64, 0, v2);
    AT_SBAR(); qkt8(pB0, pB1, K_lds + SHM_K8, q8, r32, hi);
    finishSM8(pA0, pA1, alA, l_reg, pa); AT_SBAR();
    pv8(o, V_lds + vprev * SHM_V8, pa, r32, hi); partialSM8(pB0, pB1, m_reg, mnB, alB);
    AT_RESC(alB);
    AT_VMWAIT(); __syncthreads();
    AT_DMAF((j + 2) * 64, 1, v3);
    AT_SBAR(); qkt8(pA0, pA1, K_lds, q8, r32, hi);
    finishSM8(pB0, pB1, alB, l_reg, pa); AT_SBAR();
    pv8(o, V_lds + v1 * SHM_V8, pa, r32, hi); partialSM8(pA0, pA1, m_reg, mnA, alA);
    AT_RESC(alA);
    AT_VMWAIT(); __syncthreads();
    vprev = v2;
  }
  {
    const int v1 = vprev == 2 ? 0 : vprev + 1;
    AT_SBAR(); qkt8(pB0, pB1, K_lds + SHM_K8, q8, r32, hi);
    finishSM8(pA0, pA1, alA, l_reg, pa); AT_SBAR();
    pv8(o, V_lds + vprev * SHM_V8, pa, r32, hi); partialSM8(pB0, pB1, m_reg, mnB, alB);
    AT_RESC(alB);
    finishSM8(pB0, pB1, alB, l_reg, pa); AT_SBAR();
    pv8(o, V_lds + v1 * SHM_V8, pa, r32, hi);
  }
  if (hi == 0) li_l[r32] = l_reg;
  asm volatile("s_waitcnt lgkmcnt(0)" ::: "memory");
  float rli[16];
#pragma unroll
  for (int r = 0; r < 16; ++r) rli[r] = __builtin_amdgcn_rcpf(li_l[crow(r, hi)]);
  bf16* Ow = Ob + (size_t)(wid * 32) * 1024 + (hi * 4) * 1024 + r32;
#pragma unroll
  for (int r = 0; r < 16; ++r) {
#pragma unroll
    for (int d0 = 0; d0 < 4; ++d0) Ow[((r & 3) + 8 * (r >> 2)) * 1024 + d0 * 32] = (bf16)f2bf(o[d0][r] * rli[r]); }
#undef AT_DMAF
#undef AT_RESC
}
}
__device__ __forceinline__ const float* karg(int i) {
  unsigned long long p = (unsigned long long)__builtin_amdgcn_kernarg_segment_ptr();
  asm volatile("" : "+s"(p));
  return ((const float* const __attribute__((address_space(4)))*)p)[i];
}
#define x_in karg(0)
#define C_IN karg(1)
#define positions_f karg(2)
#define ada_w karg(3)
#define ada_b karg(4)
#define norm_mix_g karg(5)
#define norm_ffn_g karg(6)
#define hy_w_in karg(7)
#define hy_b_in karg(8)
#define hy_conv_w karg(9)
#define hy_conv_b karg(10)
#define hy_f_w1 karg(11)
#define hy_f_b1 karg(12)
#define hy_f_w2 karg(13)
#define hy_f_b2 karg(14)
#define hy_f_w3 karg(15)
#define hy_f_freq karg(16)
#define hy_f_bias karg(17)
#define hy_w_out karg(18)
#define hy_b_out karg(19)
#define mla_w_in karg(20)
#define mla_q_norm_g karg(21)
#define mla_w_qb karg(22)
#define mla_kv_norm_g karg(23)
#define mla_w_kvb karg(24)
#define mla_w_out karg(25)
#define moe_w_router karg(26)
#define moe_w_gate karg(27)
#define moe_w_up karg(28)
#define moe_w_down karg(29)
#define final_norm_g karg(30)
#define positions ((const int*)karg(2))
#define XRES ((float*)karg(31))
#define WSB ((unsigned char*)karg(32))
#define MiB ((size_t)1 << 20)
#define WhoT ((bf16*)(WSB + 24 * MiB))
#define WmoT ((bf16*)(WSB + 26 * MiB))
#define Ybf ((bf16*)(WSB + 512 * MiB))
#define ws ((float*)(WSB + 40 * MiB))
#define Wmoe ((bf16*)(WSB + 48 * MiB))
#define WmoeD ((bf16*)((unsigned char*)Wmoe + (size_t)NE * 2048 * 1024))
#define XNb ((bf16*)(WSB + 144 * MiB))
#define XSb ((bf16*)(WSB + 208 * MiB))
#define HIDb ((bf16*)(WSB + 336 * MiB))
#define WinT ((bf16*)(WSB + 28 * MiB))
#define Upre ((bf16*)(WSB + 208 * MiB))
#define UTb ((bf16*)(WSB + 208 * MiB))
#define XBb ((bf16*)(WSB + 400 * MiB))
#define zTb ((bf16*)(WSB + 400 * MiB))
#define ycTb ((bf16*)(WSB + 464 * MiB))
#define KRb ((unsigned char*)(WSB + 560 * MiB))
#define K0b ((float*)(WSB + 568 * MiB))
#define W3Tb ((bf16*)(WSB + 569 * MiB))
#define WaT ((bf16*)(WSB + 34 * MiB))
#define WqbT ((bf16*)(WSB + 35 * MiB))
#define WkvbT ((bf16*)(WSB + 36 * MiB))
#define Abuf ((bf16*)(WSB + 208 * MiB))
#define CQNb ((bf16*)(WSB + 240 * MiB))
#define CKVNb ((bf16*)(WSB + 256 * MiB))
#define KPEb ((bf16*)(WSB + 272 * MiB))
#define ROPEb ((float*)(WSB + 528 * MiB))
#define Qbuf ((bf16*)(WSB + 288 * MiB))
#define KVbuf ((bf16*)(WSB + 384 * MiB))
#define KPE8b ((unsigned char*)(WSB + 276 * MiB))
#define K8nb ((unsigned char*)(WSB + 336 * MiB))
#define V8Tb ((unsigned char*)(WSB + 208 * MiB))
#define idx_id ((int*)(WSB + 10 * MiB))
#define idx_row ((int*)(WSB + 8 * MiB))
#define gsel_row ((float*)(WSB + 9 * MiB))
#define ACT ((size_t)NTOK * DM)
#define mod (ws)
#define aff (mod + 2 * NB * 6 * DM)
#define gsel (aff + (size_t)NB * NE * SEQ)
#define idx ((int*)(gsel + (size_t)NB * NE * CAP))
#define slot_of (idx + (size_t)NB * NE * CAP)
#define RA ((float*)(slot_of + (size_t)NB * NE * SEQ))
#define RF (RA + ACT)
#define RU (RF + 2 * (size_t)SEQ * DM)
#define RC (RU + (size_t)SEQ * 3072)
#define RD (RC + ACT)

__device__ __forceinline__ void vtrans_phase(int tid_in, unsigned char* lds_, const bf16* KV, unsigned char* V8T) {
  const int tid = launder(tid_in);
  LAS unsigned char* tile = (LAS unsigned char*)lds_;
  const int key = tid & 63, dg = tid >> 6;
  const int a_ = key >> 5, k5 = key & 31, hi_ = (k5 >> 2) & 1, r_ = (k5 & 3) | ((k5 >> 3) << 2), pos = 32 * hi_ + 16 * a_ + r_;
  constexpr int NITEM = NB * 8 * (SEQ / 64);
  v4u ra[2], na[2];
  { const int item = bid(), t = item & 63, bh = item >> 6, b = bh >> 3, h = bh & 7;
    const bf16* src = KV + (size_t)(b * SEQ + t * 64 + key) * 2048 + h * 256 + 128 + dg * 16;
    ra[0] = *(const v4u*)src; ra[1] = *(const v4u*)(src + 8); }
  for (int item = bid(); item < NITEM; item += GRID) {
    { const int nitem = item + GRID < NITEM ? item + GRID : item, t = nitem & 63, bh = nitem >> 6, b = bh >> 3, h = bh & 7;
      const bf16* src = KV + (size_t)(b * SEQ + t * 64 + key) * 2048 + h * 256 + 128 + dg * 16;
      na[0] = *(const v4u*)src; na[1] = *(const v4u*)(src + 8); }
    float v[16];
    unpack8(ra[0], v); unpack8(ra[1], v + 8);
    __syncthreads();
#pragma unroll
    for (int q = 0; q < 4; ++q) { const unsigned w = pg8::pack4_fp8(v[4 * q], v[4 * q + 1], v[4 * q + 2], v[4 * q + 3]);
#pragma unroll
      for (int e = 0; e < 4; ++e) tile[(dg * 16 + 4 * q + e) * 80 + pos] = (unsigned char)(w >> (8 * e)); }
    __syncthreads();
    const int d = tid >> 2, c = tid & 3;
    const v4u o = *(const LAS v4u*)(tile + d * 80 + c * 16);
    *(v4u*)(V8T + (size_t)item * 8192 + d * 64 + c * 16) = o;
    ra[0] = na[0]; ra[1] = na[1];
  }
}
__device__ __forceinline__ void attn_phase(int tid_in, unsigned char* lds_) {
  const int tid = launder(tid_in);
  const int c = bid(), x = c & 7, s_ = c >> 3;
#pragma unroll 1
  for (int i = 0; i < 4; ++i) {
    const int bh = i * 16 + x * 2 + (s_ >> 4), qb = s_ & 15, b = bh >> 3, h = bh & 7;
    __syncthreads();
    att::attn_unit_f8(launder(tid), (const unsigned char*)Qbuf + (size_t)(b * SEQ + qb * 256) * 1536 + h * 192, K8nb + (size_t)(b * SEQ) * 1024 + h * 128, KPE8b + (size_t)(b * SEQ) * 64,
                      V8Tb + (size_t)bh * (64 * 8192), Ybf + (size_t)(b * SEQ + qb * 256) * 1024 + h * 128, (LAS char*)lds_);
  }
}
#define MODL (mod + (size_t)layer * NB * 6 * DM)
#define sh1 (MODL)
#define sc1 (MODL + DM)
#define g1 (MODL + 2 * DM)
#define sh2 (MODL + 3 * DM)
#define sc2 (MODL + 4 * DM)
#define g2 (MODL + 5 * DM)
__device__ __forceinline__ void moe_convert(int tid_in, unsigned char* lds_, int k0, int nk, const float* wg, const float* wu, const float* wd, unsigned char* wm) {
  const int t_ = launder(tid_in), wave = __builtin_amdgcn_readfirstlane(t_ >> 6), lane = t_ & 63;
  LAS float* scr = (LAS float*)((LAS unsigned char*)lds_ + wave * 16384);
  constexpr int I_W = (DM / 64) * (DM / 32);
  const size_t WSZ = (size_t)DM * DM;
  const int gw = bid() * 8 + wave;
#pragma unroll 1
  for (int k = k0; k < k0 + nk; ++k) {
    const int it = gw + k * (GRID * 8);
    const int e = it / (3 * I_W), r = it - e * 3 * I_W, which = r / I_W, item = r - which * I_W;
    if (which == 0) transpose_item_fp8<1>(wg + (size_t)e * WSZ, DM, DM, wm, e * 2048, scr, item, lane);
    else if (which == 1) transpose_item_fp8<1>(wu + (size_t)e * WSZ, DM, DM, wm, e * 2048 + 128, scr, item, lane);
    else transpose_item_fp8<0>(wd + (size_t)e * WSZ, DM, DM, wm + (size_t)NE * 2048 * 1024, e * 1024, scr, item, lane);
  }
}
constexpr int MOE_TA = 20480;
__global__ void __launch_bounds__(NTHR, 2) fwd_megakernel(Args args) {
  extern __shared__ __attribute__((aligned(16))) unsigned char lds[];
  const int tid = threadIdx.x;
  volatile LAS unsigned* misc = (volatile LAS unsigned*)((LAS unsigned char*)lds + (LDS_BYTES - 256));
  if (tid < 64) misc[tid] = 0u;
  __syncthreads();
  unsigned* ctl = (unsigned*)WSB;
  (void)xcd_barrier_post(ctl + 4096, misc + 8);

  mod_phase(tid, lds, C_IN, ada_w, ada_b, mod);
  {
    const int wave = __builtin_amdgcn_readfirstlane(tid >> 6), lane = tid & 63;
    LAS float* scr = (LAS float*)((LAS unsigned char*)lds + wave * 16384);
    const int gw = bid() * 8 + wave, NGW = GRID * 8;
    constexpr int I_O = (DM / 64) * (DM / 32);
    constexpr int I_IN = (DM / 64) * (3072 / 32);
    for (int it = gw; it < 2 * I_O + I_IN; it += NGW) {
      if (it < I_O) transpose_item<0>(hy_w_out, DM, DM, WhoT, 0, scr, it, lane);
      else if (it < 2 * I_O) transpose_item<0>(mla_w_out, DM, DM, WmoT, 0, scr, it - I_O, lane);
      else transpose_item<0>(hy_w_in, DM, 3072, WinT, 0, scr, it - 2 * I_O, lane);
    }
    constexpr int I_A = (DM / 64) * (448 / 32), I_Q = (256 / 64) * (1536 / 32);
    for (int it = gw; it < I_A + I_Q; it += NGW) {
      if (it < I_A) transpose_item<2>(mla_w_in, DM, 448, WaT, 0, scr, it, lane);
      else if (it < I_A + I_Q) transpose_item<3>(mla_w_qb, 256, 1536, WqbT, 0, scr, it - I_A, lane);
    }
    {
      const int gt = bid() * NTHR + launder(tid), NGT = GRID * NTHR;
      for (int q = gt; q < NTOK * 32; q += NGT) {
        const int row = q >> 5, i = q & 31;
        const float ang = (float)positions[row] * powf(10000.0f, -(float)(2 * i) / 64.0f);
        float sn, cs; sincosf(ang, &sn, &cs);
        *(float2*)(ROPEb + (size_t)row * 64 + 2 * i) = make_float2(cs, sn);
      }
    }
    { const int gt = bid() * NTHR + launder(tid); for (int q = gt; q < NE * NB * CAP; q += GRID * NTHR) idx_id[q] = q; }
    {
      const int gt = bid() * NTHR + launder(tid);
      for (int q = gt; q < 2048 * 16; q += GRID * NTHR) {
        const int n = q & 2047, k0 = (q >> 11) * 8, hh = n >> 8, wi = n & 255;
        float w[8];
#pragma unroll
        for (int e = 0; e < 8; ++e) w[e] = mla_w_kvb[(size_t)(k0 + e) * 2048 + n];
        v4u o; o.x = pk2(w[0], w[1]); o.y = pk2(w[2], w[3]); o.z = pk2(w[4], w[5]); o.w = pk2(w[6], w[7]);
        *(v4u*)(WkvbT + (size_t)((wi < 128 ? 0 : 1024) + hh * 128 + (wi & 127)) * 128 + k0) = o;
      }
    }
    {
      const int gt = bid() * NTHR + launder(tid);
      for (int q = gt; q < 2048 * 8; q += GRID * NTHR) {
        const int col = q & 2047, j0 = (q >> 11) * 8;
        float w[8];
#pragma unroll
        for (int e = 0; e < 8; ++e) w[e] = hy_f_w3[(size_t)(j0 + e) * 2048 + col];
        v4u o; o.x = pk2(w[0], w[1]); o.y = pk2(w[2], w[3]); o.z = pk2(w[4], w[5]); o.w = pk2(w[6], w[7]);
        *(v4u*)(W3Tb + (size_t)col * 64 + j0) = o;
      }
    }
    {
      const int gt = bid() * NTHR + launder(tid), NGT = GRID * NTHR;
      for (int q = gt; q < 64 * 1024 / 8; q += NGT) *(v4u*)(WaT + (size_t)448 * 1024 + (size_t)q * 8) = (v4u){0u, 0u, 0u, 0u};
    }
  }
  GBF(0, 0, 1);

  {
    constexpr int layer = 0;
      norm_rows_phase<false>(tid, lds, x_in, norm_mix_g, sh1, sc1, XNb, nullptr, nullptr);
      filter_phase(tid, lds, hy_f_w1, hy_f_b1, hy_f_w2, hy_f_b2, W3Tb, hy_f_freq, hy_f_bias, KRb, K0b);
      GBF(0, 1, 1);
      {
        pg8::Gemm g{WinT, XNb, 3 * DM, NTOK, DM}; pg8::StaticOrder S; S.init(3 * DM, NTOK, GRID, bid());
        pg8::EpiBf16BiasT E{UTb, NTOK, hy_b_in};
        pg8::gemm_phase<pg8::EpiBf16BiasT, pg8::StaticOrder, true, true>((LAS unsigned char*)lds, g, S, E);
      }
      GBF(0, 2, 1);
      longconv_phase(tid, lds, UTb, hy_conv_w, hy_conv_b, KRb, ycTb);
      GBF(0, 3, 1);
      {
        pg8::Gemm g{ycTb, WhoT, NTOK, DM, DM}; pg8::StaticOrder S; S.init(NTOK, DM, GRID, bid());
        pg8::EpiResidT<false, true> E{x_in, XBb, hy_b_out, g1};
        pg8::gemm_phase<pg8::EpiResidT<false, true>, pg8::StaticOrder, true, true, false, true>((LAS unsigned char*)lds, g, S, E);
      }
      GBF(0, 4, 1);
    moe_convert(tid, lds, 6, 6, moe_w_gate, moe_w_up, moe_w_down, (unsigned char*)Wmoe);
    __syncthreads();
    norm_router_phase(tid, lds, XBb, norm_ffn_g + layer * DM, sh2, sc2, (unsigned char*)XNb, moe_w_router + (size_t)layer * DM * NE, aff);
    GBF(0, 5, 1);
    topk_phase(tid, lds, aff, idx_row, gsel_row, slot_of);
    GBF(1, 0, 1);
    {
      pg8::Gemm g{XNb, (bf16*)((unsigned char*)Wmoe + (size_t)layer * 48 * MiB), NE * NB * CAP, NE * 2048, DM / 2}; pg8::MoeOrder1 S{bid()};
      pg8::EpiSwiGLU E{HIDb, 1.0f, 1.0f / 32.0f};
      pg8::gemm_phase_gather<pg8::EpiSwiGLU, pg8::MoeOrder1, true>((LAS unsigned char*)lds, g, idx_row, S, E);
    }
    GBF(1, 1, 1);
    {
      pg8::Gemm g{HIDb, (bf16*)((unsigned char*)WmoeD + (size_t)layer * 48 * MiB), NE * NB * CAP, NE * 1024, DM / 2}; pg8::MoeOrder2 S{bid()};
      pg8::EpiRowScale E{XSb, gsel_row};
      pg8::gemm_phase_gather<pg8::EpiRowScale, pg8::MoeOrder2, true, DM / 2>((LAS unsigned char*)lds, g, idx_id, S, E);
    }
    GBF(1, 2, 1);
    combine_norm_phase<false>(tid, XBb, nullptr, XSb, slot_of, g2, norm_mix_g + DM, mod + (size_t)NB * 6 * DM, mod + (size_t)NB * 6 * DM + DM, XNb);
    GBF(1, 3, 1);
  }
  {
    constexpr int layer = 1;
      {
        pg8::Gemm g{XNb, WaT, NTOK, 512, DM}; pg8::StaticOrder S; S.init(NTOK, 512, GRID, bid());
        EpiMlaPrep E{mla_q_norm_g, mla_kv_norm_g, CQNb, CKVNb, KPEb, KPE8b, ROPEb};
        pg8::gemm_phase<EpiMlaPrep, pg8::StaticOrder, true, true>((LAS unsigned char*)lds, g, S, E);
      }
      GBF(1, 4, 1);
      {
        pg8::Gemm g{CQNb, WqbT, NTOK, 1536, 256}; pg8::StaticOrder S; S.init(NTOK, 1536, GRID, bid());
        pg8::EpiQRope E{Qbuf, ROPEb, 0.07216878364870323f * 1.4426950408889634f};
        pg8::gemm_phase<pg8::EpiQRope, pg8::StaticOrder, true, false>((LAS unsigned char*)lds, g, S, E);
      }
      {
        pg8::Gemm g{CKVNb, WkvbT, NTOK, 1024, 128}; pg8::StaticOrder S; S.init(NTOK, 1024, GRID, bid());
        pg8::EpiK8 E{K8nb};
        pg8::gemm_phase<pg8::EpiK8, pg8::StaticOrder, true, true>((LAS unsigned char*)lds, g, S, E);
      }
      {
        pg8::Gemm g{WkvbT + (size_t)1024 * 128, CKVNb, 1024, NTOK, 128}; pg8::StaticOrder S; S.init(1024, NTOK, GRID, bid());
        pg8::EpiVT E{V8Tb};
        pg8::gemm_phase<pg8::EpiVT, pg8::StaticOrder, true, true>((LAS unsigned char*)lds, g, S, E);
      }
      GBF(1, 5, 1);
      attn_phase(tid, lds);
      GBF(1, 6, 1);
      {
        pg8::Gemm g{Ybf, WmoT, NTOK, DM, DM}; pg8::StaticOrder S; S.init(NTOK, DM, GRID, bid());
        pg8::EpiResidT<true, true> E{XBb, XBb, nullptr, g1};
        pg8::gemm_phase<pg8::EpiResidT<true, true>, pg8::StaticOrder, true, true>((LAS unsigned char*)lds, g, S, E);
      }
      GBF(1, 7, 1);
    moe_convert(tid, lds, 9, 3, moe_w_gate + (size_t)NE * DM * DM, moe_w_up + (size_t)NE * DM * DM, moe_w_down + (size_t)NE * DM * DM, (unsigned char*)Wmoe + (size_t)48 * MiB);
    __syncthreads();
    norm_router_phase(tid, lds, XBb, norm_ffn_g + layer * DM, sh2, sc2, (unsigned char*)XNb, moe_w_router + (size_t)layer * DM * NE, aff);
    GBF(1, 8, 1);
    topk_phase(tid, lds, aff, idx_row, gsel_row, slot_of);
    GB();
    {
      pg8::Gemm g{XNb, (bf16*)((unsigned char*)Wmoe + (size_t)layer * 48 * MiB), NE * NB * CAP, NE * 2048, DM / 2}; pg8::MoeOrder1 S{bid()};
      pg8::EpiSwiGLU E{HIDb, 1.0f, 1.0f / 32.0f};
      pg8::gemm_phase_gather<pg8::EpiSwiGLU, pg8::MoeOrder1, true>((LAS unsigned char*)lds, g, idx_row, S, E);
    }
    GB();
    {
      pg8::Gemm g{HIDb, (bf16*)((unsigned char*)WmoeD + (size_t)layer * 48 * MiB), NE * NB * CAP, NE * 1024, DM / 2}; pg8::MoeOrder2 S{bid()};
      pg8::EpiRowScale E{XSb, gsel_row};
      pg8::gemm_phase_gather<pg8::EpiRowScale, pg8::MoeOrder2, true, DM / 2>((LAS unsigned char*)lds, g, idx_id, S, E);
    }
    GB();
    combine_norm_phase<true>(tid, XBb, XRES, XSb, slot_of, g2, final_norm_g, nullptr, nullptr, nullptr);
  }
}

#undef x_in
#undef C_IN
#undef positions_f
#undef ada_w
#undef ada_b
#undef norm_mix_g
#undef norm_ffn_g
#undef hy_w_in
#undef hy_b_in
#undef hy_conv_w
#undef hy_conv_b
#undef hy_f_w1
#undef hy_f_b1
#undef hy_f_w2
#undef hy_f_b2
#undef hy_f_w3
#undef hy_f_freq
#undef hy_f_bias
#undef hy_w_out
#undef hy_b_out
#undef mla_w_in
#undef mla_q_norm_g
#undef mla_w_qb
#undef mla_kv_norm_g
#undef mla_w_kvb
#undef mla_w_out
#undef moe_w_router
#undef moe_w_gate
#undef moe_w_up
#undef moe_w_down
#undef final_norm_g
#undef positions
#undef XRES
#undef WSB
#undef MiB
#undef WhoT
#undef WmoT
#undef Ybf
#undef ws
#undef ACT
#undef mod
#undef aff
#undef gsel
#undef idx
#undef slot_of
#undef RA
#undef RF
#undef RU
#undef RC
#undef RD
#undef V8Tb
#undef K8nb
#undef KPE8b
#undef idx_id
#undef g2
#undef sc2
#undef sh2
#undef g1
#undef sc1
#undef sh1
#undef MODL
#undef KVbuf
#undef Qbuf
#undef ROPEb
#undef KPEb
#undef CKVNb
#undef CQNb
#undef Abuf
#undef WkvbT
#undef WqbT
#undef WaT
#undef KRb
#undef K0b
#undef W3Tb
#undef ycTb
#undef zTb
#undef XBb
#undef Upre
#undef UTb
#undef WinT
#undef gsel_row
#undef idx_row
#undef HIDb
#undef XSb
#undef XNb
#undef WmoeD
#undef Wmoe
extern "C" void kernel_launch(void* const* d_in, const int* in_sizes, int n_in, void* d_out, int out_size,
                              void* d_ws, size_t ws_size, hipStream_t stream) {
  static int grid = 0;
  if (grid == 0) {
    int dev = 0, cus = 0;
    if (hipGetDevice(&dev) != hipSuccess ||
        hipDeviceGetAttribute(&cus, hipDeviceAttributeMultiprocessorCount, dev) != hipSuccess) { grid = -1; return; }
    if (hipFuncSetAttribute((const void*)fwd_megakernel, hipFuncAttributeMaxDynamicSharedMemorySize, LDS_BYTES) != hipSuccess) {
      fprintf(stderr, "hipFuncSetAttribute failed\n"); grid = -1; return;
    }
    int per_cu = 0;
    (void)hipOccupancyMaxActiveBlocksPerMultiprocessor(&per_cu, (const void*)fwd_megakernel, NTHR, LDS_BYTES);
    (void)hipGetLastError();
    if (per_cu < 1) fprintf(stderr, "occupancy query says %d blocks/CU\n", per_cu);
    if (ws_size < (size_t)576 * 1024 * 1024) { fprintf(stderr, "kernel_launch: workspace too small: %zu bytes (needs 576 MiB); nothing launched\n", ws_size); grid = -1; return; }
    if (cus != GRID) fprintf(stderr, "device has %d CUs, kernel built for %d\n", cus, GRID);
    grid = GRID;
  }
  if (grid < 0) return;
  (void)in_sizes; (void)n_in; (void)out_size;
  (void)hipMemsetAsync(d_ws, 0, 1u << 20, stream);
  Args a;
  memset(&a, 0, sizeof(a));
  for (int i = 0; i < 31; ++i) a.in[i] = (const float*)d_in[i];
  a.out = (float*)d_out;
  a.ws = (unsigned char*)d_ws;
  hipLaunchKernelGGL(fwd_megakernel, dim3(grid), dim3(NTHR), LDS_BYTES, stream, a);
}
```

```cpp
#include <hip/hip_runtime.h>
#include <stdint.h>
#include <math.h>
#include <string.h>
#include <cstdio>

#define DM 1024
#define NB 8
#define SEQ 4096
#define NTOK (NB * SEQ)
#define NE 16
#define CAP 512
#define NTHR 512
#define GRID 256
#define LDS_BYTES 155648
#define HALF_LDS 40960

#define LAS __attribute__((address_space(3)))

#define XB_TMO      128
#define XB_XCNT(j)  (256  + 64 * (j))
#define XB_XSUB(j)  (1280 + 64 * (j))
#define XB_XGEN(j)  (2304 + 64 * (j))
#define XB_TOP      3328
#define XB_TOPGEN   3392
#define XCD_BAR_WORDS 3456
#define XB_SPIN_CAP (1u << 22)
__device__ __forceinline__ unsigned xb_ld(unsigned* p)              { return __hip_atomic_load(p, __ATOMIC_RELAXED, __HIP_MEMORY_SCOPE_AGENT); }
__device__ __forceinline__ unsigned xb_add(unsigned* p, unsigned v) { return __hip_atomic_fetch_add(p, v, __ATOMIC_RELAXED, __HIP_MEMORY_SCOPE_AGENT); }
__device__ __forceinline__ unsigned xb_xcc_id() { return (unsigned)__builtin_amdgcn_s_getreg((3 << 11) | 20) & 0xFu; }
#define XB_SPIN(cond, bar) do { unsigned _sp = 0; while (cond) { __builtin_amdgcn_s_sleep(12); \
    if ((++_sp & 255u) == 0u) { if (xb_ld(&(bar)[XB_TMO])) break; if (_sp > XB_SPIN_CAP) { atomicAdd(&(bar)[XB_TMO], 1u); break; } } } } while (0)
struct XcdBarrier { unsigned* bar; unsigned x; volatile LAS unsigned* st; };
__device__ __forceinline__ XcdBarrier xcd_barrier_post(unsigned* bar, volatile LAS unsigned* st) {
    XcdBarrier b; b.bar = bar; b.x = xb_xcc_id(); b.st = st;
    if (threadIdx.x == 0) (void)xb_add(&bar[XB_XCNT(b.x)], 1u);
    return b;
}
__device__ __forceinline__ void xcd_barrier_complete(unsigned* bar, unsigned x, unsigned& nloc, unsigned& nx) {
    const unsigned G = gridDim.x * gridDim.y * gridDim.z;
    unsigned sum, cnt, mine, sp = 0u;
    for (;;) {
        sum = 0u; cnt = 0u; mine = 0u;
#pragma unroll
        for (unsigned j = 0; j < 16; ++j) { const unsigned c = xb_ld(&bar[XB_XCNT(j)]); sum += c; cnt += (c > 0u) ? 1u : 0u; }
        if (sum == G) { mine = xb_ld(&bar[XB_XCNT(x)]); break; }
        __builtin_amdgcn_s_sleep(1);
        if ((++sp & 255u) == 0u) { if (xb_ld(&bar[XB_TMO])) break; if (sp > XB_SPIN_CAP) { atomicAdd(&bar[XB_TMO], 1u); break; } }
    }
    nloc = mine > 0u ? mine : 1u; nx = cnt > 0u ? cnt : 1u;
}
__device__ __forceinline__ void xcd_barrier(const XcdBarrier& b_in) {
    XcdBarrier b; { unsigned long long p = (unsigned long long)b_in.bar; asm volatile("" : "+s"(p)); b.bar = (unsigned*)p; unsigned xx = xb_xcc_id(); asm volatile("" : "+s"(xx)); b.x = xx; b.st = b_in.st; }
    asm volatile("s_waitcnt vmcnt(0)" ::: "memory");
    __syncthreads();
    if (threadIdx.x == 0) {
        unsigned* bar = b.bar;
        __builtin_amdgcn_s_waitcnt(0);
        unsigned nloc = b.st[0], nx = b.st[1];
        if (nloc == 0u) { xcd_barrier_complete(bar, b.x, nloc, nx); b.st[0] = nloc; b.st[1] = nx; }
        const unsigned k = b.st[6];
        const unsigned old = xb_add(&bar[XB_XSUB(b.x)], 1u);
        const unsigned gen = old / nloc;
        if (old + 1u == (gen + 1u) * nloc) {
            __builtin_amdgcn_fence(__ATOMIC_RELEASE, "agent");
            asm volatile("s_waitcnt vmcnt(0)" ::: "memory");
            (void)xb_add(&bar[XB_TOP], 1u);
        }
        XB_SPIN(xb_ld(&bar[XB_TOP]) < (k + 1u) * nx, bar);
        __builtin_amdgcn_fence(__ATOMIC_ACQUIRE, "agent");
        asm volatile("s_waitcnt vmcnt(0)" ::: "memory");
        b.st[6] = k + 1u;
    }
    __syncthreads();
}

__device__ __forceinline__ int launder(int v) { asm volatile("" : "+v"(v)); return v; }
__device__ __forceinline__ int bid() { int b = (int)blockIdx.x; asm volatile("" : "+s"(b)); return b; }
namespace pg8 {
#define PG8_LAS __attribute__((address_space(3)))
typedef unsigned short bf16_t;
typedef short bf16x8 __attribute__((ext_vector_type(8)));
typedef float f32x4 __attribute__((ext_vector_type(4)));
typedef unsigned u32x4 __attribute__((ext_vector_type(4)));
constexpr int BM = 256, BK = 64, HALF = 128, HTB = HALF * BK * 2  , STAGE_BYTES = 8 * HTB, NXCD = 8, WGM = 2;

__host__ __device__ __forceinline__ int lds_byte(int r, int c) { const int st = (r >> 4) * 2 + (c >> 5), rr = r & 15, cc = c & 31, ob = rr * 64 + cc * 2; return st * 1024 + (ob ^ (((ob >> 9) & 1) << 5)); }
__host__ __device__ __forceinline__ void stage_rc(int b, int& R, int& C) { const int st = b / 1024, sb = b % 1024, swz = sb ^ (((sb >> 9) & 1) << 5); R = (st >> 1) * 16 + swz / 64; C = (st & 1) * 32 + (swz % 64) / 2; }
__host__ __device__ __forceinline__ int perm32(int rho) { const int n = rho >> 4, i = rho & 15; return 8 * (i >> 2) + 4 * n + (i & 3); }

struct Unit { int pm, pn; };
struct Gemm { const bf16_t* A; const bf16_t* Bt; int M, N, K; unsigned sa = 0x7f7f7f7fu, sb = 0x7f7f7f7fu; };

struct StaticOrder {
    int nM, nN, nwg, G, c;
    __host__ __device__ void init(int M, int N, int G_, int c_) { nM = M / BM; nN = N / BM; nwg = nM * nN; G = G_; c = c_; }
    __host__ __device__ bool next(int i, Unit& u) const {
        const long L = (long)i * G + c; if (L >= nwg) return false;
        int wgid = (int)L; { const int q = nwg / NXCD, r = nwg % NXCD, xcd = wgid % NXCD, off = wgid / NXCD; wgid = (xcd < r ? xcd * (q + 1) : r * (q + 1) + (xcd - r) * q) + off; }
        const int nig = WGM * nN, gid = wgid / nig, fm = gid * WGM, gsz = (nM - fm) < WGM ? (nM - fm) : WGM;
        u.pm = fm + ((wgid % nig) % gsz); u.pn = (wgid % nig) / gsz; return true;
    }
    __device__ __forceinline__ void a_ready(const Unit&) const {}
    __device__ __forceinline__ void done(const Unit&) const {}
};


__device__ __forceinline__ unsigned cvt_pk_bf16(float lo, float hi) { unsigned r; asm volatile("v_cvt_pk_bf16_f32 %0, %1, %2" : "=v"(r) : "v"(lo), "v"(hi)); return r; }
__device__ __forceinline__ unsigned pack4_fp8(float a, float b, float c, float d) { int p = __builtin_amdgcn_cvt_pk_fp8_f32(a, b, 0, false); p = __builtin_amdgcn_cvt_pk_fp8_f32(c, d, p, true); return (unsigned)p; }
template <bool IN_BF, bool OUT_BF>
struct EpiResidT {
    static constexpr bool PERM = false, AFTER_DRAIN = false;
    const void* base; void* out; const float* bias; const float* gate;
    __device__ __forceinline__ void operator()(const f32x4 (&acc)[2][2][4][2], const Unit& u, int wr, int wc, int fr, int fq) const {
        typedef unsigned u32x2r_ __attribute__((ext_vector_type(2)));
        const int col0 = u.pn * BM + wc * 32 + 4 * fq;
        const int b = (u.pm * BM) / SEQ;
        const float* gp = gate + (size_t)b * 6 * DM + col0;
        f32x4 bv[2][2], gv[2][2];
#pragma unroll
        for (int bj = 0; bj < 2; ++bj)
#pragma unroll
            for (int n = 0; n < 2; ++n) {
                bv[bj][n] = bias ? *(const f32x4*)(bias + col0 + bj * HALF + n * 16) : (f32x4){0.f, 0.f, 0.f, 0.f};
                gv[bj][n] = *(const f32x4*)(gp + bj * HALF + n * 16);
            }
#pragma unroll
        for (int ai = 0; ai < 2; ++ai)
#pragma unroll
            for (int m = 0; m < 4; ++m) {
                const size_t off = (size_t)(u.pm * BM + ai * HALF + wr * 64 + m * 16 + fr) * DM + col0;
#pragma unroll
                for (int bj = 0; bj < 2; ++bj)
#pragma unroll
                    for (int n = 0; n < 2; ++n) {
                        f32x4 xv;
                        if constexpr (IN_BF) { const u32x2r_ r = *(const u32x2r_*)((const bf16_t*)base + off + bj * HALF + n * 16);
                            xv = (f32x4){__builtin_bit_cast(float, r.x << 16), __builtin_bit_cast(float, r.x & 0xffff0000u), __builtin_bit_cast(float, r.y << 16), __builtin_bit_cast(float, r.y & 0xffff0000u)}; }
                        else xv = *(const f32x4*)((const float*)base + off + bj * HALF + n * 16);
                        const f32x4 o = xv + gv[bj][n] * (acc[ai][bj][m][n] + bv[bj][n]);
                        if constexpr (OUT_BF) { u32x2r_ w; w.x = cvt_pk_bf16(o[0], o[1]); w.y = cvt_pk_bf16(o[2], o[3]); *(u32x2r_*)((bf16_t*)out + off + bj * HALF + n * 16) = w; }
                        else *(f32x4*)((float*)out + off + bj * HALF + n * 16) = o;
                    }
            }
    }
};

struct EpiSwiGLU {
    static constexpr bool PERM = true, AFTER_DRAIN = false;
    bf16_t* O; float f8scale; float wscale;
    __device__ __forceinline__ void operator()(const f32x4 (&acc)[2][2][4][2], const Unit& u, int wr, int wc, int fr, int fq) const {
        const int row0 = u.pm * BM + wr * 64 + fr, col0 = (u.pn & 7) * 128 + wc * 32 + 8 * fq;
#pragma unroll
        for (int ai = 0; ai < 2; ++ai)
#pragma unroll
            for (int m = 0; m < 4; ++m) {
                bf16_t* rowp = O + (size_t)(row0 + ai * HALF + m * 16) * 1024 + col0;
                float h[8];
#pragma unroll
                for (int n = 0; n < 2; ++n)
#pragma unroll
                    for (int j = 0; j < 4; ++j) { const float g = acc[ai][0][m][n][j] * wscale, up = acc[ai][1][m][n][j] * wscale;
                        h[n * 4 + j] = __builtin_fminf(__builtin_fmaxf(g * __builtin_amdgcn_rcpf(1.0f + __builtin_amdgcn_exp2f(-1.4426950408889634f * g)) * up, -448.f), 448.f); }
                if (f8scale != 0.f) {
                    typedef unsigned u32x2_ __attribute__((ext_vector_type(2)));
                    u32x2_ w8; w8.x = pack4_fp8(h[0] * f8scale, h[1] * f8scale, h[2] * f8scale, h[3] * f8scale); w8.y = pack4_fp8(h[4] * f8scale, h[5] * f8scale, h[6] * f8scale, h[7] * f8scale);
                    *(u32x2_*)((unsigned char*)O + (size_t)(row0 + ai * HALF + m * 16) * 1024 + col0) = w8;
                } else {
                u32x4 w; w.x = cvt_pk_bf16(h[0], h[1]); w.y = cvt_pk_bf16(h[2], h[3]); w.z = cvt_pk_bf16(h[4], h[5]); w.w = cvt_pk_bf16(h[6], h[7]);
                *(u32x4*)rowp = w; }
            }
    }
};
struct EpiRowScale {
    static constexpr bool PERM = true, AFTER_DRAIN = false;
    bf16_t* O; const float* rs;
    static constexpr float wscale = 1.0f / 32.0f;
    __device__ __forceinline__ void operator()(const f32x4 (&acc)[2][2][4][2], const Unit& u, int wr, int wc, int fr, int fq) const {
        const int row0 = u.pm * BM + wr * 64 + fr, col0 = (u.pn & 3) * BM + wc * 32 + 8 * fq;
#pragma unroll
        for (int ai = 0; ai < 2; ++ai)
#pragma unroll
            for (int m = 0; m < 4; ++m) {
                const int row = row0 + ai * HALF + m * 16;
                const float sc = rs[row] * wscale * 16.0f;
                unsigned char* rowp = (unsigned char*)O + (size_t)row * 1024 + col0;
                typedef unsigned u32x2y_ __attribute__((ext_vector_type(2)));
#pragma unroll
                for (int bj = 0; bj < 2; ++bj) { f32x4 v0 = acc[ai][bj][m][0] * sc, v1 = acc[ai][bj][m][1] * sc;
#pragma unroll
                    for (int e = 0; e < 4; ++e) { v0[e] = __builtin_fminf(__builtin_fmaxf(v0[e], -448.f), 448.f); v1[e] = __builtin_fminf(__builtin_fmaxf(v1[e], -448.f), 448.f); }
                    u32x2y_ w; w.x = pack4_fp8(v0[0], v0[1], v0[2], v0[3]); w.y = pack4_fp8(v1[0], v1[1], v1[2], v1[3]);
                    *(u32x2y_*)(rowp + bj * HALF) = w; }
            }
    }
};

struct EpiBf16Bias {
    static constexpr bool PERM = true, AFTER_DRAIN = false;
    bf16_t* O; int ldc; const float* bias;
    __device__ __forceinline__ void operator()(const f32x4 (&acc)[2][2][4][2], const Unit& u, int wr, int wc, int fr, int fq) const {
        const int row0 = u.pm * BM + wr * 64 + fr, col0 = u.pn * BM + wc * 32 + 8 * fq;
        f32x4 bv[2][2];
#pragma unroll
        for (int bj = 0; bj < 2; ++bj)
#pragma unroll
            for (int n = 0; n < 2; ++n) bv[bj][n] = bias ? *(const f32x4*)(bias + col0 + bj * HALF + 4 * n) : (f32x4){0.f, 0.f, 0.f, 0.f};
#pragma unroll
        for (int ai = 0; ai < 2; ++ai)
#pragma unroll
            for (int m = 0; m < 4; ++m) { bf16_t* rowp = O + (size_t)(row0 + ai * HALF + m * 16) * ldc + col0;
#pragma unroll
                for (int bj = 0; bj < 2; ++bj) { const f32x4 v0 = acc[ai][bj][m][0] + bv[bj][0], v1 = acc[ai][bj][m][1] + bv[bj][1];
                    u32x4 w; w.x = cvt_pk_bf16(v0[0], v0[1]); w.y = cvt_pk_bf16(v0[2], v0[3]); w.z = cvt_pk_bf16(v1[0], v1[1]); w.w = cvt_pk_bf16(v1[2], v1[3]);
                    *(u32x4*)(rowp + bj * HALF) = w; } }
    }
};

struct EpiBf16BiasT {
    static constexpr bool PERM = true, AFTER_DRAIN = false;
    bf16_t* O; int ldc; const float* bias;
    __device__ __forceinline__ void operator()(const f32x4 (&acc)[2][2][4][2], const Unit& u, int wr, int wc, int fr, int fq) const {
        const int row0 = u.pm * BM + wr * 64 + fr, col0 = u.pn * BM + wc * 32 + 8 * fq;
#pragma unroll
        for (int ai = 0; ai < 2; ++ai)
#pragma unroll
            for (int m = 0; m < 4; ++m) { const int row = row0 + ai * HALF + m * 16; const float bb = bias[row]; bf16_t* rowp = O + (size_t)row * ldc + col0;
#pragma unroll
                for (int bj = 0; bj < 2; ++bj) { const f32x4 v0 = acc[ai][bj][m][0] + bb, v1 = acc[ai][bj][m][1] + bb;
                    u32x4 w; w.x = cvt_pk_bf16(v0[0], v0[1]); w.y = cvt_pk_bf16(v0[2], v0[3]); w.z = cvt_pk_bf16(v1[0], v1[1]); w.w = cvt_pk_bf16(v1[2], v1[3]);
                    *(u32x4*)(rowp + bj * HALF) = w; } }
    }
};

struct EpiQRope {
    static constexpr bool PERM = true, AFTER_DRAIN = false;
    bf16_t* O; const float* rope; float qscale;
    __device__ __forceinline__ void operator()(const f32x4 (&acc)[2][2][4][2], const Unit& u, int wr, int wc, int fr, int fq) const {
        const int row0 = u.pm * BM + wr * 64 + fr, col0 = u.pn * BM + wc * 32 + 8 * fq;
#pragma unroll
        for (int bj = 0; bj < 2; ++bj) {
            const int col = col0 + bj * HALF, hd = col / 192, d = col - hd * 192;
            const bool pe = d >= 128;
#pragma unroll
            for (int ai = 0; ai < 2; ++ai)
#pragma unroll
                for (int m = 0; m < 4; ++m) {
                    const unsigned row = (unsigned)(row0 + ai * HALF + m * 16);
                    f32x4 v0 = acc[ai][bj][m][0], v1 = acc[ai][bj][m][1];
                    if (pe) {
                        const unsigned ro = row * 64u + (unsigned)(d - 128);
                        const f32x4 r0 = *(const f32x4*)(rope + ro), r1 = *(const f32x4*)(rope + ro + 4u);
                        const f32x4 t0 = v0, t1 = v1;
                        v0[0] = t0[0] * r0[0] - t0[1] * r0[1]; v0[1] = t0[0] * r0[1] + t0[1] * r0[0];
                        v0[2] = t0[2] * r0[2] - t0[3] * r0[3]; v0[3] = t0[2] * r0[3] + t0[3] * r0[2];
                        v1[0] = t1[0] * r1[0] - t1[1] * r1[1]; v1[1] = t1[0] * r1[1] + t1[1] * r1[0];
                        v1[2] = t1[2] * r1[2] - t1[3] * r1[3]; v1[3] = t1[2] * r1[3] + t1[3] * r1[2];
                    }
                    v0 = v0 * qscale; v1 = v1 * qscale;
                    typedef unsigned u32x2q_ __attribute__((ext_vector_type(2)));
                    u32x2q_ w8; w8.x = pack4_fp8(v0[0], v0[1], v0[2], v0[3]); w8.y = pack4_fp8(v1[0], v1[1], v1[2], v1[3]);
                    *(u32x2q_*)((unsigned char*)O + (row * 1536u + (unsigned)col)) = w8;
                }
        }
    }
};

struct EpiKV {
    static constexpr bool PERM = true, AFTER_DRAIN = false;
    bf16_t* O; unsigned char* K8;
    __device__ __forceinline__ void operator()(const f32x4 (&acc)[2][2][4][2], const Unit& u, int wr, int wc, int fr, int fq) const {
        const int row0 = u.pm * BM + wr * 64 + fr, col0 = u.pn * BM + wc * 32 + 8 * fq;
#pragma unroll
        for (int ai = 0; ai < 2; ++ai)
#pragma unroll
            for (int m = 0; m < 4; ++m) { const unsigned row = (unsigned)(row0 + ai * HALF + m * 16); bf16_t* rowp = O + (size_t)row * 2048 + col0;
#pragma unroll
                for (int bj = 0; bj < 2; ++bj) { const f32x4 v0 = acc[ai][bj][m][0], v1 = acc[ai][bj][m][1];
                    u32x4 w; w.x = cvt_pk_bf16(v0[0], v0[1]); w.y = cvt_pk_bf16(v0[2], v0[3]); w.z = cvt_pk_bf16(v1[0], v1[1]); w.w = cvt_pk_bf16(v1[2], v1[3]);
                    *(u32x4*)(rowp + bj * HALF) = w;
                    if (bj == 0) { typedef unsigned u32x2k_ __attribute__((ext_vector_type(2)));
                        u32x2k_ w8; w8.x = pack4_fp8(v0[0], v0[1], v0[2], v0[3]); w8.y = pack4_fp8(v1[0], v1[1], v1[2], v1[3]);
                        *(u32x2k_*)(K8 + (row * 1024u + (unsigned)(u.pn * 128 + wc * 32 + 8 * fq))) = w8; } } }
    }
};
struct EpiK8 {
    static constexpr bool PERM = true, AFTER_DRAIN = false;
    unsigned char* K8;
    __device__ __forceinline__ void operator()(const f32x4 (&acc)[2][2][4][2], const Unit& u, int wr, int wc, int fr, int fq) const {
        const int row0 = u.pm * BM + wr * 64 + fr, col0 = u.pn * BM + wc * 32 + 8 * fq;
        typedef unsigned u32x2e_ __attribute__((ext_vector_type(2)));
#pragma unroll
        for (int ai = 0; ai < 2; ++ai)
#pragma unroll
            for (int m = 0; m < 4; ++m) { const unsigned row = (unsigned)(row0 + ai * HALF + m * 16);
#pragma unroll
                for (int bj = 0; bj < 2; ++bj) { const f32x4 v0 = acc[ai][bj][m][0], v1 = acc[ai][bj][m][1];
                    u32x2e_ w8; w8.x = pack4_fp8(v0[0], v0[1], v0[2], v0[3]); w8.y = pack4_fp8(v1[0], v1[1], v1[2], v1[3]);
                    *(u32x2e_*)(K8 + (row * 1024u + (unsigned)(col0 + bj * HALF))) = w8; } }
    }
};
struct EpiVT {
    static constexpr bool PERM = true, AFTER_DRAIN = false;
    unsigned char* V8T;
    __device__ __forceinline__ void operator()(const f32x4 (&acc)[2][2][4][2], const Unit& u, int wr, int wc, int fr, int fq) const {
        const int dg0 = u.pm * BM + wr * 64 + fr, n0 = u.pn * BM + wc * 32 + 8 * fq;
#pragma unroll
        for (int ai = 0; ai < 2; ++ai)
#pragma unroll
            for (int m = 0; m < 4; ++m) { const int dg = dg0 + ai * HALF + m * 16, h = dg >> 7, d = dg & 127;
#pragma unroll
                for (int bj = 0; bj < 2; ++bj) { const f32x4 v0 = acc[ai][bj][m][0], v1 = acc[ai][bj][m][1];
                    const int n = n0 + bj * HALF, b = n >> 12, key = n & 4095, j = key >> 6, kk0 = key & 63, pos0 = 16 * (kk0 >> 5) + 4 * ((kk0 >> 3) & 3);
                    unsigned char* p = V8T + ((size_t)((b * 8 + h) * 64 + j) * 8192 + (size_t)(d * 64 + pos0));
                    *(unsigned*)p = pack4_fp8(v0[0], v0[1], v0[2], v0[3]); *(unsigned*)(p + 32) = pack4_fp8(v1[0], v1[1], v1[2], v1[3]); } }
    }
};
struct MoeOrder1 { int c;
    __device__ __forceinline__ bool next(int i, Unit& u) const { if (i >= 8) return false; const int x = c & 7, s = c >> 3, e = 2 * i + (x >> 2); u.pm = e * 16 + 4 * (x & 3) + (s >> 3); u.pn = e * 8 + (s & 7); return true; }
    __device__ __forceinline__ void a_ready(const Unit&) const {}
    __device__ __forceinline__ void done(const Unit&) const {} };
struct MoeOrder2 { int c;
    __device__ __forceinline__ bool next(int i, Unit& u) const { if (i >= 4) return false; const int x = c & 7, s = c >> 3, e = 4 * i + (x >> 1); u.pm = e * 16 + 8 * (x & 1) + (s >> 2); u.pn = e * 4 + (s & 3); return true; }
    __device__ __forceinline__ void a_ready(const Unit&) const {}
    __device__ __forceinline__ void done(const Unit&) const {} };

typedef int v8i32_t __attribute__((ext_vector_type(8)));
typedef int v4i32_t __attribute__((ext_vector_type(4)));
typedef short v4i16_t __attribute__((ext_vector_type(4)));
__device__ __forceinline__ v8i32_t cat8(bf16x8 lo, bf16x8 hi) { const v4i32_t a = __builtin_bit_cast(v4i32_t, lo), b = __builtin_bit_cast(v4i32_t, hi); return __builtin_shufflevector(a, b, 0, 1, 2, 3, 4, 5, 6, 7); }
template <class Epi, class Sched, bool ALIGN_EPI = false, bool SP2 = false, bool FP8 = false, bool AT = false>
__device__ __forceinline__ void gemm_phase(PG8_LAS unsigned char* lds, const Gemm g, const Sched& S, const Epi& E) {
    int tid_ = threadIdx.x; asm volatile("" : "+v"(tid_));
    const int tid = tid_, wid = __builtin_amdgcn_readfirstlane(tid >> 6), lane = tid & 63, wr = wid >> 2, wc = wid & 3, fr = lane & 15, fq = lane >> 4;
    const int K = g.K, nt = K / BK;
    unsigned voffA[1], voffB[1];
    { int R, C; stage_rc(tid * 16, R, C); const int Rb = Epi::PERM ? ((R & ~31) + perm32(R & 31)) : R;
        voffA[0] = (unsigned)(R * K + C) * 2u; voffB[0] = (unsigned)(Rb * K + C) * 2u;
        if constexpr (AT) { const int k_ = (tid >> 2) & 63, j_ = tid & 3; voffA[0] = (unsigned)(k_ * g.M + (tid >> 8) * 32 + 8 * (j_ ^ (2 * ((k_ >> 3) & 1)))) * 2u; } }
    const size_t pstep = (size_t)64 * K * 2;
    const size_t kstep = (size_t)(BK * 2);
    const size_t hstep = (size_t)HALF * K * 2;
    const size_t tstep = 2 * hstep;
    const size_t pstepA = AT ? (size_t)128 : pstep, kstepA = AT ? (size_t)BK * g.M * 2 : kstep, hstepA = AT ? (size_t)256 : hstep, tstepA = AT ? (size_t)512 : tstep;
    const unsigned ldsw = (unsigned)wid * 1024u;
    const int aoff = lds_byte(wr * 64 + fr, fq * 8), boff = lds_byte(wc * 32 + fr, fq * 8);
    const int aoT0 = wr * 8192 + (8 * fq + (fr >> 2)) * 64 + ((fq & 1) * 32) + (fr & 3) * 8, aoT1 = aoT0 ^ 32;
#define PG8_SA(b, h) (((b) * 2 + (h)) * HTB)
#define PG8_SB(b, h) ((4 + (b) * 2 + (h)) * HTB)
#define PG8_STAGE(bufoff, gbase, voff) do { _Pragma("unroll") for (int _i = 0; _i < 2; ++_i) \
        __builtin_amdgcn_global_load_lds((const unsigned*)((const char*)(gbase) + _i * pstep + (voff)[0]), (PG8_LAS unsigned*)(lds + (bufoff) + ldsw + _i * 8192), 16, 0, 0); } while (0)
#define PG8_STAGEA(bufoff, gbase) do { _Pragma("unroll") for (int _i = 0; _i < 2; ++_i) \
        __builtin_amdgcn_global_load_lds((const unsigned*)((const char*)(gbase) + _i * pstepA + voffA[0]), (PG8_LAS unsigned*)(lds + (bufoff) + ldsw + _i * 8192), 16, 0, 0); } while (0)
#define PG8_TR(off_) __builtin_amdgcn_ds_read_tr16_b64_v4i16((PG8_LAS v4i16_t*)(lds + (off_)))
#define PG8_LDA(dst, b, h) do { if constexpr (AT) { _Pragma("unroll") for (int m = 0; m < 4; ++m) _Pragma("unroll") for (int k = 0; k < 2; ++k) { \
            const int o_ = PG8_SA(b, h) + ((m & 1) ? aoT1 : aoT0) + (m >> 1) * 4096 + k * 2048; const v4i16_t lo_ = PG8_TR(o_), hi_ = PG8_TR(o_ + 256); \
            dst[m][k] = __builtin_shufflevector(lo_, hi_, 0, 1, 2, 3, 4, 5, 6, 7); } } else _Pragma("unroll") for (int m = 0; m < 4; ++m) { if constexpr (FP8) dst##8[m] = cat8(*(const PG8_LAS bf16x8*)(lds + PG8_SA(b, h) + aoff + m * 2048), *(const PG8_LAS bf16x8*)(lds + PG8_SA(b, h) + aoff + m * 2048 + 1024)); \
        else { _Pragma("unroll") for (int k = 0; k < 2; ++k) dst[m][k] = *(const PG8_LAS bf16x8*)(lds + PG8_SA(b, h) + aoff + m * 2048 + k * 1024); } } } while (0)
#define PG8_LDB(dst, b, h) do { _Pragma("unroll") for (int n = 0; n < 2; ++n) { if constexpr (FP8) dst##8[n] = cat8(*(const PG8_LAS bf16x8*)(lds + PG8_SB(b, h) + boff + n * 2048), *(const PG8_LAS bf16x8*)(lds + PG8_SB(b, h) + boff + n * 2048 + 1024)); \
        else { _Pragma("unroll") for (int k = 0; k < 2; ++k) dst[n][k] = *(const PG8_LAS bf16x8*)(lds + PG8_SB(b, h) + boff + n * 2048 + k * 1024); } } } while (0)
#define PG8_MMA(ai, bj, At, Bt) do { __builtin_amdgcn_s_setprio(1);     \
        if constexpr (FP8) { _Pragma("unroll") for (int m = 0; m < 4; ++m) _Pragma("unroll") for (int n = 0; n < 2; ++n) \
            acc[ai][bj][m][n] = __builtin_amdgcn_mfma_scale_f32_16x16x128_f8f6f4(Bt##8[n], At##8[m], acc[ai][bj][m][n], 0, 0, 0, 0x7f7f7f7f, 0, 0x7f7f7f7f); } \
        else { _Pragma("unroll") for (int m = 0; m < 4; ++m) _Pragma("unroll") for (int n = 0; n < 2; ++n) _Pragma("unroll") for (int k = 0; k < 2; ++k) \
            acc[ai][bj][m][n] = __builtin_amdgcn_mfma_f32_16x16x32_bf16(Bt[n][k], At[m][k], acc[ai][bj][m][n], 0, 0, 0); } \
        __builtin_amdgcn_s_setprio(0); } while (0)
#define PG8_WAIT_V(n) asm volatile("s_waitcnt vmcnt(" #n ")" ::: "memory")
#define PG8_WAIT_L(n) asm volatile("s_waitcnt lgkmcnt(" #n ")" ::: "memory")
#define PG8_BAR __builtin_amdgcn_s_barrier()
#define PG8_SCHED __builtin_amdgcn_sched_barrier(0)
    Unit cur, nxt; int ui = 0;
    if (!S.next(0, cur)) return;
    f32x4 acc[2][2][4][2];
#pragma unroll
    for (int a = 0; a < 2; ++a)
#pragma unroll
        for (int b = 0; b < 2; ++b)
#pragma unroll
            for (int m = 0; m < 4; ++m)
#pragma unroll
                for (int n = 0; n < 2; ++n) { acc[a][b][m][n] = (f32x4){0.f, 0.f, 0.f, 0.f}; }
    bf16x8 At[4][2], B0[2][2], B1[2][2];
    v8i32_t At8[4], B08[2], B18[2];
    const char* cA = (const char*)g.A + (size_t)cur.pm * tstepA; const char* cB = (const char*)g.Bt + (size_t)cur.pn * tstep;
    S.a_ready(cur);
    if constexpr (SP2) {
        PG8_STAGE(PG8_SB(0, 0), cB, voffB); PG8_STAGE(PG8_SB(0, 1), cB + hstep, voffB); PG8_STAGEA(PG8_SA(0, 0), cA); PG8_STAGEA(PG8_SA(0, 1), cA + hstepA);
        if (wr == 1) PG8_BAR;
        PG8_WAIT_V(2); PG8_BAR;
        PG8_STAGE(PG8_SB(1, 0), cB + kstep, voffB); PG8_STAGEA(PG8_SA(1, 0), cA + kstepA); PG8_STAGE(PG8_SB(1, 1), cB + hstep + kstep, voffB);
        PG8_WAIT_V(6); PG8_BAR;
    } else {
        PG8_STAGE(PG8_SB(0, 0), cB, voffB); PG8_STAGEA(PG8_SA(0, 0), cA); PG8_STAGE(PG8_SB(0, 1), cB + hstep, voffB); PG8_STAGEA(PG8_SA(0, 1), cA + hstepA);
        if (wr == 1) PG8_BAR;
        PG8_WAIT_V(4); PG8_BAR;
        PG8_STAGE(PG8_SB(1, 0), cB + kstep, voffB); PG8_STAGEA(PG8_SA(1, 0), cA + kstepA); PG8_STAGE(PG8_SB(1, 1), cB + hstep + kstep, voffB);
        PG8_WAIT_V(6); PG8_BAR;
    }
    for (;;) {
        const bool has_next = S.next(ui + 1, nxt);
        const char* nA = has_next ? (const char*)g.A + (size_t)nxt.pm * tstepA : cA; const char* nB = has_next ? (const char*)g.Bt + (size_t)nxt.pn * tstep : cB;
#pragma unroll 1
        for (int t = 0; t < nt; t += 2) {
            const bool last = (t == nt - 2);
            const char* a1 = cA + (size_t)(t + 1) * kstepA;
            const char* a2 = last ? nA : cA + (size_t)(t + 2) * kstepA; const char* b2 = last ? nB : cB + (size_t)(t + 2) * kstep;
            const char* a3 = a2 + kstepA; const char* b3 = b2 + kstep;
            if (last && has_next) S.a_ready(nxt);
            if constexpr (SP2) {
            PG8_LDB(B0, 0, 0); PG8_LDB(B1, 0, 1); PG8_SCHED; PG8_LDA(At, 0, 0); PG8_STAGEA(PG8_SA(1, 1), a1 + hstepA);
            PG8_WAIT_V(8); PG8_WAIT_L(0); PG8_BAR; PG8_MMA(0, 0, At, B0); PG8_MMA(0, 1, At, B1); PG8_BAR; PG8_SCHED;
            PG8_LDA(At, 0, 1); PG8_STAGE(PG8_SB(0, 0), b2, voffB); PG8_STAGE(PG8_SB(0, 1), b2 + hstep, voffB); PG8_STAGEA(PG8_SA(0, 0), a2);
            PG8_WAIT_V(8); PG8_WAIT_L(0); PG8_BAR; PG8_MMA(1, 0, At, B0); PG8_MMA(1, 1, At, B1); PG8_BAR; PG8_SCHED;
            PG8_LDB(B0, 1, 0); PG8_LDB(B1, 1, 1); PG8_SCHED; PG8_LDA(At, 1, 0); PG8_STAGEA(PG8_SA(0, 1), a2 + hstepA);
            PG8_WAIT_V(8); PG8_WAIT_L(0); PG8_BAR; PG8_MMA(0, 0, At, B0); PG8_MMA(0, 1, At, B1); PG8_BAR; PG8_SCHED;
            PG8_LDA(At, 1, 1); PG8_STAGE(PG8_SB(1, 0), b3, voffB); PG8_STAGE(PG8_SB(1, 1), b3 + hstep, voffB); PG8_STAGEA(PG8_SA(1, 0), a3);
            PG8_WAIT_V(8); PG8_WAIT_L(0); PG8_BAR; PG8_MMA(1, 0, At, B0); PG8_MMA(1, 1, At, B1); PG8_BAR; PG8_SCHED;
            } else {
            PG8_LDB(B0, 0, 0); PG8_SCHED; PG8_LDA(At, 0, 0); PG8_STAGEA(PG8_SA(1, 1), a1 + hstepA);
            PG8_WAIT_L(8); PG8_BAR; PG8_WAIT_L(0); PG8_MMA(0, 0, At, B0); PG8_BAR; PG8_SCHED;
            PG8_LDB(B1, 0, 1); PG8_STAGE(PG8_SB(0, 0), b2, voffB);
            PG8_BAR; PG8_WAIT_L(0); PG8_MMA(0, 1, At, B1); PG8_BAR;
            PG8_LDA(At, 0, 1); PG8_STAGEA(PG8_SA(0, 0), a2);
            PG8_BAR; PG8_WAIT_L(0); PG8_MMA(1, 0, At, B0); PG8_BAR; PG8_SCHED;
            PG8_STAGE(PG8_SB(0, 1), b2 + hstep, voffB);
            PG8_WAIT_V(6); PG8_BAR; PG8_MMA(1, 1, At, B1); PG8_BAR;
            PG8_LDB(B0, 1, 0); PG8_SCHED; PG8_LDA(At, 1, 0); PG8_STAGEA(PG8_SA(0, 1), a2 + hstepA);
            PG8_WAIT_L(8); PG8_BAR; PG8_WAIT_L(0); PG8_MMA(0, 0, At, B0); PG8_BAR; PG8_SCHED;
            PG8_LDB(B1, 1, 1); PG8_STAGE(PG8_SB(1, 0), b3, voffB);
            PG8_BAR; PG8_WAIT_L(0); PG8_MMA(0, 1, At, B1); PG8_BAR;
            PG8_LDA(At, 1, 1); PG8_STAGEA(PG8_SA(1, 0), a3);
            PG8_BAR; PG8_WAIT_L(0); PG8_MMA(1, 0, At, B0); PG8_BAR; PG8_SCHED;
            PG8_STAGE(PG8_SB(1, 1), b3 + hstep, voffB);
            PG8_WAIT_V(6); PG8_BAR; PG8_MMA(1, 1, At, B1); PG8_BAR;
            }
        }
        if constexpr (ALIGN_EPI) { if (wr == 0) PG8_BAR; }
        if constexpr (!Epi::AFTER_DRAIN) { E(acc, cur, wr, wc, fr, fq); S.done(cur); }
        if (!has_next) break;
#pragma unroll
        for (int a = 0; a < 2; ++a)
#pragma unroll
            for (int b = 0; b < 2; ++b)
#pragma unroll
                for (int m = 0; m < 4; ++m)
#pragma unroll
                    for (int n = 0; n < 2; ++n) { acc[a][b][m][n] = (f32x4){0.f, 0.f, 0.f, 0.f}; }
        cur = nxt; cA = nA; cB = nB; ++ui;
        if constexpr (ALIGN_EPI) { if (wr == 1) PG8_BAR; }
    }
    PG8_WAIT_V(0);
    if constexpr (!ALIGN_EPI) { if (wr == 0) PG8_BAR; }
    PG8_BAR;
    if constexpr (Epi::AFTER_DRAIN) { E.fused(acc, cur, wr, wc, fr, fq, lds, wid, lane); S.done(cur); }
#undef PG8_SA
#undef PG8_SB
#undef PG8_STAGE
#undef PG8_STAGEA
#undef PG8_TR
#undef PG8_LDA
#undef PG8_LDB
#undef PG8_MMA
#undef PG8_WAIT_V
#undef PG8_WAIT_L
#undef PG8_BAR
#undef PG8_SCHED
}
__device__ __forceinline__ int tid_now_() { int t_ = threadIdx.x; asm volatile("" : "+v"(t_)); return t_; }
template <class Epi, class Sched, bool FP8 = false, int KC = 0>
__device__ __forceinline__ void gemm_phase_gather(PG8_LAS unsigned char* lds, const Gemm g, const int* arow, const Sched& S, const Epi& E) {
    constexpr bool ALIGN_EPI = true, SP2 = true;
    int tid_ = threadIdx.x; asm volatile("" : "+v"(tid_));
    const int tid = tid_, wid = __builtin_amdgcn_readfirstlane(tid >> 6), lane = tid & 63, wr = wid >> 2, wc = wid & 3, fr = lane & 15, fq = lane >> 4;
    const int K = KC > 0 ? KC : g.K, nt = K / BK;
    unsigned voffA[1], voffB[1];
    { int R, C; stage_rc(tid * 16, R, C); const int Rb = Epi::PERM ? ((R & ~31) + perm32(R & 31)) : R;
        voffA[0] = (unsigned)(R * K + C) * 2u; voffB[0] = (unsigned)(Rb * K + C) * 2u; }
    const size_t pstep = (size_t)64 * K * 2;
    const size_t kstep = (size_t)(BK * 2);
    const size_t hstep = (size_t)HALF * K * 2;
    const size_t tstep = 2 * hstep;
    const unsigned ldsw = (unsigned)wid * 1024u;
    const int aoff = lds_byte(wr * 64 + fr, fq * 8), boff = lds_byte(wc * 32 + fr, fq * 8);
#define PG8_SA(b, h) (((b) * 2 + (h)) * HTB)
#define PG8_SB(b, h) ((4 + (b) * 2 + (h)) * HTB)
#define PG8_STAGE(bufoff, gbase, voff) do { _Pragma("unroll") for (int _i = 0; _i < 2; ++_i) \
        __builtin_amdgcn_global_load_lds((const unsigned*)((const char*)(gbase) + _i * pstep + (voff)[0]), (PG8_LAS unsigned*)(lds + (bufoff) + ldsw + _i * 8192), 16, 0, 0); } while (0)
#define PG8_LDA(dst, b, h) do { _Pragma("unroll") for (int m = 0; m < 4; ++m) { if constexpr (FP8) dst##8[m] = cat8(*(const PG8_LAS bf16x8*)(lds + PG8_SA(b, h) + aoff + m * 2048), *(const PG8_LAS bf16x8*)(lds + PG8_SA(b, h) + aoff + m * 2048 + 1024)); \
        else { _Pragma("unroll") for (int k = 0; k < 2; ++k) dst[m][k] = *(const PG8_LAS bf16x8*)(lds + PG8_SA(b, h) + aoff + m * 2048 + k * 1024); } } } while (0)
#define PG8_LDB(dst, b, h) do { _Pragma("unroll") for (int n = 0; n < 2; ++n) { if constexpr (FP8) dst##8[n] = cat8(*(const PG8_LAS bf16x8*)(lds + PG8_SB(b, h) + boff + n * 2048), *(const PG8_LAS bf16x8*)(lds + PG8_SB(b, h) + boff + n * 2048 + 1024)); \
        else { _Pragma("unroll") for (int k = 0; k < 2; ++k) dst[n][k] = *(const PG8_LAS bf16x8*)(lds + PG8_SB(b, h) + boff + n * 2048 + k * 1024); } } } while (0)
#define PG8_MMA(ai, bj, At, Bt) do { __builtin_amdgcn_s_setprio(1);     \
        if constexpr (FP8) { _Pragma("unroll") for (int m = 0; m < 4; ++m) _Pragma("unroll") for (int n = 0; n < 2; ++n) \
            acc[ai][bj][m][n] = __builtin_amdgcn_mfma_scale_f32_16x16x128_f8f6f4(Bt##8[n], At##8[m], acc[ai][bj][m][n], 0, 0, 0, 0x7f7f7f7f, 0, 0x7f7f7f7f); } \
        else { _Pragma("unroll") for (int m = 0; m < 4; ++m) _Pragma("unroll") for (int n = 0; n < 2; ++n) _Pragma("unroll") for (int k = 0; k < 2; ++k) \
            acc[ai][bj][m][n] = __builtin_amdgcn_mfma_f32_16x16x32_bf16(Bt[n][k], At[m][k], acc[ai][bj][m][n], 0, 0, 0); } \
        __builtin_amdgcn_s_setprio(0); } while (0)
#define PG8_WAIT_V(n) asm volatile("s_waitcnt vmcnt(" #n ")" ::: "memory")
#define PG8_WAIT_L(n) asm volatile("s_waitcnt lgkmcnt(" #n ")" ::: "memory")
#define PG8_BAR __builtin_amdgcn_s_barrier()
#define PG8_SCHED __builtin_amdgcn_sched_barrier(0)
    Unit cur, nxt; int ui = 0;
    if (!S.next(0, cur)) return;
    f32x4 acc[2][2][4][2];
#pragma unroll
    for (int a = 0; a < 2; ++a)
#pragma unroll
        for (int b = 0; b < 2; ++b)
#pragma unroll
            for (int m = 0; m < 4; ++m)
#pragma unroll
                for (int n = 0; n < 2; ++n) { acc[a][b][m][n] = (f32x4){0.f, 0.f, 0.f, 0.f}; }
    bf16x8 At[4][2], B0[2][2], B1[2][2];
    v8i32_t At8[4], B08[2], B18[2];
    const char* cB = (const char*)g.Bt + (size_t)cur.pn * tstep;
    int R0_, C0_; stage_rc(tid * 16, R0_, C0_);
    const unsigned rowb = (unsigned)(K * 2), colb = (unsigned)(C0_ * 2);
#define ost ((PG8_LAS unsigned*)(lds + STAGE_BYTES) + tid_now_() * 8)
#define cbuf (ui & 1)
#pragma unroll
    for (int h = 0; h < 2; ++h)
#pragma unroll
        for (int i = 0; i < 2; ++i) ost[h * 2 + i] = (unsigned)arow[cur.pm * BM + h * HALF + 64 * i + R0_] * rowb + colb;
#define PG8_STAGE_A(bufoff, h, kb, nx) do { typedef unsigned u32x2s_ __attribute__((ext_vector_type(2))); \
        const u32x2s_ o_ = *(const PG8_LAS u32x2s_*)(ost + (((nx) ? (cbuf ^ 1) : cbuf) * 4 + (h) * 2)); _Pragma("unroll") for (int _i = 0; _i < 2; ++_i) \
        __builtin_amdgcn_global_load_lds((const unsigned*)((const char*)g.A + (size_t)(kb) + o_[_i]), (PG8_LAS unsigned*)(lds + (bufoff) + ldsw + _i * 8192), 16, 0, 0); } while (0)
    S.a_ready(cur);
    if constexpr (SP2) {
        PG8_STAGE(PG8_SB(0, 0), cB, voffB); PG8_STAGE(PG8_SB(0, 1), cB + hstep, voffB); PG8_STAGE_A(PG8_SA(0, 0), 0, 0, false); PG8_STAGE_A(PG8_SA(0, 1), 1, 0, false);
        if (wr == 1) PG8_BAR;
        PG8_WAIT_V(2); PG8_BAR;
        PG8_STAGE(PG8_SB(1, 0), cB + kstep, voffB); PG8_STAGE_A(PG8_SA(1, 0), 0, kstep, false); PG8_STAGE(PG8_SB(1, 1), cB + hstep + kstep, voffB);
        PG8_WAIT_V(6); PG8_BAR;
    }
    for (;;) {
        const bool has_next = S.next(ui + 1, nxt);
        const char* nB = has_next ? (const char*)g.Bt + (size_t)nxt.pn * tstep : cB;
        int tu_ = threadIdx.x; asm volatile("" : "+v"(tu_)); int R1_, C1_; stage_rc(tu_ * 16, R1_, C1_);
#pragma unroll
        for (int h = 0; h < 2; ++h)
#pragma unroll
            for (int i = 0; i < 2; ++i) ost[(cbuf ^ 1) * 4 + h * 2 + i] = has_next ? (unsigned)arow[nxt.pm * BM + h * HALF + 64 * i + R1_] * rowb + (unsigned)(C1_ * 2) : ost[cbuf * 4 + h * 2 + i];
#pragma unroll 1
        for (int t = 0; t < nt; t += 2) {
            const bool last = (t == nt - 2);
            const size_t k1 = (size_t)(t + 1) * kstep, k2 = last ? 0 : (size_t)(t + 2) * kstep, k3 = k2 + kstep;
            const char* b2 = last ? nB : cB + (size_t)(t + 2) * kstep; const char* b3 = b2 + kstep;
            if (last && has_next) S.a_ready(nxt);
            if constexpr (SP2) {
            PG8_LDB(B0, 0, 0); PG8_LDB(B1, 0, 1); PG8_SCHED; PG8_LDA(At, 0, 0); PG8_STAGE_A(PG8_SA(1, 1), 1, k1, false);
            PG8_WAIT_V(8); PG8_WAIT_L(0); PG8_BAR; PG8_MMA(0, 0, At, B0); PG8_MMA(0, 1, At, B1); PG8_BAR; PG8_SCHED;
            PG8_LDA(At, 0, 1); PG8_STAGE(PG8_SB(0, 0), b2, voffB); PG8_STAGE(PG8_SB(0, 1), b2 + hstep, voffB); PG8_STAGE_A(PG8_SA(0, 0), 0, k2, last);
            PG8_WAIT_V(8); PG8_WAIT_L(0); PG8_BAR; PG8_MMA(1, 0, At, B0); PG8_MMA(1, 1, At, B1); PG8_BAR; PG8_SCHED;
            PG8_LDB(B0, 1, 0); PG8_LDB(B1, 1, 1); PG8_SCHED; PG8_LDA(At, 1, 0); PG8_STAGE_A(PG8_SA(0, 1), 1, k2, last);
            PG8_WAIT_V(8); PG8_WAIT_L(0); PG8_BAR; PG8_MMA(0, 0, At, B0); PG8_MMA(0, 1, At, B1); PG8_BAR; PG8_SCHED;
            PG8_LDA(At, 1, 1); PG8_STAGE(PG8_SB(1, 0), b3, voffB); PG8_STAGE(PG8_SB(1, 1), b3 + hstep, voffB); PG8_STAGE_A(PG8_SA(1, 0), 0, k3, last);
            PG8_WAIT_V(8); PG8_WAIT_L(0); PG8_BAR; PG8_MMA(1, 0, At, B0); PG8_MMA(1, 1, At, B1); PG8_BAR; PG8_SCHED;
            }
        }
        if constexpr (ALIGN_EPI) { if (wr == 0) PG8_BAR; }
        if constexpr (!Epi::AFTER_DRAIN) { int te_ = threadIdx.x; asm volatile("" : "+v"(te_)); const int we_ = __builtin_amdgcn_readfirstlane(te_ >> 6);
            E(acc, cur, we_ >> 2, we_ & 3, te_ & 15, (te_ & 63) >> 4); S.done(cur); }
        if (!has_next) break;
#pragma unroll
        for (int a = 0; a < 2; ++a)
#pragma unroll
            for (int b = 0; b < 2; ++b)
#pragma unroll
                for (int m = 0; m < 4; ++m)
#pragma unroll
                    for (int n = 0; n < 2; ++n) { acc[a][b][m][n] = (f32x4){0.f, 0.f, 0.f, 0.f}; }
        cur = nxt; cB = nB; ++ui;
        if constexpr (ALIGN_EPI) { if (wr == 1) PG8_BAR; }
    }
    PG8_WAIT_V(0);
    if constexpr (!ALIGN_EPI) { if (wr == 0) PG8_BAR; }
    PG8_BAR;
    if constexpr (Epi::AFTER_DRAIN) { E.fused(acc, cur, wr, wc, fr, fq, lds, wid, lane); S.done(cur); }
#undef PG8_STAGE_A
#undef cbuf
#undef ost
#undef PG8_SA
#undef PG8_SB
#undef PG8_STAGE
#undef PG8_LDA
#undef PG8_LDB
#undef PG8_MMA
#undef PG8_WAIT_V
#undef PG8_WAIT_L
#undef PG8_BAR
#undef PG8_SCHED
}
}

typedef unsigned short bf16;
typedef unsigned v4u __attribute__((ext_vector_type(4)));
typedef unsigned v2u __attribute__((ext_vector_type(2)));
#define GAS __attribute__((address_space(1)))
#define LDS_WAIT() asm volatile("s_waitcnt lgkmcnt(0)" ::: "memory")
__device__ __forceinline__ unsigned f2bf(float f) { unsigned u = __builtin_bit_cast(unsigned, f); return (u + 0x7fffu + ((u >> 16) & 1u)) >> 16; }
__device__ __forceinline__ unsigned pk2(float lo, float hi) { return f2bf(lo) | (f2bf(hi) << 16); }
template <int MODE> __device__ __forceinline__ int tr_row(int n) {
    if (MODE == 1) return (n >> 7) * 256 + (n & 127);
    if (MODE == 2) { if (n < 384) return n; const int i = n - 384; return 384 + (i < 32 ? 2 * i : 2 * (i - 32) + 1); }
    if (MODE == 3) { const int h = n / 192, d = n - h * 192; if (d < 128) return n; const int i = d - 128; return h * 192 + 128 + (i < 32 ? 2 * i : 2 * (i - 32) + 1); }
    return n;
}
template <int MODE>
__device__ __forceinline__ void transpose_item(const float* W, int K, int N, bf16* WT, int row_off, LAS float* scr, int item, int lane, int ldk = 0) {
    if (ldk == 0) ldk = K;
    const int nblk = N / 32, kb = item / nblk, nb = item % nblk, k0 = 64 * kb, n0 = 32 * nb;
#pragma unroll 8
    for (int i = 0; i < 32; ++i) { const int kk = 2 * i + (lane >> 5); scr[kk * 33 + (lane & 31)] = W[(size_t)(k0 + kk) * N + n0 + (lane & 31)]; }
    LDS_WAIT(); asm volatile("" ::: "memory");
    const int c = lane & 7;
#pragma unroll
    for (int j = 0; j < 4; ++j) { const int n = (lane >> 3) + 8 * j; const LAS float* s = scr + (8 * c) * 33 + n;
        v4u o; o.x = pk2(s[0 * 33], s[1 * 33]); o.y = pk2(s[2 * 33], s[3 * 33]); o.z = pk2(s[4 * 33], s[5 * 33]); o.w = pk2(s[6 * 33], s[7 * 33]);
        *(GAS v4u*)(WT + (size_t)(row_off + tr_row<MODE>(n0 + n)) * ldk + k0 + 8 * c) = o; }
    LDS_WAIT(); asm volatile("" ::: "memory");
}
template <int MODE>
__device__ __forceinline__ void transpose_item_fp8(const float* W, int K, int N, unsigned char* WT, int row_off, LAS float* scr, int item, int lane) {
    const int nblk = N / 32, kb = item / nblk, nb = item % nblk, k0 = 64 * kb, n0 = 32 * nb;
#pragma unroll 8
    for (int i = 0; i < 32; ++i) { const int kk = 2 * i + (lane >> 5); scr[kk * 33 + (lane & 31)] = W[(size_t)(k0 + kk) * N + n0 + (lane & 31)]; }
    LDS_WAIT(); asm volatile("" ::: "memory");
    const int c = lane & 7;
#pragma unroll
    for (int j = 0; j < 4; ++j) { const int n = (lane >> 3) + 8 * j; const LAS float* s = scr + (8 * c) * 33 + n;
        v2u o; o.x = pg8::pack4_fp8(s[0 * 33] * 32.f, s[1 * 33] * 32.f, s[2 * 33] * 32.f, s[3 * 33] * 32.f); o.y = pg8::pack4_fp8(s[4 * 33] * 32.f, s[5 * 33] * 32.f, s[6 * 33] * 32.f, s[7 * 33] * 32.f);
        *(GAS v2u*)(WT + (size_t)(row_off + tr_row<MODE>(n0 + n)) * K + k0 + 8 * c) = o; }
    LDS_WAIT(); asm volatile("" ::: "memory");
}
__device__ __forceinline__ void mod_phase(int tid_in, unsigned char* lds_, const float* c, const float* ada_w, const float* ada_b, float* modp) {
  const int tid = launder(tid_in), wave = __builtin_amdgcn_readfirstlane(tid >> 6), lane = tid & 63;
  LAS float* cs = (LAS float*)lds_;
  LAS float* part = cs + NB * DM;
  __syncthreads();
  for (int q = tid; q < NB * DM; q += NTHR) { const float v = c[q]; cs[q] = v / (1.f + expf(-v)); }
  __syncthreads();
  const int col0 = bid() * 48, i = col0 / (6 * DM), j0 = col0 - i * 6 * DM;
  float acc[NB];
#pragma unroll
  for (int b = 0; b < NB; ++b) acc[b] = 0.f;
  if (lane < 48) {
    const float* w = ada_w + (size_t)i * DM * 6 * DM + j0 + lane;
#pragma unroll 8
    for (int kk = 0; kk < 128; ++kk) {
      const int k = wave * 128 + kk;
      const float wv = w[(size_t)k * 6 * DM];
#pragma unroll
      for (int b = 0; b < NB; ++b) acc[b] += cs[b * DM + k] * wv;
    }
#pragma unroll
    for (int b = 0; b < NB; ++b) part[(wave * NB + b) * 48 + lane] = acc[b];
  }
  __syncthreads();
  if (tid < NB * 48) {
    const int b = tid / 48, j = tid - b * 48;
    float sacc = ada_b[i * 6 * DM + j0 + j];
#pragma unroll
    for (int w8 = 0; w8 < 8; ++w8) sacc += part[(w8 * NB + b) * 48 + j];
    modp[(size_t)(i * NB + b) * 6 * DM + j0 + j] = sacc;
  }
  __syncthreads();
}

struct Args { const float* in[31]; float* out; unsigned char* ws; };

#define FOR_VB(n) for (int vb = bid() * 2 + (launder(tid) >> 8); vb < (n); vb += GRID * 2) \
    if (const int t = launder(tid) & 255; true) if (float* sm = (float*)(lds + (launder(tid) >> 8) * HALF_LDS); true)
#define GB() do { XcdBarrier b_; b_.bar = (unsigned*)WSB + 4096; b_.x = 0; b_.st = (volatile LAS unsigned*)((LAS unsigned char*)lds + (LDS_BYTES - 256)) + 8; xcd_barrier(b_); } while (0)

typedef float f32x4_t __attribute__((ext_vector_type(4)));

template <int M> __device__ __forceinline__ float swz_xor(float v) { return __uint_as_float((unsigned)__builtin_amdgcn_ds_swizzle((int)__float_as_uint(v), (M << 10) | 0x1f)); }
__device__ __forceinline__ float sum_x32(float v) { auto rr = __builtin_amdgcn_permlane32_swap(__float_as_uint(v), __float_as_uint(v), false, false); return __uint_as_float(rr[0]) + __uint_as_float(rr[1]); }
__device__ __forceinline__ float max_x32(float v) { auto rr = __builtin_amdgcn_permlane32_swap(__float_as_uint(v), __float_as_uint(v), false, false); return fmaxf(__uint_as_float(rr[0]), __uint_as_float(rr[1])); }
__device__ __forceinline__ float get_x32(float v, bool hi) { auto rr = __builtin_amdgcn_permlane32_swap(__float_as_uint(v), __float_as_uint(v), false, false); return hi ? __uint_as_float(rr[0]) : __uint_as_float(rr[1]); }
__device__ __forceinline__ float wsum64(float v) {
  v += swz_xor<1>(v); v += swz_xor<2>(v); v += swz_xor<4>(v); v += swz_xor<8>(v); v += swz_xor<16>(v);
  return sum_x32(v);
}
__device__ __forceinline__ float router_reduce(const float* acc, int lane) {
  float a8[8], a4[4], a2[2], a1;
  { const bool hi = (lane & 32) != 0;
#pragma unroll
    for (int i = 0; i < 8; ++i) { const float keep = hi ? acc[i + 8] : acc[i], send = hi ? acc[i] : acc[i + 8]; a8[i] = keep + get_x32(send, hi); } }
  { const bool hi = (lane & 16) != 0;
#pragma unroll
    for (int i = 0; i < 4; ++i) { const float keep = hi ? a8[i + 4] : a8[i], send = hi ? a8[i] : a8[i + 4]; a4[i] = keep + swz_xor<16>(send); } }
  { const bool hi = (lane & 8) != 0;
#pragma unroll
    for (int i = 0; i < 2; ++i) { const float keep = hi ? a4[i + 2] : a4[i], send = hi ? a4[i] : a4[i + 2]; a2[i] = keep + swz_xor<8>(send); } }
  { const bool hi = (lane & 4) != 0; const float keep = hi ? a2[1] : a2[0], send = hi ? a2[0] : a2[1]; a1 = keep + swz_xor<4>(send); }
  a1 += swz_xor<1>(a1); a1 += swz_xor<2>(a1);
  return a1;
}
template <bool ROUTER>
__device__ __forceinline__ void norm_rows_phase(int tid_in, unsigned char* lds, const float* xin, const float* gnorm, const float* sh, const float* sc,
                                                bf16* XN, const float* wr, float* aff) {
  const int tid = launder(tid_in), wave = __builtin_amdgcn_readfirstlane(tid >> 6), lane = tid & 63;
  LAS float* wl = (LAS float*)lds;
  constexpr int NR = ROUTER ? 4 : 2;
  if (ROUTER) {
    __syncthreads();
    for (int q = tid; q < DM * NE / 4; q += NTHR) { const f32x4_t w4 = ((const f32x4_t*)wr)[q]; const int k = q >> 2, e0 = (q & 3) * 4;
      wl[(e0 + 0) * DM + k] = w4.x; wl[(e0 + 1) * DM + k] = w4.y; wl[(e0 + 2) * DM + k] = w4.z; wl[(e0 + 3) * DM + k] = w4.w; }
    __syncthreads();
  }
  for (int rp = bid() * 8 + wave; rp < NTOK / NR; rp += GRID * 8) {
    const int row0 = NR * rp, b = row0 / SEQ;
    float rs[NR];
#pragma unroll
    for (int r = 0; r < NR; ++r) {
      const f32x4_t* xr = (const f32x4_t*)(xin + (size_t)(row0 + r) * DM) + lane; float ss = 0.f;
#pragma unroll
      for (int j = 0; j < 4; ++j) { const f32x4_t v = xr[64 * j]; ss += (v.x * v.x + v.y * v.y) + (v.z * v.z + v.w * v.w); }
      rs[r] = rsqrtf(wsum64(ss) * (1.f / DM) + 1e-6f);
    }
    float acc[NR][NE];
#pragma unroll
    for (int r = 0; r < NR; ++r)
#pragma unroll
      for (int e = 0; e < NE; ++e) acc[r][e] = 0.f;
#pragma unroll 1
    for (int j = 0; j < 4; ++j) {
      const int cj = launder(lane + 64 * j);
      const f32x4_t gg = ((const f32x4_t*)gnorm)[cj];
      const f32x4_t s1 = ((const f32x4_t*)(sc + (size_t)b * 6 * DM))[cj];
      const f32x4_t s0 = ((const f32x4_t*)(sh + (size_t)b * 6 * DM))[cj];
      f32x4_t y[NR];
#pragma unroll
      for (int r = 0; r < NR; ++r) {
        y[r] = ((const f32x4_t*)(xin + (size_t)(row0 + r) * DM))[cj] * rs[r] * gg * (s1 + 1.0f) + s0;
        if (ROUTER) ((unsigned*)((unsigned char*)XN + (size_t)(row0 + r) * DM))[cj] = pg8::pack4_fp8(y[r].x, y[r].y, y[r].z, y[r].w);
        else { uint2 w; w.x = pk2(y[r].x, y[r].y); w.y = pk2(y[r].z, y[r].w);
        ((uint2*)(XN + (size_t)(row0 + r) * DM))[cj] = w; }
      }
      if (ROUTER) {
        const unsigned wofs = (unsigned)cj * 16u;
#pragma unroll
        for (int e = 0; e < NE; ++e) {
          const f32x4_t w4 = *(const LAS f32x4_t*)((LAS unsigned char*)wl + wofs + e * (DM * 4));
#pragma unroll
          for (int r = 0; r < NR; ++r) acc[r][e] += (y[r].x * w4.x + y[r].y * w4.y) + (y[r].z * w4.z + y[r].w * w4.w);
        }
      }
    }
    if (ROUTER) {
#pragma unroll
      for (int r = 0; r < NR; ++r) {
        const float a1 = router_reduce(acc[r], lane);
        float mx = a1;
        mx = fmaxf(mx, swz_xor<4>(mx)); mx = fmaxf(mx, swz_xor<8>(mx)); mx = fmaxf(mx, swz_xor<16>(mx)); mx = max_x32(mx);
        const float p = expf(a1 - mx);
        float sm_ = p;
        sm_ += swz_xor<4>(sm_); sm_ += swz_xor<8>(sm_); sm_ += swz_xor<16>(sm_); sm_ = sum_x32(sm_);
        if ((lane & 3) == 0) aff[((size_t)b * NE + (lane >> 2)) * SEQ + (row0 + r - b * SEQ)] = p / sm_;
      }
    }
  }
}

__device__ __forceinline__ void topk_phase(int tid_in, unsigned char* lds, const float* aff, int* idx_row, float* gsel_row, int* slot_of) {
  const int tid = launder(tid_in), wave = __builtin_amdgcn_readfirstlane(tid >> 6), lane = tid & 63;
  LAS unsigned* hist = (LAS unsigned*)lds;
  LAS unsigned* bc = hist + 256;
  LAS unsigned* wtot = hist + 272;
  for (int be = bid(); be < NB * NE; be += GRID) {
    const int b = be / NE, e = be % NE;
    unsigned v[8];
    { const uint4* src = (const uint4*)(aff + (size_t)be * SEQ) + 2 * tid; const uint4 p0 = src[0], p1 = src[1];
      v[0] = p0.x; v[1] = p0.y; v[2] = p0.z; v[3] = p0.w; v[4] = p1.x; v[5] = p1.y; v[6] = p1.z; v[7] = p1.w; }
    unsigned prefix = 0u, need = CAP;
#pragma unroll 1
    for (int pass = 0; pass < 4; ++pass) {
      const int shift = 24 - 8 * pass;
      __syncthreads();
      if (tid < 256) hist[tid] = 0u;
      __syncthreads();
#pragma unroll
      for (int i = 0; i < 8; ++i) {
        const bool match = (pass == 0) || ((v[i] >> (shift + 8)) == prefix);
        if (match) __hip_atomic_fetch_add(&hist[(v[i] >> shift) & 255u], 1u, __ATOMIC_RELAXED, __HIP_MEMORY_SCOPE_WORKGROUP);
      }
      __syncthreads();
      if (wave == 0) {
        const unsigned c0 = hist[4 * lane], c1 = hist[4 * lane + 1], c2 = hist[4 * lane + 2], c3 = hist[4 * lane + 3];
        const unsigned cs = c0 + c1 + c2 + c3;
        unsigned suf = cs;
#pragma unroll
        for (int o = 1; o < 64; o <<= 1) { const unsigned t2 = (unsigned)__builtin_amdgcn_ds_bpermute(((lane + o) & 63) << 2, (int)suf); if (lane + o < 64) suf += t2; }
        const unsigned above = suf - cs;
        if (suf >= need && above < need) {
          unsigned ab = above, bin;
          if (ab + c3 >= need) bin = 3; else { ab += c3; if (ab + c2 >= need) bin = 2; else { ab += c2; if (ab + c1 >= need) bin = 1; else { ab += c1; bin = 0; } } }
          bc[0] = 4 * lane + bin; bc[1] = ab;
        }
      }
      __syncthreads();
      prefix = (prefix << 8) | bc[0];
      need -= bc[1];
    }
    unsigned cg = 0u, ce = 0u;
#pragma unroll
    for (int i = 0; i < 8; ++i) { cg += (v[i] > prefix) ? 1u : 0u; ce += (v[i] == prefix) ? 1u : 0u; }
    unsigned pk = cg | (ce << 16), inc = pk;
#pragma unroll
    for (int o = 1; o < 64; o <<= 1) { const unsigned t2 = (unsigned)__builtin_amdgcn_ds_bpermute(((lane - o) & 63) << 2, (int)inc); if (lane >= o) inc += t2; }
    __syncthreads();
    if (lane == 63) wtot[wave] = inc;
    __syncthreads();
    unsigned base = 0u;
#pragma unroll
    for (int w = 0; w < 8; ++w) if (w < wave) base += wtot[w];
    unsigned ex = base + inc - pk;
    unsigned gtb = ex & 0xffffu, eqb = ex >> 16;
#pragma unroll
    for (int i = 0; i < 8; ++i) {
      const int t = 8 * tid + i;
      const bool gt = v[i] > prefix, eq = v[i] == prefix;
      const bool sel = gt || (eq && eqb < need);
      const unsigned slot = gtb + (eqb < need ? eqb : need);
      if (sel) { const size_t r = (size_t)e * (NB * CAP) + b * CAP + slot; idx_row[r] = b * SEQ + t; gsel_row[r] = __uint_as_float(v[i]); }
      slot_of[(size_t)be * SEQ + t] = sel ? (int)slot : -1;
      gtb += gt ? 1u : 0u; eqb += eq ? 1u : 0u;
    }
  }
}

__device__ __forceinline__ void gather_phase(int tid_in, const bf16* XN, const int* idx_row, bf16* XS) {
  const int tid = launder(tid_in), wave = __builtin_amdgcn_readfirstlane(tid >> 6), lane = tid & 63;
  for (int r = bid() * 8 + wave; r < NE * NB * CAP; r += GRID * 8) {
    const int src = idx_row[r];
    const uint4* s = (const uint4*)(XN + (size_t)src * DM) + lane;
    uint4* d = (uint4*)(XS + (size_t)r * DM) + lane;
    const uint4 a = s[0], c = s[64];
    d[0] = a; d[64] = c;
  }
}

template <bool FINAL>
__device__ __forceinline__ void combine_norm_phase(int tid_in, bf16* xb, float* xfin, const bf16* ye, const int* slot_of, const float* g2, const float* gnext, const float* sh, const float* sc, bf16* XN) {
  const int tid = launder(tid_in), wave = __builtin_amdgcn_readfirstlane(tid >> 6), lane = tid & 63;
  for (int row = bid() * 8 + wave; row < NTOK; row += GRID * 8) {
    const int b = row / SEQ, t = row - b * SEQ;
    const int myslot = slot_of[((size_t)b * NE + (lane & 15)) * SEQ + t];
    uint2* xr = (uint2*)(xb + (size_t)row * DM) + lane;
    uint2 xw[4];
#pragma unroll
    for (int j = 0; j < 4; ++j) xw[j] = xr[64 * j];
    unsigned long long m = __ballot(myslot >= 0) & 0xffffull;
    f32x4_t acc[4];
#pragma unroll
    for (int j = 0; j < 4; ++j) acc[j] = (f32x4_t){0.f, 0.f, 0.f, 0.f};
    while (m) {
      const int e0 = __builtin_ctzll(m); m &= m - 1;
      const int e1 = m ? __builtin_ctzll(m) : -1; if (m) m &= m - 1;
      const int s0 = __builtin_amdgcn_readlane(myslot, e0);
      const unsigned* y0 = (const unsigned*)((const unsigned char*)ye + ((size_t)e0 * (NB * CAP) + b * CAP + s0) * DM) + lane;
      unsigned w0[4], w1[4];
#pragma unroll
      for (int j = 0; j < 4; ++j) w0[j] = y0[64 * j];
      if (e1 >= 0) {
        const int s1 = __builtin_amdgcn_readlane(myslot, e1);
        const unsigned* y1 = (const unsigned*)((const unsigned char*)ye + ((size_t)e1 * (NB * CAP) + b * CAP + s1) * DM) + lane;
#pragma unroll
        for (int j = 0; j < 4; ++j) w1[j] = y1[64 * j];
      } else {
#pragma unroll
        for (int j = 0; j < 4; ++j) w1[j] = 0u;
      }
#pragma unroll
      for (int j = 0; j < 4; ++j) {
        const auto a0 = __builtin_amdgcn_cvt_pk_f32_fp8((int)w0[j], false), a1 = __builtin_amdgcn_cvt_pk_f32_fp8((int)w0[j], true);
        const auto b0 = __builtin_amdgcn_cvt_pk_f32_fp8((int)w1[j], false), b1 = __builtin_amdgcn_cvt_pk_f32_fp8((int)w1[j], true);
        acc[j].x += a0[0] + b0[0]; acc[j].y += a0[1] + b0[1]; acc[j].z += a1[0] + b1[0]; acc[j].w += a1[1] + b1[1]; }
    }
    float ss = 0.f;
#pragma unroll
    for (int j = 0; j < 4; ++j) { const f32x4_t gv = ((const f32x4_t*)(g2 + (size_t)b * 6 * DM))[lane + 64 * j] * (1.f / 16.f);
      const f32x4_t xv = {__uint_as_float(xw[j].x << 16), __uint_as_float(xw[j].x & 0xffff0000u), __uint_as_float(xw[j].y << 16), __uint_as_float(xw[j].y & 0xffff0000u)}; acc[j] = xv + gv * acc[j];
      ss += (acc[j].x * acc[j].x + acc[j].y * acc[j].y) + (acc[j].z * acc[j].z + acc[j].w * acc[j].w); }
    const float r = rsqrtf(wsum64(ss) * (1.f / DM) + 1e-6f);
#pragma unroll
    for (int j = 0; j < 4; ++j) {
      const f32x4_t gg = ((const f32x4_t*)gnext)[lane + 64 * j];
      if (FINAL) ((f32x4_t*)(xfin + (size_t)row * DM) + lane)[64 * j] = acc[j] * r * gg;
      else {
        { uint2 w; w.x = pk2(acc[j].x, acc[j].y); w.y = pk2(acc[j].z, acc[j].w); xr[64 * j] = w; }
        const f32x4_t s1 = ((const f32x4_t*)(sc + (size_t)b * 6 * DM))[lane + 64 * j], s0 = ((const f32x4_t*)(sh + (size_t)b * 6 * DM))[lane + 64 * j];
        const f32x4_t y = acc[j] * r * gg * (s1 + 1.0f) + s0;
        uint2 w; w.x = pk2(y.x, y.y); w.y = pk2(y.z, y.w);
        ((uint2*)(XN + (size_t)row * DM) + lane)[64 * j] = w;
      }
    }
  }
}

typedef short bf16x8_t __attribute__((ext_vector_type(8)));
typedef float f32x16_t __attribute__((ext_vector_type(16)));
__device__ __forceinline__ float bflo(unsigned w) { return __uint_as_float(w << 16); }
__device__ __forceinline__ float bfhi(unsigned w) { return __uint_as_float(w & 0xffff0000u); }
__device__ __forceinline__ void unpack8(const v4u v, float* f) { f[0] = bflo(v.x); f[1] = bfhi(v.x); f[2] = bflo(v.y); f[3] = bfhi(v.y); f[4] = bflo(v.z); f[5] = bfhi(v.z); f[6] = bflo(v.w); f[7] = bfhi(v.w); }

__device__ __forceinline__ void norm_router_phase(int tid_in, unsigned char* lds_, const bf16* xin, const float* gnorm, const float* sh, const float* sc,
                                                  unsigned char* XN8, const float* wr, float* aff) {
  const int tid = launder(tid_in), wave = __builtin_amdgcn_readfirstlane(tid >> 6), lane = tid & 63, r = lane & 15, kg = lane >> 4;
  LAS unsigned char* lds = (LAS unsigned char*)lds_;
  constexpr int O_A = 0, O_S0 = 4096, O_SS = 8192, O_LP = 9216, O_CP = 25600;
  const int b = bid() / (SEQ / 128), rowW = bid() * 128, c0 = wave * 128 + kg * 8;
  __syncthreads();
  for (int k = tid; k < DM; k += NTHR) {
    *(LAS float*)(lds + O_A + k * 4) = gnorm[k] * (sc[(size_t)b * 6 * DM + k] + 1.0f); *(LAS float*)(lds + O_S0 + k * 4) = sh[(size_t)b * 6 * DM + k]; }
  bf16x8_t bh[4], bl[4];
  { float cpart = 0.f;
#pragma unroll
    for (int ks = 0; ks < 4; ++ks) {
      float wv[8];
#pragma unroll
      for (int j = 0; j < 8; ++j) wv[j] = wr[(size_t)(c0 + 32 * ks + j) * NE + r];
      const f32x4_t s0 = *(const f32x4_t*)(sh + (size_t)b * 6 * DM + c0 + 32 * ks), s1 = *(const f32x4_t*)(sh + (size_t)b * 6 * DM + c0 + 32 * ks + 4);
      cpart += (s0.x * wv[0] + s0.y * wv[1]) + (s0.z * wv[2] + s0.w * wv[3]) + (s1.x * wv[4] + s1.y * wv[5]) + (s1.z * wv[6] + s1.w * wv[7]);
      unsigned h[4], l[4];
#pragma unroll
      for (int j = 0; j < 4; ++j) { h[j] = pg8::cvt_pk_bf16(wv[2 * j], wv[2 * j + 1]);
        l[j] = pg8::cvt_pk_bf16(wv[2 * j] - __uint_as_float(h[j] << 16), wv[2 * j + 1] - __uint_as_float(h[j] & 0xffff0000u)); }
      const v4u hu = {h[0], h[1], h[2], h[3]}, lu = {l[0], l[1], l[2], l[3]};
      bh[ks] = __builtin_bit_cast(bf16x8_t, hu); bl[ks] = __builtin_bit_cast(bf16x8_t, lu);
    }
    cpart += swz_xor<16>(cpart); cpart = sum_x32(cpart);
    if (kg == 0) *(LAS float*)(lds + O_CP + (wave * 16 + r) * 4) = cpart;
  }
  __syncthreads();
  float csum = 0.f;
#pragma unroll
  for (int w = 0; w < 8; ++w) csum += *(const LAS float*)(lds + O_CP + (w * 16 + (tid & 15)) * 4);
  const bf16* xp = xin + (size_t)(rowW + r) * DM + c0;
  unsigned char* xo = XN8 + (size_t)(rowW + r) * DM + c0;
  unsigned aoff = (unsigned)(O_A + c0 * 4), soff = (unsigned)(O_S0 + c0 * 4);
  asm volatile("" : "+v"(aoff), "+v"(soff));
#define NR_LOAD(V, G) do { _Pragma("unroll") for (int ks = 0; ks < 4; ++ks) { const v4u r_ = *(const v4u*)(xp + (size_t)(G) * 16 * DM + 32 * ks); \
      V[2 * ks] = (f32x4_t){__uint_as_float(r_.x << 16), __uint_as_float(r_.x & 0xffff0000u), __uint_as_float(r_.y << 16), __uint_as_float(r_.y & 0xffff0000u)}; \
      V[2 * ks + 1] = (f32x4_t){__uint_as_float(r_.z << 16), __uint_as_float(r_.z & 0xffff0000u), __uint_as_float(r_.w << 16), __uint_as_float(r_.w & 0xffff0000u)}; } } while (0)
#define NR_PROC(V, G, BUF) do { \
    f32x4_t acc = {0.f, 0.f, 0.f, 0.f}; float ss = 0.f; \
    _Pragma("unroll") for (int ks = 0; ks < 4; ++ks) { \
      const f32x4_t a0 = *(const LAS f32x4_t*)(lds + aoff + 128 * ks), a1 = *(const LAS f32x4_t*)(lds + aoff + 128 * ks + 16); \
      const f32x4_t v0 = V[2 * ks], v1 = V[2 * ks + 1]; \
      ss += (v0.x * v0.x + v0.y * v0.y) + (v0.z * v0.z + v0.w * v0.w) + (v1.x * v1.x + v1.y * v1.y) + (v1.z * v1.z + v1.w * v1.w); \
      const f32x4_t y0 = v0 * a0, y1 = v1 * a1; V[2 * ks] = y0; V[2 * ks + 1] = y1; \
      const unsigned h0 = pg8::cvt_pk_bf16(y0.x, y0.y), h1 = pg8::cvt_pk_bf16(y0.z, y0.w), h2 = pg8::cvt_pk_bf16(y1.x, y1.y), h3 = pg8::cvt_pk_bf16(y1.z, y1.w); \
      const unsigned l0 = pg8::cvt_pk_bf16(y0.x - __uint_as_float(h0 << 16), y0.y - __uint_as_float(h0 & 0xffff0000u)), l1 = pg8::cvt_pk_bf16(y0.z - __uint_as_float(h1 << 16), y0.w - __uint_as_float(h1 & 0xffff0000u)); \
      const unsigned l2 = pg8::cvt_pk_bf16(y1.x - __uint_as_float(h2 << 16), y1.y - __uint_as_float(h2 & 0xffff0000u)), l3 = pg8::cvt_pk_bf16(y1.z - __uint_as_float(h3 << 16), y1.w - __uint_as_float(h3 & 0xffff0000u)); \
      const v4u ahu = {h0, h1, h2, h3}, alu = {l0, l1, l2, l3}; \
      const bf16x8_t ah = __builtin_bit_cast(bf16x8_t, ahu), al = __builtin_bit_cast(bf16x8_t, alu); \
      acc = __builtin_amdgcn_mfma_f32_16x16x32_bf16(ah, bh[ks], acc, 0, 0, 0); \
      acc = __builtin_amdgcn_mfma_f32_16x16x32_bf16(al, bh[ks], acc, 0, 0, 0); \
      acc = __builtin_amdgcn_mfma_f32_16x16x32_bf16(ah, bl[ks], acc, 0, 0, 0); } \
    ss += swz_xor<16>(ss); ss = sum_x32(ss); \
    if (kg == 0) *(LAS float*)(lds + O_SS + ((BUF) * 128 + wave * 16 + r) * 4) = ss; \
    _Pragma("unroll") for (int j = 0; j < 4; ++j) *(LAS float*)(lds + O_LP + ((BUF) * 2048 + wave * 256 + (4 * kg + j) * 16 + r) * 4) = acc[j]; \
    __syncthreads(); \
    { float st = 0.f; _Pragma("unroll") for (int w = 0; w < 8; ++w) st += *(const LAS float*)(lds + O_SS + ((BUF) * 128 + w * 16 + r) * 4); \
      const float rs = rsqrtf(st * (1.f / DM) + 1e-6f); \
      _Pragma("unroll") for (int ks = 0; ks < 4; ++ks) { \
        const f32x4_t s0 = *(const LAS f32x4_t*)(lds + soff + 128 * ks), s1 = *(const LAS f32x4_t*)(lds + soff + 128 * ks + 16); \
        const f32x4_t y0 = V[2 * ks] * rs + s0, y1 = V[2 * ks + 1] * rs + s1; \
        v2u o; o.x = pg8::pack4_fp8(y0.x, y0.y, y0.z, y0.w); o.y = pg8::pack4_fp8(y1.x, y1.y, y1.z, y1.w); \
        *(v2u*)(xo + (size_t)(G) * 16 * DM + 32 * ks) = o; } } \
    if (tid < 256) { const int row = tid >> 4, e = tid & 15; float st = 0.f, lg = 0.f; \
      _Pragma("unroll") for (int w = 0; w < 8; ++w) { st += *(const LAS float*)(lds + O_SS + ((BUF) * 128 + w * 16 + row) * 4); lg += *(const LAS float*)(lds + O_LP + ((BUF) * 2048 + w * 256 + tid) * 4); } \
      const float a1 = lg * rsqrtf(st * (1.f / DM) + 1e-6f) + csum; \
      float mx = a1; mx = fmaxf(mx, swz_xor<1>(mx)); mx = fmaxf(mx, swz_xor<2>(mx)); mx = fmaxf(mx, swz_xor<4>(mx)); mx = fmaxf(mx, swz_xor<8>(mx)); \
      const float p = expf(a1 - mx); \
      float sm_ = p; sm_ += swz_xor<1>(sm_); sm_ += swz_xor<2>(sm_); sm_ += swz_xor<4>(sm_); sm_ += swz_xor<8>(sm_); \
      aff[((size_t)b * NE + e) * SEQ + (rowW + (G) * 16 + row - b * SEQ)] = p / sm_; } \
  } while (0)
  f32x4_t va[8], vb[8];
  NR_LOAD(va, 0);
#pragma unroll 1
  for (int gi = 0; gi < 8; gi += 2) {
    NR_LOAD(vb, gi + 1);
    NR_PROC(va, gi, 0);
    if (gi + 2 < 8) NR_LOAD(va, gi + 2);
    NR_PROC(vb, gi + 1, 1);
  }
#undef NR_LOAD
#undef NR_PROC
}
__device__ __forceinline__ void filter_phase(int tid_in, unsigned char* lds_, const float* w1, const float* b1, const float* w2, const float* b2,
                                             const bf16* W3T, const float* freq, const float* fbias, unsigned char* KR8, float* K0) {
  const int tid = launder(tid_in);
  LAS float* zf = (LAS float*)lds_;
  LAS float* h1 = zf + 16 * 36;
  LAS float* h2 = h1 + 16 * 64;
  LAS float* w1l = h2 + 64 * 16;
  LAS float* w2l = w1l + 33 * 64;
  __syncthreads();
  for (int q = tid; q < 33 * 64; q += NTHR) w1l[q] = w1[q];
  for (int q = tid; q < 64 * 64; q += NTHR) w2l[q] = w2[q];
  for (int item = bid(); item < SEQ / 16; item += GRID) {
    const int l0 = item * 16;
    __syncthreads();
    if (tid < 16 * 17) {
      const int li = tid / 17, f = tid - li * 17, l = l0 + li;
      if (f == 0) zf[li * 36] = (float)l / (float)(SEQ - 1);
      else {
        const int j = f - 1;
        const float wv = 2.0f * 3.14159265358979323846f * (float)l / (float)SEQ;
        const float fr = 1e-4f + (float)j * ((15.0f - 1e-4f) / 15.0f);
        const float ang = fr * wv;
        zf[li * 36 + 1 + j] = cosf(ang);
        zf[li * 36 + 17 + j] = -sinf(ang);
      }
    }
    __syncthreads();
    for (int o = tid; o < 1024; o += NTHR) {
      const int li = o >> 6, j = o & 63;
      float a = b1[j];
#pragma unroll
      for (int i = 0; i < 33; ++i) a += zf[li * 36 + i] * w1l[i * 64 + j];
      h1[li * 64 + j] = sinf(freq[j] * a);
    }
    __syncthreads();
    for (int o = tid; o < 1024; o += NTHR) {
      const int li = o >> 6, j = o & 63;
      float a = b2[j];
#pragma unroll 16
      for (int i = 0; i < 64; ++i) a += h1[li * 64 + i] * w2l[i * 64 + j];
      ((LAS unsigned short*)h2)[li * 64 + j] = (unsigned short)f2bf(sinf(freq[j] * a));
    }
    __syncthreads();
    const float min_decay = logf(1e-2f) / 0.3f, max_decay = logf(1e-2f) / 1.5f;
    {
      const int wave = __builtin_amdgcn_readfirstlane(tid >> 6), lane = tid & 63, cn = lane & 15, g = lane >> 4;
      const bf16x8_t a0 = *(const LAS bf16x8_t*)((LAS unsigned char*)h2 + cn * 128 + g * 16), a1 = *(const LAS bf16x8_t*)((LAS unsigned char*)h2 + cn * 128 + 64 + g * 16);
#pragma unroll 1
      for (int tb = 0; tb < 16; tb += 8) {
        bf16x8_t b0[8], b1[8];
#pragma unroll
        for (int t = 0; t < 8; ++t) { const bf16* wp = W3T + (size_t)(wave * 256 + (tb + t) * 16 + cn) * 64 + g * 8;
          b0[t] = *(const bf16x8_t*)wp; b1[t] = *(const bf16x8_t*)(wp + 32); }
#pragma unroll
        for (int t = 0; t < 8; ++t) {
          f32x4_t acc = {0.f, 0.f, 0.f, 0.f};
          acc = __builtin_amdgcn_mfma_f32_16x16x32_bf16(a0, b0[t], acc, 0, 0, 0);
          acc = __builtin_amdgcn_mfma_f32_16x16x32_bf16(a1, b1[t], acc, 0, 0, 0);
          const int col = wave * 256 + (tb + t) * 16 + cn, d = col & 1023, lb = l0 + 4 * g;
          const float delta = min_decay + (float)d * ((max_decay - min_decay) / (float)(DM - 1));
          unsigned char* kr = KR8 + (size_t)d * 8192;
          float h[4];
#pragma unroll
          for (int e = 0; e < 4; ++e) {
            const int l = lb + e;
            const float tl = (float)l / (float)(SEQ - 1);
            float v = acc[e] * expf(-tl * fabsf(delta));
            if (wave < 4 && l == 0) v += fbias[d];
            h[e] = fminf(fmaxf(v * 32.f, -448.f), 448.f);
          }
          if (wave < 4) {
            unsigned char* cb_ = kr + 4092 - lb;
            const unsigned pa = pg8::pack4_fp8(h[0], h[3], h[2], h[1]);
            cb_[4] = (unsigned char)pa;
            cb_[1] = (unsigned char)(pa >> 8);
            *(unsigned short*)(cb_ + 2) = (unsigned short)(pa >> 16);
            if (lb == 4092) cb_[0] = 0;
          } else {
            const unsigned w0 = pg8::pack4_fp8(h[0], h[1], h[2], h[3]);
            if (lb == 0) { kr[4097] = (unsigned char)(w0 >> 8); *(unsigned short*)(kr + 4098) = (unsigned short)(w0 >> 16); }
            else *(unsigned*)(kr + 4096 + lb) = w0;
          }
        }
      }
    }
  }
}

template <int LD> __device__ __forceinline__ void sconv8_load(const bf16* up, int col, int t, v4u* r) {
  const v4u z4 = (v4u){0u, 0u, 0u, 0u};
  r[0] = t > 0 ? *(const v4u*)(up - LD + col) : z4;
  r[1] = *(const v4u*)(up + col);
  r[2] = t < SEQ - 1 ? *(const v4u*)(up + LD + col) : z4;
}
__device__ __forceinline__ void sconv8_calc(const v4u* r, int col, const float* cw, const float* cb, float* out) {
  float um[8], u0[8], u1[8];
  unpack8(r[0], um); unpack8(r[1], u0); unpack8(r[2], u1);
#pragma unroll
  for (int h = 0; h < 2; ++h) {
    const f32x4_t w0 = *(const f32x4_t*)(cw + col + 4 * h), w1 = *(const f32x4_t*)(cw + 3072 + col + 4 * h), w2 = *(const f32x4_t*)(cw + 6144 + col + 4 * h), bb = *(const f32x4_t*)(cb + col + 4 * h);
#pragma unroll
    for (int k = 0; k < 4; ++k) out[4 * h + k] = bb[k] + w0[k] * um[4 * h + k] + w1[k] * u0[4 * h + k] + w2[k] * u1[4 * h + k];
  }
}
__device__ __forceinline__ void gateT_phase(int tid_in, unsigned char* lds_, const bf16* U, const float* cw, const float* cb, const bf16* ycT, bf16* Yg) {
  const int tid = launder(tid_in), cch = tid & 7, tl = tid >> 3;
  LAS bf16* tile = (LAS bf16*)lds_;
  constexpr int NITEM = NB * 64 * 16;
  const int rowc = tid >> 3, chunk = tid & 7;
  v4u ra[3], na[3], yv, nyv;
  {
    const int item = bid(), cbk = item & 15, r = item >> 4, tb = r & 63, b = r >> 6, c0 = cbk * 64 + cch * 8, t = tb * 64 + tl;
    yv = *(const v4u*)(ycT + ((size_t)(cbk * 64 + rowc) * NB + b) * SEQ + tb * 64 + chunk * 8);
    sconv8_load<DM>(U + (size_t)(b * SEQ + t) * DM, c0, t, ra);
  }
  for (int item = bid(); item < NITEM; item += GRID) {
    const int cbk = item & 15, r = item >> 4, tb = r & 63, b = r >> 6;
    const int c0 = cbk * 64 + cch * 8, t = tb * 64 + tl;
    {
      const int nitem = item + GRID < NITEM ? item + GRID : item, nr = nitem >> 4, ntb = nr & 63, nbb = nr >> 6, nt = ntb * 64 + tl;
      nyv = *(const v4u*)(ycT + ((size_t)(cbk * 64 + rowc) * NB + nbb) * SEQ + ntb * 64 + chunk * 8);
      sconv8_load<DM>(U + (size_t)(nbb * SEQ + nt) * DM, c0, nt, na);
    }
    float a0[8];
    sconv8_calc(ra, c0, cw, cb, a0);
    __syncthreads();
    *(LAS v4u*)(tile + rowc * 72 + chunk * 8) = yv;
    __syncthreads();
    float y[8];
#pragma unroll
    for (int k = 0; k < 8; ++k) y[k] = __uint_as_float((unsigned)tile[(cch * 8 + k) * 72 + tl] << 16) * a0[k];
    v4u o; o.x = pk2(y[0], y[1]); o.y = pk2(y[2], y[3]); o.z = pk2(y[4], y[5]); o.w = pk2(y[6], y[7]);
    *(v4u*)(Yg + (size_t)(b * SEQ + t) * DM + c0) = o;
#pragma unroll
    for (int k = 0; k < 3; ++k) ra[k] = na[k];
    yv = nyv;
  }
}

#define LC8_ZB 34816
#define LC8_FS 4208
#define LC8_ZF (LC8_ZB + 16 * LC8_FS)
typedef int lc_v4i __attribute__((ext_vector_type(4)));
typedef int lc_v8i __attribute__((ext_vector_type(8)));
__device__ __forceinline__ unsigned lc8_zslot(int Jp, int e, int b) { return (unsigned)((((Jp >> 1) * 4 + e * 2 + (Jp & 1)) * 8 + b) * 16); }
__device__ __forceinline__ lc_v8i lc_cat(lc_v4i a, lc_v4i b) { return __builtin_shufflevector(a, b, 0, 1, 2, 3, 4, 5, 6, 7); }
__device__ __forceinline__ void longconv_phase(int tid_in, unsigned char* lds_, const bf16* UT, const float* cw, const float* cb, const unsigned char* KR8, bf16* ycT) {
  LAS unsigned char* lds = (LAS unsigned char*)lds_;
  for (int c = bid(); c < DM; c += GRID) {
    const int tid = launder(tid_in), wave = __builtin_amdgcn_readfirstlane(tid >> 6), lane = tid & 63;
    const int n = lane & 31, half = lane >> 5, q = n >> 3, bb = n & 7, sigma = n >> 4, rho = n & 15;
    const int IL = 8 * wave, IH = 120 - 8 * wave;
    __syncthreads();
    if (tid >= 128 && tid < 132) *(LAS v4u*)(lds + LC8_ZF + (tid - 128) * 16) = (v4u){0u, 0u, 0u, 0u};
    if (tid < 128) {
      const int b = tid & 7, e = (tid >> 3) & 1, jb = tid >> 4, Jp = jb < 4 ? jb : 128 + jb;
      *(LAS v4u*)(lds + lc8_zslot(Jp, e, b)) = (v4u){0u, 0u, 0u, 0u};
    }
    {
      const float w10 = cw[1024 + c], w11 = cw[3072 + 1024 + c], w12 = cw[6144 + 1024 + c], b1_ = cb[1024 + c];
      const float w20 = cw[2048 + c], w21 = cw[3072 + 2048 + c], w22 = cw[6144 + 2048 + c], b2_ = cb[2048 + c];
      const bf16* x1r = UT + (size_t)(1024 + c) * NTOK; const bf16* vr = UT + (size_t)(2048 + c) * NTOK;
      v4u xa[4], xb[4], va[4], vb[4]; unsigned xm[4], xn[4], vm[4], vn[4];
#pragma unroll
      for (int k = 0; k < 4; ++k) {
        const int s_ = tid + NTHR * k, b = s_ >> 8, ch = s_ & 255, t0 = ch * 16;
        const bf16* xp = x1r + b * SEQ + t0; const bf16* vp = vr + b * SEQ + t0;
        xa[k] = *(const v4u*)xp; xb[k] = *(const v4u*)(xp + 8); va[k] = *(const v4u*)vp; vb[k] = *(const v4u*)(vp + 8);
        xm[k] = t0 > 0 ? (unsigned)xp[-1] : 0u; xn[k] = t0 + 16 < SEQ ? (unsigned)xp[16] : 0u; vm[k] = t0 > 0 ? (unsigned)vp[-1] : 0u; vn[k] = t0 + 16 < SEQ ? (unsigned)vp[16] : 0u;
      }
#pragma unroll
      for (int k = 0; k < 4; ++k) {
        const int s_ = tid + NTHR * k, b = s_ >> 8, ch = s_ & 255;
        float x[18], v[18];
        x[0] = __uint_as_float(xm[k] << 16); x[17] = __uint_as_float(xn[k] << 16); v[0] = __uint_as_float(vm[k] << 16); v[17] = __uint_as_float(vn[k] << 16);
        { const unsigned dx[8] = {xa[k].x, xa[k].y, xa[k].z, xa[k].w, xb[k].x, xb[k].y, xb[k].z, xb[k].w}, dv[8] = {va[k].x, va[k].y, va[k].z, va[k].w, vb[k].x, vb[k].y, vb[k].z, vb[k].w};
#pragma unroll
          for (int e = 0; e < 8; ++e) { x[1 + 2 * e] = __uint_as_float(dx[e] << 16); x[2 + 2 * e] = __uint_as_float(dx[e] & 0xffff0000u); v[1 + 2 * e] = __uint_as_float(dv[e] << 16); v[2 + 2 * e] = __uint_as_float(dv[e] & 0xffff0000u); } }
        float f[16];
#pragma unroll
        for (int e = 0; e < 16; ++e) { const float c1 = b1_ + w10 * x[e] + w11 * x[e + 1] + w12 * x[e + 2], c2 = b2_ + w20 * v[e] + w21 * v[e + 1] + w22 * v[e + 2];
          f[e] = fminf(fmaxf(c1 * c2 * 4.f, -448.f), 448.f); }
        v4u o; o.x = pg8::pack4_fp8(f[0], f[1], f[2], f[3]); o.y = pg8::pack4_fp8(f[4], f[5], f[6], f[7]); o.z = pg8::pack4_fp8(f[8], f[9], f[10], f[11]); o.w = pg8::pack4_fp8(f[12], f[13], f[14], f[15]);
        *(LAS v4u*)(lds + lc8_zslot((ch >> 1) + 4, ch & 1, b)) = o;
        __builtin_amdgcn_sched_barrier(0);
      }
    }
    f32x16_t acc[4];
#pragma unroll
    for (int tau = 0; tau < 4; ++tau)
#pragma unroll
      for (int r = 0; r < 16; ++r) acc[tau][r] = 0.f;
    const unsigned char* krc = KR8 + (size_t)c * 8192;
#pragma unroll 1
    for (int pass = 0; pass < 2; ++pass) {
      __syncthreads();
      for (int a = tid; a < 263; a += NTHR) {
        const int cl = a + (pass ? 255 : -3);
        const v4u lo = (cl >= 0 && cl < 512) ? *(const v4u*)(krc + (size_t)cl * 16) : (v4u){0u, 0u, 0u, 0u};
        const v4u hi = (cl >= -1 && cl < 511) ? *(const v4u*)(krc + (size_t)(cl + 1) * 16) : (v4u){0u, 0u, 0u, 0u};
        const unsigned d[8] = {lo.x, lo.y, lo.z, lo.w, hi.x, hi.y, hi.z, hi.w};
#pragma unroll
        for (int rh = 0; rh < 16; ++rh) {
          const int o_ = 16 - rh, j0 = o_ >> 2, sh = o_ & 3;
          v4u o;
          if (sh == 0) { o.x = d[j0]; o.y = d[j0 + 1]; o.z = d[j0 + 2]; o.w = d[j0 + 3]; }
          else { o.x = __builtin_amdgcn_alignbyte(d[j0 + 1], d[j0], sh); o.y = __builtin_amdgcn_alignbyte(d[j0 + 2], d[j0 + 1], sh);
                 o.z = __builtin_amdgcn_alignbyte(d[j0 + 3], d[j0 + 2], sh); o.w = __builtin_amdgcn_alignbyte(d[(j0 + 4) & 7], d[j0 + 3], sh); }
          *(LAS v4u*)(lds + LC8_ZB + rh * LC8_FS + a * 16) = o;
        }
      }
      __syncthreads();
      const int Dlo = pass ? -128 : 0, Dhi = pass ? -2 : 128, Ca = pass ? 0 : 258;
      const unsigned fbaseu = (unsigned)(LC8_ZB + rho * LC8_FS + (2 * half - sigma + Ca) * 16);
      const unsigned zfragu = (unsigned)LC8_ZF;
      lc_v8i P, Q, R, S, Bf;
#define LC_LDA(X, PTR, D_) do { const unsigned fa_ = ((D_) >= Dlo && (D_) <= Dhi) ? (PTR) : zfragu; X = lc_cat(*(const LAS lc_v4i*)(lds + fa_), *(const LAS lc_v4i*)(lds + fa_ + 16)); } while (0)
#define LC_MMA(A_, C_) C_ = __builtin_amdgcn_mfma_scale_f32_32x32x64_f8f6f4(A_, Bf, C_, 0, 0, 0, 0x7f7f7f7f, 0, 0x7f7f7f7f)
#define LC_STEP(DOL, DOH, T0, T1, T2, T3) do { \
        if (DOL) LC_LDA(T0, pl_, IL - J0); if (DOH) LC_LDA(T2, ph_, IH - J0); \
        Bf = lc_cat(*(const LAS lc_v4i*)(lds + pb_), *(const LAS lc_v4i*)(lds + pb_ + 256)); \
        if (DOL) { LC_MMA(T0, acc[0]); LC_MMA(T1, acc[1]); } \
        if (DOH) { LC_MMA(T2, acc[2]); LC_MMA(T3, acc[3]); } \
        J0 += 4; pl_ += 128u; ph_ += 128u; pb_ += 1024u; } while (0)
#define LC_RUN(DOL, DOH, JLO, JHI) do { \
        int J0 = (JLO) + (((r - (JLO)) % 4) + 4) % 4; const int jhi_ = (JHI); \
        unsigned pl_ = fbaseu + (unsigned)(32 * (J0 - IL)), ph_ = fbaseu + (unsigned)(32 * (J0 - IH)), pb_ = lc8_zslot(J0 + q + half + 4, 0, bb); \
        asm volatile("" : "+v"(pl_), "+v"(ph_), "+v"(pb_)); \
        if (DOL) LC_LDA(Q, pl_ - 128u, IL + 4 - J0); if (DOH) LC_LDA(S, ph_ - 128u, IH + 4 - J0); \
        _Pragma("unroll 1") while (J0 <= jhi_) { \
          LC_STEP(DOL, DOH, P, Q, R, S); if (J0 > jhi_) break; \
          LC_STEP(DOL, DOH, Q, P, S, R); } } while (0)
#pragma unroll 1
      for (int r = 0; r < 4; r += 2) {
        if (pass == 0) {
          LC_RUN(1, 1, -4, IL + 4);
          LC_RUN(0, 1, IL + 5, IH + 4);
        } else {
          LC_RUN(1, 0, IL + 1, IH);
          LC_RUN(1, 1, IH + 1, 126);
        }
      }
#undef LC_RUN
#undef LC_LDA
#undef LC_MMA
#undef LC_STEP
    }
    __syncthreads();
#pragma unroll
    for (int tau = 0; tau < 4; ++tau)
#pragma unroll
      for (int g = 0; g < 4; ++g) {
        const int t = 32 * ((tau < 2 ? IL : IH) + 4 * (tau & 1) + q) + 8 * g + 4 * half;
        v2u w; w.x = pk2(acc[tau][4 * g] * (1.f / 128.f), acc[tau][4 * g + 1] * (1.f / 128.f)); w.y = pk2(acc[tau][4 * g + 2] * (1.f / 128.f), acc[tau][4 * g + 3] * (1.f / 128.f));
        *(LAS v2u*)(lds + bb * 8208 + t * 2) = w;
      }
    {
      const float w0 = cw[c], w1 = cw[3072 + c], w2 = cw[6144 + c], b0_ = cb[c];
      const bf16* x0r = UT + (size_t)c * NTOK;
      v4u xg[8]; unsigned xm[8], xn[8];
#pragma unroll
      for (int k = 0; k < 8; ++k) {
        const int s_ = tid + NTHR * k, b = s_ >> 9, ch = s_ & 511, t0 = ch * 8; const bf16* xp = x0r + b * SEQ + t0;
        xg[k] = *(const v4u*)xp; xm[k] = t0 > 0 ? (unsigned)xp[-1] : 0u; xn[k] = t0 + 8 < SEQ ? (unsigned)xp[8] : 0u;
      }
      __syncthreads();
#pragma unroll
      for (int k = 0; k < 8; ++k) {
        const int s_ = tid + NTHR * k, b = s_ >> 9, ch = s_ & 511;
        const v4u yv = *(const LAS v4u*)(lds + b * 8208 + ch * 16);
        float x[10], y[8];
        x[0] = __uint_as_float(xm[k] << 16); x[9] = __uint_as_float(xn[k] << 16);
        { const unsigned dx[4] = {xg[k].x, xg[k].y, xg[k].z, xg[k].w};
#pragma unroll
          for (int e = 0; e < 4; ++e) { x[1 + 2 * e] = __uint_as_float(dx[e] << 16); x[2 + 2 * e] = __uint_as_float(dx[e] & 0xffff0000u); } }
        unpack8(yv, y);
#pragma unroll
        for (int e = 0; e < 8; ++e) y[e] *= b0_ + w0 * x[e] + w1 * x[e + 1] + w2 * x[e + 2];
        v4u o; o.x = pk2(y[0], y[1]); o.y = pk2(y[2], y[3]); o.z = pk2(y[4], y[5]); o.w = pk2(y[6], y[7]);
        *(v4u*)(ycT + ((size_t)c * NB + b) * SEQ + ch * 8) = o;
      }
    }
  }
}

__device__ __forceinline__ void mla_prep_phase(int tid_in, const bf16* A, const int* pos, const float* qg, const float* kvg, bf16* CQN, bf16* CKVN, bf16* KPE, unsigned char* KPE8, const float* ROPE) {
  const int tid = launder(tid_in), wave = __builtin_amdgcn_readfirstlane(tid >> 6), lane = tid & 63;
  for (int row4 = (bid() * 8 + wave) * 4; row4 < NTOK; row4 += GRID * 8 * 4) {
    v4u raw[4];
#pragma unroll
    for (int rr = 0; rr < 4; ++rr) raw[rr] = *(const v4u*)(A + (size_t)(row4 + rr) * 512 + lane * 8);
#pragma unroll
    for (int rr = 0; rr < 4; ++rr) {
    const int row = row4 + rr;
    float v[8];
    unpack8(raw[rr], v);
    float ss = 0.f;
#pragma unroll
    for (int k = 0; k < 8; ++k) ss += v[k] * v[k];
    const float ssq = wsum64(lane < 32 ? ss : 0.f), sskv = wsum64((lane >= 32 && lane < 48) ? ss : 0.f);
    if (lane < 32) {
      const float r = rsqrtf(ssq * (1.f / 256.f) + 1e-6f);
      const f32x4_t g0 = *(const f32x4_t*)(qg + lane * 8), g1 = *(const f32x4_t*)(qg + lane * 8 + 4);
      v4u o; o.x = pk2(v[0] * r * g0.x, v[1] * r * g0.y); o.y = pk2(v[2] * r * g0.z, v[3] * r * g0.w); o.z = pk2(v[4] * r * g1.x, v[5] * r * g1.y); o.w = pk2(v[6] * r * g1.z, v[7] * r * g1.w);
      *(v4u*)(CQN + (size_t)row * 256 + lane * 8) = o;
    } else if (lane < 48) {
      const int l = lane - 32;
      const float r = rsqrtf(sskv * (1.f / 128.f) + 1e-6f);
      const f32x4_t g0 = *(const f32x4_t*)(kvg + l * 8), g1 = *(const f32x4_t*)(kvg + l * 8 + 4);
      v4u o; o.x = pk2(v[0] * r * g0.x, v[1] * r * g0.y); o.y = pk2(v[2] * r * g0.z, v[3] * r * g0.w); o.z = pk2(v[4] * r * g1.x, v[5] * r * g1.y); o.w = pk2(v[6] * r * g1.z, v[7] * r * g1.w);
      *(v4u*)(CKVN + (size_t)row * 128 + l * 8) = o;
    } else {
      if (lane < 56) {
        const int l = lane - 48;
        const float* rp = ROPE + (size_t)row * 64 + l * 8;
        const f32x4_t r0 = *(const f32x4_t*)rp, r1 = *(const f32x4_t*)(rp + 4);
        const float cs[4] = {r0.x, r0.z, r1.x, r1.z}, sn[4] = {r0.y, r0.w, r1.y, r1.w};
        float o1[4], o2[4];
#pragma unroll
        for (int k = 0; k < 4; ++k) {
          o1[k] = v[2 * k] * cs[k] - v[2 * k + 1] * sn[k];
          o2[k] = v[2 * k] * sn[k] + v[2 * k + 1] * cs[k];
        }
        v4u o; o.x = pk2(o1[0], o2[0]); o.y = pk2(o1[1], o2[1]); o.z = pk2(o1[2], o2[2]); o.w = pk2(o1[3], o2[3]);
        *(v4u*)(KPE + (size_t)row * 64 + l * 8) = o;
        { v2u o8; o8.x = pg8::pack4_fp8(o1[0], o2[0], o1[1], o2[1]); o8.y = pg8::pack4_fp8(o1[2], o2[2], o1[3], o2[3]); *(v2u*)(KPE8 + (size_t)row * 64 + l * 8) = o8; }
      }
    }
    }
  }
}

struct EpiMlaPrep {
    static constexpr bool PERM = true, AFTER_DRAIN = true;
    const float* qg; const float* kvg; bf16* CQN; bf16* CKVN; bf16* KPE; unsigned char* KPE8; const float* ROPE;
    __device__ __forceinline__ void fused(const pg8::f32x4 (&acc)[2][2][4][2], const pg8::Unit& u, int wr, int wc, int fr, int fq, PG8_LAS unsigned char* lds, int wid, int lane) const {
        constexpr int RS = 528;
#pragma unroll
        for (int ai = 0; ai < 2; ++ai)
#pragma unroll
            for (int m = 0; m < 4; ++m) { const int rl = wr * 64 + fr + ai * pg8::HALF + m * 16;
#pragma unroll
                for (int bj = 0; bj < 2; ++bj) { const pg8::f32x4 v0 = acc[ai][bj][m][0], v1 = acc[ai][bj][m][1];
                    v4u w; w.x = pg8::cvt_pk_bf16(v0[0], v0[1]); w.y = pg8::cvt_pk_bf16(v0[2], v0[3]); w.z = pg8::cvt_pk_bf16(v1[0], v1[1]); w.w = pg8::cvt_pk_bf16(v1[2], v1[3]);
                    *(PG8_LAS v4u*)(lds + rl * RS + (wc * 32 + 8 * fq + bj * pg8::HALF) * 2) = w; } }
        __syncthreads();
        const int l = lane & 31;
#pragma unroll 1
        for (int p = 0; p < 16; ++p) {
            const int rl = wid * 32 + 2 * p + (lane >> 5); const size_t row = (size_t)u.pm * pg8::BM + rl;
            if (u.pn == 0) {
                float v[8]; unpack8(*(const PG8_LAS v4u*)(lds + rl * RS + l * 16), v);
                float ss = 0.f;
#pragma unroll
                for (int k = 0; k < 8; ++k) ss += v[k] * v[k];
                ss += swz_xor<1>(ss); ss += swz_xor<2>(ss); ss += swz_xor<4>(ss); ss += swz_xor<8>(ss); ss += swz_xor<16>(ss);
                const float r = rsqrtf(ss * (1.f / 256.f) + 1e-6f);
                const f32x4_t g0 = *(const f32x4_t*)(qg + l * 8), g1 = *(const f32x4_t*)(qg + l * 8 + 4);
                v4u o; o.x = pk2(v[0] * r * g0.x, v[1] * r * g0.y); o.y = pk2(v[2] * r * g0.z, v[3] * r * g0.w); o.z = pk2(v[4] * r * g1.x, v[5] * r * g1.y); o.w = pk2(v[6] * r * g1.z, v[7] * r * g1.w);
                *(v4u*)(CQN + row * 256 + l * 8) = o;
            } else {
                float v[8]; unpack8(*(const PG8_LAS v4u*)(lds + rl * RS + (l < 24 ? l : 0) * 16), v);
                float ss = 0.f;
#pragma unroll
                for (int k = 0; k < 8; ++k) ss += v[k] * v[k];
                ss += swz_xor<1>(ss); ss += swz_xor<2>(ss); ss += swz_xor<4>(ss); ss += swz_xor<8>(ss);
                if (l < 16) {
                    const float r = rsqrtf(ss * (1.f / 128.f) + 1e-6f);
                    const f32x4_t g0 = *(const f32x4_t*)(kvg + l * 8), g1 = *(const f32x4_t*)(kvg + l * 8 + 4);
                    v4u o; o.x = pk2(v[0] * r * g0.x, v[1] * r * g0.y); o.y = pk2(v[2] * r * g0.z, v[3] * r * g0.w); o.z = pk2(v[4] * r * g1.x, v[5] * r * g1.y); o.w = pk2(v[6] * r * g1.z, v[7] * r * g1.w);
                    *(v4u*)(CKVN + row * 128 + l * 8) = o;
                } else if (l < 24) {
                    const int lp = l - 16;
                    const float* rp = ROPE + row * 64 + lp * 8;
                    const f32x4_t r0 = *(const f32x4_t*)rp, r1 = *(const f32x4_t*)(rp + 4);
                    const float cs[4] = {r0.x, r0.z, r1.x, r1.z}, sn[4] = {r0.y, r0.w, r1.y, r1.w};
                    float o1[4], o2[4];
#pragma unroll
                    for (int k = 0; k < 4; ++k) { o1[k] = v[2 * k] * cs[k] - v[2 * k + 1] * sn[k]; o2[k] = v[2 * k] * sn[k] + v[2 * k + 1] * cs[k]; }
                    v4u o; o.x = pk2(o1[0], o2[0]); o.y = pk2(o1[1], o2[1]); o.z = pk2(o1[2], o2[2]); o.w = pk2(o1[3], o2[3]);
                    *(v4u*)(KPE + row * 64 + lp * 8) = o;
                    { v2u o8; o8.x = pg8::pack4_fp8(o1[0], o2[0], o1[1], o2[1]); o8.y = pg8::pack4_fp8(o1[2], o2[2], o1[3], o2[3]); *(v2u*)(KPE8 + row * 64 + lp * 8) = o8; }
                }
            }
        }
    }
};

namespace att {
typedef short s16x4 __attribute__((ext_vector_type(4)));
typedef unsigned u32x4_ __attribute__((ext_vector_type(4)));
constexpr int SHM_V = 64 * 128 * 2, SHM_K = 64 * 192 * 2;
constexpr float THRL = 8.f * 1.4426950408889634f;
constexpr int NQR = 12;
#define AT_KSWZ(row, colB) ((row) * 384 + ((colB) ^ (((row) & 7) << 4)))
#define AT_SBAR() __builtin_amdgcn_sched_barrier(0)
__device__ __forceinline__ int crow(int r, int hi) { return (r & 3) + 8 * (r >> 2) + 4 * hi; }
__device__ __forceinline__ unsigned cvtpk(float lo, float hi) { unsigned r; asm volatile("v_cvt_pk_bf16_f32 %0, %1, %2" : "=v"(r) : "v"(lo), "v"(hi)); return r; }
__device__ __forceinline__ void partialSM(f32x16_t& p0, f32x16_t& p1, float& m_reg, float& mn, float& alpha) {
  float pmax = p0[0];
#pragma unroll
  for (int r = 1; r < 16; ++r) pmax = fmaxf(pmax, p0[r]);
#pragma unroll
  for (int r = 0; r < 16; ++r) pmax = fmaxf(pmax, p1[r]);
  { auto rr = __builtin_amdgcn_permlane32_swap(__float_as_uint(pmax), __float_as_uint(pmax), false, false);
    pmax = fmaxf(__uint_as_float(rr[0]), __uint_as_float(rr[1])); }
  if (__builtin_expect(__all(pmax - m_reg <= THRL), 1)) { mn = m_reg; alpha = 1.f; }
  else { mn = fmaxf(m_reg, pmax); alpha = __builtin_amdgcn_exp2f(m_reg - mn); m_reg = mn; }
#pragma unroll
  for (int r = 0; r < 16; ++r) p0[r] = p0[r] - mn;
#pragma unroll
  for (int r = 0; r < 16; ++r) p1[r] = p1[r] - mn;
#pragma unroll
  for (int r = 0; r < 16; ++r) p0[r] = __builtin_amdgcn_exp2f(p0[r]);
}
__device__ __forceinline__ void finishSM(f32x16_t& p0, f32x16_t& p1, float alpha, float& l_reg, bf16x8_t& pa0, bf16x8_t& pa1, bf16x8_t& pa2, bf16x8_t& pa3) {
#pragma unroll
  for (int r = 0; r < 16; ++r) p1[r] = __builtin_amdgcn_exp2f(p1[r]);
  float ps = 0;
#pragma unroll
  for (int r = 0; r < 16; ++r) ps += p0[r];
#pragma unroll
  for (int r = 0; r < 16; ++r) ps += p1[r];
  { auto rr = __builtin_amdgcn_permlane32_swap(__float_as_uint(ps), __float_as_uint(ps), false, false);
    ps = __uint_as_float(rr[0]) + __uint_as_float(rr[1]); }
  l_reg = l_reg * alpha + ps;
#define AT_PK4(P, BASE, OUT) do { unsigned a0 = cvtpk(P[BASE + 0], P[BASE + 1]), a1 = cvtpk(P[BASE + 2], P[BASE + 3]);   \
    unsigned b0 = cvtpk(P[BASE + 4], P[BASE + 5]), b1 = cvtpk(P[BASE + 6], P[BASE + 7]);                              \
    auto r0 = __builtin_amdgcn_permlane32_swap(a0, b0, false, false); auto r1 = __builtin_amdgcn_permlane32_swap(a1, b1, false, false); \
    u32x4_ w = {r0[0], r1[0], r0[1], r1[1]}; OUT = __builtin_bit_cast(bf16x8_t, w); } while (0)
  AT_PK4(p0, 0, pa0); AT_PK4(p0, 8, pa1); AT_PK4(p1, 0, pa2); AT_PK4(p1, 8, pa3);
#undef AT_PK4
}
__device__ __forceinline__ void qkt(f32x16_t& p0, f32x16_t& p1, const LAS char* Ks, const bf16x8_t* qr, const LAS char* qpe, int r32, int hi) {
#pragma unroll
  for (int r = 0; r < 16; ++r) { p0[r] = 0.f; p1[r] = 0.f; }
#pragma unroll
  for (int d0 = 0; d0 < 12; ++d0) { const int cb = (d0 * 16 + hi * 8) * 2;
    const bf16x8_t b0 = *(const LAS bf16x8_t*)(Ks + AT_KSWZ(r32, cb));
    const bf16x8_t b1 = *(const LAS bf16x8_t*)(Ks + AT_KSWZ(32 + r32, cb));
    const bf16x8_t qf = d0 < NQR ? qr[d0 < NQR ? d0 : 0] : *(const LAS bf16x8_t*)(qpe + (d0 - NQR) * 1024);
    p0 = __builtin_amdgcn_mfma_f32_32x32x16_bf16(b0, qf, p0, 0, 0, 0);
    p1 = __builtin_amdgcn_mfma_f32_32x32x16_bf16(b1, qf, p1, 0, 0, 0);
    if ((d0 & 3) == 3) AT_SBAR(); }
}
__device__ __forceinline__ int v_st(int k, int c) { const int kk = (k & ~0xC) | ((k & 4) << 1) | ((k & 8) >> 1); return ((kk >> 3) * 4 + (c >> 5)) * 512 + ((kk & 7) * 32 + (c & 31)) * 2; }
__device__ __forceinline__ int v_rd_base(int lane) { return ((lane & 3) << 3) | (((lane >> 2) & 3) << 6) | (((lane >> 4) & 1) << 5) | (((lane >> 5) & 1) << 8); }
constexpr int v_rd_off(int d0, int ks, int half) { return d0 * 512 + ks * 4096 + half * 2048; }
template <int OFF> __device__ __forceinline__ s16x4 tr_read(int vb) {
  s16x4 r; asm volatile("ds_read_b64_tr_b16 %0, %1 offset:%2" : "=&v"(r) : "v"(vb), "i"(OFF) : "memory"); return r;
}
template <int D0> __device__ __forceinline__ void pv_one(f32x16_t& od, int vb, bf16x8_t pa0, bf16x8_t pa1, bf16x8_t pa2, bf16x8_t pa3) {
  const s16x4 l0 = tr_read<v_rd_off(D0, 0, 0)>(vb), h0 = tr_read<v_rd_off(D0, 0, 1)>(vb), l1 = tr_read<v_rd_off(D0, 1, 0)>(vb), h1 = tr_read<v_rd_off(D0, 1, 1)>(vb);
  const s16x4 l2 = tr_read<v_rd_off(D0, 2, 0)>(vb), h2 = tr_read<v_rd_off(D0, 2, 1)>(vb), l3 = tr_read<v_rd_off(D0, 3, 0)>(vb), h3 = tr_read<v_rd_off(D0, 3, 1)>(vb);
  asm volatile("s_waitcnt lgkmcnt(0)" ::: "memory"); AT_SBAR();
#define AT_PK(L, H) (bf16x8_t){L[0], L[1], L[2], L[3], H[0], H[1], H[2], H[3]}
  od = __builtin_amdgcn_mfma_f32_32x32x16_bf16(pa0, AT_PK(l0, h0), od, 0, 0, 0);
  od = __builtin_amdgcn_mfma_f32_32x32x16_bf16(pa1, AT_PK(l1, h1), od, 0, 0, 0);
  od = __builtin_amdgcn_mfma_f32_32x32x16_bf16(pa2, AT_PK(l2, h2), od, 0, 0, 0);
  od = __builtin_amdgcn_mfma_f32_32x32x16_bf16(pa3, AT_PK(l3, h3), od, 0, 0, 0);
#undef AT_PK
}
__device__ __forceinline__ void pv_d0(f32x16_t* o, int vb, bf16x8_t pa0, bf16x8_t pa1, bf16x8_t pa2, bf16x8_t pa3) {
  pv_one<0>(o[0], vb, pa0, pa1, pa2, pa3); pv_one<1>(o[1], vb, pa0, pa1, pa2, pa3); pv_one<2>(o[2], vb, pa0, pa1, pa2, pa3); pv_one<3>(o[3], vb, pa0, pa1, pa2, pa3);
}
__device__ __forceinline__ void attn_unit(int tid, const bf16* __restrict__ Qb, const bf16* __restrict__ Kn, const bf16* __restrict__ Kp, const bf16* __restrict__ Vh,
                                          bf16* __restrict__ Ob, LAS char* lds) {
  (void)Vh;
  const int wid = tid >> 6, lane = tid & 63, r32 = lane & 31, hi = lane >> 5;
  LAS char* V_lds = lds; LAS char* K_lds = lds + 2 * SHM_V;
  LAS float* wsx = (LAS float*)(lds + 2 * SHM_V + 2 * SHM_K) + wid * 64; LAS float* li_l = wsx; LAS float* al_l = wsx + 32;
  float m_reg = -1e30f, l_reg = 0;
  f32x16_t o[4];
#pragma unroll
  for (int d = 0; d < 4; ++d)
#pragma unroll
    for (int r = 0; r < 16; ++r) o[d][r] = 0.f;
  bf16x8_t qr[NQR];
  LAS char* qpe = lds + 2 * SHM_V + 2 * SHM_K + 2048 + wid * ((12 - NQR) * 1024) + lane * 16;
  const unsigned qoff = (unsigned)((wid * 32 + r32) * 1536 + hi * 8);
#pragma unroll
  for (int d0 = 0; d0 < NQR; ++d0) qr[d0] = *(const bf16x8_t*)(Qb + (qoff + (unsigned)(d0 * 16)));
#pragma unroll
  for (int d0 = NQR; d0 < 12; ++d0) *(LAS bf16x8_t*)(qpe + (d0 - NQR) * 1024) = *(const bf16x8_t*)(Qb + (qoff + (unsigned)(d0 * 16)));
  const int sr = tid >> 4, sc = (tid & 15) * 8, vst0 = v_st(sr, sc), vst1 = v_st(32 + sr, sc);
  const int rk = tid >> 3, ck = (tid & 7) * 8;
  const int vb0 = (int)(unsigned)(size_t)V_lds + v_rd_base(lane);
  bf16x8_t vs0, vs1, ks0, ks1, kp0;
  const unsigned okv = (unsigned)(sr * 2048 + sc), okp = (unsigned)(rk * 64 + ck);
#define AT_SLOAD(k0) do { const unsigned t0_ = (unsigned)(k0) * 2048u + okv, t1_ = t0_ + 32u * 2048u; \
    ks0 = *(const bf16x8_t*)(Kn + t0_); vs0 = *(const bf16x8_t*)(Kn + t0_ + 128u); ks1 = *(const bf16x8_t*)(Kn + t1_); vs1 = *(const bf16x8_t*)(Kn + t1_ + 128u); \
    kp0 = *(const bf16x8_t*)(Kp + (unsigned)(k0) * 64u + okp); } while (0)
#define AT_SWRITE(b) do { *(LAS bf16x8_t*)(V_lds + (b) * SHM_V + vst0) = vs0; *(LAS bf16x8_t*)(V_lds + (b) * SHM_V + vst1) = vs1; \
    *(LAS bf16x8_t*)(K_lds + (b) * SHM_K + AT_KSWZ(sr, sc * 2)) = ks0; *(LAS bf16x8_t*)(K_lds + (b) * SHM_K + AT_KSWZ(32 + sr, sc * 2)) = ks1; \
    *(LAS bf16x8_t*)(K_lds + (b) * SHM_K + AT_KSWZ(rk, 256 + ck * 2)) = kp0; } while (0)
#define AT_SWAIT() asm volatile("s_waitcnt vmcnt(0)" ::: "memory")
#define AT_RESC(a) do { if (__any((a) < 1.f)) { if (hi == 0) al_l[r32] = (a); asm volatile("s_waitcnt lgkmcnt(0)" ::: "memory"); \
    _Pragma("unroll") for (int d = 0; d < 4; ++d) _Pragma("unroll") for (int r = 0; r < 16; ++r) o[d][r] *= al_l[crow(r, hi)]; } } while (0)
  f32x16_t pA0, pA1, pB0, pB1; float mnA, mnB, alA, alB; bf16x8_t pa0, pa1, pa2, pa3; constexpr int NT = SEQ / 64;
  AT_SLOAD(0); AT_SWAIT(); AT_SWRITE(0); __syncthreads();
  qkt(pA0, pA1, K_lds, qr, qpe, r32, hi); partialSM(pA0, pA1, m_reg, mnA, alA);
  AT_SLOAD(64);
  AT_SWAIT(); AT_SWRITE(1); __syncthreads();
  for (int j = 1; j + 1 < NT; j += 2) {
    AT_SBAR(); AT_SLOAD((j + 1) * 64); AT_SBAR();
    qkt(pB0, pB1, K_lds + SHM_K, qr, qpe, r32, hi);
    finishSM(pA0, pA1, alA, l_reg, pa0, pa1, pa2, pa3); AT_SBAR();
    pv_d0(o, vb0, pa0, pa1, pa2, pa3); partialSM(pB0, pB1, m_reg, mnB, alB);
    __syncthreads(); AT_SWAIT(); AT_SWRITE(0);
    AT_RESC(alB); __syncthreads();
    AT_SBAR(); AT_SLOAD((j + 2) * 64); AT_SBAR();
    qkt(pA0, pA1, K_lds, qr, qpe, r32, hi);
    finishSM(pB0, pB1, alB, l_reg, pa0, pa1, pa2, pa3); AT_SBAR();
    pv_d0(o, vb0 + SHM_V, pa0, pa1, pa2, pa3); partialSM(pA0, pA1, m_reg, mnA, alA);
    __syncthreads(); AT_SWAIT(); AT_SWRITE(1);
    AT_RESC(alA); __syncthreads();
  }
  AT_SBAR(); qkt(pB0, pB1, K_lds + SHM_K, qr, qpe, r32, hi);
  finishSM(pA0, pA1, alA, l_reg, pa0, pa1, pa2, pa3); AT_SBAR();
  pv_d0(o, vb0, pa0, pa1, pa2, pa3); partialSM(pB0, pB1, m_reg, mnB, alB);
  __syncthreads(); AT_RESC(alB);
  finishSM(pB0, pB1, alB, l_reg, pa0, pa1, pa2, pa3); AT_SBAR();
  pv_d0(o, vb0 + SHM_V, pa0, pa1, pa2, pa3);
  if (hi == 0) li_l[r32] = l_reg;
  asm volatile("s_waitcnt lgkmcnt(0)" ::: "memory");
  float rli[16];
#pragma unroll
  for (int r = 0; r < 16; ++r) rli[r] = __builtin_amdgcn_rcpf(li_l[crow(r, hi)]);
  bf16* Ow = Ob + (size_t)(wid * 32) * 1024 + (hi * 4) * 1024 + r32;
#pragma unroll
  for (int r = 0; r < 16; ++r) {
#pragma unroll
    for (int d0 = 0; d0 < 4; ++d0) Ow[((r & 3) + 8 * (r >> 2)) * 1024 + d0 * 32] = (bf16)f2bf(o[d0][r] * rli[r]); }
#undef AT_SLOAD
#undef AT_SWRITE
#undef AT_SWAIT
#undef AT_RESC
}

constexpr int DK0 = 0, DV0 = 2 * SHM_K, DWS = DV0 + 3 * SHM_V, DQ = DWS + 2048;
__device__ __forceinline__ void glds16(const void* gsrc, unsigned lds_dst) { unsigned keep;
  asm volatile("s_mov_b32 %0, m0\n\ts_mov_b32 m0, %2\n\ts_nop 0\n\tglobal_load_lds_dwordx4 %1, off\n\ts_mov_b32 m0, %0" : "=&s"(keep) : "v"(gsrc), "s"(lds_dst) : "memory"); }
#define AT_VMWAIT() asm volatile("s_waitcnt vmcnt(0)" ::: "memory")
__device__ __forceinline__ void attn_unit_dma(int tid, const bf16* __restrict__ Qb, const bf16* __restrict__ Kn, const bf16* __restrict__ Kp, bf16* __restrict__ Ob, LAS char* lds) {
  const int wid = __builtin_amdgcn_readfirstlane(tid >> 6), lane = tid & 63, r32 = lane & 31, hi = lane >> 5;
  LAS char* K_lds = lds + DK0; LAS char* V_lds = lds + DV0;
  LAS float* wsx = (LAS float*)(lds + DWS) + wid * 64; LAS float* li_l = wsx; LAS float* al_l = wsx + 32;
  float m_reg = -1e30f, l_reg = 0;
  f32x16_t o[4];
#pragma unroll
  for (int d = 0; d < 4; ++d)
#pragma unroll
    for (int r = 0; r < 16; ++r) o[d][r] = 0.f;
  bf16x8_t qr[NQR];
  LAS char* qpe = lds + DQ + wid * ((12 - NQR) * 1024) + lane * 16;
  const unsigned qoff = (unsigned)((wid * 32 + r32) * 1536 + hi * 8);
#pragma unroll
  for (int d0 = 0; d0 < NQR; ++d0) qr[d0] = *(const bf16x8_t*)(Qb + (qoff + (unsigned)(d0 * 16)));
#pragma unroll
  for (int d0 = NQR; d0 < 12; ++d0) *(LAS bf16x8_t*)(qpe + (d0 - NQR) * 1024) = *(const bf16x8_t*)(Qb + (qoff + (unsigned)(d0 * 16)));
  unsigned ksrc[3]; bool kpe[3]; unsigned vsrc[2];
#pragma unroll
  for (int i = 0; i < 3; ++i) { const int p = (3 * wid + i) * 64 + lane, row = p / 24, chp = p - row * 24, c = chp ^ (row & 7);
    kpe[i] = c >= 16; ksrc[i] = kpe[i] ? (unsigned)(row * 64 + (c - 16) * 8) : (unsigned)(row * 2048 + c * 8); }
#pragma unroll
  for (int i = 0; i < 2; ++i) { const int p = (2 * wid + i) * 64 + lane, sub = p >> 5, kk = (sub >> 2) * 8 + ((p >> 2) & 7), c = (sub & 3) * 32 + (p & 3) * 8;
    const int k = (kk & ~0xC) | ((kk & 4) << 1) | ((kk & 8) >> 1);
    vsrc[i] = (unsigned)(k * 2048 + c + 128); }
  const unsigned ldsb = (unsigned)(size_t)lds;
  const unsigned kdst = ldsb + DK0 + (unsigned)(3 * wid) * 1024u, vdst = ldsb + DV0 + (unsigned)(2 * wid) * 1024u;
#define AT_DMA(k0, ks, vs) do { const unsigned tk_ = (unsigned)(k0) * 2048u, tp_ = (unsigned)(k0) * 64u; \
    _Pragma("unroll") for (int i_ = 0; i_ < 3; ++i_) glds16(kpe[i_] ? (const void*)(Kp + (tp_ + ksrc[i_])) : (const void*)(Kn + (tk_ + ksrc[i_])), kdst + (unsigned)(ks) * SHM_K + i_ * 1024u); \
    _Pragma("unroll") for (int i_ = 0; i_ < 2; ++i_) glds16((const void*)(Kn + (tk_ + vsrc[i_])), vdst + (unsigned)(vs) * SHM_V + i_ * 1024u); } while (0)
#define AT_RESC(a) do { if (__any((a) < 1.f)) { if (hi == 0) al_l[r32] = (a); asm volatile("s_waitcnt lgkmcnt(0)" ::: "memory"); \
    _Pragma("unroll") for (int d = 0; d < 4; ++d) _Pragma("unroll") for (int r = 0; r < 16; ++r) o[d][r] *= al_l[crow(r, hi)]; } } while (0)
  const int vbb = (int)(ldsb + DV0) + v_rd_base(lane);
  f32x16_t pA0, pA1, pB0, pB1; float mnA, mnB, alA, alB; bf16x8_t pa0, pa1, pa2, pa3; constexpr int NT = SEQ / 64;
  AT_DMA(0, 0, 0); AT_VMWAIT(); __syncthreads();
  AT_DMA(64, 1, 1);
  qkt(pA0, pA1, K_lds, qr, qpe, r32, hi); partialSM(pA0, pA1, m_reg, mnA, alA);
  AT_VMWAIT(); __syncthreads();
  int vprev = 0;
#pragma unroll 1
  for (int j = 1; j + 1 < NT; j += 2) {
    const int v1 = vprev == 2 ? 0 : vprev + 1, v2 = v1 == 2 ? 0 : v1 + 1, v3 = v2 == 2 ? 0 : v2 + 1;
    AT_DMA((j + 1) * 64, 0, v2);
    AT_SBAR(); qkt(pB0, pB1, K_lds + SHM_K, qr, qpe, r32, hi);
    finishSM(pA0, pA1, alA, l_reg, pa0, pa1, pa2, pa3); AT_SBAR();
    pv_d0(o, vbb + vprev * SHM_V, pa0, pa1, pa2, pa3); partialSM(pB0, pB1, m_reg, mnB, alB);
    AT_RESC(alB);
    AT_VMWAIT(); __syncthreads();
    AT_DMA((j + 2) * 64, 1, v3);
    AT_SBAR(); qkt(pA0, pA1, K_lds, qr, qpe, r32, hi);
    finishSM(pB0, pB1, alB, l_reg, pa0, pa1, pa2, pa3); AT_SBAR();
    pv_d0(o, vbb + v1 * SHM_V, pa0, pa1, pa2, pa3); partialSM(pA0, pA1, m_reg, mnA, alA);
    AT_RESC(alA);
    AT_VMWAIT(); __syncthreads();
    vprev = v2;
  }
  {
    const int v1 = vprev == 2 ? 0 : vprev + 1;
    AT_SBAR(); qkt(pB0, pB1, K_lds + SHM_K, qr, qpe, r32, hi);
    finishSM(pA0, pA1, alA, l_reg, pa0, pa1, pa2, pa3); AT_SBAR();
    pv_d0(o, vbb + vprev * SHM_V, pa0, pa1, pa2, pa3); partialSM(pB0, pB1, m_reg, mnB, alB);
    AT_RESC(alB);
    finishSM(pB0, pB1, alB, l_reg, pa0, pa1, pa2, pa3); AT_SBAR();
    pv_d0(o, vbb + v1 * SHM_V, pa0, pa1, pa2, pa3);
  }
  if (hi == 0) li_l[r32] = l_reg;
  asm volatile("s_waitcnt lgkmcnt(0)" ::: "memory");
  float rli[16];
#pragma unroll
  for (int r = 0; r < 16; ++r) rli[r] = __builtin_amdgcn_rcpf(li_l[crow(r, hi)]);
  bf16* Ow = Ob + (size_t)(wid * 32) * 1024 + (hi * 4) * 1024 + r32;
#pragma unroll
  for (int r = 0; r < 16; ++r) {
#pragma unroll
    for (int d0 = 0; d0 < 4; ++d0) Ow[((r & 3) + 8 * (r >> 2)) * 1024 + d0 * 32] = (bf16)f2bf(o[d0][r] * rli[r]); }
#undef AT_DMA
#undef AT_RESC
}

constexpr int SHM_K8 = 64 * 192;
constexpr int EK0 = 0, EV0 = 2 * SHM_K8, EWS = EV0 + 3 * SHM_V;
typedef int v8i32a_t __attribute__((ext_vector_type(8)));
typedef int v4i32a_t __attribute__((ext_vector_type(4)));
__device__ __forceinline__ v8i32a_t cat8a(v4i32a_t a, v4i32a_t b) { return __builtin_shufflevector(a, b, 0, 1, 2, 3, 4, 5, 6, 7); }
__device__ __forceinline__ void qkt8(f32x16_t& p0, f32x16_t& p1, const LAS char* Ks, const v8i32a_t* q8, int r32, int hi) {
#pragma unroll
  for (int r = 0; r < 16; ++r) { p0[r] = 0.f; p1[r] = 0.f; }
  const int f0 = (r32 >> 2) & 3;
#pragma unroll
  for (int ks = 0; ks < 3; ++ks) {
    const int L0 = 4 * ks + 2 * hi;
    const LAS char* ra = Ks + r32 * 192; const LAS char* rb = Ks + (32 + r32) * 192;
    const v8i32a_t ka = cat8a(*(const LAS v4i32a_t*)(ra + ((L0 ^ f0) << 4)), *(const LAS v4i32a_t*)(ra + (((L0 + 1) ^ f0) << 4)));
    const v8i32a_t kb = cat8a(*(const LAS v4i32a_t*)(rb + ((L0 ^ f0) << 4)), *(const LAS v4i32a_t*)(rb + (((L0 + 1) ^ f0) << 4)));
    p0 = __builtin_amdgcn_mfma_scale_f32_32x32x64_f8f6f4(ka, q8[ks], p0, 0, 0, 0, 0x7f7f7f7f, 0, 0x7f7f7f7f);
    p1 = __builtin_amdgcn_mfma_scale_f32_32x32x64_f8f6f4(kb, q8[ks], p1, 0, 0, 0, 0x7f7f7f7f, 0, 0x7f7f7f7f);
  }
}
__device__ __forceinline__ void attn_unit_dma8(int tid, const unsigned char* __restrict__ Q8, const unsigned char* __restrict__ K8, const unsigned char* __restrict__ Kp8,
                                               const bf16* __restrict__ Vb, bf16* __restrict__ Ob, LAS char* lds) {
  const int wid = __builtin_amdgcn_readfirstlane(tid >> 6), lane = tid & 63, r32 = lane & 31, hi = lane >> 5;
  LAS char* K_lds = lds + EK0;
  LAS float* wsx = (LAS float*)(lds + EWS) + wid * 64; LAS float* li_l = wsx; LAS float* al_l = wsx + 32;
  float m_reg = -1e30f, l_reg = 0;
  f32x16_t o[4];
#pragma unroll
  for (int d = 0; d < 4; ++d)
#pragma unroll
    for (int r = 0; r < 16; ++r) o[d][r] = 0.f;
  v8i32a_t q8[3];
  { const unsigned qoff = (unsigned)((wid * 32 + r32) * 1536 + hi * 32);
#pragma unroll
    for (int ks = 0; ks < 3; ++ks) q8[ks] = cat8a(*(const v4i32a_t*)(Q8 + qoff + ks * 64), *(const v4i32a_t*)(Q8 + qoff + ks * 64 + 16)); }
  unsigned ksrc[2]; bool kpe[2]; unsigned vsrc[2];
#pragma unroll
  for (int i = 0; i < 2; ++i) { const int p = (8 * i + wid) * 64 + lane, row = p / 12, chp = p - row * 12, c = chp ^ ((row >> 2) & 3);
    kpe[i] = c >= 8; ksrc[i] = kpe[i] ? (unsigned)(row * 64 + (c - 8) * 16) : (unsigned)(row * 1024 + c * 16); }
#pragma unroll
  for (int i = 0; i < 2; ++i) { const int p = (2 * wid + i) * 64 + lane, sub = p >> 5, kk = (sub >> 2) * 8 + ((p >> 2) & 7), c = (sub & 3) * 32 + (p & 3) * 8;
    const int k = (kk & ~0xC) | ((kk & 4) << 1) | ((kk & 8) >> 1);
    vsrc[i] = (unsigned)(k * 2048 + c); }
  const unsigned ldsb = (unsigned)(size_t)lds;
  const unsigned kdst = ldsb + EK0 + (unsigned)wid * 1024u, vdst = ldsb + EV0 + (unsigned)(2 * wid) * 1024u;
#define AT_DMA8(k0, ks, vs) do { const unsigned tk_ = (unsigned)(k0) * 1024u, tp_ = (unsigned)(k0) * 64u, tv_ = (unsigned)(k0) * 2048u; \
    glds16(kpe[0] ? (const void*)(Kp8 + (tp_ + ksrc[0])) : (const void*)(K8 + (tk_ + ksrc[0])), kdst + (unsigned)(ks) * SHM_K8); \
    if (wid < 4) glds16(kpe[1] ? (const void*)(Kp8 + (tp_ + ksrc[1])) : (const void*)(K8 + (tk_ + ksrc[1])), kdst + (unsigned)(ks) * SHM_K8 + 8192u); \
    _Pragma("unroll") for (int i_ = 0; i_ < 2; ++i_) glds16((const void*)(Vb + (tv_ + vsrc[i_])), vdst + (unsigned)(vs) * SHM_V + i_ * 1024u); } while (0)
#define AT_RESC(a) do { if (__any((a) < 1.f)) { if (hi == 0) al_l[r32] = (a); asm volatile("s_waitcnt lgkmcnt(0)" ::: "memory"); \
    _Pragma("unroll") for (int d = 0; d < 4; ++d) _Pragma("unroll") for (int r = 0; r < 16; ++r) o[d][r] *= al_l[crow(r, hi)]; } } while (0)
  const int vbb = (int)(ldsb + EV0) + v_rd_base(lane);
  f32x16_t pA0, pA1, pB0, pB1; float mnA, mnB, alA, alB; bf16x8_t pa0, pa1, pa2, pa3; constexpr int NT = SEQ / 64;
  AT_DMA8(0, 0, 0); AT_VMWAIT(); __syncthreads();
  AT_DMA8(64, 1, 1);
  qkt8(pA0, pA1, K_lds, q8, r32, hi); partialSM(pA0, pA1, m_reg, mnA, alA);
  AT_VMWAIT(); __syncthreads();
  int vprev = 0;
#pragma unroll 1
  for (int j = 1; j + 1 < NT; j += 2) {
    const int v1 = vprev == 2 ? 0 : vprev + 1, v2 = v1 == 2 ? 0 : v1 + 1, v3 = v2 == 2 ? 0 : v2 + 1;
    AT_DMA8((j + 1) * 64, 0, v2);
    AT_SBAR(); qkt8(pB0, pB1, K_lds + SHM_K8, q8, r32, hi);
    finishSM(pA0, pA1, alA, l_reg, pa0, pa1, pa2, pa3); AT_SBAR();
    pv_d0(o, vbb + vprev * SHM_V, pa0, pa1, pa2, pa3); partialSM(pB0, pB1, m_reg, mnB, alB);
    AT_RESC(alB);
    AT_VMWAIT(); __syncthreads();
    AT_DMA8((j + 2) * 64, 1, v3);
    AT_SBAR(); qkt8(pA0, pA1, K_lds, q8, r32, hi);
    finishSM(pB0, pB1, alB, l_reg, pa0, pa1, pa2, pa3); AT_SBAR();
    pv_d0(o, vbb + v1 * SHM_V, pa0, pa1, pa2, pa3); partialSM(pA0, pA1, m_reg, mnA, alA);
    AT_RESC(alA);
    AT_VMWAIT(); __syncthreads();
    vprev = v2;
  }
  {
    const int v1 = vprev == 2 ? 0 : vprev + 1;
    AT_SBAR(); qkt8(pB0, pB1, K_lds + SHM_K8, q8, r32, hi);
    finishSM(pA0, pA1, alA, l_reg, pa0, pa1, pa2, pa3); AT_SBAR();
    pv_d0(o, vbb + vprev * SHM_V, pa0, pa1, pa2, pa3); partialSM(pB0, pB1, m_reg, mnB, alB);
    AT_RESC(alB);
    finishSM(pB0, pB1, alB, l_reg, pa0, pa1, pa2, pa3); AT_SBAR();
    pv_d0(o, vbb + v1 * SHM_V, pa0, pa1, pa2, pa3);
  }
  if (hi == 0) li_l[r32] = l_reg;
  asm volatile("s_waitcnt lgkmcnt(0)" ::: "memory");
  float rli[16];
#pragma unroll
  for (int r = 0; r < 16; ++r) rli[r] = __builtin_amdgcn_rcpf(li_l[crow(r, hi)]);
  bf16* Ow = Ob + (size_t)(wid * 32) * 1024 + (hi * 4) * 1024 + r32;
#pragma unroll
  for (int r = 0; r < 16; ++r) {
#pragma unroll
    for (int d0 = 0; d0 < 4; ++d0) Ow[((r & 3) + 8 * (r >> 2)) * 1024 + d0 * 32] = (bf16)f2bf(o[d0][r] * rli[r]); }
#undef AT_DMA8
#undef AT_RESC
}

constexpr int SHM_V8 = 128 * 64;
constexpr int FK0 = 0, FV0 = 2 * SHM_K8, FWS = FV0 + 3 * SHM_V8;
constexpr float THRL8 = 8.0f;
__device__ __forceinline__ unsigned pk4f8(float a, float b, float c, float d) { int p = __builtin_amdgcn_cvt_pk_fp8_f32(a, b, 0, false); p = __builtin_amdgcn_cvt_pk_fp8_f32(c, d, p, true); return (unsigned)p; }
__device__ __forceinline__ void partialSM8(f32x16_t& p0, f32x16_t& p1, float& m_reg, float& mn, float& alpha) {
  float pmax = p0[0];
#pragma unroll
  for (int r = 1; r < 16; ++r) pmax = fmaxf(pmax, p0[r]);
#pragma unroll
  for (int r = 0; r < 16; ++r) pmax = fmaxf(pmax, p1[r]);
  { auto rr = __builtin_amdgcn_permlane32_swap(__float_as_uint(pmax), __float_as_uint(pmax), false, false);
    pmax = fmaxf(__uint_as_float(rr[0]), __uint_as_float(rr[1])); }
  if (__builtin_expect(__all(pmax - m_reg <= THRL8), 1)) { mn = m_reg; alpha = 1.f; }
  else { mn = fmaxf(m_reg, pmax); alpha = __builtin_amdgcn_exp2f(m_reg - mn); m_reg = mn; }
#pragma unroll
  for (int r = 0; r < 16; ++r) p0[r] = p0[r] - mn;
#pragma unroll
  for (int r = 0; r < 16; ++r) p1[r] = p1[r] - mn;
#pragma unroll
  for (int r = 0; r < 16; ++r) p0[r] = __builtin_amdgcn_exp2f(p0[r]);
}
__device__ __forceinline__ void finishSM8(f32x16_t& p0, f32x16_t& p1, float alpha, float& l_reg, v8i32a_t& pa) {
#pragma unroll
  for (int r = 0; r < 16; ++r) p1[r] = __builtin_amdgcn_exp2f(p1[r]);
  float ps = 0;
#pragma unroll
  for (int r = 0; r < 16; ++r) ps += p0[r];
#pragma unroll
  for (int r = 0; r < 16; ++r) ps += p1[r];
  { auto rr = __builtin_amdgcn_permlane32_swap(__float_as_uint(ps), __float_as_uint(ps), false, false);
    ps = __uint_as_float(rr[0]) + __uint_as_float(rr[1]); }
  l_reg = l_reg * alpha + ps;
  pa[0] = (int)pk4f8(p0[0], p0[1], p0[2], p0[3]);   pa[1] = (int)pk4f8(p0[4], p0[5], p0[6], p0[7]);
  pa[2] = (int)pk4f8(p0[8], p0[9], p0[10], p0[11]); pa[3] = (int)pk4f8(p0[12], p0[13], p0[14], p0[15]);
  pa[4] = (int)pk4f8(p1[0], p1[1], p1[2], p1[3]);   pa[5] = (int)pk4f8(p1[4], p1[5], p1[6], p1[7]);
  pa[6] = (int)pk4f8(p1[8], p1[9], p1[10], p1[11]); pa[7] = (int)pk4f8(p1[12], p1[13], p1[14], p1[15]);
}
__device__ __forceinline__ void pv8(f32x16_t* o, const LAS char* Vs, v8i32a_t pa, int r32, int hi) {
#pragma unroll
  for (int d0 = 0; d0 < 4; ++d0) {
    const int d = 32 * d0 + r32, f = (d >> 2) & 3;
    const LAS char* rp = Vs + d * 64;
    const v8i32a_t vf = cat8a(*(const LAS v4i32a_t*)(rp + (((2 * hi) ^ f) << 4)), *(const LAS v4i32a_t*)(rp + (((2 * hi + 1) ^ f) << 4)));
    o[d0] = __builtin_amdgcn_mfma_scale_f32_32x32x64_f8f6f4(pa, vf, o[d0], 0, 0, 0, 0x7f7f7f7f, 0, 0x7f7f7f7f);
  }
}
__device__ __forceinline__ void attn_unit_f8(int tid, const unsigned char* __restrict__ Q8, const unsigned char* __restrict__ K8, const unsigned char* __restrict__ Kp8,
                                             const unsigned char* __restrict__ V8T, bf16* __restrict__ Ob, LAS char* lds) {
  const int wid = __builtin_amdgcn_readfirstlane(tid >> 6), lane = tid & 63, r32 = lane & 31, hi = lane >> 5;
  LAS char* K_lds = lds + FK0; LAS char* V_lds = lds + FV0;
  LAS float* wsx = (LAS float*)(lds + FWS) + wid * 64; LAS float* li_l = wsx; LAS float* al_l = wsx + 32;
  float m_reg = -1e30f, l_reg = 0;
  f32x16_t o[4];
#pragma unroll
  for (int d = 0; d < 4; ++d)
#pragma unroll
    for (int r = 0; r < 16; ++r) o[d][r] = 0.f;
  v8i32a_t q8[3];
  { const unsigned qoff = (unsigned)((wid * 32 + r32) * 1536 + hi * 32);
#pragma unroll
    for (int ks = 0; ks < 3; ++ks) q8[ks] = cat8a(*(const v4i32a_t*)(Q8 + qoff + ks * 64), *(const v4i32a_t*)(Q8 + qoff + ks * 64 + 16)); }
  unsigned ksrc[2]; bool kpe[2]; unsigned vsrc;
#pragma unroll
  for (int i = 0; i < 2; ++i) { const int p = (8 * i + wid) * 64 + lane, row = p / 12, chp = p - row * 12, c = chp ^ ((row >> 2) & 3);
    kpe[i] = c >= 8; ksrc[i] = kpe[i] ? (unsigned)(row * 64 + (c - 8) * 16) : (unsigned)(row * 1024 + c * 16); }
  { const int p = wid * 64 + lane, d = p >> 2, c = (p & 3) ^ ((d >> 2) & 3); vsrc = (unsigned)(d * 64 + c * 16); }
  const unsigned ldsb = (unsigned)(size_t)lds;
  const unsigned kdst = ldsb + FK0 + (unsigned)wid * 1024u, vdst = ldsb + FV0 + (unsigned)wid * 1024u;
#define AT_DMAF(k0, ks, vs) do { const unsigned tk_ = (unsigned)(k0) * 1024u, tp_ = (unsigned)(k0) * 64u, tv_ = (unsigned)(k0) * 128u; \
    glds16(kpe[0] ? (const void*)(Kp8 + (tp_ + ksrc[0])) : (const void*)(K8 + (tk_ + ksrc[0])), kdst + (unsigned)(ks) * SHM_K8); \
    if (wid < 4) glds16(kpe[1] ? (const void*)(Kp8 + (tp_ + ksrc[1])) : (const void*)(K8 + (tk_ + ksrc[1])), kdst + (unsigned)(ks) * SHM_K8 + 8192u); \
    glds16((const void*)(V8T + (tv_ + vsrc)), vdst + (unsigned)(vs) * SHM_V8); } while (0)
#define AT_RESC(a) do { if (__any((a) < 1.f)) { if (hi == 0) al_l[r32] = (a); asm volatile("s_waitcnt lgkmcnt(0)" ::: "memory"); \
    _Pragma("unroll") for (int d = 0; d < 4; ++d) _Pragma("unroll") for (int r = 0; r < 16; ++r) o[d][r] *= al_l[crow(r, hi)]; } } while (0)
  f32x16_t pA0, pA1, pB0, pB1; float mnA, mnB, alA, alB; v8i32a_t pa; constexpr int NT = SEQ / 64;
  AT_DMAF(0, 0, 0); AT_VMWAIT(); __syncthreads();
  AT_DMAF(64, 1, 1);
  qkt8(pA0, pA1, K_lds, q8, r32, hi); partialSM8(pA0, pA1, m_reg, mnA, alA);
  AT_VMWAIT(); __syncthreads();
  int vprev = 0;
#pragma unroll 1
  for (int j = 1; j + 1 < NT; j += 2) {
    const int v1 = vprev == 2 ? 0 : vprev + 1, v2 = v1 == 2 ? 0 : v1 + 1, v3 = v2 == 2 ? 0 : v2 + 1;
    AT_DMAF((j + 1) * 64, 0, v2);
    AT_SBAR(); qkt8(pB0, pB1, K_lds + SHM_K8, q8, r32, hi);
    finishSM8(pA0, pA1, alA, l_reg, pa); AT_SBAR();
    pv8(o, V_lds + vprev * SHM_V8, pa, r32, hi); partialSM8(pB0, pB1, m_reg, mnB, alB);
    AT_RESC(alB);
    AT_VMWAIT(); __syncthreads();
    AT_DMAF((j + 2) * 64, 1, v3);
    AT_SBAR(); qkt8(pA0, pA1, K_lds, q8, r32, hi);
    finishSM8(pB0, pB1, alB, l_reg, pa); AT_SBAR();
    pv8(o, V_lds + v1 * SHM_V8, pa, r32, hi); partialSM8(pA0, pA1, m_reg, mnA, alA);
    AT_RESC(alA);
    AT_VMWAIT(); __syncthreads();
    vprev = v2;
  }
  {
    const int v1 = vprev == 2 ? 0 : vprev + 1;
    AT_SBAR(); qkt8(pB0, pB1, K_lds + SHM_K8, q8, r32, hi);
    finishSM8(pA0, pA1, alA, l_reg, pa); AT_SBAR();
    pv8(o, V_lds + vprev * SHM_V8, pa, r32, hi); partialSM8(pB0, pB1, m_reg, mnB, alB);
    AT_RESC(alB);
    finishSM8(pB0, pB1, alB, l_reg, pa); AT_SBAR();
    pv8(o, V_lds + v1 * SHM_V8, pa, r32, hi);
  }
  if (hi == 0) li_l[r32] = l_reg;
  asm volatile("s_waitcnt lgkmcnt(0)" ::: "memory");
  float rli[16];
#pragma unroll
  for (int r = 0; r < 16; ++r) rli[r] = __builtin_amdgcn_rcpf(li_l[crow(r, hi)]);
  bf16* Ow = Ob + (size_t)(wid * 32) * 1024 + (hi * 4) * 1024 + r32;
#pragma unroll
  for (int r = 0; r < 16; ++r) {
#pragma unroll
    for (int d0 = 0; d0 < 4; ++d0) Ow[((r & 3) + 8 * (r >> 2)) * 1024 + d0 * 32] = (bf16)f2bf(o[d0][r] * rli[r]); }
#undef AT_DMAF
#undef AT_RESC
}
}
__device__ __forceinline__ const float* karg(int i) {
  unsigned long long p = (unsigned long long)__builtin_amdgcn_kernarg_segment_ptr();
  asm volatile("" : "+s"(p));
  return ((const float* const __attribute__((address_space(4)))*)p)[i];
}
#define x_in karg(0)
#define C_IN karg(1)
#define positions_f karg(2)
#define ada_w karg(3)
#define ada_b karg(4)
#define norm_mix_g karg(5)
#define norm_ffn_g karg(6)
#define hy_w_in karg(7)
#define hy_b_in karg(8)
#define hy_conv_w karg(9)
#define hy_conv_b karg(10)
#define hy_f_w1 karg(11)
#define hy_f_b1 karg(12)
#define hy_f_w2 karg(13)
#define hy_f_b2 karg(14)
#define hy_f_w3 karg(15)
#define hy_f_freq karg(16)
#define hy_f_bias karg(17)
#define hy_w_out karg(18)
#define hy_b_out karg(19)
#define mla_w_in karg(20)
#define mla_q_norm_g karg(21)
#define mla_w_qb karg(22)
#define mla_kv_norm_g karg(23)
#define mla_w_kvb karg(24)
#define mla_w_out karg(25)
#define moe_w_router karg(26)
#define moe_w_gate karg(27)
#define moe_w_up karg(28)
#define moe_w_down karg(29)
#define final_norm_g karg(30)
#define positions ((const int*)karg(2))
#define XRES ((float*)karg(31))
#define WSB ((unsigned char*)karg(32))
#define MiB ((size_t)1 << 20)
#define WhoT ((bf16*)(WSB + 24 * MiB))
#define WmoT ((bf16*)(WSB + 26 * MiB))
#define Ybf ((bf16*)(WSB + 512 * MiB))
#define ws ((float*)(WSB + 40 * MiB))
#define Wmoe ((bf16*)(WSB + 48 * MiB))
#define WmoeD ((bf16*)((unsigned char*)Wmoe + (size_t)NE * 2048 * 1024))
#define XNb ((bf16*)(WSB + 144 * MiB))
#define XSb ((bf16*)(WSB + 208 * MiB))
#define HIDb ((bf16*)(WSB + 336 * MiB))
#define WinT ((bf16*)(WSB + 28 * MiB))
#define Upre ((bf16*)(WSB + 208 * MiB))
#define UTb ((bf16*)(WSB + 208 * MiB))
#define XBb ((bf16*)(WSB + 400 * MiB))
#define zTb ((bf16*)(WSB + 400 * MiB))
#define ycTb ((bf16*)(WSB + 464 * MiB))
#define KRb ((unsigned char*)(WSB + 560 * MiB))
#define K0b ((float*)(WSB + 568 * MiB))
#define W3Tb ((bf16*)(WSB + 569 * MiB))
#define WaT ((bf16*)(WSB + 34 * MiB))
#define WqbT ((bf16*)(WSB + 35 * MiB))
#define WkvbT ((bf16*)(WSB + 36 * MiB))
#define Abuf ((bf16*)(WSB + 208 * MiB))
#define CQNb ((bf16*)(WSB + 240 * MiB))
#define CKVNb ((bf16*)(WSB + 256 * MiB))
#define KPEb ((bf16*)(WSB + 272 * MiB))
#define ROPEb ((float*)(WSB + 528 * MiB))
#define Qbuf ((bf16*)(WSB + 288 * MiB))
#define KVbuf ((bf16*)(WSB + 384 * MiB))
#define KPE8b ((unsigned char*)(WSB + 276 * MiB))
#define K8nb ((unsigned char*)(WSB + 336 * MiB))
#define V8Tb ((unsigned char*)(WSB + 208 * MiB))
#define idx_id ((int*)(WSB + 10 * MiB))
#define idx_row ((int*)(WSB + 8 * MiB))
#define gsel_row ((float*)(WSB + 9 * MiB))
#define ACT ((size_t)NTOK * DM)
#define mod (ws)
#define aff (mod + 2 * NB * 6 * DM)
#define gsel (aff + (size_t)NB * NE * SEQ)
#define idx ((int*)(gsel + (size_t)NB * NE * CAP))
#define slot_of (idx + (size_t)NB * NE * CAP)
#define RA ((float*)(slot_of + (size_t)NB * NE * SEQ))
#define RF (RA + ACT)
#define RU (RF + 2 * (size_t)SEQ * DM)
#define RC (RU + (size_t)SEQ * 3072)
#define RD (RC + ACT)

__device__ __forceinline__ void vtrans_phase(int tid_in, unsigned char* lds_, const bf16* KV, unsigned char* V8T) {
  const int tid = launder(tid_in);
  LAS unsigned char* tile = (LAS unsigned char*)lds_;
  const int key = tid & 63, dg = tid >> 6;
  const int a_ = key >> 5, k5 = key & 31, hi_ = (k5 >> 2) & 1, r_ = (k5 & 3) | ((k5 >> 3) << 2), pos = 32 * hi_ + 16 * a_ + r_;
  constexpr int NITEM = NB * 8 * (SEQ / 64);
  v4u ra[2], na[2];
  { const int item = bid(), t = item & 63, bh = item >> 6, b = bh >> 3, h = bh & 7;
    const bf16* src = KV + (size_t)(b * SEQ + t * 64 + key) * 2048 + h * 256 + 128 + dg * 16;
    ra[0] = *(const v4u*)src; ra[1] = *(const v4u*)(src + 8); }
  for (int item = bid(); item < NITEM; item += GRID) {
    { const int nitem = item + GRID < NITEM ? item + GRID : item, t = nitem & 63, bh = nitem >> 6, b = bh >> 3, h = bh & 7;
      const bf16* src = KV + (size_t)(b * SEQ + t * 64 + key) * 2048 + h * 256 + 128 + dg * 16;
      na[0] = *(const v4u*)src; na[1] = *(const v4u*)(src + 8); }
    float v[16];
    unpack8(ra[0], v); unpack8(ra[1], v + 8);
    __syncthreads();
#pragma unroll
    for (int q = 0; q < 4; ++q) { const unsigned w = pg8::pack4_fp8(v[4 * q], v[4 * q + 1], v[4 * q + 2], v[4 * q + 3]);
#pragma unroll
      for (int e = 0; e < 4; ++e) tile[(dg * 16 + 4 * q + e) * 80 + pos] = (unsigned char)(w >> (8 * e)); }
    __syncthreads();
    const int d = tid >> 2, c = tid & 3;
    const v4u o = *(const LAS v4u*)(tile + d * 80 + c * 16);
    *(v4u*)(V8T + (size_t)item * 8192 + d * 64 + c * 16) = o;
    ra[0] = na[0]; ra[1] = na[1];
  }
}
__device__ __forceinline__ void attn_phase(int tid_in, unsigned char* lds_) {
  const int tid = launder(tid_in);
  const int c = bid(), x = c & 7, s_ = c >> 3;
#pragma unroll 1
  for (int i = 0; i < 4; ++i) {
    const int bh = i * 16 + x * 2 + (s_ >> 4), qb = s_ & 15, b = bh >> 3, h = bh & 7;
    __syncthreads();
    att::attn_unit_f8(launder(tid), (const unsigned char*)Qbuf + (size_t)(b * SEQ + qb * 256) * 1536 + h * 192, K8nb + (size_t)(b * SEQ) * 1024 + h * 128, KPE8b + (size_t)(b * SEQ) * 64,
                      V8Tb + (size_t)bh * (64 * 8192), Ybf + (size_t)(b * SEQ + qb * 256) * 1024 + h * 128, (LAS char*)lds_);
  }
}
#define MODL (mod + (size_t)layer * NB * 6 * DM)
#define sh1 (MODL)
#define sc1 (MODL + DM)
#define g1 (MODL + 2 * DM)
#define sh2 (MODL + 3 * DM)
#define sc2 (MODL + 4 * DM)
#define g2 (MODL + 5 * DM)
constexpr int MOE_TA = 19456;
constexpr int MOE_TB = 18432;
__global__ void __launch_bounds__(NTHR, 2) fwd_megakernel(Args args) {
  extern __shared__ __attribute__((aligned(16))) unsigned char lds[];
  const int tid = threadIdx.x;
  volatile LAS unsigned* misc = (volatile LAS unsigned*)((LAS unsigned char*)lds + (LDS_BYTES - 256));
  if (tid < 64) misc[tid] = 0u;
  __syncthreads();
  unsigned* ctl = (unsigned*)WSB;
  (void)xcd_barrier_post(ctl + 4096, misc + 8);

  mod_phase(tid, lds, C_IN, ada_w, ada_b, mod);
  {
    const int wave = __builtin_amdgcn_readfirstlane(tid >> 6), lane = tid & 63;
    LAS float* scr = (LAS float*)((LAS unsigned char*)lds + wave * 16384);
    const int gw = bid() * 8 + wave, NGW = GRID * 8;
    constexpr int I_O = (DM / 64) * (DM / 32);
    constexpr int I_IN = (DM / 64) * (3072 / 32);
    for (int it = gw; it < 2 * I_O + I_IN; it += NGW) {
      if (it < I_O) transpose_item<0>(hy_w_out, DM, DM, WhoT, 0, scr, it, lane);
      else if (it < 2 * I_O) transpose_item<0>(mla_w_out, DM, DM, WmoT, 0, scr, it - I_O, lane);
      else transpose_item<0>(hy_w_in, DM, 3072, WinT, 0, scr, it - 2 * I_O, lane);
    }
    constexpr int I_A = (DM / 64) * (448 / 32), I_Q = (256 / 64) * (1536 / 32);
    for (int it = gw; it < I_A + I_Q; it += NGW) {
      if (it < I_A) transpose_item<2>(mla_w_in, DM, 448, WaT, 0, scr, it, lane);
      else if (it < I_A + I_Q) transpose_item<3>(mla_w_qb, 256, 1536, WqbT, 0, scr, it - I_A, lane);
    }
    {
      const int gt = bid() * NTHR + launder(tid), NGT = GRID * NTHR;
      for (int q = gt; q < NTOK * 32; q += NGT) {
        const int row = q >> 5, i = q & 31;
        const float ci = __builtin_amdgcn_exp2f(-(float)(2 * i) * (13.287712379549449f / 64.0f)) * 0.15915494309189535f, p = (float)positions[row];
        const float fr = fmaf(p, ci, -rintf(p * ci));
        const float sn = __builtin_amdgcn_sinf(fr), cs = __builtin_amdgcn_cosf(fr);
        *(float2*)(ROPEb + (size_t)row * 64 + 2 * i) = make_float2(cs, sn);
      }
    }
    { const int gt = bid() * NTHR + launder(tid); for (int q = gt; q < NE * NB * CAP; q += GRID * NTHR) idx_id[q] = q; }
    {
      const int gt = bid() * NTHR + launder(tid);
      for (int q = gt; q < 2048 * 16; q += GRID * NTHR) {
        const int n = q & 2047, k0 = (q >> 11) * 8, hh = n >> 8, wi = n & 255;
        float w[8];
#pragma unroll
        for (int e = 0; e < 8; ++e) w[e] = mla_w_kvb[(size_t)(k0 + e) * 2048 + n];
        v4u o; o.x = pk2(w[0], w[1]); o.y = pk2(w[2], w[3]); o.z = pk2(w[4], w[5]); o.w = pk2(w[6], w[7]);
        *(v4u*)(WkvbT + (size_t)((wi < 128 ? 0 : 1024) + hh * 128 + (wi & 127)) * 128 + k0) = o;
      }
    }
    {
      const int gt = bid() * NTHR + launder(tid);
      for (int q = gt; q < 2048 * 8; q += GRID * NTHR) {
        const int col = q & 2047, j0 = (q >> 11) * 8;
        float w[8];
#pragma unroll
        for (int e = 0; e < 8; ++e) w[e] = hy_f_w3[(size_t)(j0 + e) * 2048 + col];
        v4u o; o.x = pk2(w[0], w[1]); o.y = pk2(w[2], w[3]); o.z = pk2(w[4], w[5]); o.w = pk2(w[6], w[7]);
        *(v4u*)(W3Tb + (size_t)col * 64 + j0) = o;
      }
    }
    {
      const int gt = bid() * NTHR + launder(tid), NGT = GRID * NTHR;
      for (int q = gt; q < 64 * 1024 / 8; q += NGT) *(v4u*)(WaT + (size_t)448 * 1024 + (size_t)q * 8) = (v4u){0u, 0u, 0u, 0u};
    }
  }
  GB();

  {
    constexpr int layer = 0;
      norm_rows_phase<false>(tid, lds, x_in, norm_mix_g, sh1, sc1, XNb, nullptr, nullptr);
      filter_phase(tid, lds, hy_f_w1, hy_f_b1, hy_f_w2, hy_f_b2, W3Tb, hy_f_freq, hy_f_bias, KRb, K0b);
      GB();
      {
        pg8::Gemm g{WinT, XNb, 3 * DM, NTOK, DM}; pg8::StaticOrder S; S.init(3 * DM, NTOK, GRID, bid());
        pg8::EpiBf16BiasT E{UTb, NTOK, hy_b_in};
        pg8::gemm_phase<pg8::EpiBf16BiasT, pg8::StaticOrder, true, true>((LAS unsigned char*)lds, g, S, E);
      }
      GB();
      longconv_phase(tid, lds, UTb, hy_conv_w, hy_conv_b, KRb, ycTb);
      GB();
      {
        pg8::Gemm g{ycTb, WhoT, NTOK, DM, DM}; pg8::StaticOrder S; S.init(NTOK, DM, GRID, bid());
        pg8::EpiResidT<false, true> E{x_in, XBb, hy_b_out, g1};
        pg8::gemm_phase<pg8::EpiResidT<false, true>, pg8::StaticOrder, true, true, false, true>((LAS unsigned char*)lds, g, S, E);
      }
      GB();
    {
      const int wave = __builtin_amdgcn_readfirstlane(launder(tid) >> 6), lane = launder(tid) & 63;
      LAS float* scr = (LAS float*)((LAS unsigned char*)lds + wave * 16384);
      const int gw = bid() * 8 + wave, NGW = GRID * 8;
      constexpr int I_W = (DM / 64) * (DM / 32);
      const size_t WSZ = (size_t)DM * DM;
      __syncthreads();
      for (int it = gw; it < MOE_TB; it += NGW) {
        const int e = it / (3 * I_W), r = it - e * 3 * I_W, which = r / I_W, item = r - which * I_W;
        if (which == 0) transpose_item_fp8<1>(moe_w_gate + ((size_t)layer * NE + e) * WSZ, DM, DM, (unsigned char*)Wmoe, e * 2048, scr, item, lane);
        else if (which == 1) transpose_item_fp8<1>(moe_w_up + ((size_t)layer * NE + e) * WSZ, DM, DM, (unsigned char*)Wmoe, e * 2048 + 128, scr, item, lane);
        else transpose_item_fp8<0>(moe_w_down + ((size_t)layer * NE + e) * WSZ, DM, DM, (unsigned char*)WmoeD, e * 1024, scr, item, lane);
      }
      __syncthreads();
    }
    norm_router_phase(tid, lds, XBb, norm_ffn_g + layer * DM, sh2, sc2, (unsigned char*)XNb, moe_w_router + (size_t)layer * DM * NE, aff);
    GB();
    if (bid() < NB * NE) {
      topk_phase(tid, lds, aff, idx_row, gsel_row, slot_of);
      {
        const int wave = __builtin_amdgcn_readfirstlane(launder(tid) >> 6), lane = launder(tid) & 63;
        LAS float* scr = (LAS float*)((LAS unsigned char*)lds + wave * 16384);
        constexpr int I_W = (DM / 64) * (DM / 32);
        const size_t WSZ = (size_t)DM * DM;
        __syncthreads();
        const int it = MOE_TB + bid() * 8 + wave;
        const int e = it / (3 * I_W), r = it - e * 3 * I_W, which = r / I_W, item = r - which * I_W;
        if (which == 0) transpose_item_fp8<1>(moe_w_gate + ((size_t)layer * NE + e) * WSZ, DM, DM, (unsigned char*)Wmoe, e * 2048, scr, item, lane);
        else if (which == 1) transpose_item_fp8<1>(moe_w_up + ((size_t)layer * NE + e) * WSZ, DM, DM, (unsigned char*)Wmoe, e * 2048 + 128, scr, item, lane);
        else transpose_item_fp8<0>(moe_w_down + ((size_t)layer * NE + e) * WSZ, DM, DM, (unsigned char*)WmoeD, e * 1024, scr, item, lane);
        __syncthreads();
      }
    } else {
      const int wave = __builtin_amdgcn_readfirstlane(launder(tid) >> 6), lane = launder(tid) & 63;
      LAS float* scr = (LAS float*)((LAS unsigned char*)lds + wave * 16384);
      constexpr int I_W = (DM / 64) * (DM / 32);
      const size_t WSZ = (size_t)DM * DM;
      __syncthreads();
      for (int it = MOE_TA + (bid() - NB * NE) * 8 + wave; it < NE * 3 * I_W; it += (GRID - NB * NE) * 8) {
        const int e = it / (3 * I_W), r = it - e * 3 * I_W, which = r / I_W, item = r - which * I_W;
        if (which == 0) transpose_item_fp8<1>(moe_w_gate + ((size_t)layer * NE + e) * WSZ, DM, DM, (unsigned char*)Wmoe, e * 2048, scr, item, lane);
        else if (which == 1) transpose_item_fp8<1>(moe_w_up + ((size_t)layer * NE + e) * WSZ, DM, DM, (unsigned char*)Wmoe, e * 2048 + 128, scr, item, lane);
        else transpose_item_fp8<0>(moe_w_down + ((size_t)layer * NE + e) * WSZ, DM, DM, (unsigned char*)WmoeD, e * 1024, scr, item, lane);
      }
      __syncthreads();
    }
    GB();
    {
      pg8::Gemm g{XNb, Wmoe, NE * NB * CAP, NE * 2048, DM / 2}; pg8::MoeOrder1 S{bid()};
      pg8::EpiSwiGLU E{HIDb, 1.0f, 1.0f / 32.0f};
      pg8::gemm_phase_gather<pg8::EpiSwiGLU, pg8::MoeOrder1, true>((LAS unsigned char*)lds, g, idx_row, S, E);
    }
    GB();
    {
      pg8::Gemm g{HIDb, WmoeD, NE * NB * CAP, NE * 1024, DM / 2}; pg8::MoeOrder2 S{bid()};
      pg8::EpiRowScale E{XSb, gsel_row};
      pg8::gemm_phase_gather<pg8::EpiRowScale, pg8::MoeOrder2, true, DM / 2>((LAS unsigned char*)lds, g, idx_id, S, E);
    }
    GB();
    combine_norm_phase<false>(tid, XBb, nullptr, XSb, slot_of, g2, norm_mix_g + DM, mod + (size_t)NB * 6 * DM, mod + (size_t)NB * 6 * DM + DM, XNb);
    GB();
  }
  {
    constexpr int layer = 1;
      {
        pg8::Gemm g{XNb, WaT, NTOK, 512, DM}; pg8::StaticOrder S; S.init(NTOK, 512, GRID, bid());
        EpiMlaPrep E{mla_q_norm_g, mla_kv_norm_g, CQNb, CKVNb, KPEb, KPE8b, ROPEb};
        pg8::gemm_phase<EpiMlaPrep, pg8::StaticOrder, true, true>((LAS unsigned char*)lds, g, S, E);
      }
      GB();
      {
        pg8::Gemm g{CQNb, WqbT, NTOK, 1536, 256}; pg8::StaticOrder S; S.init(NTOK, 1536, GRID, bid());
        pg8::EpiQRope E{Qbuf, ROPEb, 0.07216878364870323f * 1.4426950408889634f};
        pg8::gemm_phase<pg8::EpiQRope, pg8::StaticOrder, true, false>((LAS unsigned char*)lds, g, S, E);
      }
      {
        pg8::Gemm g{CKVNb, WkvbT, NTOK, 1024, 128}; pg8::StaticOrder S; S.init(NTOK, 1024, GRID, bid());
        pg8::EpiK8 E{K8nb};
        pg8::gemm_phase<pg8::EpiK8, pg8::StaticOrder, true, true>((LAS unsigned char*)lds, g, S, E);
      }
      {
        pg8::Gemm g{WkvbT + (size_t)1024 * 128, CKVNb, 1024, NTOK, 128}; pg8::StaticOrder S; S.init(1024, NTOK, GRID, bid());
        pg8::EpiVT E{V8Tb};
        pg8::gemm_phase<pg8::EpiVT, pg8::StaticOrder, true, true>((LAS unsigned char*)lds, g, S, E);
      }
      GB();
      attn_phase(tid, lds);
      GB();
      {
        pg8::Gemm g{Ybf, WmoT, NTOK, DM, DM}; pg8::StaticOrder S; S.init(NTOK, DM, GRID, bid());
        pg8::EpiResidT<true, true> E{XBb, XBb, nullptr, g1};
        pg8::gemm_phase<pg8::EpiResidT<true, true>, pg8::StaticOrder, true, true>((LAS unsigned char*)lds, g, S, E);
      }
      GB();
    {
      const int wave = __builtin_amdgcn_readfirstlane(launder(tid) >> 6), lane = launder(tid) & 63;
      LAS float* scr = (LAS float*)((LAS unsigned char*)lds + wave * 16384);
      const int gw = bid() * 8 + wave, NGW = GRID * 8;
      constexpr int I_W = (DM / 64) * (DM / 32);
      const size_t WSZ = (size_t)DM * DM;
      __syncthreads();
      for (int it = gw; it < MOE_TB; it += NGW) {
        const int e = it / (3 * I_W), r = it - e * 3 * I_W, which = r / I_W, item = r - which * I_W;
        if (which == 0) transpose_item_fp8<1>(moe_w_gate + ((size_t)layer * NE + e) * WSZ, DM, DM, (unsigned char*)Wmoe, e * 2048, scr, item, lane);
        else if (which == 1) transpose_item_fp8<1>(moe_w_up + ((size_t)layer * NE + e) * WSZ, DM, DM, (unsigned char*)Wmoe, e * 2048 + 128, scr, item, lane);
        else transpose_item_fp8<0>(moe_w_down + ((size_t)layer * NE + e) * WSZ, DM, DM, (unsigned char*)WmoeD, e * 1024, scr, item, lane);
      }
      __syncthreads();
    }
    norm_router_phase(tid, lds, XBb, norm_ffn_g + layer * DM, sh2, sc2, (unsigned char*)XNb, moe_w_router + (size_t)layer * DM * NE, aff);
    GB();
    if (bid() < NB * NE) {
      topk_phase(tid, lds, aff, idx_row, gsel_row, slot_of);
      {
        const int wave = __builtin_amdgcn_readfirstlane(launder(tid) >> 6), lane = launder(tid) & 63;
        LAS float* scr = (LAS float*)((LAS unsigned char*)lds + wave * 16384);
        constexpr int I_W = (DM / 64) * (DM / 32);
        const size_t WSZ = (size_t)DM * DM;
        __syncthreads();
        const int it = MOE_TB + bid() * 8 + wave;
        const int e = it / (3 * I_W), r = it - e * 3 * I_W, which = r / I_W, item = r - which * I_W;
        if (which == 0) transpose_item_fp8<1>(moe_w_gate + ((size_t)layer * NE + e) * WSZ, DM, DM, (unsigned char*)Wmoe, e * 2048, scr, item, lane);
        else if (which == 1) transpose_item_fp8<1>(moe_w_up + ((size_t)layer * NE + e) * WSZ, DM, DM, (unsigned char*)Wmoe, e * 2048 + 128, scr, item, lane);
        else transpose_item_fp8<0>(moe_w_down + ((size_t)layer * NE + e) * WSZ, DM, DM, (unsigned char*)WmoeD, e * 1024, scr, item, lane);
        __syncthreads();
      }
    } else {
      const int wave = __builtin_amdgcn_readfirstlane(launder(tid) >> 6), lane = launder(tid) & 63;
      LAS float* scr = (LAS float*)((LAS unsigned char*)lds + wave * 16384);
      constexpr int I_W = (DM / 64) * (DM / 32);
      const size_t WSZ = (size_t)DM * DM;
      __syncthreads();
      for (int it = MOE_TA + (bid() - NB * NE) * 8 + wave; it < NE * 3 * I_W; it += (GRID - NB * NE) * 8) {
        const int e = it / (3 * I_W), r = it - e * 3 * I_W, which = r / I_W, item = r - which * I_W;
        if (which == 0) transpose_item_fp8<1>(moe_w_gate + ((size_t)layer * NE + e) * WSZ, DM, DM, (unsigned char*)Wmoe, e * 2048, scr, item, lane);
        else if (which == 1) transpose_item_fp8<1>(moe_w_up + ((size_t)layer * NE + e) * WSZ, DM, DM, (unsigned char*)Wmoe, e * 2048 + 128, scr, item, lane);
        else transpose_item_fp8<0>(moe_w_down + ((size_t)layer * NE + e) * WSZ, DM, DM, (unsigned char*)WmoeD, e * 1024, scr, item, lane);
      }
      __syncthreads();
    }
    GB();
    {
      pg8::Gemm g{XNb, Wmoe, NE * NB * CAP, NE * 2048, DM / 2}; pg8::MoeOrder1 S{bid()};
      pg8::EpiSwiGLU E{HIDb, 1.0f, 1.0f / 32.0f};
      pg8::gemm_phase_gather<pg8::EpiSwiGLU, pg8::MoeOrder1, true>((LAS unsigned char*)lds, g, idx_row, S, E);
    }
    GB();
    {
      pg8::Gemm g{HIDb, WmoeD, NE * NB * CAP, NE * 1024, DM / 2}; pg8::MoeOrder2 S{bid()};
      pg8::EpiRowScale E{XSb, gsel_row};
      pg8::gemm_phase_gather<pg8::EpiRowScale, pg8::MoeOrder2, true, DM / 2>((LAS unsigned char*)lds, g, idx_id, S, E);
    }
    GB();
    combine_norm_phase<true>(tid, XBb, XRES, XSb, slot_of, g2, final_norm_g, nullptr, nullptr, nullptr);
  }
}

#undef x_in
#undef C_IN
#undef positions_f
#undef ada_w
#undef ada_b
#undef norm_mix_g
#undef norm_ffn_g
#undef hy_w_in
#undef hy_b_in
#undef hy_conv_w
#undef hy_conv_b
#undef hy_f_w1
#undef hy_f_b1
#undef hy_f_w2
#undef hy_f_b2
#undef hy_f_w3
#undef hy_f_freq
#undef hy_f_bias
#undef hy_w_out
#undef hy_b_out
#undef mla_w_in
#undef mla_q_norm_g
#undef mla_w_qb
#undef mla_kv_norm_g
#undef mla_w_kvb
#undef mla_w_out
#undef moe_w_router
#undef moe_w_gate
#undef moe_w_up
#undef moe_w_down
#undef final_norm_g
#undef positions
#undef XRES
#undef WSB
#undef MiB
#undef WhoT
#undef WmoT
#undef Ybf
#undef ws
#undef ACT
#undef mod
#undef aff
#undef gsel
#undef idx
#undef slot_of
#undef RA
#undef RF
#undef RU
#undef RC
#undef RD
#undef V8Tb
#undef K8nb
#undef KPE8b
#undef idx_id
#undef g2
#undef sc2
#undef sh2
#undef g1
#undef sc1
#undef sh1
#undef MODL
#undef KVbuf
#undef Qbuf
#undef ROPEb
#undef KPEb
#undef CKVNb
#undef CQNb
#undef Abuf
#undef WkvbT
#undef WqbT
#undef WaT
#undef KRb
#undef K0b
#undef W3Tb
#undef ycTb
#undef zTb
#undef XBb
#undef Upre
#undef UTb
#undef WinT
#undef gsel_row
#undef idx_row
#undef HIDb
#undef XSb
#undef XNb
#undef WmoeD
#undef Wmoe
extern "C" void kernel_launch(void* const* d_in, const int* in_sizes, int n_in, void* d_out, int out_size,
                              void* d_ws, size_t ws_size, hipStream_t stream) {
  static int grid = 0;
  if (grid == 0) {
    int dev = 0, cus = 0;
    if (hipGetDevice(&dev) != hipSuccess ||
        hipDeviceGetAttribute(&cus, hipDeviceAttributeMultiprocessorCount, dev) != hipSuccess) { grid = -1; return; }
    if (hipFuncSetAttribute((const void*)fwd_megakernel, hipFuncAttributeMaxDynamicSharedMemorySize, LDS_BYTES) != hipSuccess) {
      fprintf(stderr, "hipFuncSetAttribute failed\n"); grid = -1; return;
    }
    int per_cu = 0;
    (void)hipOccupancyMaxActiveBlocksPerMultiprocessor(&per_cu, (const void*)fwd_megakernel, NTHR, LDS_BYTES);
    (void)hipGetLastError();
    if (per_cu < 1) fprintf(stderr, "occupancy query says %d blocks/CU\n", per_cu);
    if (ws_size < (size_t)576 * 1024 * 1024) { fprintf(stderr, "kernel_launch: workspace too small: %zu bytes (needs 576 MiB); nothing launched\n", ws_size); grid = -1; return; }
    if (cus != GRID) fprintf(stderr, "device has %d CUs, kernel built for %d\n", cus, GRID);
    grid = GRID;
  }
  if (grid < 0) return;
  (void)in_sizes; (void)n_in; (void)out_size;
  (void)hipMemsetAsync(d_ws, 0, 1u << 20, stream);
  Args a;
  memset(&a, 0, sizeof(a));
  for (int i = 0; i < 31; ++i) a.in[i] = (const float*)d_in[i];
  a.out = (float*)d_out;
  a.ws = (unsigned char*)d_ws;
  hipLaunchKernelGGL(fwd_megakernel, dim3(grid), dim3(NTHR), LDS_BYTES, stream, a);
}
```
